# Optimizing an MI355X kernel written in HIP

```python
import jax, jax.numpy as jnp
from jax import lax
import numpy as np

D_MODEL = 1024
BATCH = 8
SEQ = 4096
DEPTH = 1

HEAD_DIM = 64
DILATED_GROUPS = ((128, 1), (512, 4), (2048, 16))
N_GROUPS = 3
HEADS_PER_GROUP = 8
ATTN_HEADS = N_GROUPS * HEADS_PER_GROUP
ATTN_QKV_WIDTH = ATTN_HEADS * HEAD_DIM
ATTN_WIDTH = HEADS_PER_GROUP * HEAD_DIM
CONV_WIDTH = D_MODEL // 2
CONV_KERNEL = 31
N_BRANCHES = 2
NORM_EPS = 1e-6
SPLITS = (ATTN_QKV_WIDTH, ATTN_QKV_WIDTH, ATTN_QKV_WIDTH, ATTN_WIDTH, 2 * CONV_WIDTH, CONV_WIDTH, N_BRANCHES * D_MODEL)
IN_WIDTH = 1536 * 3 + 512 + 1024 + 512 + 2048

kernel_name = "hybrid_dilated_attn_conformer_gated_merge"


def rms_norm(x, w):
    xf = x.astype(jnp.float32)
    y = xf * lax.rsqrt(jnp.mean(xf * xf, axis=-1, keepdims=True) + NORM_EPS)
    return (y * w.astype(jnp.float32)).astype(x.dtype)


def layer_norm(x, w, b):
    xf = x.astype(jnp.float32)
    mu = jnp.mean(xf, axis=-1, keepdims=True)
    var = jnp.mean(jnp.square(xf - mu), axis=-1, keepdims=True)
    y = (xf - mu) * lax.rsqrt(var + NORM_EPS)
    return (y * w.astype(jnp.float32) + b.astype(jnp.float32)).astype(x.dtype)


def dilated_window_attention(q, k, v, window, dilation):
    B, S, H, Dh = q.shape
    d = dilation
    n = window // dilation
    L = S // d
    nb = -(-L // n)
    Lp = nb * n

    def to_sub(t):
        t = t.reshape(B, L, d, H, Dh).transpose(0, 2, 1, 3, 4).reshape(B * d, L, H, Dh)
        return jnp.pad(t, ((0, 0), (0, Lp - L), (0, 0), (0, 0)))

    qs, ks, vs = to_sub(q), to_sub(k), to_sub(v)
    BD = B * d
    qb = qs.reshape(BD, nb, n, H, Dh)

    def band(t):
        tp = jnp.pad(t, ((0, 0), (n, 0), (0, 0), (0, 0))).reshape(BD, nb + 1, n, H, Dh)
        return jnp.concatenate([tp[:, :-1], tp[:, 1:]], axis=2)

    kb, vb = band(ks), band(vs)
    s = jnp.einsum('bnqhd,bnkhd->bnhqk', qb, kb).astype(jnp.float32)
    blk = jnp.arange(nb)[:, None, None]
    qi = jnp.arange(n)[None, :, None]
    kj = jnp.arange(2 * n)[None, None, :]
    dist = qi + n - kj
    valid = (dist >= 0) & (dist <= n) & (blk * n - n + kj >= 0)
    s = jnp.where(valid[None, :, None], s, -jnp.inf)
    m = jnp.max(s, axis=-1, keepdims=True)
    p = jnp.exp(s - m)
    denom = jnp.sum(p, axis=-1, keepdims=True)
    o = jnp.einsum('bnhqk,bnkhd->bnqhd', p, vb.astype(jnp.float32))
    o = o / denom.transpose(0, 1, 3, 2, 4)
    lse = (m + jnp.log(denom))[..., 0].transpose(0, 1, 3, 2)

    def from_sub(t):
        rest = t.shape[3:]
        t = t.reshape((B, d, Lp) + rest)[:, :, :L]
        t = jnp.moveaxis(t, 1, 2)
        return t.reshape((B, S) + rest)

    return from_sub(o), from_sub(lse)


def depthwise_causal_conv(u, w, b):
    C = u.shape[-1]
    y = lax.conv_general_dilated(u, w.astype(u.dtype)[:, None, :], window_strides=(1,),
                                 padding=((CONV_KERNEL - 1, 0),),
                                 dimension_numbers=('NWC', 'WIO', 'NWC'),
                                 feature_group_count=C)
    return y + b.astype(u.dtype)


def hybrid_layer(x, c, w_ada, b_ada, norm_w, w_in, b_gate, q_norm_w, k_norm_w,
                 w_attn_proj, conv_w, conv_b, conv_ln_w, conv_ln_b, w_conv_proj, w_out):
    B, S, D = x.shape
    ada = jax.nn.silu(c) @ w_ada + b_ada
    shift, scale, gate = jnp.split(ada, 3, axis=-1)
    h = rms_norm(x, norm_w) * (1 + scale[:, None, :]) + shift[:, None, :]

    proj = h @ w_in
    offsets = tuple(int(o) for o in np.cumsum(SPLITS)[:-1])
    q, k, v, z_attn, u_conv, z_conv, g = jnp.split(proj, offsets, axis=-1)

    q = rms_norm(q.reshape(B, S, N_GROUPS, HEADS_PER_GROUP, HEAD_DIM), q_norm_w) * (HEAD_DIM ** -0.5)
    k = rms_norm(k.reshape(B, S, N_GROUPS, HEADS_PER_GROUP, HEAD_DIM), k_norm_w)
    v = v.reshape(B, S, N_GROUPS, HEADS_PER_GROUP, HEAD_DIM)
    outs, lses = [], []
    for gi, (window, dilation) in enumerate(DILATED_GROUPS):
        o, lse = dilated_window_attention(q[:, :, gi], k[:, :, gi], v[:, :, gi], window, dilation)
        outs.append(o)
        lses.append(lse)
    o_all = jnp.stack(outs, axis=0)
    wts = jax.nn.softmax(jnp.stack(lses, axis=0), axis=0)
    attn = jnp.sum(wts[..., None] * o_all, axis=0).reshape(B, S, ATTN_WIDTH).astype(x.dtype)
    y_attn = (attn * jax.nn.silu(z_attn)) @ w_attn_proj

    a_half, b_half = jnp.split(u_conv, 2, axis=-1)
    glu = a_half * jax.nn.sigmoid(b_half)
    cv = depthwise_causal_conv(glu, conv_w, conv_b)
    cv = jax.nn.silu(layer_norm(cv, conv_ln_w, conv_ln_b))
    y_conv = (cv * jax.nn.silu(z_conv)) @ w_conv_proj

    g_attn, g_conv = jnp.split(g + b_gate, 2, axis=-1)
    merged = jax.nn.sigmoid(g_attn) * y_attn + jax.nn.sigmoid(g_conv) * y_conv
    return x + gate[:, None, :] * (merged @ w_out)


def setup_inputs(seed: int = 0) -> dict:
    key = jax.random.key(seed)
    ks = jax.random.split(key, 18)
    f32 = jnp.float32

    def nrm(k, shape, scale):
        return jax.random.normal(k, shape, f32) * scale

    return {
        "x": nrm(ks[0], (BATCH, SEQ, D_MODEL), 1.0),
        "c": nrm(ks[1], (BATCH, D_MODEL), 1.0),
        "w_ada": nrm(ks[2], (DEPTH, D_MODEL, 3 * D_MODEL), D_MODEL ** -0.5),
        "b_ada": nrm(ks[3], (DEPTH, 3 * D_MODEL), 0.02),
        "norm_w": 1.0 + nrm(ks[4], (DEPTH, D_MODEL), 0.02),
        "w_in": nrm(ks[5], (DEPTH, D_MODEL, IN_WIDTH), D_MODEL ** -0.5),
        "b_gate": nrm(ks[6], (DEPTH, N_BRANCHES * D_MODEL), 0.02),
        "q_norm_w": 1.0 + nrm(ks[7], (DEPTH, HEAD_DIM), 0.02),
        "k_norm_w": 1.0 + nrm(ks[8], (DEPTH, HEAD_DIM), 0.02),
        "w_attn_proj": nrm(ks[9], (DEPTH, ATTN_WIDTH, D_MODEL), ATTN_WIDTH ** -0.5),
        "conv_w": nrm(ks[10], (DEPTH, CONV_KERNEL, CONV_WIDTH), CONV_KERNEL ** -0.5),
        "conv_b": nrm(ks[11], (DEPTH, CONV_WIDTH), 0.02),
        "conv_ln_w": 1.0 + nrm(ks[12], (DEPTH, CONV_WIDTH), 0.02),
        "conv_ln_b": nrm(ks[13], (DEPTH, CONV_WIDTH), 0.02),
        "w_conv_proj": nrm(ks[14], (DEPTH, CONV_WIDTH, D_MODEL), CONV_WIDTH ** -0.5),
        "w_out": nrm(ks[15], (DEPTH, D_MODEL, D_MODEL), D_MODEL ** -0.5),
    }


def reference(x, c, w_ada, b_ada, norm_w, w_in, b_gate, q_norm_w, k_norm_w,
              w_attn_proj, conv_w, conv_b, conv_ln_w, conv_ln_b, w_conv_proj, w_out):
    for l in range(DEPTH):
        x = hybrid_layer(x, c, w_ada[l], b_ada[l], norm_w[l], w_in[l], b_gate[l],
                         q_norm_w[l], k_norm_w[l], w_attn_proj[l], conv_w[l], conv_b[l],
                         conv_ln_w[l], conv_ln_b[l], w_conv_proj[l], w_out[l])
    return x
```

```cpp
#include <hip/hip_runtime.h>
#include <cstdio>
#include <cstdint>

namespace pg8 {
#define PG8_LAS __attribute__((address_space(3)))
typedef unsigned short bf16_t;
typedef short bf16x8 __attribute__((ext_vector_type(8)));
typedef float f32x4 __attribute__((ext_vector_type(4)));
typedef unsigned u32x4 __attribute__((ext_vector_type(4)));
constexpr int BM = 256, BK = 64, HALF = 128, HTB = HALF * BK * 2, STAGE_BYTES = 8 * HTB, NXCD = 8, WGM = 8;

__host__ __device__ __forceinline__ int lds_byte(int r, int c) { const int st = (r >> 4) * 2 + (c >> 5), rr = r & 15, cc = c & 31, ob = rr * 64 + cc * 2; return st * 1024 + (ob ^ (((ob >> 9) & 1) << 5)); }
__host__ __device__ __forceinline__ void stage_rc(int b, int& R, int& C) { const int st = b / 1024, sb = b % 1024, swz = sb ^ (((sb >> 9) & 1) << 5); R = (st >> 1) * 16 + swz / 64; C = (st & 1) * 32 + (swz % 64) / 2; }
__host__ __device__ __forceinline__ int perm32(int rho) { const int n = rho >> 4, i = rho & 15; return 8 * (i >> 2) + 4 * n + (i & 3); }

struct Unit { int pm, pn; };
struct Gemm { const bf16_t* A; const bf16_t* Bt; int M, N, K; };

struct StaticOrder {
    int nM, nN, nwg, G, c;
    __host__ __device__ void init(int M, int N, int G_, int c_) { nM = M / BM; nN = N / BM; nwg = nM * nN; G = G_; c = c_; }
    __host__ __device__ bool next(int i, Unit& u) const {
        const long L = (long)i * G + c; if (L >= nwg) return false;
        int wgid = (int)L; { const int q = nwg / NXCD, r = nwg % NXCD, xcd = wgid % NXCD, off = wgid / NXCD; wgid = (xcd < r ? xcd * (q + 1) : r * (q + 1) + (xcd - r) * q) + off; }
        const int nig = WGM * nN, gid = wgid / nig, fm = gid * WGM, gsz = (nM - fm) < WGM ? (nM - fm) : WGM;
        u.pm = fm + ((wgid % nig) % gsz); u.pn = (wgid % nig) / gsz; return true;
    }
    __device__ __forceinline__ void a_ready(const Unit&) const {}
    __device__ __forceinline__ void done(const Unit&) const {}
};

typedef float f32x2_t __attribute__((ext_vector_type(2))); typedef __bf16 bf16x2_t __attribute__((ext_vector_type(2)));
__device__ __forceinline__ unsigned cvt_pk_bf16(float lo, float hi) { f32x2_t v = {lo, hi}; bf16x2_t b = __builtin_convertvector(v, bf16x2_t); return __builtin_bit_cast(unsigned, b); }
__device__ __forceinline__ float bf_lo(unsigned w) { return __uint_as_float(w << 16); }
__device__ __forceinline__ float bf_hi(unsigned w) { return __uint_as_float(w & 0xffff0000u); }
__device__ __forceinline__ float sigmoidf_(float x) { return __builtin_amdgcn_rcpf(1.0f + __builtin_amdgcn_exp2f(-1.4426950408889634f * x)); }
__device__ __forceinline__ u32x4 pack8(const f32x4& a, const f32x4& b) { u32x4 w; w.x = cvt_pk_bf16(a[0], a[1]); w.y = cvt_pk_bf16(a[2], a[3]); w.z = cvt_pk_bf16(b[0], b[1]); w.w = cvt_pk_bf16(b[2], b[3]); return w; }


constexpr float QSCALE = 0.125f * 1.4426950408889634f;
constexpr float NORM_EPS = 1e-6f;
struct EpiIn {
    static constexpr bool PERM = true, AFTER_DRAIN = false; static constexpr int MIDK = 0;
    bf16_t *Q; size_t qkv_stride; bf16_t *ZA; size_t zc_off; bf16_t *GLU, *SG; const float *qw, *kw, *bgate;
    __device__ __forceinline__ void operator()(const f32x4 (&acc)[2][2][4][2], const Unit& u, int wr, int wc, int fr, int fq) const {
        const int pn = u.pn; const int rowb = u.pm * BM + wr * 64 + fr;
        if (pn < 18) {
            const int kind = pn / 6, rel = pn - kind * 6, g = rel >> 1, hb = ((rel & 1) << 2) + wc, sh = 2 * g;
            bf16_t* base = Q + (size_t)kind * qkv_stride;
            f32x4 wv[2][2];
            if (kind < 2) { const float* w = qw; if (kind == 1) w = kw; const float sc = kind == 0 ? QSCALE : 1.0f;
#pragma unroll
                for (int bj = 0; bj < 2; ++bj)
#pragma unroll
                    for (int n = 0; n < 2; ++n) wv[bj][n] = *(const f32x4*)(w + 32 * bj + 8 * fq + 4 * n) * sc; }
#pragma unroll
            for (int ai = 0; ai < 2; ++ai)
#pragma unroll
                for (int m = 0; m < 4; ++m) {
                    const int row = rowb + ai * HALF + m * 16, b = row >> 12, t = row & 4095;
                    const int tp = ((t & ((1 << sh) - 1)) << (12 - sh)) | (t >> sh);
                    bf16_t* dst = base + ((size_t)(((b * 3 + g) * 8 + hb) * 4096 + tp) * 64 + 8 * fq);
                    f32x4 v00 = acc[ai][0][m][0], v01 = acc[ai][0][m][1], v10 = acc[ai][1][m][0], v11 = acc[ai][1][m][1];
                    if (kind < 2) {
                        f32x4 q = v00 * v00 + v01 * v01 + v10 * v10 + v11 * v11; float ss = (q[0] + q[1]) + (q[2] + q[3]);
                        ss += __shfl_xor(ss, 16); ss += __shfl_xor(ss, 32);
                        const float rstd = __builtin_amdgcn_rsqf(ss * (1.0f / 64.0f) + NORM_EPS);
                        v00 = v00 * rstd * wv[0][0]; v01 = v01 * rstd * wv[0][1]; v10 = v10 * rstd * wv[1][0]; v11 = v11 * rstd * wv[1][1];
                    }
                    __builtin_nontemporal_store(pack8(v00, v01), (u32x4*)(dst)); __builtin_nontemporal_store(pack8(v10, v11), (u32x4*)(dst + 32));
                }
        } else if (pn < 20 || (pn >= 24 && pn < 26)) {
            bf16_t* base = ZA + (pn < 20 ? (size_t)0 : zc_off); const int rel = pn < 20 ? pn - 18 : pn - 24; const int col0 = rel * BM + wc * 32 + 8 * fq;
#pragma unroll
            for (int ai = 0; ai < 2; ++ai)
#pragma unroll
                for (int m = 0; m < 4; ++m) { bf16_t* dst = base + (size_t)(rowb + ai * HALF + m * 16) * 512 + col0;
#pragma unroll
                    for (int bj = 0; bj < 2; ++bj) { f32x4 a = acc[ai][bj][m][0], b = acc[ai][bj][m][1];
#pragma unroll
                        for (int i = 0; i < 4; ++i) { a[i] = a[i] * sigmoidf_(a[i]); b[i] = b[i] * sigmoidf_(b[i]); }
                        __builtin_nontemporal_store(pack8(a, b), (u32x4*)(dst + bj * HALF)); } }
        } else if (pn < 24) {
            const int col0 = (pn - 20) * HALF + wc * 32 + 8 * fq;
#pragma unroll
            for (int ai = 0; ai < 2; ++ai)
#pragma unroll
                for (int m = 0; m < 4; ++m) { bf16_t* dst = GLU + (size_t)(rowb + ai * HALF + m * 16) * 512 + col0;
                    f32x4 a0 = acc[ai][0][m][0], a1 = acc[ai][0][m][1]; const f32x4 b0 = acc[ai][1][m][0], b1 = acc[ai][1][m][1];
#pragma unroll
                    for (int i = 0; i < 4; ++i) { a0[i] = a0[i] * sigmoidf_(b0[i]); a1[i] = a1[i] * sigmoidf_(b1[i]); }
                    __builtin_nontemporal_store(pack8(a0, a1), (u32x4*)(dst)); }
        } else {
            const int lc0 = (pn - 26) * BM + wc * 64 + 16 * fq;
            f32x4 bv[2][2];
#pragma unroll
            for (int bj = 0; bj < 2; ++bj)
#pragma unroll
                for (int n = 0; n < 2; ++n) bv[bj][n] = *(const f32x4*)(bgate + lc0 + 8 * bj + 4 * n);
#pragma unroll
            for (int ai = 0; ai < 2; ++ai)
#pragma unroll
                for (int m = 0; m < 4; ++m) { unsigned char* dst = (unsigned char*)SG + (size_t)(rowb + ai * HALF + m * 16) * 2048 + lc0;
                    u32x4 w;
#pragma unroll
                    for (int bj = 0; bj < 2; ++bj) { f32x4 a = acc[ai][bj][m][0] + bv[bj][0], b = acc[ai][bj][m][1] + bv[bj][1];
                        unsigned wa = 0u, wb = 0u;
#pragma unroll
                        for (int i = 0; i < 4; ++i) { wa = __builtin_amdgcn_cvt_pk_u8_f32(sigmoidf_(a[i]) * 255.0f, i, wa); wb = __builtin_amdgcn_cvt_pk_u8_f32(sigmoidf_(b[i]) * 255.0f, i, wb); }
                        if (bj == 0) { w.x = wa; w.y = wb; } else { w.z = wa; w.w = wb; } }
                    __builtin_nontemporal_store(w, (u32x4*)dst); }
        }
    }
};
struct EpiMerge2 {
    static constexpr bool PERM = true, AFTER_DRAIN = false; static constexpr int MIDK = 8;
    const unsigned char* SG; bf16_t* OUT;
    __device__ __forceinline__ void mid(f32x4 (&acc)[2][2][4][2], const Unit& u, int wr, int wc, int fr, int fq) const {
        asm volatile("" : "+v"(fr), "+v"(fq));
        const int rowb = u.pm * BM + wr * 64 + fr, col0 = u.pn * BM + wc * 32 + 8 * fq;
        typedef unsigned u32x2 __attribute__((ext_vector_type(2)));
#pragma unroll
        for (int ai = 0; ai < 2; ++ai)
#pragma unroll
            for (int m = 0; m < 4; ++m) { const size_t row = (size_t)(rowb + ai * HALF + m * 16);
#pragma unroll
                for (int bj = 0; bj < 2; ++bj) {
                    const u32x2 ga = *(const u32x2*)(SG + row * 2048 + col0 + bj * HALF), gc = *(const u32x2*)(SG + row * 2048 + 1024 + col0 + bj * HALF);
                    f32x4& a = acc[ai][bj][m][0]; f32x4& b = acc[ai][bj][m][1];
#pragma unroll
                    for (int i = 0; i < 4; ++i) {
                        a[i] *= (float)((ga.x >> (8 * i)) & 255u) * __builtin_amdgcn_rcpf(fmaxf((float)((gc.x >> (8 * i)) & 255u), 0.5f));
                        b[i] *= (float)((ga.y >> (8 * i)) & 255u) * __builtin_amdgcn_rcpf(fmaxf((float)((gc.y >> (8 * i)) & 255u), 0.5f)); } }
                if (m & 1) asm volatile("" ::: "memory"); }
    }
    __device__ __forceinline__ void operator()(const f32x4 (&acc)[2][2][4][2], const Unit& u, int wr, int wc, int fr, int fq) const {
        asm volatile("" : "+v"(fr), "+v"(fq));
        const int rowb = u.pm * BM + wr * 64 + fr, col0 = u.pn * BM + wc * 32 + 8 * fq;
        typedef unsigned u32x2 __attribute__((ext_vector_type(2)));
#pragma unroll
        for (int ai = 0; ai < 2; ++ai) {
            u32x2 gw[4][2];
#pragma unroll
            for (int m = 0; m < 4; ++m)
#pragma unroll
                for (int bj = 0; bj < 2; ++bj) gw[m][bj] = *(const u32x2*)(SG + (size_t)(rowb + ai * HALF + m * 16) * 2048 + 1024 + col0 + bj * HALF);
#pragma unroll
            for (int m = 0; m < 4; ++m) { const size_t row = (size_t)(rowb + ai * HALF + m * 16);
#pragma unroll
                for (int bj = 0; bj < 2; ++bj) { const u32x2 g2 = gw[m][bj];
                    f32x4 a = acc[ai][bj][m][0], b = acc[ai][bj][m][1];
#pragma unroll
                    for (int i = 0; i < 4; ++i) { a[i] *= fmaxf((float)((g2.x >> (8 * i)) & 255u), 0.5f) * (1.0f / 255.0f); b[i] *= fmaxf((float)((g2.y >> (8 * i)) & 255u), 0.5f) * (1.0f / 255.0f); }
                    *(u32x4*)(OUT + row * 1024 + col0 + bj * HALF) = pack8(a, b); } }
        }
    }
};
struct EpiOut {
    static constexpr bool PERM = true, AFTER_DRAIN = false; static constexpr int MIDK = 0;
    const float* X; float* OUT; const float* ADA;
    __device__ __forceinline__ void operator()(const f32x4 (&acc)[2][2][4][2], const Unit& u, int wr, int wc, int fr, int fq) const {
        asm volatile("" : "+v"(fr), "+v"(fq));
        const int rowb = u.pm * BM + wr * 64 + fr, col0 = u.pn * BM + wc * 32 + 8 * fq; const int b = (u.pm * BM) >> 12;
        f32x4 gv[2][2];
#pragma unroll
        for (int bj = 0; bj < 2; ++bj)
#pragma unroll
            for (int n = 0; n < 2; ++n) gv[bj][n] = *(const f32x4*)(ADA + (size_t)b * 3072 + 2048 + col0 + bj * HALF + 4 * n);
#pragma unroll
        for (int ai = 0; ai < 2; ++ai) {
            f32x4 xv[4][2][2];
#pragma unroll
            for (int m = 0; m < 4; ++m) { const size_t off = (size_t)(rowb + ai * HALF + m * 16) * 1024 + col0;
#pragma unroll
                for (int bj = 0; bj < 2; ++bj)
#pragma unroll
                    for (int n = 0; n < 2; ++n) xv[m][bj][n] = *(const f32x4*)(X + off + bj * HALF + 4 * n); }
#pragma unroll
            for (int m = 0; m < 4; ++m) { const size_t off = (size_t)(rowb + ai * HALF + m * 16) * 1024 + col0;
#pragma unroll
                for (int bj = 0; bj < 2; ++bj)
#pragma unroll
                    for (int n = 0; n < 2; ++n) *(f32x4*)(OUT + off + bj * HALF + 4 * n) = xv[m][bj][n] + gv[bj][n] * acc[ai][bj][m][n]; }
        }
    }
};

template <class Epi, class Sched, bool ALIGN_EPI = false, bool SP2 = false>
__device__ __forceinline__ void gemm_phase(PG8_LAS unsigned char* lds, const Gemm g, const Sched& S, const Epi& E) {
    const int tid = threadIdx.x, wid = __builtin_amdgcn_readfirstlane(tid >> 6), lane = tid & 63, wr = wid >> 2, wc = wid & 3, fr = lane & 15, fq = lane >> 4;
    const int K = g.K, nt = K / BK;
    unsigned voffA[2], voffB[2];
#pragma unroll
    for (int i = 0; i < 2; ++i) { int R, C; stage_rc(tid * 16 + i * 8192, R, C); const int Rb = Epi::PERM ? ((R & ~31) + perm32(R & 31)) : R;
        voffA[i] = (unsigned)(R * K + C) * 2u; voffB[i] = (unsigned)(Rb * K + C) * 2u; }
    const size_t kstep = (size_t)(BK * 2);
    const size_t hstep = (size_t)HALF * K * 2;
    const size_t tstep = 2 * hstep;
    const unsigned ldsw = (unsigned)wid * 1024u;
    const int aoff = lds_byte(wr * 64 + fr, fq * 8), boff = lds_byte(wc * 32 + fr, fq * 8);
#define PG8_SA(b, h) (((b) * 2 + (h)) * HTB)
#define PG8_SB(b, h) ((4 + (b) * 2 + (h)) * HTB)
#define PG8_STAGE(bufoff, gbase, voff) do { _Pragma("unroll") for (int _i = 0; _i < 2; ++_i) \
        __builtin_amdgcn_global_load_lds((const unsigned*)((const char*)(gbase) + (voff)[_i]), (PG8_LAS unsigned*)(lds + (bufoff) + ldsw + _i * 8192), 16, 0, 0); } while (0)
#define PG8_LDA(dst, b, h) do { _Pragma("unroll") for (int m = 0; m < 4; ++m) _Pragma("unroll") for (int k = 0; k < 2; ++k) dst[m][k] = *(const PG8_LAS bf16x8*)(lds + PG8_SA(b, h) + aoff + m * 2048 + k * 1024); } while (0)
#define PG8_LDB(dst, b, h) do { _Pragma("unroll") for (int n = 0; n < 2; ++n) _Pragma("unroll") for (int k = 0; k < 2; ++k) dst[n][k] = *(const PG8_LAS bf16x8*)(lds + PG8_SB(b, h) + boff + n * 2048 + k * 1024); } while (0)
#define PG8_MMA(ai, bj, At, Bt) do { __builtin_amdgcn_s_setprio(1); _Pragma("unroll") for (int m = 0; m < 4; ++m) _Pragma("unroll") for (int n = 0; n < 2; ++n) _Pragma("unroll") for (int k = 0; k < 2; ++k) \
        acc[ai][bj][m][n] = __builtin_amdgcn_mfma_f32_16x16x32_bf16(Bt[n][k], At[m][k], acc[ai][bj][m][n], 0, 0, 0); __builtin_amdgcn_s_setprio(0); } while (0)
#define PG8_WAIT_V(n) asm volatile("s_waitcnt vmcnt(" #n ")" ::: "memory")
#define PG8_WAIT_L(n) asm volatile("s_waitcnt lgkmcnt(" #n ")" ::: "memory")
#define PG8_BAR __builtin_amdgcn_s_barrier()
#define PG8_SCHED __builtin_amdgcn_sched_barrier(0)
    Unit cur, nxt; int ui = 0;
    if (!S.next(0, cur)) return;
    f32x4 acc[2][2][4][2];
#pragma unroll
    for (int a = 0; a < 2; ++a)
#pragma unroll
        for (int b = 0; b < 2; ++b)
#pragma unroll
            for (int m = 0; m < 4; ++m)
#pragma unroll
                for (int n = 0; n < 2; ++n) acc[a][b][m][n] = (f32x4){0.f, 0.f, 0.f, 0.f};
    bf16x8 At[4][2], B0[2][2], B1[2][2];
    const char* cA = (const char*)g.A + (size_t)cur.pm * tstep; const char* cB = (const char*)g.Bt + (size_t)cur.pn * tstep;
    S.a_ready(cur);
    if constexpr (SP2) {
        PG8_STAGE(PG8_SB(0, 0), cB, voffB); PG8_STAGE(PG8_SB(0, 1), cB + hstep, voffB); PG8_STAGE(PG8_SA(0, 0), cA, voffA); PG8_STAGE(PG8_SA(0, 1), cA + hstep, voffA);
        if (wr == 1) PG8_BAR;
        PG8_WAIT_V(2); PG8_BAR;
        PG8_STAGE(PG8_SB(1, 0), cB + kstep, voffB); PG8_STAGE(PG8_SA(1, 0), cA + kstep, voffA); PG8_STAGE(PG8_SB(1, 1), cB + hstep + kstep, voffB);
        PG8_WAIT_V(6); PG8_BAR;
    } else {
        PG8_STAGE(PG8_SB(0, 0), cB, voffB); PG8_STAGE(PG8_SA(0, 0), cA, voffA); PG8_STAGE(PG8_SB(0, 1), cB + hstep, voffB); PG8_STAGE(PG8_SA(0, 1), cA + hstep, voffA);
        if (wr == 1) PG8_BAR;
        PG8_WAIT_V(4); PG8_BAR;
        PG8_STAGE(PG8_SB(1, 0), cB + kstep, voffB); PG8_STAGE(PG8_SA(1, 0), cA + kstep, voffA); PG8_STAGE(PG8_SB(1, 1), cB + hstep + kstep, voffB);
        PG8_WAIT_V(6); PG8_BAR;
    }
    for (;;) {
        const bool has_next = S.next(ui + 1, nxt);
        const char* nA = has_next ? (const char*)g.A + (size_t)nxt.pm * tstep : cA; const char* nB = has_next ? (const char*)g.Bt + (size_t)nxt.pn * tstep : cB;
        for (int t = 0; t < nt; t += 2) {
            const bool last = (t == nt - 2);
            const char* a1 = cA + (size_t)(t + 1) * kstep;
            const char* a2 = last ? nA : cA + (size_t)(t + 2) * kstep; const char* b2 = last ? nB : cB + (size_t)(t + 2) * kstep;
            const char* a3 = a2 + kstep; const char* b3 = b2 + kstep;
            if (last && has_next) S.a_ready(nxt);
            if constexpr (Epi::MIDK > 0) { if (t == Epi::MIDK) E.mid(acc, cur, wr, wc, fr, fq); }
            if constexpr (SP2) {
            PG8_LDB(B0, 0, 0); PG8_LDB(B1, 0, 1); PG8_SCHED; PG8_LDA(At, 0, 0); PG8_STAGE(PG8_SA(1, 1), a1 + hstep, voffA);
            PG8_WAIT_V(8); PG8_WAIT_L(0); PG8_BAR; PG8_MMA(0, 0, At, B0); PG8_MMA(0, 1, At, B1); PG8_BAR; PG8_SCHED;
            PG8_LDA(At, 0, 1); PG8_STAGE(PG8_SB(0, 0), b2, voffB); PG8_STAGE(PG8_SB(0, 1), b2 + hstep, voffB); PG8_STAGE(PG8_SA(0, 0), a2, voffA);
            PG8_WAIT_V(8); PG8_WAIT_L(0); PG8_BAR; PG8_MMA(1, 0, At, B0); PG8_MMA(1, 1, At, B1); PG8_BAR; PG8_SCHED;
            PG8_LDB(B0, 1, 0); PG8_LDB(B1, 1, 1); PG8_SCHED; PG8_LDA(At, 1, 0); PG8_STAGE(PG8_SA(0, 1), a2 + hstep, voffA);
            PG8_WAIT_V(8); PG8_WAIT_L(0); PG8_BAR; PG8_MMA(0, 0, At, B0); PG8_MMA(0, 1, At, B1); PG8_BAR; PG8_SCHED;
            PG8_LDA(At, 1, 1); PG8_STAGE(PG8_SB(1, 0), b3, voffB); PG8_STAGE(PG8_SB(1, 1), b3 + hstep, voffB); PG8_STAGE(PG8_SA(1, 0), a3, voffA);
            PG8_WAIT_V(8); PG8_WAIT_L(0); PG8_BAR; PG8_MMA(1, 0, At, B0); PG8_MMA(1, 1, At, B1); PG8_BAR; PG8_SCHED;
            } else {
            PG8_LDB(B0, 0, 0); PG8_SCHED; PG8_LDA(At, 0, 0); PG8_STAGE(PG8_SA(1, 1), a1 + hstep, voffA);
            PG8_WAIT_L(8); PG8_BAR; PG8_WAIT_L(0); PG8_MMA(0, 0, At, B0); PG8_BAR; PG8_SCHED;
            PG8_LDB(B1, 0, 1); PG8_STAGE(PG8_SB(0, 0), b2, voffB);
            PG8_BAR; PG8_WAIT_L(0); PG8_MMA(0, 1, At, B1); PG8_BAR;
            PG8_LDA(At, 0, 1); PG8_STAGE(PG8_SA(0, 0), a2, voffA);
            PG8_BAR; PG8_WAIT_L(0); PG8_MMA(1, 0, At, B0); PG8_BAR; PG8_SCHED;
            PG8_STAGE(PG8_SB(0, 1), b2 + hstep, voffB);
            PG8_WAIT_V(6); PG8_BAR; PG8_MMA(1, 1, At, B1); PG8_BAR;
            PG8_LDB(B0, 1, 0); PG8_SCHED; PG8_LDA(At, 1, 0); PG8_STAGE(PG8_SA(0, 1), a2 + hstep, voffA);
            PG8_WAIT_L(8); PG8_BAR; PG8_WAIT_L(0); PG8_MMA(0, 0, At, B0); PG8_BAR; PG8_SCHED;
            PG8_LDB(B1, 1, 1); PG8_STAGE(PG8_SB(1, 0), b3, voffB);
            PG8_BAR; PG8_WAIT_L(0); PG8_MMA(0, 1, At, B1); PG8_BAR;
            PG8_LDA(At, 1, 1); PG8_STAGE(PG8_SA(1, 0), a3, voffA);
            PG8_BAR; PG8_WAIT_L(0); PG8_MMA(1, 0, At, B0); PG8_BAR; PG8_SCHED;
            PG8_STAGE(PG8_SB(1, 1), b3 + hstep, voffB);
            PG8_WAIT_V(6); PG8_BAR; PG8_MMA(1, 1, At, B1); PG8_BAR;
            }
        }
        if constexpr (ALIGN_EPI) { if (wr == 0) PG8_BAR; }
        if constexpr (!Epi::AFTER_DRAIN) { E(acc, cur, wr, wc, fr, fq); S.done(cur); }
        if (!has_next) break;
#pragma unroll
        for (int a = 0; a < 2; ++a)
#pragma unroll
            for (int b = 0; b < 2; ++b)
#pragma unroll
                for (int m = 0; m < 4; ++m)
#pragma unroll
                    for (int n = 0; n < 2; ++n) acc[a][b][m][n] = (f32x4){0.f, 0.f, 0.f, 0.f};
        cur = nxt; cA = nA; cB = nB; ++ui;
        if constexpr (ALIGN_EPI) { if (wr == 1) PG8_BAR; }
    }
    PG8_WAIT_V(0);
    if constexpr (!ALIGN_EPI) { if (wr == 0) PG8_BAR; }
    PG8_BAR;
#undef PG8_SA
#undef PG8_SB
#undef PG8_STAGE
#undef PG8_LDA
#undef PG8_LDB
#undef PG8_MMA
#undef PG8_WAIT_V
#undef PG8_WAIT_L
#undef PG8_BAR
#undef PG8_SCHED
}
}

constexpr int NWAVES = 8;
constexpr int N_PHASES = 6;
constexpr int BATCH = 8, SEQ = 4096, DM = 1024, M = BATCH * SEQ;
constexpr int NIN = 8704, NHEAD = 24, NG = 3, HPG = 8, HD = 64, CW = 512, CK = 31;
constexpr int ADA_N = 3 * DM;

constexpr size_t MiB = 1u << 20;
constexpr size_t WS_CTL = 0, CTL_ZERO_BYTES = 64 * 1024;
constexpr size_t WS_ADA = 1 * MiB;
constexpr size_t WS_WIN = 422 * MiB;
constexpr size_t WS_WA = 440 * MiB, WS_WO = 442 * MiB;
constexpr size_t WS_LSE = 2 * MiB;
constexpr size_t WS_H = 448 * MiB;
constexpr size_t WS_A2A = 448 * MiB, WS_A2C = 480 * MiB;
constexpr size_t WS_Q = 38 * MiB, WS_K = 134 * MiB, WS_V = 230 * MiB;
constexpr size_t WS_T1 = 134 * MiB, WS_MG = 230 * MiB;
constexpr size_t WS_ZA = 326 * MiB, WS_GLU = 358 * MiB, WS_ZC = 390 * MiB;
constexpr size_t WS_PB = 6 * MiB;
constexpr size_t WS_END = 512 * MiB;

constexpr int RING_OFF = 0, RING_BYTES = 131072;
constexpr int ATT_K0 = 0, ATT_K1 = 49152, ATT_V = 98304, ATT_END = 147456;
constexpr int MISC_OFF = ATT_END;
constexpr int LDS_BYTES = 151552;

#define GAS __attribute__((address_space(1)))
#define LAS __attribute__((address_space(3)))
typedef unsigned short bf16;
typedef unsigned v4u __attribute__((ext_vector_type(4)));
typedef unsigned v2u __attribute__((ext_vector_type(2)));
typedef float f32x4 __attribute__((ext_vector_type(4)));
typedef float f32x2 __attribute__((ext_vector_type(2)));
typedef float f32x16 __attribute__((ext_vector_type(16)));
typedef short bf16x8 __attribute__((ext_vector_type(8)));
typedef short s16x4 __attribute__((ext_vector_type(4)));
#define RLX_AGENT __ATOMIC_RELAXED, __HIP_MEMORY_SCOPE_AGENT
#define LDS_WAIT() asm volatile("s_waitcnt lgkmcnt(0)" ::: "memory")
using pg8::cvt_pk_bf16; using pg8::bf_lo; using pg8::bf_hi; using pg8::sigmoidf_;

#define XB_TMO      128
#define XB_XCNT(j)  (256  + 64 * (j))
#define XB_XSUB(j)  (1280 + 64 * (j))
#define XB_XGEN(j)  (2304 + 64 * (j))
#define XB_TOP      3328
#define XB_TOPGEN   3392
#define XCD_BAR_WORDS 3456
#define XB_SPIN_CAP (1u << 18)
__device__ __forceinline__ unsigned xb_ld(unsigned* p)              { return __hip_atomic_load(p, __ATOMIC_RELAXED, __HIP_MEMORY_SCOPE_AGENT); }
__device__ __forceinline__ unsigned xb_add(unsigned* p, unsigned v) { return __hip_atomic_fetch_add(p, v, __ATOMIC_RELAXED, __HIP_MEMORY_SCOPE_AGENT); }
__device__ __forceinline__ unsigned xb_xcc_id() { return (unsigned)__builtin_amdgcn_s_getreg((3 << 11) | 20) & 0xFu; }
#define XB_SPIN(cond, bar) do { unsigned _sp = 0; while (cond) { __builtin_amdgcn_s_sleep(1); \
    if ((++_sp & 255u) == 0u) { if (xb_ld(&(bar)[XB_TMO])) break; if (_sp > XB_SPIN_CAP) { atomicAdd(&(bar)[XB_TMO], 1u); break; } } } } while (0)
struct XcdBarrier { unsigned* bar; unsigned x; volatile LAS unsigned* st; };
__device__ __forceinline__ XcdBarrier xcd_barrier_post(unsigned* bar, volatile LAS unsigned* st) {
    XcdBarrier b; b.bar = bar; b.x = xb_xcc_id(); b.st = st;
    if (threadIdx.x == 0) (void)xb_add(&bar[XB_XCNT(b.x)], 1u);
    return b;
}
__device__ __forceinline__ void xcd_barrier_complete(unsigned* bar, unsigned x, unsigned& nloc, unsigned& nx) {
    const unsigned G = gridDim.x * gridDim.y * gridDim.z;
    unsigned sum, cnt, mine, sp = 0u;
    for (;;) {
        sum = 0u; cnt = 0u; mine = 0u;
#pragma unroll
        for (unsigned j = 0; j < 16; ++j) { const unsigned c = xb_ld(&bar[XB_XCNT(j)]); sum += c; cnt += (c > 0u) ? 1u : 0u; mine = (j == x) ? c : mine; }
        if (sum == G) break;
        __builtin_amdgcn_s_sleep(1);
        if ((++sp & 255u) == 0u) { if (xb_ld(&bar[XB_TMO])) break; if (sp > XB_SPIN_CAP) { atomicAdd(&bar[XB_TMO], 1u); break; } }
    }
    nloc = mine > 0u ? mine : 1u; nx = cnt > 0u ? cnt : 1u;
}
__device__ __forceinline__ void xcd_barrier(const XcdBarrier& b) {
    asm volatile("s_waitcnt vmcnt(0)" ::: "memory");
    __syncthreads();
    if (threadIdx.x == 0) {
        unsigned* bar = b.bar;
        __builtin_amdgcn_s_waitcnt(0);
        unsigned nloc = b.st[0], nx = b.st[1];
        if (nloc == 0u) { xcd_barrier_complete(bar, b.x, nloc, nx); b.st[0] = nloc; b.st[1] = nx; }
        const unsigned old = xb_add(&bar[XB_XSUB(b.x)], 1u);
        const unsigned gen = old / nloc;
        if (old + 1u == (gen + 1u) * nloc) {
            __builtin_amdgcn_fence(__ATOMIC_RELEASE, "agent");
            asm volatile("s_waitcnt vmcnt(0)" ::: "memory");
            const unsigned og = xb_add(&bar[XB_TOP], 1u);
            const unsigned tg = og / nx;
            if (og + 1u == (tg + 1u) * nx) xb_add(&bar[XB_TOPGEN], 1u);
            else XB_SPIN(xb_ld(&bar[XB_TOPGEN]) == tg, bar);
            __builtin_amdgcn_fence(__ATOMIC_ACQUIRE, "agent");
            xb_add(&bar[XB_XGEN(b.x)], 1u);
            asm volatile("s_waitcnt vmcnt(0)" ::: "memory");
        } else {
            XB_SPIN(xb_ld(&bar[XB_XGEN(b.x)]) == gen, bar);
            __builtin_amdgcn_fence(__ATOMIC_ACQUIRE, "agent");
            asm volatile("s_waitcnt vmcnt(0)" ::: "memory");
        }
    }
    __syncthreads();
}

__device__ __forceinline__ float wave_sum(float v) {
#pragma unroll
    for (int o = 1; o < 64; o <<= 1) v += __shfl_xor(v, o);
    return v;
}
__device__ __forceinline__ unsigned f2bf(float f) { unsigned u = __builtin_bit_cast(unsigned, f); return (u + 0x7fffu + ((u >> 16) & 1u)) >> 16; }
__device__ __forceinline__ unsigned pk2(float lo, float hi) { return f2bf(lo) | (f2bf(hi) << 16); }

__device__ __forceinline__ int win_phys(int n0) {
    if (n0 < 4608) { const int reg = n0 / 1536, c = n0 - reg * 1536, head = c >> 6, dh = (c >> 5) & 1; return (reg * 6 + (head >> 2)) * 256 + 128 * dh + 32 * (head & 3); }
    if (n0 >= 5120 && n0 < 6144) { const int c = n0 - 5120, half = c >> 9, cc = c & 511; return (20 + (cc >> 7)) * 256 + 128 * half + (cc & 127); }
    return n0;
}
__device__ __forceinline__ int win_phys_g(int n) { const int c = n - 6656, cl = c & 255; return 6656 + (c & ~255) + 128 * ((cl >> 3) & 1) + 32 * (cl >> 6) + 8 * ((cl >> 4) & 3) + (cl & 7); }
template <bool WIN>
__device__ __forceinline__ void p0_transpose_item(const float* W, int K, int N, bf16* WT, LAS float* scr, int item, int lane, int ldt = 0) {
    if (ldt == 0) ldt = K;
    const int nblk = N / 32, kb = item / nblk, nb = item % nblk, k0 = 64 * kb, n0 = 32 * nb;
    const int prow = WIN ? win_phys(n0) : n0;
#pragma unroll 8
    for (int i = 0; i < 32; ++i) { const int kk = 2 * i + (lane >> 5); scr[kk * 33 + (lane & 31)] = __builtin_nontemporal_load(W + (size_t)(k0 + kk) * N + n0 + (lane & 31)); }
    LDS_WAIT(); asm volatile("" ::: "memory");
    const int c = lane & 7;
#pragma unroll
    for (int j = 0; j < 4; ++j) { const int n = (lane >> 3) + 8 * j; const LAS float* s = scr + (8 * c) * 33 + n;
        v4u o; o.x = pk2(s[0 * 33], s[1 * 33]); o.y = pk2(s[2 * 33], s[3 * 33]); o.z = pk2(s[4 * 33], s[5 * 33]); o.w = pk2(s[6 * 33], s[7 * 33]);
        const int rown = (WIN && n0 >= 6656) ? win_phys_g(n0 + n) : prow + n;
        *(GAS v4u*)(WT + (size_t)rown * ldt + k0 + 8 * c) = o; }
    LDS_WAIT(); asm volatile("" ::: "memory");
}

template <bool WIN>
__device__ __forceinline__ void p0_transpose_item64(const float* W, int K, int N, bf16* WT, LAS float* scr, int item, int lane, int ldt = 0) {
    if (ldt == 0) ldt = K;
    const int nblk = N / 64, kb = item / nblk, nb = item % nblk, k0 = 64 * kb, n0 = 64 * nb;
#pragma unroll 4
    for (int i = 0; i < 16; ++i) { const int kk = 4 * i + (lane >> 4), c4 = 4 * (lane & 15);
        const f32x4 v = __builtin_nontemporal_load((const f32x4*)(W + (size_t)(k0 + kk) * N + n0 + c4));
        LAS float* d = scr + kk * 65 + c4; d[0] = v.x; d[1] = v.y; d[2] = v.z; d[3] = v.w; }
    LDS_WAIT(); asm volatile("" ::: "memory");
    const int c = lane & 7;
#pragma unroll
    for (int j = 0; j < 8; ++j) { const int n = (lane >> 3) + 8 * j; const LAS float* s = scr + (8 * c) * 65 + n;
        v4u o; o.x = pk2(s[0 * 65], s[1 * 65]); o.y = pk2(s[2 * 65], s[3 * 65]); o.z = pk2(s[4 * 65], s[5 * 65]); o.w = pk2(s[6 * 65], s[7 * 65]);
        const int nn = n0 + n; const int rown = !WIN ? nn : (nn >= 6656 ? win_phys_g(nn) : win_phys(nn & ~31) + (nn & 31));
        *(GAS v4u*)(WT + (size_t)rown * ldt + k0 + 8 * c) = o; }
    LDS_WAIT(); asm volatile("" ::: "memory");
}

struct Args { const float* in[16]; float* out; unsigned char* ws; int ph_lo, ph_hi; };
__device__ __forceinline__ int crow(int r, int hi) { return (r & 3) + 8 * (r >> 2) + 4 * hi; }
__device__ __forceinline__ s16x4 vtr(const LAS char* p) { typedef short v4i16_t __attribute__((ext_vector_type(4))); return __builtin_bit_cast(s16x4, __builtin_amdgcn_ds_read_tr16_b64_v4i16((LAS v4i16_t*)p)); }

__device__ __forceinline__ void glds16s(const void* sbase, unsigned voff, unsigned lds_dst) { unsigned keep;
    const unsigned long long sb = (unsigned long long)sbase;
    const unsigned lo = (unsigned)__builtin_amdgcn_readfirstlane((int)(unsigned)sb), hi = (unsigned)__builtin_amdgcn_readfirstlane((int)(unsigned)(sb >> 32));
    const unsigned long long sbu = ((unsigned long long)hi << 32) | lo;
    asm volatile("s_mov_b32 %0, m0\n\ts_mov_b32 m0, %3\n\ts_nop 4\n\tglobal_load_lds_dwordx4 %1, %2\n\ts_mov_b32 m0, %0" : "=&s"(keep) : "v"(voff), "s"(sbu), "s"(lds_dst) : "memory"); }
struct KTile { bf16x8 k[4]; };
struct VTile { v4u v[4]; };
__device__ __forceinline__ void load_k(KTile& T, const bf16* Kp, int row0, int r32, int hi) {
    const bf16* kr = Kp + (size_t)(row0 + r32) * HD + 8 * hi;
#pragma unroll
    for (int ks = 0; ks < 4; ++ks) T.k[ks] = *(const GAS bf16x8*)(kr + 16 * ks);
}
__device__ __forceinline__ void load_v(VTile& T, const bf16* Vp, int row0, int lane) {
#pragma unroll
    for (int i = 0; i < 4; ++i) { const int c = lane + 64 * i; T.v[i] = *(const GAS v4u*)(Vp + (size_t)(row0 + (c >> 3)) * HD + (c & 7) * 8); }
}
template <int TAU>
__device__ __forceinline__ void att_tile(const KTile& TK, const VTile& TV, const bf16x8 (&qf)[4], float& m, float& l, f32x16 (&o)[2], LAS char* vl, const LAS char* vrd, int lane, int r32, int hi) {
    f32x16 s = {};
#pragma unroll
    for (int ks = 0; ks < 4; ++ks) s = __builtin_amdgcn_mfma_f32_32x32x16_bf16(TK.k[ks], qf[ks], s, 0, 0, 0);
#pragma unroll
    for (int i = 0; i < 4; ++i) { const int c = lane + 64 * i, key = c >> 3, ch = c & 7; *(LAS v4u*)(vl + (ch >> 2) * 2048 + key * 64 + (ch & 3) * 16) = TV.v[i]; }
    if (TAU == 0) {
#pragma unroll
        for (int r = 0; r < 16; ++r) if (crow(r, hi) < r32) s[r] = -INFINITY;
    }
    if (TAU == 4) {
#pragma unroll
        for (int r = 0; r < 16; ++r) if (crow(r, hi) > r32) s[r] = -INFINITY;
    }
    float tm = fmaxf(fmaxf(s[0], s[1]), s[2]);
#pragma unroll
    for (int r = 3; r < 15; r += 2) tm = fmaxf(fmaxf(tm, s[r]), s[r + 1]);
    tm = fmaxf(tm, s[15]);
    tm = fmaxf(tm, __shfl_xor(tm, 32));
    if (__any(tm > m)) {
        const float mn = fmaxf(m, tm), al = __builtin_amdgcn_exp2f(m - mn);
        l *= al; o[0] = o[0] * al; o[1] = o[1] * al; m = mn;
    }
    float ps = 0.f;
#pragma unroll
    for (int r = 0; r < 16; ++r) { s[r] = __builtin_amdgcn_exp2f(s[r] - m); ps += s[r]; }
    l += ps;
    v4u pw0, pw1;
    pw0.x = cvt_pk_bf16(s[0], s[1]); pw0.y = cvt_pk_bf16(s[2], s[3]); pw0.z = cvt_pk_bf16(s[4], s[5]); pw0.w = cvt_pk_bf16(s[6], s[7]);
    pw1.x = cvt_pk_bf16(s[8], s[9]); pw1.y = cvt_pk_bf16(s[10], s[11]); pw1.z = cvt_pk_bf16(s[12], s[13]); pw1.w = cvt_pk_bf16(s[14], s[15]);
    const bf16x8 pf0 = __builtin_bit_cast(bf16x8, pw0), pf1 = __builtin_bit_cast(bf16x8, pw1);
    LDS_WAIT(); asm volatile("" ::: "memory");
#pragma unroll
    for (int d0 = 0; d0 < 2; ++d0) {
        const s16x4 a0 = vtr(vrd + d0 * 2048), a1 = vtr(vrd + d0 * 2048 + 512), a2 = vtr(vrd + d0 * 2048 + 1024), a3 = vtr(vrd + d0 * 2048 + 1536);
        const bf16x8 vf0 = (bf16x8){a0[0], a0[1], a0[2], a0[3], a1[0], a1[1], a1[2], a1[3]};
        const bf16x8 vf1 = (bf16x8){a2[0], a2[1], a2[2], a2[3], a3[0], a3[1], a3[2], a3[3]};
        o[d0] = __builtin_amdgcn_mfma_f32_32x32x16_bf16(vf0, pf0, o[d0], 0, 0, 0);
        o[d0] = __builtin_amdgcn_mfma_f32_32x32x16_bf16(vf1, pf1, o[d0], 0, 0, 0);
    }
    asm volatile("" ::: "memory");
}

__global__ void __launch_bounds__(NWAVES * 64, 2) mega_fwd(Args args) {
    extern __shared__ __attribute__((aligned(16))) unsigned char lds_raw[];
    LAS unsigned char* lds = (LAS unsigned char*)lds_raw;
    const int tid = threadIdx.x, lane = tid & 63, wave = __builtin_amdgcn_readfirstlane(tid >> 6);
    const int G = gridDim.x; const int bx = blockIdx.x; const int vcu = (G % 8 == 0) ? (bx % 8) * (G / 8) + bx / 8 : bx;
    unsigned char* ws = args.ws;
    const float* x = args.in[0]; const float* cvec = args.in[1]; const float* w_ada = args.in[2]; const float* b_ada = args.in[3]; const float* norm_w = args.in[4];
    const float* w_in = args.in[5]; const float* b_gate = args.in[6]; const float* q_norm_w = args.in[7]; const float* k_norm_w = args.in[8]; const float* w_attn_proj = args.in[9];
    const float* conv_w = args.in[10]; const float* conv_b = args.in[11]; const float* conv_ln_w = args.in[12]; const float* conv_ln_b = args.in[13];
    const float* w_conv_proj = args.in[14]; const float* w_out = args.in[15];
    float* out = args.out;
    float* ADA = (float*)(ws + WS_ADA);
    bf16* WIN = (bf16*)(ws + WS_WIN); bf16* W2 = (bf16*)(ws + WS_WA); bf16* WO = (bf16*)(ws + WS_WO);
    float* LSE = (float*)(ws + WS_LSE);
    bf16* HB = (bf16*)(ws + WS_H); bf16* A2 = (bf16*)(ws + WS_A2A);
    bf16* QB = (bf16*)(ws + WS_Q); bf16* KB = (bf16*)(ws + WS_K); bf16* VB = (bf16*)(ws + WS_V);
    bf16* MG = (bf16*)(ws + WS_MG);
    bf16* ZA = (bf16*)(ws + WS_ZA); bf16* GLU = (bf16*)(ws + WS_GLU); bf16* ZC = (bf16*)(ws + WS_ZC);
    bf16* SG = (bf16*)out;

    if (tid < 32) ((LAS unsigned*)(lds + MISC_OFF))[tid] = 0u;
    __syncthreads();
    XcdBarrier bar = xcd_barrier_post((unsigned*)(ws + WS_CTL) + 4096, (volatile LAS unsigned*)(lds + MISC_OFF) + 8);
#define GRID_BAR(k) xcd_barrier(bar)
    const int lo = args.ph_lo, hi_ph = args.ph_hi;
#define IN(k) (lo <= (k) && (k) < hi_ph)
#define BOTH(k) (IN(k) && IN((k) + 1))
    const int gw = vcu * NWAVES + wave, NGW = G * NWAVES;

    if (IN(0)) {
        {
            LAS float* sc = (LAS float*)lds; LAS float* part = (LAS float*)(lds + 32768);
            if (bx < ADA_N / 64) {
                for (int i = tid; i < BATCH * DM; i += NWAVES * 64) { const float v = cvec[i]; sc[i] = v * sigmoidf_(v); }
                __syncthreads();
                for (int item = bx; item < ADA_N / 64; item += G) {
                    const int j = item * 64 + lane; float a[BATCH];
#pragma unroll
                    for (int b = 0; b < BATCH; ++b) a[b] = 0.f;
#pragma unroll 4
                    for (int kk = 0; kk < 128; ++kk) { const int k = wave * 128 + kk; const float w = __builtin_nontemporal_load(w_ada + (size_t)k * ADA_N + j);
#pragma unroll
                        for (int b = 0; b < BATCH; ++b) a[b] += sc[b * DM + k] * w; }
#pragma unroll
                    for (int b = 0; b < BATCH; ++b) part[(wave * BATCH + b) * 64 + lane] = a[b];
                    __syncthreads();
                    { float s = b_ada[j];
#pragma unroll
                      for (int w = 0; w < NWAVES; ++w) s += part[(w * BATCH + wave) * 64 + lane];
                      ADA[(size_t)wave * ADA_N + j] = s; }
                    __syncthreads();
                }
            }
        }
        if (bx >= ADA_N / 64 || G <= ADA_N / 64) {
            LAS float* scr = (LAS float*)(lds + RING_OFF + wave * 16640);
            constexpr int I_IN = (DM / 64) * (NIN / 64), I_A = (CW / 64) * (DM / 64), I_O = (DM / 64) * (DM / 64);
            constexpr int NITEMS = I_IN + 2 * I_A + I_O;
            const int nsk = G > ADA_N / 64 ? ADA_N / 64 : 0;
            for (int it = (bx - nsk) * NWAVES + wave; it < NITEMS; it += (G - nsk) * NWAVES) {
                int r = it;
                if (r < I_IN) { p0_transpose_item64<true>(w_in, DM, NIN, WIN, scr, r, lane); continue; } r -= I_IN;
                if (r < I_A) { p0_transpose_item64<false>(w_attn_proj, CW, DM, W2, scr, r, lane, DM); continue; } r -= I_A;
                if (r < I_A) { p0_transpose_item64<false>(w_conv_proj, CW, DM, W2 + CW, scr, r, lane, DM); continue; } r -= I_A;
                p0_transpose_item64<false>(w_out, DM, DM, WO, scr, r, lane);
            }
        }
        if (BOTH(0)) GRID_BAR(0);
    }

    if (IN(1)) {
        for (int rb = gw; rb < M / 16; rb += NGW) {
            const int row0 = rb * 16, b = row0 >> 12;
            f32x4 gm[4], ga[4];
#pragma unroll
            for (int j = 0; j < 4; ++j) { const int c = 4 * lane + 256 * j;
                const f32x4 nw = *(const f32x4*)(norm_w + c), sc = *(const f32x4*)(ADA + (size_t)b * ADA_N + DM + c);
                gm[j] = nw * (sc + 1.0f); ga[j] = *(const f32x4*)(ADA + (size_t)b * ADA_N + c); }
            for (int r = 0; r < 16; ++r) {
                const GAS f32x4* xr = (const GAS f32x4*)(x + (size_t)(row0 + r) * DM) + lane;
                f32x4 v[4]; float s2 = 0.f;
#pragma unroll
                for (int j = 0; j < 4; ++j) { v[j] = __builtin_nontemporal_load(xr + 64 * j); s2 += (v[j].x * v[j].x + v[j].y * v[j].y) + (v[j].z * v[j].z + v[j].w * v[j].w); }
                const float rstd = __builtin_amdgcn_rsqf(wave_sum(s2) * (1.f / DM) + pg8::NORM_EPS);
                GAS v2u* o8 = (GAS v2u*)(HB + (size_t)(row0 + r) * DM) + lane;
#pragma unroll
                for (int j = 0; j < 4; ++j) { const f32x4 y = v[j] * rstd * gm[j] + ga[j]; v2u w; w.x = cvt_pk_bf16(y.x, y.y); w.y = cvt_pk_bf16(y.z, y.w); o8[64 * j] = w; }
            }
        }
        if (BOTH(1)) GRID_BAR(1);
    }

    if (IN(2)) {
        pg8::Gemm g{HB, WIN, M, NIN, DM}; pg8::StaticOrder S; S.init(M, NIN, G, bx);
        pg8::EpiIn E{QB, (WS_K - WS_Q) / 2, ZA, (WS_ZC - WS_ZA) / 2, GLU, SG, q_norm_w, k_norm_w, b_gate};
        pg8::gemm_phase<pg8::EpiIn, pg8::StaticOrder, true, true>(lds + RING_OFF, g, S, E);
        if (BOTH(2)) GRID_BAR(2);
    }

    if (IN(3)) {
        {
            LAS unsigned* in32 = (LAS unsigned*)lds;
            LAS float* ot = (LAS float*)(lds + 65536);
            const int cp = tid & 255, th = tid >> 8;
            float w0[CK], w1[CK];
#pragma unroll
            for (int j = 0; j < CK; ++j) { const f32x2 w = *(const f32x2*)(conv_w + j * CW + 2 * cp); w0[j] = w.x; w1[j] = w.y; }
            const f32x2 cb = *(const f32x2*)(conv_b + 2 * cp);
            v4u pf[8];
#define CONV_FETCH(TILE) { const int b_ = (TILE) >> 7, t0_ = ((TILE) & 127) * 32; \
                _Pragma("unroll") for (int i = 0; i < 8; ++i) { int c = tid + 512 * i; c = c < 62 * 64 ? c : 62 * 64 - 1; const int r = c >> 6, ch = c & 63, t = t0_ - 30 + r; \
                    v4u val = *(const GAS v4u*)(GLU + ((size_t)b_ * SEQ + (t < 0 ? 0 : t)) * CW + ch * 8); if (t < 0) val = (v4u){0u, 0u, 0u, 0u}; pf[i] = val; } }
            if (bx < M / 32) CONV_FETCH(bx)
            for (int tile = bx; tile < M / 32; tile += G) {
                const int b = tile >> 7, t0 = (tile & 127) * 32; const size_t row0 = (size_t)b * SEQ + t0;
#pragma unroll
                for (int i = 0; i < 8; ++i) { const int c = tid + 512 * i; if (c < 62 * 64) *(LAS v4u*)(lds + (size_t)c * 16) = pf[i]; }
                v4u zc[4];
#pragma unroll
                for (int q = 0; q < 4; ++q) zc[q] = *(const GAS v4u*)(ZC + (row0 + wave + 8 * q) * CW + lane * 8);
                __syncthreads();
                { const int nt_ = tile + G < M / 32 ? tile + G : tile; CONV_FETCH(nt_) }
                unsigned xs[46];
#pragma unroll
                for (int i = 0; i < 46; ++i) xs[i] = in32[(th * 16 + i) * 256 + cp];
#pragma unroll
                for (int tl = 0; tl < 16; ++tl) { float a0 = cb.x, a1 = cb.y;
#pragma unroll
                    for (int j = 0; j < CK; ++j) { const unsigned xv = xs[tl + j]; a0 += w0[j] * bf_lo(xv); a1 += w1[j] * bf_hi(xv); }
                    *(LAS f32x2*)(ot + (th * 16 + tl) * CW + 2 * cp) = (f32x2){a0, a1}; }
                __syncthreads();
                {
                    const f32x4 lw0 = *(const f32x4*)(conv_ln_w + lane * 8), lw1 = *(const f32x4*)(conv_ln_w + lane * 8 + 4);
                    const f32x4 lb0 = *(const f32x4*)(conv_ln_b + lane * 8), lb1 = *(const f32x4*)(conv_ln_b + lane * 8 + 4);
#pragma unroll
                    for (int q = 0; q < 4; ++q) { const int tl = wave + 8 * q;
                        f32x4 v0 = *(const LAS f32x4*)(ot + tl * CW + lane * 8), v1 = *(const LAS f32x4*)(ot + tl * CW + lane * 8 + 4);
                        const float mean = wave_sum((v0.x + v0.y) + (v0.z + v0.w) + (v1.x + v1.y) + (v1.z + v1.w)) * (1.f / CW);
                        v0 = v0 - mean; v1 = v1 - mean;
                        const float var = wave_sum((v0.x * v0.x + v0.y * v0.y) + (v0.z * v0.z + v0.w * v0.w) + (v1.x * v1.x + v1.y * v1.y) + (v1.z * v1.z + v1.w * v1.w)) * (1.f / CW);
                        const float rstd = __builtin_amdgcn_rsqf(var + pg8::NORM_EPS);
                        v0 = v0 * rstd * lw0 + lb0; v1 = v1 * rstd * lw1 + lb1;
                        const v4u zq = zc[q];
                        const float z[8] = {bf_lo(zq.x), bf_hi(zq.x), bf_lo(zq.y), bf_hi(zq.y), bf_lo(zq.z), bf_hi(zq.z), bf_lo(zq.w), bf_hi(zq.w)};
#pragma unroll
                        for (int i = 0; i < 4; ++i) { v0[i] = v0[i] * sigmoidf_(v0[i]) * z[i]; v1[i] = v1[i] * sigmoidf_(v1[i]) * z[4 + i]; }
                        *(GAS v4u*)(A2 + (row0 + tl) * DM + CW + lane * 8) = pg8::pack8(v0, v1); }
                }
                __syncthreads();
            }
#undef CONV_FETCH
        }
        {
            const int r32 = lane & 31, hi = lane >> 5;
            const int vrd_off = (4 * hi + ((lane & 15) >> 2)) * 64 + ((lane >> 4) & 1) * 32 + (lane & 3) * 8;
            const int piece = wave & 3, tsel = wave >> 2;
            bf16* PB = (bf16*)(ws + WS_PB); float* PL = (float*)(ws + WS_LSE);
            const unsigned lds0 = (unsigned)(uintptr_t)lds_raw;
            const unsigned voffK = (unsigned)(((8 * piece + (lane >> 3)) * HD + (((lane & 7) ^ (((8 * piece + (lane >> 3)) >> 1) & 7)) << 3)) * 2);
            const unsigned voffV = (unsigned)(((16 * (piece & 1) + (lane >> 2)) * HD + (piece >> 1) * 32 + (lane & 3) * 8) * 2);
#define ATT_BAR() do { asm volatile("s_waitcnt lgkmcnt(0)" ::: "memory"); __builtin_amdgcn_s_barrier(); asm volatile("" ::: "memory"); } while (0)
#define ATT_DMA(ISV, SRC, RROW, JSB, NT, LDSOFF, FORCE) do { \
                _Pragma("unroll") for (int m_ = 0; m_ < 6; ++m_) { const int kt_ = 2 * m_ + tsel; const int js_ = (JSB) + 32 * kt_; \
                    if (m_ < (NT) / 2 && ((FORCE) || js_ >= 0)) \
                        glds16s((SRC) + ((size_t)(RROW) + (js_ < 0 ? 0 : js_)) * HD, ISV ? voffV : voffK, (unsigned)__builtin_amdgcn_readfirstlane((int)(lds0 + (LDSOFF) + kt_ * 4096 + piece * 1024))); } } while (0)
#define ATT_ROUND(G_, RROW, IU0, JB, KTB, KBUF, TSH, TOK0, PBO, PBL, MROW0, NKN, QNP, QNROW) do { \
                    const int iq = (IU0) + r32; const int tq = (iq << (TSH)) + (TOK0); \
                    f32x16 S[5]; \
                    _Pragma("unroll") for (int tau = 0; tau < 5; ++tau) { \
                        _Pragma("unroll") for (int r = 0; r < 16; ++r) S[tau][r] = -INFINITY; \
                        if ((JB) + 32 * tau >= 0) { \
                            const LAS char* kp = (const LAS char*)(lds + (KBUF) + ((KTB) + tau) * 4096 + r32 * 128); \
                            f32x16 sacc = {}; \
                            _Pragma("unroll") for (int ks = 0; ks < 4; ++ks) { const bf16x8 kf = *(const LAS bf16x8*)(kp + (((2 * ks + hi) ^ ((r32 >> 1) & 7)) << 4)); \
                                sacc = __builtin_amdgcn_mfma_f32_32x32x16_bf16(kf, qf[ks], sacc, 0, 0, 0); } \
                            if (tau == 0) { _Pragma("unroll") for (int r = 0; r < 16; ++r) if (crow(r, hi) < r32) sacc[r] = -INFINITY; } \
                            if (tau == 4) { _Pragma("unroll") for (int r = 0; r < 16; ++r) if (crow(r, hi) > r32) sacc[r] = -INFINITY; } \
                            S[tau] = sacc; } } \
                    float mx = -INFINITY; \
                    _Pragma("unroll") for (int tau = 0; tau < 5; ++tau) _Pragma("unroll") for (int r = 0; r < 16; r += 2) mx = fmaxf(fmaxf(mx, S[tau][r]), S[tau][r + 1]); \
                    mx = fmaxf(mx, __shfl_xor(mx, 32)); \
                    float l = 0.f; v4u P[5][2]; \
                    _Pragma("unroll") for (int tau = 0; tau < 5; ++tau) { f32x16 p = S[tau]; float ps = 0.f; \
                        _Pragma("unroll") for (int r = 0; r < 16; ++r) { p[r] = __builtin_amdgcn_exp2f(p[r] - mx); ps += p[r]; } \
                        l += ps; \
                        P[tau][0].x = cvt_pk_bf16(p[0], p[1]); P[tau][0].y = cvt_pk_bf16(p[2], p[3]); P[tau][0].z = cvt_pk_bf16(p[4], p[5]); P[tau][0].w = cvt_pk_bf16(p[6], p[7]); \
                        P[tau][1].x = cvt_pk_bf16(p[8], p[9]); P[tau][1].y = cvt_pk_bf16(p[10], p[11]); P[tau][1].z = cvt_pk_bf16(p[12], p[13]); P[tau][1].w = cvt_pk_bf16(p[14], p[15]); } \
                    l += __shfl_xor(l, 32); \
                    asm volatile("s_waitcnt vmcnt(" #NKN ")" ::: "memory"); ATT_BAR();     \
                    ATT_LOAD_Q(qn, QNP, QNROW); \
                    if ((G_) < 2) ATT_LOAD_P(PBO, PBL, tq); \
                    f32x16 o[2]; o[0] = f32x16{}; o[1] = f32x16{}; \
                    _Pragma("unroll") for (int tau = 0; tau < 5; ++tau) { \
                        if ((JB) + 32 * tau >= 0) { \
                            const LAS char* vp = (const LAS char*)(lds + ATT_V + ((KTB) + tau) * 4096 + vrd_off); \
                            const bf16x8 pf0 = __builtin_bit_cast(bf16x8, P[tau][0]), pf1 = __builtin_bit_cast(bf16x8, P[tau][1]); \
                            _Pragma("unroll") for (int d0 = 0; d0 < 2; ++d0) { \
                                const s16x4 a0 = vtr(vp + d0 * 2048), a1 = vtr(vp + d0 * 2048 + 512), a2 = vtr(vp + d0 * 2048 + 1024), a3 = vtr(vp + d0 * 2048 + 1536); \
                                const bf16x8 vf0 = (bf16x8){a0[0], a0[1], a0[2], a0[3], a1[0], a1[1], a1[2], a1[3]}; \
                                const bf16x8 vf1 = (bf16x8){a2[0], a2[1], a2[2], a2[3], a3[0], a3[1], a3[2], a3[3]}; \
                                o[d0] = __builtin_amdgcn_mfma_f32_32x32x16_bf16(vf0, pf0, o[d0], 0, 0, 0); \
                                o[d0] = __builtin_amdgcn_mfma_f32_32x32x16_bf16(vf1, pf1, o[d0], 0, 0, 0); } } } \
                    float lse = mx + __builtin_amdgcn_logf(l), sc_own = __builtin_amdgcn_rcpf(l), sc_p = 0.f; \
                    if ((G_) < 2) { const float mx2 = fmaxf(lse, plse), a = __builtin_amdgcn_exp2f(lse - mx2), bq = __builtin_amdgcn_exp2f(plse - mx2), inv = __builtin_amdgcn_rcpf(a + bq); \
                        sc_own = sc_own * a * inv; sc_p = bq * inv; lse = mx2 + __builtin_amdgcn_logf(a + bq); } \
                    if ((G_) > 0) { \
                        _Pragma("unroll") for (int d0 = 0; d0 < 2; ++d0) _Pragma("unroll") for (int rg = 0; rg < 4; ++rg) { \
                            float e0 = o[d0][4 * rg] * sc_own, e1 = o[d0][4 * rg + 1] * sc_own, e2 = o[d0][4 * rg + 2] * sc_own, e3 = o[d0][4 * rg + 3] * sc_own; \
                            if ((G_) < 2) { const v2u pw = pp[d0 * 4 + rg]; e0 += sc_p * bf_lo(pw.x); e1 += sc_p * bf_hi(pw.x); e2 += sc_p * bf_lo(pw.y); e3 += sc_p * bf_hi(pw.y); } \
                            v2u w; w.x = cvt_pk_bf16(e0, e1); w.y = cvt_pk_bf16(e2, e3); \
                            *(GAS v2u*)((PBO) + (size_t)tq * HD + 32 * d0 + 8 * rg + 4 * hi) = w; } \
                        if (hi == 0) (PBL)[tq] = lse; \
                    } else { \
                        const size_t mrow = (size_t)(MROW0) + tq; \
                        v2u zz[8]; \
                        _Pragma("unroll") for (int d0 = 0; d0 < 2; ++d0) _Pragma("unroll") for (int rg = 0; rg < 4; ++rg) zz[d0 * 4 + rg] = *(const GAS v2u*)(ZA + mrow * CW + h * 64 + 32 * d0 + 8 * rg + 4 * hi); \
                        _Pragma("unroll") for (int d0 = 0; d0 < 2; ++d0) _Pragma("unroll") for (int rg = 0; rg < 4; ++rg) { const v2u pw = pp[d0 * 4 + rg]; const v2u zw = zz[d0 * 4 + rg]; \
                            const float e0 = (o[d0][4 * rg] * sc_own + sc_p * bf_lo(pw.x)) * bf_lo(zw.x), e1 = (o[d0][4 * rg + 1] * sc_own + sc_p * bf_hi(pw.x)) * bf_hi(zw.x); \
                            const float e2 = (o[d0][4 * rg + 2] * sc_own + sc_p * bf_lo(pw.y)) * bf_lo(zw.y), e3 = (o[d0][4 * rg + 3] * sc_own + sc_p * bf_hi(pw.y)) * bf_hi(zw.y); \
                            v2u w; w.x = cvt_pk_bf16(e0, e1); w.y = cvt_pk_bf16(e2, e3); \
                            *(GAS v2u*)(A2 + mrow * DM + h * 64 + 32 * d0 + 8 * rg + 4 * hi) = w; } } \
                } while (0)
#define ATT_LOAD_Q(DST, QP, ROW) do { _Pragma("unroll") for (int ks = 0; ks < 4; ++ks) DST[ks] = *(const GAS bf16x8*)((QP) + (size_t)(ROW) * HD + 16 * ks + 8 * hi); } while (0)
#define ATT_LOAD_P(PBO, PBL, TQ) do { _Pragma("unroll") for (int d0 = 0; d0 < 2; ++d0) _Pragma("unroll") for (int rg = 0; rg < 4; ++rg) pp[d0 * 4 + rg] = *(const GAS v2u*)((PBO) + (size_t)(TQ) * HD + 32 * d0 + 8 * rg + 4 * hi); \
                plse = (PBL)[TQ]; } while (0)
            bf16x8 qf[4], qn[4]; v2u pp[8]; float plse;
            {
                const int NCH = BATCH * HPG * 16;
                if (vcu < NCH) { const int bh = vcu >> 4, res = vcu & 15; const size_t base = (size_t)(((bh >> 3) * 3 + 2) * 8 + (bh & 7)) * SEQ * HD;
                    ATT_LOAD_Q(qf, QB + base, res * 256 + 32 * wave + r32);
                    asm volatile("s_waitcnt vmcnt(0)" ::: "memory"); ATT_BAR();
                    ATT_DMA(false, KB + base, res * 256, 0, 8, ATT_K0, false); }
                int kpar = 0;
                for (int ch = vcu; ch < NCH; ch += G, kpar ^= 1) {
                    const int bh = ch >> 4, res = ch & 15, b = bh >> 3, h = bh & 7; const size_t base = (size_t)((b * 3 + 2) * 8 + h) * SEQ * HD;
                    const int chn = ch + G < NCH ? ch + G : ch, bhn = chn >> 4, resn = chn & 15; const size_t basen = (size_t)(((bhn >> 3) * 3 + 2) * 8 + (bhn & 7)) * SEQ * HD;
                    const int kbuf = kpar ? ATT_K1 : ATT_K0, knext = kpar ? ATT_K0 : ATT_K1;
                    if (ch == vcu) asm volatile("s_waitcnt vmcnt(0)" ::: "memory");
                    asm volatile("" : "+v"(qf[0]), "+v"(qf[1]), "+v"(qf[2]), "+v"(qf[3]));
                    ATT_BAR();
                    ATT_DMA(true, VB + base, res * 256, 0, 8, ATT_V, false);
                    if (ch + G < NCH) { ATT_DMA(false, KB + basen, resn * 256, 0, 8, knext, true);
                        ATT_ROUND(2, res * 256, 32 * wave, 32 * wave - 128, wave - 4, kbuf, 4, res, PB + (size_t)bh * SEQ * HD, PL + (size_t)bh * SEQ, 0, 4, QB + basen, resn * 256 + 32 * wave + r32); }
                    else { ATT_ROUND(2, res * 256, 32 * wave, 32 * wave - 128, wave - 4, kbuf, 4, res, PB + (size_t)bh * SEQ * HD, PL + (size_t)bh * SEQ, 0, 0, QB + basen, resn * 256 + 32 * wave + r32); }
#pragma unroll
                    for (int ks = 0; ks < 4; ++ks) qf[ks] = qn[ks];
                }
                asm volatile("s_waitcnt vmcnt(0)" ::: "memory"); ATT_BAR();
            }
            GRID_BAR(6);
            for (int item = vcu; item < BATCH * HPG * 4; item += G) {
                const int span = item & 3, h = (item >> 2) & 7, b = item >> 5, bh = b * 8 + h;
                bf16* pbo = PB + (size_t)bh * SEQ * HD; float* pbl = PL + (size_t)bh * SEQ;
                const size_t base1 = (size_t)((b * 3 + 1) * 8 + h) * SEQ * HD, base0 = (size_t)((b * 3 + 0) * 8 + h) * SEQ * HD;
#define ITEM_RND(RD, G_, BASE_, RROW_, QB0_, TSH_, TOK0_) const int G_ = (RD) < 4 ? 1 : 0; const size_t BASE_ = (RD) < 4 ? base1 : base0; \
                const int RROW_ = (RD) < 4 ? (RD) * 1024 : 0, QB0_ = (RD) < 4 ? (span << 8) : (span << 10) + (((RD) - 4) << 8), TSH_ = (RD) < 4 ? 2 : 0, TOK0_ = (RD) < 4 ? (RD) : 0;
                { ITEM_RND(0, g_, base_, rrow_, qb0_, tsh_, tok0_)
                  ATT_LOAD_Q(qf, QB + base_, rrow_ + qb0_ + 32 * wave + r32);
                  asm volatile("s_waitcnt vmcnt(0)" ::: "memory"); ATT_BAR();
                  ATT_DMA(false, KB + base_, rrow_, qb0_ - 128, 12, ATT_K0, false); }
                for (int rd = 0; rd < 8; ++rd) {
                    ITEM_RND(rd, g, base, rrow, qb0, tsh, tok0)
                    const int rdn = rd + 1 < 8 ? rd + 1 : rd; ITEM_RND(rdn, gn, basen, rrown, qb0n, tshn, tok0n)
                    const int kbuf = (rd & 1) ? ATT_K1 : ATT_K0, knext = (rd & 1) ? ATT_K0 : ATT_K1;
                    if (rd == 0 || rd == 4) asm volatile("s_waitcnt vmcnt(0)" ::: "memory");
                    asm volatile("" : "+v"(qf[0]), "+v"(qf[1]), "+v"(qf[2]), "+v"(qf[3]));
                    ATT_BAR();
                    ATT_DMA(true, VB + base, rrow, qb0 - 128, 12, ATT_V, false);
                    if (rd + 1 < 8) { ATT_DMA(false, KB + basen, rrown, qb0n - 128, 12, knext, true);
                        ATT_ROUND(g, rrow, qb0 + 32 * wave, qb0 + 32 * wave - 128, wave, kbuf, tsh, tok0, pbo, pbl, (size_t)b * SEQ, 6, QB + basen, rrown + qb0n + 32 * wave + r32); }
                    else { ATT_ROUND(g, rrow, qb0 + 32 * wave, qb0 + 32 * wave - 128, wave, kbuf, tsh, tok0, pbo, pbl, (size_t)b * SEQ, 0, QB + basen, rrown + qb0n + 32 * wave + r32); }
#pragma unroll
                    for (int ks = 0; ks < 4; ++ks) qf[ks] = qn[ks];
                }
#undef ITEM_RND
            }
            asm volatile("s_waitcnt vmcnt(0)" ::: "memory"); ATT_BAR();
#undef ATT_BAR
#undef ATT_DMA
#undef ATT_ROUND
#undef ATT_LOAD_Q
#undef ATT_LOAD_P
        }
        if (BOTH(3)) GRID_BAR(3);
    }

    if (IN(4)) {
        { pg8::Gemm g{A2, W2, M, DM, DM}; pg8::StaticOrder S; S.init(M, DM, G, bx);
          pg8::EpiMerge2 E{(const unsigned char*)SG, MG};
          pg8::gemm_phase<pg8::EpiMerge2, pg8::StaticOrder, true, true>(lds + RING_OFF, g, S, E); }
        if (BOTH(4)) GRID_BAR(4);
    }

    if (IN(5)) {
        pg8::Gemm g{MG, WO, M, DM, DM}; pg8::StaticOrder S; S.init(M, DM, G, bx);
        pg8::EpiOut E{x, out, ADA};
        pg8::gemm_phase<pg8::EpiOut, pg8::StaticOrder, true, true>(lds + RING_OFF, g, S, E);
    }
#undef IN
#undef BOTH
}

extern "C" void kernel_launch(void* const* d_in, const int* in_sizes, int n_in, void* d_out, int out_size, void* d_ws, size_t ws_size, hipStream_t stream) {
    static int grid = 0;
    if (grid == 0) {
        if (n_in != 16 || in_sizes[0] != M * DM || out_size != M * DM || ws_size < WS_END) { fprintf(stderr, "kernel_launch: unexpected shapes (n_in %d, in0 %d, out %d, ws %zu)\n", n_in, n_in > 0 ? in_sizes[0] : -1, out_size, ws_size); grid = -1; return; }
        int dev = 0, cus = 0, per_cu = 0;
        if (hipGetDevice(&dev) != hipSuccess || hipDeviceGetAttribute(&cus, hipDeviceAttributeMultiprocessorCount, dev) != hipSuccess) { grid = -1; return; }
        if (hipFuncSetAttribute((const void*)mega_fwd, hipFuncAttributeMaxDynamicSharedMemorySize, LDS_BYTES) != hipSuccess) { fprintf(stderr, "kernel_launch: hipFuncSetAttribute failed\n"); grid = -1; return; }
        if (hipOccupancyMaxActiveBlocksPerMultiprocessor(&per_cu, (const void*)mega_fwd, NWAVES * 64, LDS_BYTES) != hipSuccess || per_cu < 1) { fprintf(stderr, "kernel_launch: occupancy query says %d\n", per_cu); (void)hipGetLastError(); per_cu = 1; }
        if (per_cu > 1) per_cu = 1;
        grid = cus * per_cu;
    }
    if (grid < 0) return;
    (void)hipMemsetAsync((char*)d_ws + WS_CTL, 0, CTL_ZERO_BYTES, stream);
    Args a{};
    for (int i = 0; i < 16; ++i) a.in[i] = (const float*)d_in[i];
    a.out = (float*)d_out; a.ws = (unsigned char*)d_ws;
    a.ph_lo = 0; a.ph_hi = N_PHASES;
    hipLaunchKernelGGL(mega_fwd, dim3(grid), dim3(NWAVES * 64), LDS_BYTES, stream, a);
}
```

```cpp
#include <hip/hip_runtime.h>
#include <cstdio>
#include <cstdint>

namespace pg8 {
#define PG8_LAS __attribute__((address_space(3)))
typedef unsigned short bf16_t;
typedef short bf16x8 __attribute__((ext_vector_type(8)));
typedef float f32x4 __attribute__((ext_vector_type(4)));
typedef unsigned u32x4 __attribute__((ext_vector_type(4)));
constexpr int BM = 256, BK = 64, HALF = 128, HTB = HALF * BK * 2, STAGE_BYTES = 8 * HTB, NXCD = 8, WGM = 8;

__host__ __device__ __forceinline__ int lds_byte(int r, int c) { const int st = (r >> 4) * 2 + (c >> 5), rr = r & 15, cc = c & 31, ob = rr * 64 + cc * 2; return st * 1024 + (ob ^ (((ob >> 9) & 1) << 5)); }
__host__ __device__ __forceinline__ void stage_rc(int b, int& R, int& C) { const int st = b / 1024, sb = b % 1024, swz = sb ^ (((sb >> 9) & 1) << 5); R = (st >> 1) * 16 + swz / 64; C = (st & 1) * 32 + (swz % 64) / 2; }
__host__ __device__ __forceinline__ int perm32(int rho) { const int n = rho >> 4, i = rho & 15; return 8 * (i >> 2) + 4 * n + (i & 3); }

struct Unit { int pm, pn; };
struct Gemm { const bf16_t* A; const bf16_t* Bt; int M, N, K; };

struct StaticOrder {
    int nM, nN, nwg, G, c;
    __host__ __device__ void init(int M, int N, int G_, int c_) { nM = M / BM; nN = N / BM; nwg = nM * nN; G = G_; c = c_; }
    __host__ __device__ bool next(int i, Unit& u) const {
        const long L = (long)i * G + c; if (L >= nwg) return false;
        int wgid = (int)L; { const int q = nwg / NXCD, r = nwg % NXCD, xcd = wgid % NXCD, off = wgid / NXCD; wgid = (xcd < r ? xcd * (q + 1) : r * (q + 1) + (xcd - r) * q) + off; }
        const int nig = WGM * nN, gid = wgid / nig, fm = gid * WGM, gsz = (nM - fm) < WGM ? (nM - fm) : WGM;
        u.pm = fm + ((wgid % nig) % gsz); u.pn = (wgid % nig) / gsz; return true;
    }
    __device__ __forceinline__ void a_ready(const Unit&) const {}
    __device__ __forceinline__ void done(const Unit&) const {}
};

typedef float f32x2_t __attribute__((ext_vector_type(2))); typedef __bf16 bf16x2_t __attribute__((ext_vector_type(2)));
__device__ __forceinline__ unsigned cvt_pk_bf16(float lo, float hi) { f32x2_t v = {lo, hi}; bf16x2_t b = __builtin_convertvector(v, bf16x2_t); return __builtin_bit_cast(unsigned, b); }
__device__ __forceinline__ float bf_lo(unsigned w) { return __uint_as_float(w << 16); }
__device__ __forceinline__ float bf_hi(unsigned w) { return __uint_as_float(w & 0xffff0000u); }
__device__ __forceinline__ float sigmoidf_(float x) { return __builtin_amdgcn_rcpf(1.0f + __builtin_amdgcn_exp2f(-1.4426950408889634f * x)); }
__device__ __forceinline__ u32x4 pack8(const f32x4& a, const f32x4& b) { u32x4 w; w.x = cvt_pk_bf16(a[0], a[1]); w.y = cvt_pk_bf16(a[2], a[3]); w.z = cvt_pk_bf16(b[0], b[1]); w.w = cvt_pk_bf16(b[2], b[3]); return w; }


constexpr float QSCALE = 0.125f * 1.4426950408889634f;
constexpr float NORM_EPS = 1e-6f;
struct EpiIn {
    static constexpr bool PERM = true, AFTER_DRAIN = false; static constexpr int MIDK = 0;
    bf16_t *Q; size_t qkv_stride; bf16_t *ZA; size_t zc_off; bf16_t *GLU, *SG; const float *qw, *kw, *bgate;
    __device__ __forceinline__ void operator()(const f32x4 (&acc)[2][2][4][2], const Unit& u, int wr, int wc, int fr, int fq) const {
        const int pn = u.pn; const int rowb = u.pm * BM + wr * 64 + fr;
        if (pn < 18) {
            const int kind = pn / 6, rel = pn - kind * 6, g = rel >> 1, hb = ((rel & 1) << 2) + wc, sh = 2 * g;
            bf16_t* base = Q + (size_t)kind * qkv_stride;
            f32x4 wv[2][2];
            if (kind < 2) { const float* w = qw; if (kind == 1) w = kw; const float sc = kind == 0 ? QSCALE : 1.0f;
#pragma unroll
                for (int bj = 0; bj < 2; ++bj)
#pragma unroll
                    for (int n = 0; n < 2; ++n) wv[bj][n] = *(const f32x4*)(w + 32 * bj + 8 * fq + 4 * n) * sc; }
#pragma unroll
            for (int ai = 0; ai < 2; ++ai)
#pragma unroll
                for (int m = 0; m < 4; ++m) {
                    const int row = rowb + ai * HALF + m * 16, b = row >> 12, t = row & 4095;
                    const int tp = ((t & ((1 << sh) - 1)) << (12 - sh)) | (t >> sh);
                    bf16_t* dst = base + ((size_t)(((b * 3 + g) * 8 + hb) * 4096 + tp) * 64 + 8 * fq);
                    f32x4 v00 = acc[ai][0][m][0], v01 = acc[ai][0][m][1], v10 = acc[ai][1][m][0], v11 = acc[ai][1][m][1];
                    if (kind < 2) {
                        f32x4 q = v00 * v00 + v01 * v01 + v10 * v10 + v11 * v11; float ss = (q[0] + q[1]) + (q[2] + q[3]);
                        ss += __shfl_xor(ss, 16); ss += __shfl_xor(ss, 32);
                        const float rstd = __builtin_amdgcn_rsqf(ss * (1.0f / 64.0f) + NORM_EPS);
                        v00 = v00 * rstd * wv[0][0]; v01 = v01 * rstd * wv[0][1]; v10 = v10 * rstd * wv[1][0]; v11 = v11 * rstd * wv[1][1];
                    }
                    __builtin_nontemporal_store(pack8(v00, v01), (u32x4*)(dst)); __builtin_nontemporal_store(pack8(v10, v11), (u32x4*)(dst + 32));
                }
        } else if (pn < 20 || (pn >= 24 && pn < 26)) {
            bf16_t* base = ZA + (pn < 20 ? (size_t)0 : zc_off); const int rel = pn < 20 ? pn - 18 : pn - 24; const int col0 = rel * BM + wc * 32 + 8 * fq;
#pragma unroll
            for (int ai = 0; ai < 2; ++ai)
#pragma unroll
                for (int m = 0; m < 4; ++m) { bf16_t* dst = base + (size_t)(rowb + ai * HALF + m * 16) * 512 + col0;
#pragma unroll
                    for (int bj = 0; bj < 2; ++bj) { f32x4 a = acc[ai][bj][m][0], b = acc[ai][bj][m][1];
#pragma unroll
                        for (int i = 0; i < 4; ++i) { a[i] = a[i] * sigmoidf_(a[i]); b[i] = b[i] * sigmoidf_(b[i]); }
                        __builtin_nontemporal_store(pack8(a, b), (u32x4*)(dst + bj * HALF)); } }
        } else if (pn < 24) {
            const int col0 = (pn - 20) * HALF + wc * 32 + 8 * fq;
#pragma unroll
            for (int ai = 0; ai < 2; ++ai)
#pragma unroll
                for (int m = 0; m < 4; ++m) { bf16_t* dst = GLU + (size_t)(rowb + ai * HALF + m * 16) * 512 + col0;
                    f32x4 a0 = acc[ai][0][m][0], a1 = acc[ai][0][m][1]; const f32x4 b0 = acc[ai][1][m][0], b1 = acc[ai][1][m][1];
#pragma unroll
                    for (int i = 0; i < 4; ++i) { a0[i] = a0[i] * sigmoidf_(b0[i]); a1[i] = a1[i] * sigmoidf_(b1[i]); }
                    __builtin_nontemporal_store(pack8(a0, a1), (u32x4*)(dst)); }
        } else {
            const int lc0 = (pn - 26) * BM + wc * 64 + 16 * fq;
            f32x4 bv[2][2];
#pragma unroll
            for (int bj = 0; bj < 2; ++bj)
#pragma unroll
                for (int n = 0; n < 2; ++n) bv[bj][n] = *(const f32x4*)(bgate + lc0 + 8 * bj + 4 * n);
#pragma unroll
            for (int ai = 0; ai < 2; ++ai)
#pragma unroll
                for (int m = 0; m < 4; ++m) { unsigned char* dst = (unsigned char*)SG + (size_t)(rowb + ai * HALF + m * 16) * 2048 + lc0;
                    u32x4 w;
#pragma unroll
                    for (int bj = 0; bj < 2; ++bj) { f32x4 a = acc[ai][bj][m][0] + bv[bj][0], b = acc[ai][bj][m][1] + bv[bj][1];
                        unsigned wa = 0u, wb = 0u;
#pragma unroll
                        for (int i = 0; i < 4; ++i) { wa = __builtin_amdgcn_cvt_pk_u8_f32(sigmoidf_(a[i]) * 255.0f, i, wa); wb = __builtin_amdgcn_cvt_pk_u8_f32(sigmoidf_(b[i]) * 255.0f, i, wb); }
                        if (bj == 0) { w.x = wa; w.y = wb; } else { w.z = wa; w.w = wb; } }
                    __builtin_nontemporal_store(w, (u32x4*)dst); }
        }
    }
};
struct EpiMerge2 {
    static constexpr bool PERM = true, AFTER_DRAIN = false; static constexpr int MIDK = 8;
    const unsigned char* SG; bf16_t* OUT;
    __device__ __forceinline__ void mid(f32x4 (&acc)[2][2][4][2], const Unit& u, int wr, int wc, int fr, int fq) const {
        asm volatile("" : "+v"(fr), "+v"(fq));
        const int rowb = u.pm * BM + wr * 64 + fr, col0 = u.pn * BM + wc * 32 + 8 * fq;
        typedef unsigned u32x2 __attribute__((ext_vector_type(2)));
#pragma unroll
        for (int ai = 0; ai < 2; ++ai)
#pragma unroll
            for (int m = 0; m < 4; ++m) { const size_t row = (size_t)(rowb + ai * HALF + m * 16);
#pragma unroll
                for (int bj = 0; bj < 2; ++bj) {
                    const u32x2 ga = *(const u32x2*)(SG + row * 2048 + col0 + bj * HALF), gc = *(const u32x2*)(SG + row * 2048 + 1024 + col0 + bj * HALF);
                    f32x4& a = acc[ai][bj][m][0]; f32x4& b = acc[ai][bj][m][1];
#pragma unroll
                    for (int i = 0; i < 4; ++i) {
                        a[i] *= (float)((ga.x >> (8 * i)) & 255u) * __builtin_amdgcn_rcpf(fmaxf((float)((gc.x >> (8 * i)) & 255u), 0.5f));
                        b[i] *= (float)((ga.y >> (8 * i)) & 255u) * __builtin_amdgcn_rcpf(fmaxf((float)((gc.y >> (8 * i)) & 255u), 0.5f)); } }
                if (m & 1) asm volatile("" ::: "memory"); }
    }
    __device__ __forceinline__ void operator()(const f32x4 (&acc)[2][2][4][2], const Unit& u, int wr, int wc, int fr, int fq) const {
        asm volatile("" : "+v"(fr), "+v"(fq));
        const int rowb = u.pm * BM + wr * 64 + fr, col0 = u.pn * BM + wc * 32 + 8 * fq;
        typedef unsigned u32x2 __attribute__((ext_vector_type(2)));
#pragma unroll
        for (int ai = 0; ai < 2; ++ai) {
            u32x2 gw[4][2];
#pragma unroll
            for (int m = 0; m < 4; ++m)
#pragma unroll
                for (int bj = 0; bj < 2; ++bj) gw[m][bj] = *(const u32x2*)(SG + (size_t)(rowb + ai * HALF + m * 16) * 2048 + 1024 + col0 + bj * HALF);
#pragma unroll
            for (int m = 0; m < 4; ++m) { const size_t row = (size_t)(rowb + ai * HALF + m * 16);
#pragma unroll
                for (int bj = 0; bj < 2; ++bj) { const u32x2 g2 = gw[m][bj];
                    f32x4 a = acc[ai][bj][m][0], b = acc[ai][bj][m][1];
#pragma unroll
                    for (int i = 0; i < 4; ++i) { a[i] *= fmaxf((float)((g2.x >> (8 * i)) & 255u), 0.5f) * (1.0f / 255.0f); b[i] *= fmaxf((float)((g2.y >> (8 * i)) & 255u), 0.5f) * (1.0f / 255.0f); }
                    *(u32x4*)(OUT + row * 1024 + col0 + bj * HALF) = pack8(a, b); } }
        }
    }
};
struct EpiOut {
    static constexpr bool PERM = true, AFTER_DRAIN = false; static constexpr int MIDK = 0;
    const float* X; float* OUT; const float* ADA; PG8_LAS unsigned char* scr;
    __device__ __forceinline__ void operator()(const f32x4 (&acc)[2][2][4][2], const Unit& u, int wr, int wc, int fr, int fq) const {
        asm volatile("" : "+v"(fr), "+v"(fq));
        const int r8 = 2 * fq + (fr >> 3), c8 = fr & 7;
        const int rowb = u.pm * BM + wr * 64 + r8, col0 = u.pn * BM + wc * 32 + 4 * c8; const int b = (u.pm * BM) >> 12;
        PG8_LAS unsigned char* w0 = scr + fr * 128 + 16 * ((2 * fq) ^ (fr & 7)); PG8_LAS unsigned char* w1 = scr + fr * 128 + 16 * ((2 * fq + 1) ^ (fr & 7));
        const PG8_LAS unsigned char* r0 = scr + r8 * 128 + 16 * (c8 ^ (r8 & 7)); const PG8_LAS unsigned char* r1 = r0 + 8 * 128;
        f32x4 gv[2];
#pragma unroll
        for (int bj = 0; bj < 2; ++bj) gv[bj] = *(const f32x4*)(ADA + (size_t)b * 3072 + 2048 + col0 + bj * HALF);
#pragma unroll
        for (int ai = 0; ai < 2; ++ai) {
            f32x4 xv[4][2][2];
#pragma unroll
            for (int m = 0; m < 4; ++m) { const size_t off = (size_t)(rowb + ai * HALF + m * 16) * 1024 + col0;
#pragma unroll
                for (int bj = 0; bj < 2; ++bj)
#pragma unroll
                    for (int h = 0; h < 2; ++h) xv[m][bj][h] = *(const f32x4*)(X + off + (size_t)h * 8 * 1024 + bj * HALF); }
#pragma unroll
            for (int m = 0; m < 4; ++m) { const size_t off = (size_t)(rowb + ai * HALF + m * 16) * 1024 + col0;
#pragma unroll
                for (int bj = 0; bj < 2; ++bj) {
                    *(PG8_LAS f32x4*)w0 = acc[ai][bj][m][0]; *(PG8_LAS f32x4*)w1 = acc[ai][bj][m][1];
                    const f32x4 t0 = *(const PG8_LAS f32x4*)r0, t1 = *(const PG8_LAS f32x4*)r1;
                    *(f32x4*)(OUT + off + bj * HALF) = xv[m][bj][0] + gv[bj] * t0;
                    *(f32x4*)(OUT + off + (size_t)8 * 1024 + bj * HALF) = xv[m][bj][1] + gv[bj] * t1; } }
        }
    }
};

template <class Epi, class Sched, bool ALIGN_EPI = false, bool SP2 = false>
__device__ __forceinline__ void gemm_phase(PG8_LAS unsigned char* lds, const Gemm g, const Sched& S, const Epi& E) {
    const int tid = threadIdx.x, wid = __builtin_amdgcn_readfirstlane(tid >> 6), lane = tid & 63, wr = wid >> 2, wc = wid & 3, fr = lane & 15, fq = lane >> 4;
    const int K = g.K, nt = K / BK;
    unsigned voffA[2], voffB[2];
#pragma unroll
    for (int i = 0; i < 2; ++i) { int R, C; stage_rc(tid * 16 + i * 8192, R, C); const int Rb = Epi::PERM ? ((R & ~31) + perm32(R & 31)) : R;
        voffA[i] = (unsigned)(R * K + C) * 2u; voffB[i] = (unsigned)(Rb * K + C) * 2u; }
    const size_t kstep = (size_t)(BK * 2);
    const size_t hstep = (size_t)HALF * K * 2;
    const size_t tstep = 2 * hstep;
    const unsigned ldsw = (unsigned)wid * 1024u;
    const int aoff = lds_byte(wr * 64 + fr, fq * 8), boff = lds_byte(wc * 32 + fr, fq * 8);
#define PG8_SA(b, h) (((b) * 2 + (h)) * HTB)
#define PG8_SB(b, h) ((4 + (b) * 2 + (h)) * HTB)
#define PG8_STAGE(bufoff, gbase, voff) do { _Pragma("unroll") for (int _i = 0; _i < 2; ++_i) \
        __builtin_amdgcn_global_load_lds((const unsigned*)((const char*)(gbase) + (voff)[_i]), (PG8_LAS unsigned*)(lds + (bufoff) + ldsw + _i * 8192), 16, 0, 0); } while (0)
#define PG8_LDA(dst, b, h) do { _Pragma("unroll") for (int m = 0; m < 4; ++m) _Pragma("unroll") for (int k = 0; k < 2; ++k) dst[m][k] = *(const PG8_LAS bf16x8*)(lds + PG8_SA(b, h) + aoff + m * 2048 + k * 1024); } while (0)
#define PG8_LDB(dst, b, h) do { _Pragma("unroll") for (int n = 0; n < 2; ++n) _Pragma("unroll") for (int k = 0; k < 2; ++k) dst[n][k] = *(const PG8_LAS bf16x8*)(lds + PG8_SB(b, h) + boff + n * 2048 + k * 1024); } while (0)
#define PG8_MMA(ai, bj, At, Bt) do { __builtin_amdgcn_s_setprio(1); _Pragma("unroll") for (int m = 0; m < 4; ++m) _Pragma("unroll") for (int n = 0; n < 2; ++n) _Pragma("unroll") for (int k = 0; k < 2; ++k) \
        acc[ai][bj][m][n] = __builtin_amdgcn_mfma_f32_16x16x32_bf16(Bt[n][k], At[m][k], acc[ai][bj][m][n], 0, 0, 0); __builtin_amdgcn_s_setprio(0); } while (0)
#define PG8_WAIT_V(n) asm volatile("s_waitcnt vmcnt(" #n ")" ::: "memory")
#define PG8_WAIT_L(n) asm volatile("s_waitcnt lgkmcnt(" #n ")" ::: "memory")
#define PG8_BAR __builtin_amdgcn_s_barrier()
#define PG8_SCHED __builtin_amdgcn_sched_barrier(0)
    Unit cur, nxt; int ui = 0;
    if (!S.next(0, cur)) return;
    f32x4 acc[2][2][4][2];
#pragma unroll
    for (int a = 0; a < 2; ++a)
#pragma unroll
        for (int b = 0; b < 2; ++b)
#pragma unroll
            for (int m = 0; m < 4; ++m)
#pragma unroll
                for (int n = 0; n < 2; ++n) acc[a][b][m][n] = (f32x4){0.f, 0.f, 0.f, 0.f};
    bf16x8 At[4][2], B0[2][2], B1[2][2];
    const char* cA = (const char*)g.A + (size_t)cur.pm * tstep; const char* cB = (const char*)g.Bt + (size_t)cur.pn * tstep;
    S.a_ready(cur);
    if constexpr (SP2) {
        PG8_STAGE(PG8_SB(0, 0), cB, voffB); PG8_STAGE(PG8_SB(0, 1), cB + hstep, voffB); PG8_STAGE(PG8_SA(0, 0), cA, voffA); PG8_STAGE(PG8_SA(0, 1), cA + hstep, voffA);
        if (wr == 1) PG8_BAR;
        PG8_WAIT_V(2); PG8_BAR;
        PG8_STAGE(PG8_SB(1, 0), cB + kstep, voffB); PG8_STAGE(PG8_SA(1, 0), cA + kstep, voffA); PG8_STAGE(PG8_SB(1, 1), cB + hstep + kstep, voffB);
        PG8_WAIT_V(6); PG8_BAR;
    } else {
        PG8_STAGE(PG8_SB(0, 0), cB, voffB); PG8_STAGE(PG8_SA(0, 0), cA, voffA); PG8_STAGE(PG8_SB(0, 1), cB + hstep, voffB); PG8_STAGE(PG8_SA(0, 1), cA + hstep, voffA);
        if (wr == 1) PG8_BAR;
        PG8_WAIT_V(4); PG8_BAR;
        PG8_STAGE(PG8_SB(1, 0), cB + kstep, voffB); PG8_STAGE(PG8_SA(1, 0), cA + kstep, voffA); PG8_STAGE(PG8_SB(1, 1), cB + hstep + kstep, voffB);
        PG8_WAIT_V(6); PG8_BAR;
    }
    for (;;) {
        const bool has_next = S.next(ui + 1, nxt);
        const char* nA = has_next ? (const char*)g.A + (size_t)nxt.pm * tstep : cA; const char* nB = has_next ? (const char*)g.Bt + (size_t)nxt.pn * tstep : cB;
        for (int t = 0; t < nt; t += 2) {
            const bool last = (t == nt - 2);
            const char* a1 = cA + (size_t)(t + 1) * kstep;
            const char* a2 = last ? nA : cA + (size_t)(t + 2) * kstep; const char* b2 = last ? nB : cB + (size_t)(t + 2) * kstep;
            const char* a3 = a2 + kstep; const char* b3 = b2 + kstep;
            if (last && has_next) S.a_ready(nxt);
            if constexpr (Epi::MIDK > 0) { if (t == Epi::MIDK) E.mid(acc, cur, wr, wc, fr, fq); }
            if constexpr (SP2) {
            PG8_LDB(B0, 0, 0); PG8_LDB(B1, 0, 1); PG8_SCHED; PG8_LDA(At, 0, 0); PG8_STAGE(PG8_SA(1, 1), a1 + hstep, voffA);
            PG8_WAIT_V(8); PG8_WAIT_L(0); PG8_BAR; PG8_MMA(0, 0, At, B0); PG8_MMA(0, 1, At, B1); PG8_BAR; PG8_SCHED;
            PG8_LDA(At, 0, 1); PG8_STAGE(PG8_SB(0, 0), b2, voffB); PG8_STAGE(PG8_SB(0, 1), b2 + hstep, voffB); PG8_STAGE(PG8_SA(0, 0), a2, voffA);
            PG8_WAIT_V(8); PG8_WAIT_L(0); PG8_BAR; PG8_MMA(1, 0, At, B0); PG8_MMA(1, 1, At, B1); PG8_BAR; PG8_SCHED;
            PG8_LDB(B0, 1, 0); PG8_LDB(B1, 1, 1); PG8_SCHED; PG8_LDA(At, 1, 0); PG8_STAGE(PG8_SA(0, 1), a2 + hstep, voffA);
            PG8_WAIT_V(8); PG8_WAIT_L(0); PG8_BAR; PG8_MMA(0, 0, At, B0); PG8_MMA(0, 1, At, B1); PG8_BAR; PG8_SCHED;
            PG8_LDA(At, 1, 1); PG8_STAGE(PG8_SB(1, 0), b3, voffB); PG8_STAGE(PG8_SB(1, 1), b3 + hstep, voffB); PG8_STAGE(PG8_SA(1, 0), a3, voffA);
            PG8_WAIT_V(8); PG8_WAIT_L(0); PG8_BAR; PG8_MMA(1, 0, At, B0); PG8_MMA(1, 1, At, B1); PG8_BAR; PG8_SCHED;
            } else {
            PG8_LDB(B0, 0, 0); PG8_SCHED; PG8_LDA(At, 0, 0); PG8_STAGE(PG8_SA(1, 1), a1 + hstep, voffA);
            PG8_WAIT_L(8); PG8_BAR; PG8_WAIT_L(0); PG8_MMA(0, 0, At, B0); PG8_BAR; PG8_SCHED;
            PG8_LDB(B1, 0, 1); PG8_STAGE(PG8_SB(0, 0), b2, voffB);
            PG8_BAR; PG8_WAIT_L(0); PG8_MMA(0, 1, At, B1); PG8_BAR;
            PG8_LDA(At, 0, 1); PG8_STAGE(PG8_SA(0, 0), a2, voffA);
            PG8_BAR; PG8_WAIT_L(0); PG8_MMA(1, 0, At, B0); PG8_BAR; PG8_SCHED;
            PG8_STAGE(PG8_SB(0, 1), b2 + hstep, voffB);
            PG8_WAIT_V(6); PG8_BAR; PG8_MMA(1, 1, At, B1); PG8_BAR;
            PG8_LDB(B0, 1, 0); PG8_SCHED; PG8_LDA(At, 1, 0); PG8_STAGE(PG8_SA(0, 1), a2 + hstep, voffA);
            PG8_WAIT_L(8); PG8_BAR; PG8_WAIT_L(0); PG8_MMA(0, 0, At, B0); PG8_BAR; PG8_SCHED;
            PG8_LDB(B1, 1, 1); PG8_STAGE(PG8_SB(1, 0), b3, voffB);
            PG8_BAR; PG8_WAIT_L(0); PG8_MMA(0, 1, At, B1); PG8_BAR;
            PG8_LDA(At, 1, 1); PG8_STAGE(PG8_SA(1, 0), a3, voffA);
            PG8_BAR; PG8_WAIT_L(0); PG8_MMA(1, 0, At, B0); PG8_BAR; PG8_SCHED;
            PG8_STAGE(PG8_SB(1, 1), b3 + hstep, voffB);
            PG8_WAIT_V(6); PG8_BAR; PG8_MMA(1, 1, At, B1); PG8_BAR;
            }
        }
        if constexpr (ALIGN_EPI) { if (wr == 0) PG8_BAR; }
        if constexpr (!Epi::AFTER_DRAIN) { E(acc, cur, wr, wc, fr, fq); S.done(cur); }
        if (!has_next) break;
#pragma unroll
        for (int a = 0; a < 2; ++a)
#pragma unroll
            for (int b = 0; b < 2; ++b)
#pragma unroll
                for (int m = 0; m < 4; ++m)
#pragma unroll
                    for (int n = 0; n < 2; ++n) acc[a][b][m][n] = (f32x4){0.f, 0.f, 0.f, 0.f};
        cur = nxt; cA = nA; cB = nB; ++ui;
        if constexpr (ALIGN_EPI) { if (wr == 1) PG8_BAR; }
    }
    PG8_WAIT_V(0);
    if constexpr (!ALIGN_EPI) { if (wr == 0) PG8_BAR; }
    PG8_BAR;
#undef PG8_SA
#undef PG8_SB
#undef PG8_STAGE
#undef PG8_LDA
#undef PG8_LDB
#undef PG8_MMA
#undef PG8_WAIT_V
#undef PG8_WAIT_L
#undef PG8_BAR
#undef PG8_SCHED
}
}

constexpr int NWAVES = 8;
constexpr int N_PHASES = 6;
constexpr int BATCH = 8, SEQ = 4096, DM = 1024, M = BATCH * SEQ;
constexpr int NIN = 8704, NHEAD = 24, NG = 3, HPG = 8, HD = 64, CW = 512, CK = 31;
constexpr int ADA_N = 3 * DM;

constexpr size_t MiB = 1u << 20;
constexpr size_t WS_CTL = 0, CTL_ZERO_BYTES = 64 * 1024;
constexpr size_t WS_ADA = 1 * MiB;
constexpr size_t WS_WIN = 422 * MiB;
constexpr size_t WS_WA = 440 * MiB, WS_WO = 442 * MiB;
constexpr size_t WS_LSE = 2 * MiB;
constexpr size_t WS_H = 448 * MiB;
constexpr size_t WS_A2A = 448 * MiB, WS_A2C = 480 * MiB;
constexpr size_t WS_Q = 38 * MiB, WS_K = 134 * MiB, WS_V = 230 * MiB;
constexpr size_t WS_T1 = 134 * MiB, WS_MG = 230 * MiB;
constexpr size_t WS_ZA = 326 * MiB, WS_GLU = 358 * MiB, WS_ZC = 390 * MiB;
constexpr size_t WS_PB = 6 * MiB;
constexpr size_t WS_END = 512 * MiB;

constexpr int RING_OFF = 0, RING_BYTES = 131072;
constexpr int ATT_K0 = 0, ATT_K1 = 49152, ATT_V = 98304, ATT_END = 147456;
constexpr int MISC_OFF = ATT_END;
constexpr int LDS_BYTES = 151552;

#define GAS __attribute__((address_space(1)))
#define LAS __attribute__((address_space(3)))
typedef unsigned short bf16;
typedef unsigned v4u __attribute__((ext_vector_type(4)));
typedef unsigned v2u __attribute__((ext_vector_type(2)));
typedef float f32x4 __attribute__((ext_vector_type(4)));
typedef float f32x2 __attribute__((ext_vector_type(2)));
typedef float f32x16 __attribute__((ext_vector_type(16)));
typedef short bf16x8 __attribute__((ext_vector_type(8)));
typedef short s16x4 __attribute__((ext_vector_type(4)));
#define RLX_AGENT __ATOMIC_RELAXED, __HIP_MEMORY_SCOPE_AGENT
#define LDS_WAIT() asm volatile("s_waitcnt lgkmcnt(0)" ::: "memory")
using pg8::cvt_pk_bf16; using pg8::bf_lo; using pg8::bf_hi; using pg8::sigmoidf_;

#define XB_TMO      128
#define XB_XCNT(j)  (256  + 64 * (j))
#define XB_XSUB(j)  (1280 + 64 * (j))
#define XB_XGEN(j)  (2304 + 64 * (j))
#define XB_TOP      3328
#define XB_TOPGEN   3392
#define XCD_BAR_WORDS 3456
#define XB_SPIN_CAP (1u << 18)
__device__ __forceinline__ unsigned xb_ld(unsigned* p)              { return __hip_atomic_load(p, __ATOMIC_RELAXED, __HIP_MEMORY_SCOPE_AGENT); }
__device__ __forceinline__ unsigned xb_add(unsigned* p, unsigned v) { return __hip_atomic_fetch_add(p, v, __ATOMIC_RELAXED, __HIP_MEMORY_SCOPE_AGENT); }
__device__ __forceinline__ unsigned xb_xcc_id() { return (unsigned)__builtin_amdgcn_s_getreg((3 << 11) | 20) & 0xFu; }
#define XB_SPIN(cond, bar) do { unsigned _sp = 0; while (cond) { __builtin_amdgcn_s_sleep(1); \
    if ((++_sp & 255u) == 0u) { if (xb_ld(&(bar)[XB_TMO])) break; if (_sp > XB_SPIN_CAP) { atomicAdd(&(bar)[XB_TMO], 1u); break; } } } } while (0)
struct XcdBarrier { unsigned* bar; unsigned x; volatile LAS unsigned* st; };
__device__ __forceinline__ XcdBarrier xcd_barrier_post(unsigned* bar, volatile LAS unsigned* st) {
    XcdBarrier b; b.bar = bar; b.x = xb_xcc_id(); b.st = st;
    if (threadIdx.x == 0) (void)xb_add(&bar[XB_XCNT(b.x)], 1u);
    return b;
}
__device__ __forceinline__ void xcd_barrier_complete(unsigned* bar, unsigned x, unsigned& nloc, unsigned& nx) {
    const unsigned G = gridDim.x * gridDim.y * gridDim.z;
    unsigned sum, cnt, mine, sp = 0u;
    for (;;) {
        sum = 0u; cnt = 0u; mine = 0u;
#pragma unroll
        for (unsigned j = 0; j < 16; ++j) { const unsigned c = xb_ld(&bar[XB_XCNT(j)]); sum += c; cnt += (c > 0u) ? 1u : 0u; mine = (j == x) ? c : mine; }
        if (sum == G) break;
        __builtin_amdgcn_s_sleep(1);
        if ((++sp & 255u) == 0u) { if (xb_ld(&bar[XB_TMO])) break; if (sp > XB_SPIN_CAP) { atomicAdd(&bar[XB_TMO], 1u); break; } }
    }
    nloc = mine > 0u ? mine : 1u; nx = cnt > 0u ? cnt : 1u;
}
__device__ __forceinline__ void xcd_barrier(const XcdBarrier& b) {
    asm volatile("s_waitcnt vmcnt(0)" ::: "memory");
    __syncthreads();
    if (threadIdx.x == 0) {
        unsigned* bar = b.bar;
        __builtin_amdgcn_s_waitcnt(0);
        unsigned nloc = b.st[0], nx = b.st[1];
        if (nloc == 0u) { xcd_barrier_complete(bar, b.x, nloc, nx); b.st[0] = nloc; b.st[1] = nx; }
        const unsigned old = xb_add(&bar[XB_XSUB(b.x)], 1u);
        const unsigned gen = old / nloc;
        if (old + 1u == (gen + 1u) * nloc) {
            __builtin_amdgcn_fence(__ATOMIC_RELEASE, "agent");
            asm volatile("s_waitcnt vmcnt(0)" ::: "memory");
            const unsigned og = xb_add(&bar[XB_TOP], 1u);
            const unsigned tg = og / nx;
            if (og + 1u == (tg + 1u) * nx) xb_add(&bar[XB_TOPGEN], 1u);
            else XB_SPIN(xb_ld(&bar[XB_TOPGEN]) == tg, bar);
            __builtin_amdgcn_fence(__ATOMIC_ACQUIRE, "agent");
            xb_add(&bar[XB_XGEN(b.x)], 1u);
            asm volatile("s_waitcnt vmcnt(0)" ::: "memory");
        } else {
            XB_SPIN(xb_ld(&bar[XB_XGEN(b.x)]) == gen, bar);
            __builtin_amdgcn_fence(__ATOMIC_ACQUIRE, "agent");
            asm volatile("s_waitcnt vmcnt(0)" ::: "memory");
        }
    }
    __syncthreads();
}

__device__ __forceinline__ float wave_sum(float v) {
#pragma unroll
    for (int o = 1; o < 64; o <<= 1) v += __shfl_xor(v, o);
    return v;
}
__device__ __forceinline__ unsigned f2bf(float f) { unsigned u = __builtin_bit_cast(unsigned, f); return (u + 0x7fffu + ((u >> 16) & 1u)) >> 16; }
__device__ __forceinline__ unsigned pk2(float lo, float hi) { return f2bf(lo) | (f2bf(hi) << 16); }

__device__ __forceinline__ int win_phys(int n0) {
    if (n0 < 4608) { const int reg = n0 / 1536, c = n0 - reg * 1536, head = c >> 6, dh = (c >> 5) & 1; return (reg * 6 + (head >> 2)) * 256 + 128 * dh + 32 * (head & 3); }
    if (n0 >= 5120 && n0 < 6144) { const int c = n0 - 5120, half = c >> 9, cc = c & 511; return (20 + (cc >> 7)) * 256 + 128 * half + (cc & 127); }
    return n0;
}
__device__ __forceinline__ int win_phys_g(int n) { const int c = n - 6656, cl = c & 255; return 6656 + (c & ~255) + 128 * ((cl >> 3) & 1) + 32 * (cl >> 6) + 8 * ((cl >> 4) & 3) + (cl & 7); }
template <bool WIN>
__device__ __forceinline__ void p0_transpose_item(const float* W, int K, int N, bf16* WT, LAS float* scr, int item, int lane, int ldt = 0) {
    if (ldt == 0) ldt = K;
    const int nblk = N / 32, kb = item / nblk, nb = item % nblk, k0 = 64 * kb, n0 = 32 * nb;
    const int prow = WIN ? win_phys(n0) : n0;
#pragma unroll 8
    for (int i = 0; i < 32; ++i) { const int kk = 2 * i + (lane >> 5); scr[kk * 33 + (lane & 31)] = __builtin_nontemporal_load(W + (size_t)(k0 + kk) * N + n0 + (lane & 31)); }
    LDS_WAIT(); asm volatile("" ::: "memory");
    const int c = lane & 7;
#pragma unroll
    for (int j = 0; j < 4; ++j) { const int n = (lane >> 3) + 8 * j; const LAS float* s = scr + (8 * c) * 33 + n;
        v4u o; o.x = pk2(s[0 * 33], s[1 * 33]); o.y = pk2(s[2 * 33], s[3 * 33]); o.z = pk2(s[4 * 33], s[5 * 33]); o.w = pk2(s[6 * 33], s[7 * 33]);
        const int rown = (WIN && n0 >= 6656) ? win_phys_g(n0 + n) : prow + n;
        *(GAS v4u*)(WT + (size_t)rown * ldt + k0 + 8 * c) = o; }
    LDS_WAIT(); asm volatile("" ::: "memory");
}

struct Args { const float* in[16]; float* out; unsigned char* ws; int ph_lo, ph_hi; };
__device__ __forceinline__ int crow(int r, int hi) { return (r & 3) + 8 * (r >> 2) + 4 * hi; }
__device__ __forceinline__ s16x4 vtr(const LAS char* p) { typedef short v4i16_t __attribute__((ext_vector_type(4))); return __builtin_bit_cast(s16x4, __builtin_amdgcn_ds_read_tr16_b64_v4i16((LAS v4i16_t*)p)); }

__device__ __forceinline__ void glds16s(const void* sbase, unsigned voff, unsigned lds_dst) { unsigned keep;
    const unsigned long long sb = (unsigned long long)sbase;
    const unsigned lo = (unsigned)__builtin_amdgcn_readfirstlane((int)(unsigned)sb), hi = (unsigned)__builtin_amdgcn_readfirstlane((int)(unsigned)(sb >> 32));
    const unsigned long long sbu = ((unsigned long long)hi << 32) | lo;
    asm volatile("s_mov_b32 %0, m0\n\ts_mov_b32 m0, %3\n\ts_nop 4\n\tglobal_load_lds_dwordx4 %1, %2\n\ts_mov_b32 m0, %0" : "=&s"(keep) : "v"(voff), "s"(sbu), "s"(lds_dst) : "memory"); }
struct KTile { bf16x8 k[4]; };
struct VTile { v4u v[4]; };
__device__ __forceinline__ void load_k(KTile& T, const bf16* Kp, int row0, int r32, int hi) {
    const bf16* kr = Kp + (size_t)(row0 + r32) * HD + 8 * hi;
#pragma unroll
    for (int ks = 0; ks < 4; ++ks) T.k[ks] = *(const GAS bf16x8*)(kr + 16 * ks);
}
__device__ __forceinline__ void load_v(VTile& T, const bf16* Vp, int row0, int lane) {
#pragma unroll
    for (int i = 0; i < 4; ++i) { const int c = lane + 64 * i; T.v[i] = *(const GAS v4u*)(Vp + (size_t)(row0 + (c >> 3)) * HD + (c & 7) * 8); }
}
template <int TAU>
__device__ __forceinline__ void att_tile(const KTile& TK, const VTile& TV, const bf16x8 (&qf)[4], float& m, float& l, f32x16 (&o)[2], LAS char* vl, const LAS char* vrd, int lane, int r32, int hi) {
    f32x16 s = {};
#pragma unroll
    for (int ks = 0; ks < 4; ++ks) s = __builtin_amdgcn_mfma_f32_32x32x16_bf16(TK.k[ks], qf[ks], s, 0, 0, 0);
#pragma unroll
    for (int i = 0; i < 4; ++i) { const int c = lane + 64 * i, key = c >> 3, ch = c & 7; *(LAS v4u*)(vl + (ch >> 2) * 2048 + key * 64 + (ch & 3) * 16) = TV.v[i]; }
    if (TAU == 0) {
#pragma unroll
        for (int r = 0; r < 16; ++r) if (crow(r, hi) < r32) s[r] = -INFINITY;
    }
    if (TAU == 4) {
#pragma unroll
        for (int r = 0; r < 16; ++r) if (crow(r, hi) > r32) s[r] = -INFINITY;
    }
    float tm = fmaxf(fmaxf(s[0], s[1]), s[2]);
#pragma unroll
    for (int r = 3; r < 15; r += 2) tm = fmaxf(fmaxf(tm, s[r]), s[r + 1]);
    tm = fmaxf(tm, s[15]);
    tm = fmaxf(tm, __shfl_xor(tm, 32));
    if (__any(tm > m)) {
        const float mn = fmaxf(m, tm), al = __builtin_amdgcn_exp2f(m - mn);
        l *= al; o[0] = o[0] * al; o[1] = o[1] * al; m = mn;
    }
    float ps = 0.f;
#pragma unroll
    for (int r = 0; r < 16; ++r) { s[r] = __builtin_amdgcn_exp2f(s[r] - m); ps += s[r]; }
    l += ps;
    v4u pw0, pw1;
    pw0.x = cvt_pk_bf16(s[0], s[1]); pw0.y = cvt_pk_bf16(s[2], s[3]); pw0.z = cvt_pk_bf16(s[4], s[5]); pw0.w = cvt_pk_bf16(s[6], s[7]);
    pw1.x = cvt_pk_bf16(s[8], s[9]); pw1.y = cvt_pk_bf16(s[10], s[11]); pw1.z = cvt_pk_bf16(s[12], s[13]); pw1.w = cvt_pk_bf16(s[14], s[15]);
    const bf16x8 pf0 = __builtin_bit_cast(bf16x8, pw0), pf1 = __builtin_bit_cast(bf16x8, pw1);
    LDS_WAIT(); asm volatile("" ::: "memory");
#pragma unroll
    for (int d0 = 0; d0 < 2; ++d0) {
        const s16x4 a0 = vtr(vrd + d0 * 2048), a1 = vtr(vrd + d0 * 2048 + 512), a2 = vtr(vrd + d0 * 2048 + 1024), a3 = vtr(vrd + d0 * 2048 + 1536);
        const bf16x8 vf0 = (bf16x8){a0[0], a0[1], a0[2], a0[3], a1[0], a1[1], a1[2], a1[3]};
        const bf16x8 vf1 = (bf16x8){a2[0], a2[1], a2[2], a2[3], a3[0], a3[1], a3[2], a3[3]};
        o[d0] = __builtin_amdgcn_mfma_f32_32x32x16_bf16(vf0, pf0, o[d0], 0, 0, 0);
        o[d0] = __builtin_amdgcn_mfma_f32_32x32x16_bf16(vf1, pf1, o[d0], 0, 0, 0);
    }
    asm volatile("" ::: "memory");
}

__global__ void __launch_bounds__(NWAVES * 64, 2) mega_fwd(Args args) {
    extern __shared__ __attribute__((aligned(16))) unsigned char lds_raw[];
    LAS unsigned char* lds = (LAS unsigned char*)lds_raw;
    const int tid = threadIdx.x, lane = tid & 63, wave = __builtin_amdgcn_readfirstlane(tid >> 6);
    const int G = gridDim.x; const int bx = blockIdx.x; const int vcu = (G % 8 == 0) ? (bx % 8) * (G / 8) + bx / 8 : bx;
    unsigned char* ws = args.ws;
    const float* x = args.in[0]; const float* cvec = args.in[1]; const float* w_ada = args.in[2]; const float* b_ada = args.in[3]; const float* norm_w = args.in[4];
    const float* w_in = args.in[5]; const float* b_gate = args.in[6]; const float* q_norm_w = args.in[7]; const float* k_norm_w = args.in[8]; const float* w_attn_proj = args.in[9];
    const float* conv_w = args.in[10]; const float* conv_b = args.in[11]; const float* conv_ln_w = args.in[12]; const float* conv_ln_b = args.in[13];
    const float* w_conv_proj = args.in[14]; const float* w_out = args.in[15];
    float* out = args.out;
    float* ADA = (float*)(ws + WS_ADA);
    bf16* WIN = (bf16*)(ws + WS_WIN); bf16* W2 = (bf16*)(ws + WS_WA); bf16* WO = (bf16*)(ws + WS_WO);
    float* LSE = (float*)(ws + WS_LSE);
    bf16* HB = (bf16*)(ws + WS_H); bf16* A2 = (bf16*)(ws + WS_A2A);
    bf16* QB = (bf16*)(ws + WS_Q); bf16* KB = (bf16*)(ws + WS_K); bf16* VB = (bf16*)(ws + WS_V);
    bf16* MG = (bf16*)(ws + WS_MG);
    bf16* ZA = (bf16*)(ws + WS_ZA); bf16* GLU = (bf16*)(ws + WS_GLU); bf16* ZC = (bf16*)(ws + WS_ZC);
    bf16* SG = (bf16*)out;

    if (tid < 32) ((LAS unsigned*)(lds + MISC_OFF))[tid] = 0u;
    __syncthreads();
    XcdBarrier bar = xcd_barrier_post((unsigned*)(ws + WS_CTL) + 4096, (volatile LAS unsigned*)(lds + MISC_OFF) + 8);
#define GRID_BAR(k) xcd_barrier(bar)
    const int lo = args.ph_lo, hi_ph = args.ph_hi;
#define IN(k) (lo <= (k) && (k) < hi_ph)
#define BOTH(k) (IN(k) && IN((k) + 1))
    const int gw = vcu * NWAVES + wave, NGW = G * NWAVES;

    if (IN(0)) {
        {
            LAS float* sc = (LAS float*)lds; LAS float* part = (LAS float*)(lds + 32768);
            if (bx < ADA_N / 64) {
                for (int i = tid; i < BATCH * DM; i += NWAVES * 64) { const float v = cvec[i]; sc[i] = v * sigmoidf_(v); }
                __syncthreads();
                for (int item = bx; item < ADA_N / 64; item += G) {
                    const int j = item * 64 + lane; float a[BATCH];
#pragma unroll
                    for (int b = 0; b < BATCH; ++b) a[b] = 0.f;
#pragma unroll 4
                    for (int kk = 0; kk < 128; ++kk) { const int k = wave * 128 + kk; const float w = __builtin_nontemporal_load(w_ada + (size_t)k * ADA_N + j);
#pragma unroll
                        for (int b = 0; b < BATCH; ++b) a[b] += sc[b * DM + k] * w; }
#pragma unroll
                    for (int b = 0; b < BATCH; ++b) part[(wave * BATCH + b) * 64 + lane] = a[b];
                    __syncthreads();
                    { float s = b_ada[j];
#pragma unroll
                      for (int w = 0; w < NWAVES; ++w) s += part[(w * BATCH + wave) * 64 + lane];
                      ADA[(size_t)wave * ADA_N + j] = s; }
                    __syncthreads();
                }
            }
        }
        if (bx >= ADA_N / 64 || G <= ADA_N / 64) {
            LAS float* scr = (LAS float*)(lds + RING_OFF + wave * 16384);
            constexpr int I_IN = (DM / 64) * (NIN / 32), I_A = (CW / 64) * (DM / 32), I_O = (DM / 64) * (DM / 32);
            constexpr int NITEMS = I_IN + 2 * I_A + I_O;
            const int nsk = G > ADA_N / 64 ? ADA_N / 64 : 0;
            for (int it = (bx - nsk) * NWAVES + wave; it < NITEMS; it += (G - nsk) * NWAVES) {
                int r = it;
                if (r < I_IN) { p0_transpose_item<true>(w_in, DM, NIN, WIN, scr, r, lane); continue; } r -= I_IN;
                if (r < I_A) { p0_transpose_item<false>(w_attn_proj, CW, DM, W2, scr, r, lane, DM); continue; } r -= I_A;
                if (r < I_A) { p0_transpose_item<false>(w_conv_proj, CW, DM, W2 + CW, scr, r, lane, DM); continue; } r -= I_A;
                p0_transpose_item<false>(w_out, DM, DM, WO, scr, r, lane);
            }
        }
        if (BOTH(0)) GRID_BAR(0);
    }

    if (IN(1)) {
        for (int rb = gw; rb < M / 16; rb += NGW) {
            const int row0 = rb * 16, b = row0 >> 12;
            f32x4 gm[4], ga[4];
#pragma unroll
            for (int j = 0; j < 4; ++j) { const int c = 4 * lane + 256 * j;
                const f32x4 nw = *(const f32x4*)(norm_w + c), sc = *(const f32x4*)(ADA + (size_t)b * ADA_N + DM + c);
                gm[j] = nw * (sc + 1.0f); ga[j] = *(const f32x4*)(ADA + (size_t)b * ADA_N + c); }
            for (int r = 0; r < 16; ++r) {
                const GAS f32x4* xr = (const GAS f32x4*)(x + (size_t)(row0 + r) * DM) + lane;
                f32x4 v[4]; float s2 = 0.f;
#pragma unroll
                for (int j = 0; j < 4; ++j) { v[j] = __builtin_nontemporal_load(xr + 64 * j); s2 += (v[j].x * v[j].x + v[j].y * v[j].y) + (v[j].z * v[j].z + v[j].w * v[j].w); }
                const float rstd = __builtin_amdgcn_rsqf(wave_sum(s2) * (1.f / DM) + pg8::NORM_EPS);
                GAS v2u* o8 = (GAS v2u*)(HB + (size_t)(row0 + r) * DM) + lane;
#pragma unroll
                for (int j = 0; j < 4; ++j) { const f32x4 y = v[j] * rstd * gm[j] + ga[j]; v2u w; w.x = cvt_pk_bf16(y.x, y.y); w.y = cvt_pk_bf16(y.z, y.w); o8[64 * j] = w; }
            }
        }
        if (BOTH(1)) GRID_BAR(1);
    }

    if (IN(2)) {
        pg8::Gemm g{HB, WIN, M, NIN, DM}; pg8::StaticOrder S; S.init(M, NIN, G, bx);
        pg8::EpiIn E{QB, (WS_K - WS_Q) / 2, ZA, (WS_ZC - WS_ZA) / 2, GLU, SG, q_norm_w, k_norm_w, b_gate};
        pg8::gemm_phase<pg8::EpiIn, pg8::StaticOrder, true, true>(lds + RING_OFF, g, S, E);
        if (BOTH(2)) GRID_BAR(2);
    }

    if (IN(3)) {
        {
            LAS unsigned* in32 = (LAS unsigned*)lds;
            LAS float* ot = (LAS float*)(lds + 65536);
            const int cp = tid & 255, th = tid >> 8;
            float w0[CK], w1[CK];
#pragma unroll
            for (int j = 0; j < CK; ++j) { const f32x2 w = *(const f32x2*)(conv_w + j * CW + 2 * cp); w0[j] = w.x; w1[j] = w.y; }
            const f32x2 cb = *(const f32x2*)(conv_b + 2 * cp);
            v4u pf[8];
#define CONV_FETCH(TILE) { const int b_ = (TILE) >> 7, t0_ = ((TILE) & 127) * 32; \
                _Pragma("unroll") for (int i = 0; i < 8; ++i) { int c = tid + 512 * i; c = c < 62 * 64 ? c : 62 * 64 - 1; const int r = c >> 6, ch = c & 63, t = t0_ - 30 + r; \
                    v4u val = *(const GAS v4u*)(GLU + ((size_t)b_ * SEQ + (t < 0 ? 0 : t)) * CW + ch * 8); if (t < 0) val = (v4u){0u, 0u, 0u, 0u}; pf[i] = val; } }
            if (bx < M / 32) CONV_FETCH(bx)
            for (int tile = bx; tile < M / 32; tile += G) {
                const int b = tile >> 7, t0 = (tile & 127) * 32; const size_t row0 = (size_t)b * SEQ + t0;
#pragma unroll
                for (int i = 0; i < 8; ++i) { const int c = tid + 512 * i; if (c < 62 * 64) *(LAS v4u*)(lds + (size_t)c * 16) = pf[i]; }
                v4u zc[4];
#pragma unroll
                for (int q = 0; q < 4; ++q) zc[q] = *(const GAS v4u*)(ZC + (row0 + wave + 8 * q) * CW + lane * 8);
                __syncthreads();
                { const int nt_ = tile + G < M / 32 ? tile + G : tile; CONV_FETCH(nt_) }
                unsigned xs[46];
#pragma unroll
                for (int i = 0; i < 46; ++i) xs[i] = in32[(th * 16 + i) * 256 + cp];
#pragma unroll
                for (int tl = 0; tl < 16; ++tl) { float a0 = cb.x, a1 = cb.y;
#pragma unroll
                    for (int j = 0; j < CK; ++j) { const unsigned xv = xs[tl + j]; a0 += w0[j] * bf_lo(xv); a1 += w1[j] * bf_hi(xv); }
                    *(LAS f32x2*)(ot + (th * 16 + tl) * CW + 2 * cp) = (f32x2){a0, a1}; }
                __syncthreads();
                {
                    const f32x4 lw0 = *(const f32x4*)(conv_ln_w + lane * 8), lw1 = *(const f32x4*)(conv_ln_w + lane * 8 + 4);
                    const f32x4 lb0 = *(const f32x4*)(conv_ln_b + lane * 8), lb1 = *(const f32x4*)(conv_ln_b + lane * 8 + 4);
#pragma unroll
                    for (int q = 0; q < 4; ++q) { const int tl = wave + 8 * q;
                        f32x4 v0 = *(const LAS f32x4*)(ot + tl * CW + lane * 8), v1 = *(const LAS f32x4*)(ot + tl * CW + lane * 8 + 4);
                        const float mean = wave_sum((v0.x + v0.y) + (v0.z + v0.w) + (v1.x + v1.y) + (v1.z + v1.w)) * (1.f / CW);
                        v0 = v0 - mean; v1 = v1 - mean;
                        const float var = wave_sum((v0.x * v0.x + v0.y * v0.y) + (v0.z * v0.z + v0.w * v0.w) + (v1.x * v1.x + v1.y * v1.y) + (v1.z * v1.z + v1.w * v1.w)) * (1.f / CW);
                        const float rstd = __builtin_amdgcn_rsqf(var + pg8::NORM_EPS);
                        v0 = v0 * rstd * lw0 + lb0; v1 = v1 * rstd * lw1 + lb1;
                        const v4u zq = zc[q];
                        const float z[8] = {bf_lo(zq.x), bf_hi(zq.x), bf_lo(zq.y), bf_hi(zq.y), bf_lo(zq.z), bf_hi(zq.z), bf_lo(zq.w), bf_hi(zq.w)};
#pragma unroll
                        for (int i = 0; i < 4; ++i) { v0[i] = v0[i] * sigmoidf_(v0[i]) * z[i]; v1[i] = v1[i] * sigmoidf_(v1[i]) * z[4 + i]; }
                        *(GAS v4u*)(A2 + (row0 + tl) * DM + CW + lane * 8) = pg8::pack8(v0, v1); }
                }
                __syncthreads();
            }
#undef CONV_FETCH
        }
        {
            const int r32 = lane & 31, hi = lane >> 5;
            const int vrd_off = (4 * hi + ((lane & 15) >> 2)) * 64 + ((lane >> 4) & 1) * 32 + (lane & 3) * 8;
            const int piece = wave & 3, tsel = wave >> 2;
            bf16* PB = (bf16*)(ws + WS_PB); float* PL = (float*)(ws + WS_LSE);
            const unsigned lds0 = (unsigned)(uintptr_t)lds_raw;
            const unsigned voffK = (unsigned)(((8 * piece + (lane >> 3)) * HD + (((lane & 7) ^ (((8 * piece + (lane >> 3)) >> 1) & 7)) << 3)) * 2);
            const unsigned voffV = (unsigned)(((16 * (piece & 1) + (lane >> 2)) * HD + (piece >> 1) * 32 + (lane & 3) * 8) * 2);
#define ATT_BAR() do { asm volatile("s_waitcnt lgkmcnt(0)" ::: "memory"); __builtin_amdgcn_s_barrier(); asm volatile("" ::: "memory"); } while (0)
#define ATT_DMA(ISV, SRC, RROW, JSB, NT, LDSOFF, FORCE) do { \
                _Pragma("unroll") for (int m_ = 0; m_ < 6; ++m_) { const int kt_ = 2 * m_ + tsel; const int js_ = (JSB) + 32 * kt_; \
                    if (m_ < (NT) / 2 && ((FORCE) || js_ >= 0)) \
                        glds16s((SRC) + ((size_t)(RROW) + (js_ < 0 ? 0 : js_)) * HD, ISV ? voffV : voffK, (unsigned)__builtin_amdgcn_readfirstlane((int)(lds0 + (LDSOFF) + kt_ * 4096 + piece * 1024))); } } while (0)
#define ATT_ROUND(G_, RROW, IU0, JB, KTB, KBUF, TSH, TOK0, PBO, PBL, MROW0, NKN, QNP, QNROW) do { \
                    const int iq = (IU0) + r32; const int tq = (iq << (TSH)) + (TOK0); \
                    f32x16 S[5]; \
                    _Pragma("unroll") for (int tau = 0; tau < 5; ++tau) { \
                        _Pragma("unroll") for (int r = 0; r < 16; ++r) S[tau][r] = -INFINITY; \
                        if ((JB) + 32 * tau >= 0) { \
                            const LAS char* kp = (const LAS char*)(lds + (KBUF) + ((KTB) + tau) * 4096 + r32 * 128); \
                            f32x16 sacc = {}; \
                            _Pragma("unroll") for (int ks = 0; ks < 4; ++ks) { const bf16x8 kf = *(const LAS bf16x8*)(kp + (((2 * ks + hi) ^ ((r32 >> 1) & 7)) << 4)); \
                                sacc = __builtin_amdgcn_mfma_f32_32x32x16_bf16(kf, qf[ks], sacc, 0, 0, 0); } \
                            if (tau == 0) { _Pragma("unroll") for (int r = 0; r < 16; ++r) if (crow(r, hi) < r32) sacc[r] = -INFINITY; } \
                            if (tau == 4) { _Pragma("unroll") for (int r = 0; r < 16; ++r) if (crow(r, hi) > r32) sacc[r] = -INFINITY; } \
                            S[tau] = sacc; } } \
                    float mx = -INFINITY; \
                    _Pragma("unroll") for (int tau = 0; tau < 5; ++tau) _Pragma("unroll") for (int r = 0; r < 16; r += 2) mx = fmaxf(fmaxf(mx, S[tau][r]), S[tau][r + 1]); \
                    mx = fmaxf(mx, __shfl_xor(mx, 32)); \
                    float l = 0.f; v4u P[5][2]; \
                    _Pragma("unroll") for (int tau = 0; tau < 5; ++tau) { f32x16 p = S[tau]; float ps = 0.f; \
                        _Pragma("unroll") for (int r = 0; r < 16; ++r) { p[r] = __builtin_amdgcn_exp2f(p[r] - mx); ps += p[r]; } \
                        l += ps; \
                        P[tau][0].x = cvt_pk_bf16(p[0], p[1]); P[tau][0].y = cvt_pk_bf16(p[2], p[3]); P[tau][0].z = cvt_pk_bf16(p[4], p[5]); P[tau][0].w = cvt_pk_bf16(p[6], p[7]); \
                        P[tau][1].x = cvt_pk_bf16(p[8], p[9]); P[tau][1].y = cvt_pk_bf16(p[10], p[11]); P[tau][1].z = cvt_pk_bf16(p[12], p[13]); P[tau][1].w = cvt_pk_bf16(p[14], p[15]); } \
                    l += __shfl_xor(l, 32); \
                    asm volatile("s_waitcnt vmcnt(" #NKN ")" ::: "memory"); ATT_BAR();     \
                    ATT_LOAD_Q(qn, QNP, QNROW); \
                    if ((G_) < 2) ATT_LOAD_P(PBO, PBL, tq); \
                    f32x16 o[2]; o[0] = f32x16{}; o[1] = f32x16{}; \
                    _Pragma("unroll") for (int tau = 0; tau < 5; ++tau) { \
                        if ((JB) + 32 * tau >= 0) { \
                            const LAS char* vp = (const LAS char*)(lds + ATT_V + ((KTB) + tau) * 4096 + vrd_off); \
                            const bf16x8 pf0 = __builtin_bit_cast(bf16x8, P[tau][0]), pf1 = __builtin_bit_cast(bf16x8, P[tau][1]); \
                            _Pragma("unroll") for (int d0 = 0; d0 < 2; ++d0) { \
                                const s16x4 a0 = vtr(vp + d0 * 2048), a1 = vtr(vp + d0 * 2048 + 512), a2 = vtr(vp + d0 * 2048 + 1024), a3 = vtr(vp + d0 * 2048 + 1536); \
                                const bf16x8 vf0 = (bf16x8){a0[0], a0[1], a0[2], a0[3], a1[0], a1[1], a1[2], a1[3]}; \
                                const bf16x8 vf1 = (bf16x8){a2[0], a2[1], a2[2], a2[3], a3[0], a3[1], a3[2], a3[3]}; \
                                o[d0] = __builtin_amdgcn_mfma_f32_32x32x16_bf16(vf0, pf0, o[d0], 0, 0, 0); \
                                o[d0] = __builtin_amdgcn_mfma_f32_32x32x16_bf16(vf1, pf1, o[d0], 0, 0, 0); } } } \
                    float lse = mx + __builtin_amdgcn_logf(l), sc_own = __builtin_amdgcn_rcpf(l), sc_p = 0.f; \
                    if ((G_) < 2) { const float mx2 = fmaxf(lse, plse), a = __builtin_amdgcn_exp2f(lse - mx2), bq = __builtin_amdgcn_exp2f(plse - mx2), inv = __builtin_amdgcn_rcpf(a + bq); \
                        sc_own = sc_own * a * inv; sc_p = bq * inv; lse = mx2 + __builtin_amdgcn_logf(a + bq); } \
                    if ((G_) > 0) { \
                        _Pragma("unroll") for (int d0 = 0; d0 < 2; ++d0) _Pragma("unroll") for (int rg = 0; rg < 4; ++rg) { \
                            float e0 = o[d0][4 * rg] * sc_own, e1 = o[d0][4 * rg + 1] * sc_own, e2 = o[d0][4 * rg + 2] * sc_own, e3 = o[d0][4 * rg + 3] * sc_own; \
                            if ((G_) < 2) { const v2u pw = pp[d0 * 4 + rg]; e0 += sc_p * bf_lo(pw.x); e1 += sc_p * bf_hi(pw.x); e2 += sc_p * bf_lo(pw.y); e3 += sc_p * bf_hi(pw.y); } \
                            v2u w; w.x = cvt_pk_bf16(e0, e1); w.y = cvt_pk_bf16(e2, e3); \
                            *(GAS v2u*)((PBO) + (size_t)tq * HD + 32 * d0 + 8 * rg + 4 * hi) = w; } \
                        if (hi == 0) (PBL)[tq] = lse; \
                    } else { \
                        const size_t mrow = (size_t)(MROW0) + tq; \
                        v2u zz[8]; \
                        _Pragma("unroll") for (int d0 = 0; d0 < 2; ++d0) _Pragma("unroll") for (int rg = 0; rg < 4; ++rg) zz[d0 * 4 + rg] = *(const GAS v2u*)(ZA + mrow * CW + h * 64 + 32 * d0 + 8 * rg + 4 * hi); \
                        _Pragma("unroll") for (int d0 = 0; d0 < 2; ++d0) _Pragma("unroll") for (int rg = 0; rg < 4; ++rg) { const v2u pw = pp[d0 * 4 + rg]; const v2u zw = zz[d0 * 4 + rg]; \
                            const float e0 = (o[d0][4 * rg] * sc_own + sc_p * bf_lo(pw.x)) * bf_lo(zw.x), e1 = (o[d0][4 * rg + 1] * sc_own + sc_p * bf_hi(pw.x)) * bf_hi(zw.x); \
                            const float e2 = (o[d0][4 * rg + 2] * sc_own + sc_p * bf_lo(pw.y)) * bf_lo(zw.y), e3 = (o[d0][4 * rg + 3] * sc_own + sc_p * bf_hi(pw.y)) * bf_hi(zw.y); \
                            v2u w; w.x = cvt_pk_bf16(e0, e1); w.y = cvt_pk_bf16(e2, e3); \
                            *(GAS v2u*)(A2 + mrow * DM + h * 64 + 32 * d0 + 8 * rg + 4 * hi) = w; } } \
                } while (0)
#define ATT_LOAD_Q(DST, QP, ROW) do { _Pragma("unroll") for (int ks = 0; ks < 4; ++ks) DST[ks] = *(const GAS bf16x8*)((QP) + (size_t)(ROW) * HD + 16 * ks + 8 * hi); } while (0)
#define ATT_LOAD_P(PBO, PBL, TQ) do { _Pragma("unroll") for (int d0 = 0; d0 < 2; ++d0) _Pragma("unroll") for (int rg = 0; rg < 4; ++rg) pp[d0 * 4 + rg] = *(const GAS v2u*)((PBO) + (size_t)(TQ) * HD + 32 * d0 + 8 * rg + 4 * hi); \
                plse = (PBL)[TQ]; } while (0)
            bf16x8 qf[4], qn[4]; v2u pp[8]; float plse;
            {
                const int NCH = BATCH * HPG * 16;
                if (vcu < NCH) { const int bh = vcu >> 4, res = vcu & 15; const size_t base = (size_t)(((bh >> 3) * 3 + 2) * 8 + (bh & 7)) * SEQ * HD;
                    ATT_LOAD_Q(qf, QB + base, res * 256 + 32 * wave + r32);
                    asm volatile("s_waitcnt vmcnt(0)" ::: "memory"); ATT_BAR();
                    ATT_DMA(false, KB + base, res * 256, 0, 8, ATT_K0, false); }
                int kpar = 0;
                for (int ch = vcu; ch < NCH; ch += G, kpar ^= 1) {
                    const int bh = ch >> 4, res = ch & 15, b = bh >> 3, h = bh & 7; const size_t base = (size_t)((b * 3 + 2) * 8 + h) * SEQ * HD;
                    const int chn = ch + G < NCH ? ch + G : ch, bhn = chn >> 4, resn = chn & 15; const size_t basen = (size_t)(((bhn >> 3) * 3 + 2) * 8 + (bhn & 7)) * SEQ * HD;
                    const int kbuf = kpar ? ATT_K1 : ATT_K0, knext = kpar ? ATT_K0 : ATT_K1;
                    if (ch == vcu) asm volatile("s_waitcnt vmcnt(0)" ::: "memory");
                    asm volatile("" : "+v"(qf[0]), "+v"(qf[1]), "+v"(qf[2]), "+v"(qf[3]));
                    ATT_BAR();
                    ATT_DMA(true, VB + base, res * 256, 0, 8, ATT_V, false);
                    if (ch + G < NCH) { ATT_DMA(false, KB + basen, resn * 256, 0, 8, knext, true);
                        ATT_ROUND(2, res * 256, 32 * wave, 32 * wave - 128, wave - 4, kbuf, 4, res, PB + (size_t)bh * SEQ * HD, PL + (size_t)bh * SEQ, 0, 4, QB + basen, resn * 256 + 32 * wave + r32); }
                    else { ATT_ROUND(2, res * 256, 32 * wave, 32 * wave - 128, wave - 4, kbuf, 4, res, PB + (size_t)bh * SEQ * HD, PL + (size_t)bh * SEQ, 0, 0, QB + basen, resn * 256 + 32 * wave + r32); }
#pragma unroll
                    for (int ks = 0; ks < 4; ++ks) qf[ks] = qn[ks];
                }
                asm volatile("s_waitcnt vmcnt(0)" ::: "memory"); ATT_BAR();
            }
            GRID_BAR(6);
            for (int item = vcu; item < BATCH * HPG * 4; item += G) {
                const int span = item & 3, h = (item >> 2) & 7, b = item >> 5, bh = b * 8 + h;
                bf16* pbo = PB + (size_t)bh * SEQ * HD; float* pbl = PL + (size_t)bh * SEQ;
                const size_t base1 = (size_t)((b * 3 + 1) * 8 + h) * SEQ * HD, base0 = (size_t)((b * 3 + 0) * 8 + h) * SEQ * HD;
#define ITEM_RND(RD, G_, BASE_, RROW_, QB0_, TSH_, TOK0_) const int G_ = (RD) < 4 ? 1 : 0; const size_t BASE_ = (RD) < 4 ? base1 : base0; \
                const int RROW_ = (RD) < 4 ? (RD) * 1024 : 0, QB0_ = (RD) < 4 ? (span << 8) : (span << 10) + (((RD) - 4) << 8), TSH_ = (RD) < 4 ? 2 : 0, TOK0_ = (RD) < 4 ? (RD) : 0;
                { ITEM_RND(0, g_, base_, rrow_, qb0_, tsh_, tok0_)
                  ATT_LOAD_Q(qf, QB + base_, rrow_ + qb0_ + 32 * wave + r32);
                  asm volatile("s_waitcnt vmcnt(0)" ::: "memory"); ATT_BAR();
                  ATT_DMA(false, KB + base_, rrow_, qb0_ - 128, 12, ATT_K0, false); }
                for (int rd = 0; rd < 8; ++rd) {
                    ITEM_RND(rd, g, base, rrow, qb0, tsh, tok0)
                    const int rdn = rd + 1 < 8 ? rd + 1 : rd; ITEM_RND(rdn, gn, basen, rrown, qb0n, tshn, tok0n)
                    const int kbuf = (rd & 1) ? ATT_K1 : ATT_K0, knext = (rd & 1) ? ATT_K0 : ATT_K1;
                    if (rd == 0 || rd == 4) asm volatile("s_waitcnt vmcnt(0)" ::: "memory");
                    asm volatile("" : "+v"(qf[0]), "+v"(qf[1]), "+v"(qf[2]), "+v"(qf[3]));
                    ATT_BAR();
                    ATT_DMA(true, VB + base, rrow, qb0 - 128, 12, ATT_V, false);
                    if (rd + 1 < 8) { ATT_DMA(false, KB + basen, rrown, qb0n - 128, 12, knext, true);
                        ATT_ROUND(g, rrow, qb0 + 32 * wave, qb0 + 32 * wave - 128, wave, kbuf, tsh, tok0, pbo, pbl, (size_t)b * SEQ, 6, QB + basen, rrown + qb0n + 32 * wave + r32); }
                    else { ATT_ROUND(g, rrow, qb0 + 32 * wave, qb0 + 32 * wave - 128, wave, kbuf, tsh, tok0, pbo, pbl, (size_t)b * SEQ, 0, QB + basen, rrown + qb0n + 32 * wave + r32); }
#pragma unroll
                    for (int ks = 0; ks < 4; ++ks) qf[ks] = qn[ks];
                }
#undef ITEM_RND
            }
            asm volatile("s_waitcnt vmcnt(0)" ::: "memory"); ATT_BAR();
#undef ATT_BAR
#undef ATT_DMA
#undef ATT_ROUND
#undef ATT_LOAD_Q
#undef ATT_LOAD_P
        }
        if (BOTH(3)) GRID_BAR(3);
    }

    if (IN(4)) {
        { pg8::Gemm g{A2, W2, M, DM, DM}; pg8::StaticOrder S; S.init(M, DM, G, bx);
          pg8::EpiMerge2 E{(const unsigned char*)SG, MG};
          pg8::gemm_phase<pg8::EpiMerge2, pg8::StaticOrder, true, true>(lds + RING_OFF, g, S, E); }
        if (BOTH(4)) GRID_BAR(4);
    }

    if (IN(5)) {
        pg8::Gemm g{MG, WO, M, DM, DM}; pg8::StaticOrder S; S.init(M, DM, G, bx);
        pg8::EpiOut E{x, out, ADA, lds + RING_OFF + RING_BYTES + wave * 2048};
        pg8::gemm_phase<pg8::EpiOut, pg8::StaticOrder, true, true>(lds + RING_OFF, g, S, E);
    }
#undef IN
#undef BOTH
}

extern "C" void kernel_launch(void* const* d_in, const int* in_sizes, int n_in, void* d_out, int out_size, void* d_ws, size_t ws_size, hipStream_t stream) {
    static int grid = 0;
    if (grid == 0) {
        if (n_in != 16 || in_sizes[0] != M * DM || out_size != M * DM || ws_size < WS_END) { fprintf(stderr, "kernel_launch: unexpected shapes (n_in %d, in0 %d, out %d, ws %zu)\n", n_in, n_in > 0 ? in_sizes[0] : -1, out_size, ws_size); grid = -1; return; }
        int dev = 0, cus = 0, per_cu = 0;
        if (hipGetDevice(&dev) != hipSuccess || hipDeviceGetAttribute(&cus, hipDeviceAttributeMultiprocessorCount, dev) != hipSuccess) { grid = -1; return; }
        if (hipFuncSetAttribute((const void*)mega_fwd, hipFuncAttributeMaxDynamicSharedMemorySize, LDS_BYTES) != hipSuccess) { fprintf(stderr, "kernel_launch: hipFuncSetAttribute failed\n"); grid = -1; return; }
        if (hipOccupancyMaxActiveBlocksPerMultiprocessor(&per_cu, (const void*)mega_fwd, NWAVES * 64, LDS_BYTES) != hipSuccess || per_cu < 1) { fprintf(stderr, "kernel_launch: occupancy query says %d\n", per_cu); (void)hipGetLastError(); per_cu = 1; }
        if (per_cu > 1) per_cu = 1;
        grid = cus * per_cu;
    }
    if (grid < 0) return;
    (void)hipMemsetAsync((char*)d_ws + WS_CTL, 0, CTL_ZERO_BYTES, stream);
    Args a{};
    for (int i = 0; i < 16; ++i) a.in[i] = (const float*)d_in[i];
    a.out = (float*)d_out; a.ws = (unsigned char*)d_ws;
    a.ph_lo = 0; a.ph_hi = N_PHASES;
    hipLaunchKernelGGL(mega_fwd, dim3(grid), dim3(NWAVES * 64), LDS_BYTES, stream, a);
}
```

```cpp
#include <hip/hip_runtime.h>
#include <cstdio>
#include <cstdint>

namespace pg8 {
#define PG8_LAS __attribute__((address_space(3)))
typedef unsigned short bf16_t;
typedef short bf16x8 __attribute__((ext_vector_type(8)));
typedef float f32x4 __attribute__((ext_vector_type(4)));
typedef unsigned u32x4 __attribute__((ext_vector_type(4)));
constexpr int BM = 256, BK = 64, HALF = 128, HTB = HALF * BK * 2, STAGE_BYTES = 8 * HTB, NXCD = 8, WGM = 8;

__host__ __device__ __forceinline__ int lds_byte(int r, int c) { const int st = (r >> 4) * 2 + (c >> 5), rr = r & 15, cc = c & 31, ob = rr * 64 + cc * 2; return st * 1024 + (ob ^ (((ob >> 9) & 1) << 5)); }
__host__ __device__ __forceinline__ void stage_rc(int b, int& R, int& C) { const int st = b / 1024, sb = b % 1024, swz = sb ^ (((sb >> 9) & 1) << 5); R = (st >> 1) * 16 + swz / 64; C = (st & 1) * 32 + (swz % 64) / 2; }
__host__ __device__ __forceinline__ int perm32(int rho) { const int n = rho >> 4, i = rho & 15; return 8 * (i >> 2) + 4 * n + (i & 3); }

struct Unit { int pm, pn; };
struct Gemm { const bf16_t* A; const bf16_t* Bt; int M, N, K; };

struct StaticOrder {
    int nM, nN, nwg, G, c;
    __host__ __device__ void init(int M, int N, int G_, int c_) { nM = M / BM; nN = N / BM; nwg = nM * nN; G = G_; c = c_; }
    __host__ __device__ bool next(int i, Unit& u) const {
        const long L = (long)i * G + c; if (L >= nwg) return false;
        int wgid = (int)L; { const int q = nwg / NXCD, r = nwg % NXCD, xcd = wgid % NXCD, off = wgid / NXCD; wgid = (xcd < r ? xcd * (q + 1) : r * (q + 1) + (xcd - r) * q) + off; }
        const int nig = WGM * nN, gid = wgid / nig, fm = gid * WGM, gsz = (nM - fm) < WGM ? (nM - fm) : WGM;
        u.pm = fm + ((wgid % nig) % gsz); u.pn = (wgid % nig) / gsz; return true;
    }
    __device__ __forceinline__ void a_ready(const Unit&) const {}
    __device__ __forceinline__ void done(const Unit&) const {}
};

typedef float f32x2_t __attribute__((ext_vector_type(2))); typedef __bf16 bf16x2_t __attribute__((ext_vector_type(2)));
__device__ __forceinline__ unsigned cvt_pk_bf16(float lo, float hi) { f32x2_t v = {lo, hi}; bf16x2_t b = __builtin_convertvector(v, bf16x2_t); return __builtin_bit_cast(unsigned, b); }
__device__ __forceinline__ float bf_lo(unsigned w) { return __uint_as_float(w << 16); }
__device__ __forceinline__ float bf_hi(unsigned w) { return __uint_as_float(w & 0xffff0000u); }
__device__ __forceinline__ float sigmoidf_(float x) { return __builtin_amdgcn_rcpf(1.0f + __builtin_amdgcn_exp2f(-1.4426950408889634f * x)); }
__device__ __forceinline__ u32x4 pack8(const f32x4& a, const f32x4& b) { u32x4 w; w.x = cvt_pk_bf16(a[0], a[1]); w.y = cvt_pk_bf16(a[2], a[3]); w.z = cvt_pk_bf16(b[0], b[1]); w.w = cvt_pk_bf16(b[2], b[3]); return w; }


constexpr float QSCALE = 0.125f * 1.4426950408889634f;
constexpr float NORM_EPS = 1e-6f;
#define PG8_XPOSE(P0, P1, T0, T1) do { *(PG8_LAS u32x4*)xw0 = (P0); *(PG8_LAS u32x4*)xw1 = (P1); T0 = *(const PG8_LAS u32x4*)xr0; T1 = *(const PG8_LAS u32x4*)(xr0 + 1024); } while (0)
#define PG8_XPOSE_ADDR PG8_LAS unsigned char* xw0 = scr + fr * 128 + 16 * (fq ^ (fr & 7)); PG8_LAS unsigned char* xw1 = scr + fr * 128 + 16 * ((4 + fq) ^ (fr & 7)); \
        const int r8 = 2 * fq + (fr >> 3), c8 = fr & 7; const PG8_LAS unsigned char* xr0 = scr + r8 * 128 + 16 * (c8 ^ (r8 & 7));
__device__ __forceinline__ size_t sg_frag(int pm, int t, int ai, int m, int wave, int lane) { return ((((((size_t)pm * 8 + t) * 2 + ai) * 4 + m) * 8 + wave) * 64 + lane) * 16; }
struct EpiIn {
    static constexpr bool PERM = true, AFTER_DRAIN = false; static constexpr int MIDK = 0;
    bf16_t *Q; size_t qkv_stride; bf16_t *ZA; size_t zc_off; bf16_t *GLU; unsigned char* SG; const float *qw, *kw, *bgate; PG8_LAS unsigned char* scr;
    __device__ __forceinline__ void operator()(const f32x4 (&acc)[2][2][4][2], const Unit& u, int wr, int wc, int fr, int fq) const {
        const int pn = u.pn;
        PG8_XPOSE_ADDR
        const int rown = u.pm * BM + wr * 64 + r8;
        if (pn < 18) {
            const int kind = pn / 6, rel = pn - kind * 6, g = rel >> 1, hb = ((rel & 1) << 2) + wc, sh = 2 * g;
            bf16_t* base = Q + (size_t)kind * qkv_stride;
            f32x4 wv[2][2];
            if (kind < 2) { const float* w = qw; if (kind == 1) w = kw; const float sc = kind == 0 ? QSCALE : 1.0f;
#pragma unroll
                for (int bj = 0; bj < 2; ++bj)
#pragma unroll
                    for (int n = 0; n < 2; ++n) wv[bj][n] = *(const f32x4*)(w + 32 * bj + 8 * fq + 4 * n) * sc; }
#pragma unroll
            for (int ai = 0; ai < 2; ++ai)
#pragma unroll
                for (int m = 0; m < 4; ++m) {
                    f32x4 v00 = acc[ai][0][m][0], v01 = acc[ai][0][m][1], v10 = acc[ai][1][m][0], v11 = acc[ai][1][m][1];
                    if (kind < 2) {
                        f32x4 q = v00 * v00 + v01 * v01 + v10 * v10 + v11 * v11; float ss = (q[0] + q[1]) + (q[2] + q[3]);
                        ss += __shfl_xor(ss, 16); ss += __shfl_xor(ss, 32);
                        const float rstd = __builtin_amdgcn_rsqf(ss * (1.0f / 64.0f) + NORM_EPS);
                        v00 = v00 * rstd * wv[0][0]; v01 = v01 * rstd * wv[0][1]; v10 = v10 * rstd * wv[1][0]; v11 = v11 * rstd * wv[1][1];
                    }
                    u32x4 t0, t1; PG8_XPOSE(pack8(v00, v01), pack8(v10, v11), t0, t1);
#pragma unroll
                    for (int h = 0; h < 2; ++h) { const int row = rown + ai * HALF + m * 16 + 8 * h, b = row >> 12, t = row & 4095;
                        const int tp = ((t & ((1 << sh) - 1)) << (12 - sh)) | (t >> sh);
                        __builtin_nontemporal_store(h ? t1 : t0, (u32x4*)(base + ((size_t)(((b * 3 + g) * 8 + hb) * 4096 + tp) * 64 + 8 * c8))); }
                }
        } else if (pn < 20 || (pn >= 24 && pn < 26)) {
            bf16_t* base = ZA + (pn < 20 ? (size_t)0 : zc_off); const int rel = pn < 20 ? pn - 18 : pn - 24; const int colN = rel * BM + wc * 32 + (c8 >> 2) * HALF + 8 * (c8 & 3);
#pragma unroll
            for (int ai = 0; ai < 2; ++ai)
#pragma unroll
                for (int m = 0; m < 4; ++m) { u32x4 p[2];
#pragma unroll
                    for (int bj = 0; bj < 2; ++bj) { f32x4 a = acc[ai][bj][m][0], b = acc[ai][bj][m][1];
#pragma unroll
                        for (int i = 0; i < 4; ++i) { a[i] = a[i] * sigmoidf_(a[i]); b[i] = b[i] * sigmoidf_(b[i]); }
                        p[bj] = pack8(a, b); }
                    u32x4 t0, t1; PG8_XPOSE(p[0], p[1], t0, t1);
                    bf16_t* dst = base + (size_t)(rown + ai * HALF + m * 16) * 512 + colN;
                    __builtin_nontemporal_store(t0, (u32x4*)dst); __builtin_nontemporal_store(t1, (u32x4*)(dst + 8 * 512)); }
        } else if (pn < 24) {
            const int colN = (pn - 20) * HALF + wc * 32 + 8 * (c8 & 3);
#pragma unroll
            for (int ai = 0; ai < 2; ++ai)
#pragma unroll
                for (int mp = 0; mp < 2; ++mp) { u32x4 p[2];
#pragma unroll
                    for (int q = 0; q < 2; ++q) { const int m = 2 * mp + q;
                        f32x4 a0 = acc[ai][0][m][0], a1 = acc[ai][0][m][1]; const f32x4 b0 = acc[ai][1][m][0], b1 = acc[ai][1][m][1];
#pragma unroll
                        for (int i = 0; i < 4; ++i) { a0[i] = a0[i] * sigmoidf_(b0[i]); a1[i] = a1[i] * sigmoidf_(b1[i]); }
                        p[q] = pack8(a0, a1); }
                    u32x4 t0, t1; PG8_XPOSE(p[0], p[1], t0, t1);
                    bf16_t* dst = GLU + (size_t)(rown + ai * HALF + (2 * mp + (c8 >> 2)) * 16) * 512 + colN;
                    __builtin_nontemporal_store(t0, (u32x4*)dst); __builtin_nontemporal_store(t1, (u32x4*)(dst + 8 * 512)); }
        } else {
            const int t = pn - 26; const int gc0 = t * BM + wc * 32 + 8 * fq;
            f32x4 bv[2][2];
#pragma unroll
            for (int bj = 0; bj < 2; ++bj)
#pragma unroll
                for (int n = 0; n < 2; ++n) bv[bj][n] = *(const f32x4*)(bgate + gc0 + HALF * bj + 4 * n);
#pragma unroll
            for (int ai = 0; ai < 2; ++ai)
#pragma unroll
                for (int m = 0; m < 4; ++m) {
                    u32x4 w;
#pragma unroll
                    for (int bj = 0; bj < 2; ++bj) { f32x4 a = acc[ai][bj][m][0] + bv[bj][0], b = acc[ai][bj][m][1] + bv[bj][1];
                        unsigned wa = 0u, wb = 0u;
#pragma unroll
                        for (int i = 0; i < 4; ++i) { wa = __builtin_amdgcn_cvt_pk_u8_f32(sigmoidf_(a[i]) * 255.0f, i, wa); wb = __builtin_amdgcn_cvt_pk_u8_f32(sigmoidf_(b[i]) * 255.0f, i, wb); }
                        if (bj == 0) { w.x = wa; w.y = wb; } else { w.z = wa; w.w = wb; } }
                    __builtin_nontemporal_store(w, (u32x4*)(SG + sg_frag(u.pm, t, ai, m, wr * 4 + wc, fq * 16 + fr))); }
        }
    }
};
struct EpiMerge2 {
    static constexpr bool PERM = true, AFTER_DRAIN = false; static constexpr int MIDK = 8;
    const unsigned char* SG; bf16_t* OUT; PG8_LAS unsigned char* scr;
    __device__ __forceinline__ void mid(f32x4 (&acc)[2][2][4][2], const Unit& u, int wr, int wc, int fr, int fq) const {
        asm volatile("" : "+v"(fr), "+v"(fq));
        const int wave = wr * 4 + wc, lane = fq * 16 + fr;
#pragma unroll
        for (int ai = 0; ai < 2; ++ai)
#pragma unroll
            for (int m = 0; m < 4; ++m) {
                const u32x4 ga = *(const u32x4*)(SG + sg_frag(u.pm, u.pn, ai, m, wave, lane)), gc = *(const u32x4*)(SG + sg_frag(u.pm, u.pn + 4, ai, m, wave, lane));
#pragma unroll
                for (int bj = 0; bj < 2; ++bj) {
                    const unsigned gax = bj ? ga.z : ga.x, gay = bj ? ga.w : ga.y, gcx = bj ? gc.z : gc.x, gcy = bj ? gc.w : gc.y;
                    f32x4& a = acc[ai][bj][m][0]; f32x4& b = acc[ai][bj][m][1];
#pragma unroll
                    for (int i = 0; i < 4; ++i) {
                        a[i] *= (float)((gax >> (8 * i)) & 255u) * __builtin_amdgcn_rcpf(fmaxf((float)((gcx >> (8 * i)) & 255u), 0.5f));
                        b[i] *= (float)((gay >> (8 * i)) & 255u) * __builtin_amdgcn_rcpf(fmaxf((float)((gcy >> (8 * i)) & 255u), 0.5f)); } }
                if (m & 1) asm volatile("" ::: "memory"); }
    }
    __device__ __forceinline__ void operator()(const f32x4 (&acc)[2][2][4][2], const Unit& u, int wr, int wc, int fr, int fq) const {
        asm volatile("" : "+v"(fr), "+v"(fq));
        const int wave = wr * 4 + wc, lane = fq * 16 + fr;
        PG8_XPOSE_ADDR
        const int rown = u.pm * BM + wr * 64 + r8, colN = u.pn * BM + wc * 32 + (c8 >> 2) * HALF + 8 * (c8 & 3);
#pragma unroll
        for (int ai = 0; ai < 2; ++ai) {
            u32x4 gw[4];
#pragma unroll
            for (int m = 0; m < 4; ++m) gw[m] = *(const u32x4*)(SG + sg_frag(u.pm, u.pn + 4, ai, m, wave, lane));
#pragma unroll
            for (int m = 0; m < 4; ++m) { u32x4 p[2];
#pragma unroll
                for (int bj = 0; bj < 2; ++bj) { const unsigned gx = bj ? gw[m].z : gw[m].x, gy = bj ? gw[m].w : gw[m].y;
                    f32x4 a = acc[ai][bj][m][0], b = acc[ai][bj][m][1];
#pragma unroll
                    for (int i = 0; i < 4; ++i) { a[i] *= fmaxf((float)((gx >> (8 * i)) & 255u), 0.5f) * (1.0f / 255.0f); b[i] *= fmaxf((float)((gy >> (8 * i)) & 255u), 0.5f) * (1.0f / 255.0f); }
                    p[bj] = pack8(a, b); }
                u32x4 t0, t1; PG8_XPOSE(p[0], p[1], t0, t1);
                bf16_t* dst = OUT + (size_t)(rown + ai * HALF + m * 16) * 1024 + colN;
                *(u32x4*)dst = t0; *(u32x4*)(dst + 8 * 1024) = t1; }
        }
    }
};
struct EpiOut {
    static constexpr bool PERM = true, AFTER_DRAIN = false; static constexpr int MIDK = 0;
    const float* X; float* OUT; const float* ADA; PG8_LAS unsigned char* scr;
    __device__ __forceinline__ void operator()(const f32x4 (&acc)[2][2][4][2], const Unit& u, int wr, int wc, int fr, int fq) const {
        asm volatile("" : "+v"(fr), "+v"(fq));
        const int r8 = 2 * fq + (fr >> 3), c8 = fr & 7;
        const int rowb = u.pm * BM + wr * 64 + r8, col0 = u.pn * BM + wc * 32 + 4 * c8; const int b = (u.pm * BM) >> 12;
        PG8_LAS unsigned char* w0 = scr + fr * 128 + 16 * ((2 * fq) ^ (fr & 7)); PG8_LAS unsigned char* w1 = scr + fr * 128 + 16 * ((2 * fq + 1) ^ (fr & 7));
        const PG8_LAS unsigned char* r0 = scr + r8 * 128 + 16 * (c8 ^ (r8 & 7)); const PG8_LAS unsigned char* r1 = r0 + 8 * 128;
        f32x4 gv[2];
#pragma unroll
        for (int bj = 0; bj < 2; ++bj) gv[bj] = *(const f32x4*)(ADA + (size_t)b * 3072 + 2048 + col0 + bj * HALF);
#pragma unroll
        for (int ai = 0; ai < 2; ++ai) {
            f32x4 xv[4][2][2];
#pragma unroll
            for (int m = 0; m < 4; ++m) { const size_t off = (size_t)(rowb + ai * HALF + m * 16) * 1024 + col0;
#pragma unroll
                for (int bj = 0; bj < 2; ++bj)
#pragma unroll
                    for (int h = 0; h < 2; ++h) xv[m][bj][h] = *(const f32x4*)(X + off + (size_t)h * 8 * 1024 + bj * HALF); }
#pragma unroll
            for (int m = 0; m < 4; ++m) { const size_t off = (size_t)(rowb + ai * HALF + m * 16) * 1024 + col0;
#pragma unroll
                for (int bj = 0; bj < 2; ++bj) {
                    *(PG8_LAS f32x4*)w0 = acc[ai][bj][m][0]; *(PG8_LAS f32x4*)w1 = acc[ai][bj][m][1];
                    const f32x4 t0 = *(const PG8_LAS f32x4*)r0, t1 = *(const PG8_LAS f32x4*)r1;
                    *(f32x4*)(OUT + off + bj * HALF) = xv[m][bj][0] + gv[bj] * t0;
                    *(f32x4*)(OUT + off + (size_t)8 * 1024 + bj * HALF) = xv[m][bj][1] + gv[bj] * t1; } }
        }
    }
};

template <class Epi, class Sched, bool ALIGN_EPI = false, bool SP2 = false>
__device__ __forceinline__ void gemm_phase(PG8_LAS unsigned char* lds, const Gemm g, const Sched& S, const Epi& E) {
    const int tid = threadIdx.x, wid = __builtin_amdgcn_readfirstlane(tid >> 6), lane = tid & 63, wr = wid >> 2, wc = wid & 3, fr = lane & 15, fq = lane >> 4;
    const int K = g.K, nt = K / BK;
    unsigned voffA[2], voffB[2];
#pragma unroll
    for (int i = 0; i < 2; ++i) { int R, C; stage_rc(tid * 16 + i * 8192, R, C); const int Rb = Epi::PERM ? ((R & ~31) + perm32(R & 31)) : R;
        voffA[i] = (unsigned)(R * K + C) * 2u; voffB[i] = (unsigned)(Rb * K + C) * 2u; }
    const size_t kstep = (size_t)(BK * 2);
    const size_t hstep = (size_t)HALF * K * 2;
    const size_t tstep = 2 * hstep;
    const unsigned ldsw = (unsigned)wid * 1024u;
    const int aoff = lds_byte(wr * 64 + fr, fq * 8), boff = lds_byte(wc * 32 + fr, fq * 8);
#define PG8_SA(b, h) (((b) * 2 + (h)) * HTB)
#define PG8_SB(b, h) ((4 + (b) * 2 + (h)) * HTB)
#define PG8_STAGE(bufoff, gbase, voff) do { _Pragma("unroll") for (int _i = 0; _i < 2; ++_i) \
        __builtin_amdgcn_global_load_lds((const unsigned*)((const char*)(gbase) + (voff)[_i]), (PG8_LAS unsigned*)(lds + (bufoff) + ldsw + _i * 8192), 16, 0, 0); } while (0)
#define PG8_LDA(dst, b, h) do { _Pragma("unroll") for (int m = 0; m < 4; ++m) _Pragma("unroll") for (int k = 0; k < 2; ++k) dst[m][k] = *(const PG8_LAS bf16x8*)(lds + PG8_SA(b, h) + aoff + m * 2048 + k * 1024); } while (0)
#define PG8_LDB(dst, b, h) do { _Pragma("unroll") for (int n = 0; n < 2; ++n) _Pragma("unroll") for (int k = 0; k < 2; ++k) dst[n][k] = *(const PG8_LAS bf16x8*)(lds + PG8_SB(b, h) + boff + n * 2048 + k * 1024); } while (0)
#define PG8_MMA(ai, bj, At, Bt) do { __builtin_amdgcn_s_setprio(1); _Pragma("unroll") for (int m = 0; m < 4; ++m) _Pragma("unroll") for (int n = 0; n < 2; ++n) _Pragma("unroll") for (int k = 0; k < 2; ++k) \
        acc[ai][bj][m][n] = __builtin_amdgcn_mfma_f32_16x16x32_bf16(Bt[n][k], At[m][k], acc[ai][bj][m][n], 0, 0, 0); __builtin_amdgcn_s_setprio(0); } while (0)
#define PG8_WAIT_V(n) asm volatile("s_waitcnt vmcnt(" #n ")" ::: "memory")
#define PG8_WAIT_L(n) asm volatile("s_waitcnt lgkmcnt(" #n ")" ::: "memory")
#define PG8_BAR __builtin_amdgcn_s_barrier()
#define PG8_SCHED __builtin_amdgcn_sched_barrier(0)
    Unit cur, nxt; int ui = 0;
    if (!S.next(0, cur)) return;
    f32x4 acc[2][2][4][2];
#pragma unroll
    for (int a = 0; a < 2; ++a)
#pragma unroll
        for (int b = 0; b < 2; ++b)
#pragma unroll
            for (int m = 0; m < 4; ++m)
#pragma unroll
                for (int n = 0; n < 2; ++n) acc[a][b][m][n] = (f32x4){0.f, 0.f, 0.f, 0.f};
    bf16x8 At[4][2], B0[2][2], B1[2][2];
    const char* cA = (const char*)g.A + (size_t)cur.pm * tstep; const char* cB = (const char*)g.Bt + (size_t)cur.pn * tstep;
    S.a_ready(cur);
    if constexpr (SP2) {
        PG8_STAGE(PG8_SB(0, 0), cB, voffB); PG8_STAGE(PG8_SB(0, 1), cB + hstep, voffB); PG8_STAGE(PG8_SA(0, 0), cA, voffA); PG8_STAGE(PG8_SA(0, 1), cA + hstep, voffA);
        if (wr == 1) PG8_BAR;
        PG8_WAIT_V(2); PG8_BAR;
        PG8_STAGE(PG8_SB(1, 0), cB + kstep, voffB); PG8_STAGE(PG8_SA(1, 0), cA + kstep, voffA); PG8_STAGE(PG8_SB(1, 1), cB + hstep + kstep, voffB);
        PG8_WAIT_V(6); PG8_BAR;
    } else {
        PG8_STAGE(PG8_SB(0, 0), cB, voffB); PG8_STAGE(PG8_SA(0, 0), cA, voffA); PG8_STAGE(PG8_SB(0, 1), cB + hstep, voffB); PG8_STAGE(PG8_SA(0, 1), cA + hstep, voffA);
        if (wr == 1) PG8_BAR;
        PG8_WAIT_V(4); PG8_BAR;
        PG8_STAGE(PG8_SB(1, 0), cB + kstep, voffB); PG8_STAGE(PG8_SA(1, 0), cA + kstep, voffA); PG8_STAGE(PG8_SB(1, 1), cB + hstep + kstep, voffB);
        PG8_WAIT_V(6); PG8_BAR;
    }
    for (;;) {
        const bool has_next = S.next(ui + 1, nxt);
        const char* nA = has_next ? (const char*)g.A + (size_t)nxt.pm * tstep : cA; const char* nB = has_next ? (const char*)g.Bt + (size_t)nxt.pn * tstep : cB;
        for (int t = 0; t < nt; t += 2) {
            const bool last = (t == nt - 2);
            const char* a1 = cA + (size_t)(t + 1) * kstep;
            const char* a2 = last ? nA : cA + (size_t)(t + 2) * kstep; const char* b2 = last ? nB : cB + (size_t)(t + 2) * kstep;
            const char* a3 = a2 + kstep; const char* b3 = b2 + kstep;
            if (last && has_next) S.a_ready(nxt);
            if constexpr (Epi::MIDK > 0) { if (t == Epi::MIDK) E.mid(acc, cur, wr, wc, fr, fq); }
            if constexpr (SP2) {
            PG8_LDB(B0, 0, 0); PG8_LDB(B1, 0, 1); PG8_SCHED; PG8_LDA(At, 0, 0); PG8_STAGE(PG8_SA(1, 1), a1 + hstep, voffA);
            PG8_WAIT_V(8); PG8_WAIT_L(0); PG8_BAR; PG8_MMA(0, 0, At, B0); PG8_MMA(0, 1, At, B1); PG8_BAR; PG8_SCHED;
            PG8_LDA(At, 0, 1); PG8_STAGE(PG8_SB(0, 0), b2, voffB); PG8_STAGE(PG8_SB(0, 1), b2 + hstep, voffB); PG8_STAGE(PG8_SA(0, 0), a2, voffA);
            PG8_WAIT_V(8); PG8_WAIT_L(0); PG8_BAR; PG8_MMA(1, 0, At, B0); PG8_MMA(1, 1, At, B1); PG8_BAR; PG8_SCHED;
            PG8_LDB(B0, 1, 0); PG8_LDB(B1, 1, 1); PG8_SCHED; PG8_LDA(At, 1, 0); PG8_STAGE(PG8_SA(0, 1), a2 + hstep, voffA);
            PG8_WAIT_V(8); PG8_WAIT_L(0); PG8_BAR; PG8_MMA(0, 0, At, B0); PG8_MMA(0, 1, At, B1); PG8_BAR; PG8_SCHED;
            PG8_LDA(At, 1, 1); PG8_STAGE(PG8_SB(1, 0), b3, voffB); PG8_STAGE(PG8_SB(1, 1), b3 + hstep, voffB); PG8_STAGE(PG8_SA(1, 0), a3, voffA);
            PG8_WAIT_V(8); PG8_WAIT_L(0); PG8_BAR; PG8_MMA(1, 0, At, B0); PG8_MMA(1, 1, At, B1); PG8_BAR; PG8_SCHED;
            } else {
            PG8_LDB(B0, 0, 0); PG8_SCHED; PG8_LDA(At, 0, 0); PG8_STAGE(PG8_SA(1, 1), a1 + hstep, voffA);
            PG8_WAIT_L(8); PG8_BAR; PG8_WAIT_L(0); PG8_MMA(0, 0, At, B0); PG8_BAR; PG8_SCHED;
            PG8_LDB(B1, 0, 1); PG8_STAGE(PG8_SB(0, 0), b2, voffB);
            PG8_BAR; PG8_WAIT_L(0); PG8_MMA(0, 1, At, B1); PG8_BAR;
            PG8_LDA(At, 0, 1); PG8_STAGE(PG8_SA(0, 0), a2, voffA);
            PG8_BAR; PG8_WAIT_L(0); PG8_MMA(1, 0, At, B0); PG8_BAR; PG8_SCHED;
            PG8_STAGE(PG8_SB(0, 1), b2 + hstep, voffB);
            PG8_WAIT_V(6); PG8_BAR; PG8_MMA(1, 1, At, B1); PG8_BAR;
            PG8_LDB(B0, 1, 0); PG8_SCHED; PG8_LDA(At, 1, 0); PG8_STAGE(PG8_SA(0, 1), a2 + hstep, voffA);
            PG8_WAIT_L(8); PG8_BAR; PG8_WAIT_L(0); PG8_MMA(0, 0, At, B0); PG8_BAR; PG8_SCHED;
            PG8_LDB(B1, 1, 1); PG8_STAGE(PG8_SB(1, 0), b3, voffB);
            PG8_BAR; PG8_WAIT_L(0); PG8_MMA(0, 1, At, B1); PG8_BAR;
            PG8_LDA(At, 1, 1); PG8_STAGE(PG8_SA(1, 0), a3, voffA);
            PG8_BAR; PG8_WAIT_L(0); PG8_MMA(1, 0, At, B0); PG8_BAR; PG8_SCHED;
            PG8_STAGE(PG8_SB(1, 1), b3 + hstep, voffB);
            PG8_WAIT_V(6); PG8_BAR; PG8_MMA(1, 1, At, B1); PG8_BAR;
            }
        }
        if constexpr (ALIGN_EPI) { if (wr == 0) PG8_BAR; }
        if constexpr (!Epi::AFTER_DRAIN) { E(acc, cur, wr, wc, fr, fq); S.done(cur); }
        if (!has_next) break;
#pragma unroll
        for (int a = 0; a < 2; ++a)
#pragma unroll
            for (int b = 0; b < 2; ++b)
#pragma unroll
                for (int m = 0; m < 4; ++m)
#pragma unroll
                    for (int n = 0; n < 2; ++n) acc[a][b][m][n] = (f32x4){0.f, 0.f, 0.f, 0.f};
        cur = nxt; cA = nA; cB = nB; ++ui;
        if constexpr (ALIGN_EPI) { if (wr == 1) PG8_BAR; }
    }
    PG8_WAIT_V(0);
    if constexpr (!ALIGN_EPI) { if (wr == 0) PG8_BAR; }
    PG8_BAR;
#undef PG8_SA
#undef PG8_SB
#undef PG8_STAGE
#undef PG8_LDA
#undef PG8_LDB
#undef PG8_MMA
#undef PG8_WAIT_V
#undef PG8_WAIT_L
#undef PG8_BAR
#undef PG8_SCHED
}
}

constexpr int NWAVES = 8;
constexpr int N_PHASES = 6;
constexpr int BATCH = 8, SEQ = 4096, DM = 1024, M = BATCH * SEQ;
constexpr int NIN = 8704, NHEAD = 24, NG = 3, HPG = 8, HD = 64, CW = 512, CK = 31;
constexpr int ADA_N = 3 * DM;

constexpr size_t MiB = 1u << 20;
constexpr size_t WS_CTL = 0, CTL_ZERO_BYTES = 64 * 1024;
constexpr size_t WS_ADA = 1 * MiB;
constexpr size_t WS_WIN = 422 * MiB;
constexpr size_t WS_WA = 440 * MiB, WS_WO = 442 * MiB;
constexpr size_t WS_LSE = 2 * MiB;
constexpr size_t WS_H = 448 * MiB;
constexpr size_t WS_A2A = 448 * MiB, WS_A2C = 480 * MiB;
constexpr size_t WS_Q = 38 * MiB, WS_K = 134 * MiB, WS_V = 230 * MiB;
constexpr size_t WS_T1 = 134 * MiB, WS_MG = 230 * MiB;
constexpr size_t WS_ZA = 326 * MiB, WS_GLU = 358 * MiB, WS_ZC = 390 * MiB;
constexpr size_t WS_PB = 6 * MiB;
constexpr size_t WS_END = 512 * MiB;

constexpr int RING_OFF = 0, RING_BYTES = 131072;
constexpr int ATT_K0 = 0, ATT_K1 = 49152, ATT_V = 98304, ATT_END = 147456;
constexpr int MISC_OFF = ATT_END;
constexpr int LDS_BYTES = 151552;

#define GAS __attribute__((address_space(1)))
#define LAS __attribute__((address_space(3)))
typedef unsigned short bf16;
typedef unsigned v4u __attribute__((ext_vector_type(4)));
typedef unsigned v2u __attribute__((ext_vector_type(2)));
typedef float f32x4 __attribute__((ext_vector_type(4)));
typedef float f32x2 __attribute__((ext_vector_type(2)));
typedef float f32x16 __attribute__((ext_vector_type(16)));
typedef short bf16x8 __attribute__((ext_vector_type(8)));
typedef short s16x4 __attribute__((ext_vector_type(4)));
#define RLX_AGENT __ATOMIC_RELAXED, __HIP_MEMORY_SCOPE_AGENT
#define LDS_WAIT() asm volatile("s_waitcnt lgkmcnt(0)" ::: "memory")
using pg8::cvt_pk_bf16; using pg8::bf_lo; using pg8::bf_hi; using pg8::sigmoidf_;

#define XB_TMO      128
#define XB_XCNT(j)  (256  + 64 * (j))
#define XB_XSUB(j)  (1280 + 64 * (j))
#define XB_XGEN(j)  (2304 + 64 * (j))
#define XB_TOP      3328
#define XB_TOPGEN   3392
#define XCD_BAR_WORDS 3456
#define XB_SPIN_CAP (1u << 18)
__device__ __forceinline__ unsigned xb_ld(unsigned* p)              { return __hip_atomic_load(p, __ATOMIC_RELAXED, __HIP_MEMORY_SCOPE_AGENT); }
__device__ __forceinline__ unsigned xb_add(unsigned* p, unsigned v) { return __hip_atomic_fetch_add(p, v, __ATOMIC_RELAXED, __HIP_MEMORY_SCOPE_AGENT); }
__device__ __forceinline__ unsigned xb_xcc_id() { return (unsigned)__builtin_amdgcn_s_getreg((3 << 11) | 20) & 0xFu; }
#define XB_SPIN(cond, bar) do { unsigned _sp = 0; while (cond) { __builtin_amdgcn_s_sleep(1); \
    if ((++_sp & 255u) == 0u) { if (xb_ld(&(bar)[XB_TMO])) break; if (_sp > XB_SPIN_CAP) { atomicAdd(&(bar)[XB_TMO], 1u); break; } } } } while (0)
struct XcdBarrier { unsigned* bar; unsigned x; volatile LAS unsigned* st; };
__device__ __forceinline__ XcdBarrier xcd_barrier_post(unsigned* bar, volatile LAS unsigned* st) {
    XcdBarrier b; b.bar = bar; b.x = xb_xcc_id(); b.st = st;
    if (threadIdx.x == 0) (void)xb_add(&bar[XB_XCNT(b.x)], 1u);
    return b;
}
__device__ __forceinline__ void xcd_barrier_complete(unsigned* bar, unsigned x, unsigned& nloc, unsigned& nx) {
    const unsigned G = gridDim.x * gridDim.y * gridDim.z;
    unsigned sum, cnt, mine, sp = 0u;
    for (;;) {
        sum = 0u; cnt = 0u; mine = 0u;
#pragma unroll
        for (unsigned j = 0; j < 16; ++j) { const unsigned c = xb_ld(&bar[XB_XCNT(j)]); sum += c; cnt += (c > 0u) ? 1u : 0u; mine = (j == x) ? c : mine; }
        if (sum == G) break;
        __builtin_amdgcn_s_sleep(1);
        if ((++sp & 255u) == 0u) { if (xb_ld(&bar[XB_TMO])) break; if (sp > XB_SPIN_CAP) { atomicAdd(&bar[XB_TMO], 1u); break; } }
    }
    nloc = mine > 0u ? mine : 1u; nx = cnt > 0u ? cnt : 1u;
}
__device__ __forceinline__ void xcd_barrier(const XcdBarrier& b) {
    asm volatile("s_waitcnt vmcnt(0)" ::: "memory");
    __syncthreads();
    if (threadIdx.x == 0) {
        unsigned* bar = b.bar;
        __builtin_amdgcn_s_waitcnt(0);
        unsigned nloc = b.st[0], nx = b.st[1];
        if (nloc == 0u) { xcd_barrier_complete(bar, b.x, nloc, nx); b.st[0] = nloc; b.st[1] = nx; }
        const unsigned old = xb_add(&bar[XB_XSUB(b.x)], 1u);
        const unsigned gen = old / nloc;
        if (old + 1u == (gen + 1u) * nloc) {
            __builtin_amdgcn_fence(__ATOMIC_RELEASE, "agent");
            asm volatile("s_waitcnt vmcnt(0)" ::: "memory");
            const unsigned og = xb_add(&bar[XB_TOP], 1u);
            const unsigned tg = og / nx;
            if (og + 1u == (tg + 1u) * nx) xb_add(&bar[XB_TOPGEN], 1u);
            else XB_SPIN(xb_ld(&bar[XB_TOPGEN]) == tg, bar);
            __builtin_amdgcn_fence(__ATOMIC_ACQUIRE, "agent");
            xb_add(&bar[XB_XGEN(b.x)], 1u);
            asm volatile("s_waitcnt vmcnt(0)" ::: "memory");
        } else {
            XB_SPIN(xb_ld(&bar[XB_XGEN(b.x)]) == gen, bar);
            __builtin_amdgcn_fence(__ATOMIC_ACQUIRE, "agent");
            asm volatile("s_waitcnt vmcnt(0)" ::: "memory");
        }
    }
    __syncthreads();
}

__device__ __forceinline__ float wave_sum(float v) {
#pragma unroll
    for (int o = 1; o < 64; o <<= 1) v += __shfl_xor(v, o);
    return v;
}
__device__ __forceinline__ unsigned f2bf(float f) { unsigned u = __builtin_bit_cast(unsigned, f); return (u + 0x7fffu + ((u >> 16) & 1u)) >> 16; }
__device__ __forceinline__ unsigned pk2(float lo, float hi) { return f2bf(lo) | (f2bf(hi) << 16); }

__device__ __forceinline__ int win_phys(int n0) {
    if (n0 < 4608) { const int reg = n0 / 1536, c = n0 - reg * 1536, head = c >> 6, dh = (c >> 5) & 1; return (reg * 6 + (head >> 2)) * 256 + 128 * dh + 32 * (head & 3); }
    if (n0 >= 5120 && n0 < 6144) { const int c = n0 - 5120, half = c >> 9, cc = c & 511; return (20 + (cc >> 7)) * 256 + 128 * half + (cc & 127); }
    return n0;
}
__device__ __forceinline__ int win_phys_g(int n) { return n; }
template <bool WIN>
__device__ __forceinline__ void p0_transpose_item(const float* W, int K, int N, bf16* WT, LAS float* scr, int item, int lane, int ldt = 0) {
    if (ldt == 0) ldt = K;
    const int nblk = N / 32, kb = item / nblk, nb = item % nblk, k0 = 64 * kb, n0 = 32 * nb;
    const int prow = WIN ? win_phys(n0) : n0;
#pragma unroll 8
    for (int i = 0; i < 32; ++i) { const int kk = 2 * i + (lane >> 5); scr[kk * 33 + (lane & 31)] = __builtin_nontemporal_load(W + (size_t)(k0 + kk) * N + n0 + (lane & 31)); }
    LDS_WAIT(); asm volatile("" ::: "memory");
    const int c = lane & 7;
#pragma unroll
    for (int j = 0; j < 4; ++j) { const int n = (lane >> 3) + 8 * j; const LAS float* s = scr + (8 * c) * 33 + n;
        v4u o; o.x = pk2(s[0 * 33], s[1 * 33]); o.y = pk2(s[2 * 33], s[3 * 33]); o.z = pk2(s[4 * 33], s[5 * 33]); o.w = pk2(s[6 * 33], s[7 * 33]);
        const int rown = (WIN && n0 >= 6656) ? win_phys_g(n0 + n) : prow + n;
        *(GAS v4u*)(WT + (size_t)rown * ldt + k0 + 8 * c) = o; }
    LDS_WAIT(); asm volatile("" ::: "memory");
}

struct Args { const float* in[16]; float* out; unsigned char* ws; int ph_lo, ph_hi; };
__device__ __forceinline__ int crow(int r, int hi) { return (r & 3) + 8 * (r >> 2) + 4 * hi; }
__device__ __forceinline__ s16x4 vtr(const LAS char* p) { typedef short v4i16_t __attribute__((ext_vector_type(4))); return __builtin_bit_cast(s16x4, __builtin_amdgcn_ds_read_tr16_b64_v4i16((LAS v4i16_t*)p)); }

__device__ __forceinline__ void glds16s(const void* sbase, unsigned voff, unsigned lds_dst) { unsigned keep;
    const unsigned long long sb = (unsigned long long)sbase;
    const unsigned lo = (unsigned)__builtin_amdgcn_readfirstlane((int)(unsigned)sb), hi = (unsigned)__builtin_amdgcn_readfirstlane((int)(unsigned)(sb >> 32));
    const unsigned long long sbu = ((unsigned long long)hi << 32) | lo;
    asm volatile("s_mov_b32 %0, m0\n\ts_mov_b32 m0, %3\n\ts_nop 4\n\tglobal_load_lds_dwordx4 %1, %2\n\ts_mov_b32 m0, %0" : "=&s"(keep) : "v"(voff), "s"(sbu), "s"(lds_dst) : "memory"); }
struct KTile { bf16x8 k[4]; };
struct VTile { v4u v[4]; };
__device__ __forceinline__ void load_k(KTile& T, const bf16* Kp, int row0, int r32, int hi) {
    const bf16* kr = Kp + (size_t)(row0 + r32) * HD + 8 * hi;
#pragma unroll
    for (int ks = 0; ks < 4; ++ks) T.k[ks] = *(const GAS bf16x8*)(kr + 16 * ks);
}
__device__ __forceinline__ void load_v(VTile& T, const bf16* Vp, int row0, int lane) {
#pragma unroll
    for (int i = 0; i < 4; ++i) { const int c = lane + 64 * i; T.v[i] = *(const GAS v4u*)(Vp + (size_t)(row0 + (c >> 3)) * HD + (c & 7) * 8); }
}
template <int TAU>
__device__ __forceinline__ void att_tile(const KTile& TK, const VTile& TV, const bf16x8 (&qf)[4], float& m, float& l, f32x16 (&o)[2], LAS char* vl, const LAS char* vrd, int lane, int r32, int hi) {
    f32x16 s = {};
#pragma unroll
    for (int ks = 0; ks < 4; ++ks) s = __builtin_amdgcn_mfma_f32_32x32x16_bf16(TK.k[ks], qf[ks], s, 0, 0, 0);
#pragma unroll
    for (int i = 0; i < 4; ++i) { const int c = lane + 64 * i, key = c >> 3, ch = c & 7; *(LAS v4u*)(vl + (ch >> 2) * 2048 + key * 64 + (ch & 3) * 16) = TV.v[i]; }
    if (TAU == 0) {
#pragma unroll
        for (int r = 0; r < 16; ++r) if (crow(r, hi) < r32) s[r] = -INFINITY;
    }
    if (TAU == 4) {
#pragma unroll
        for (int r = 0; r < 16; ++r) if (crow(r, hi) > r32) s[r] = -INFINITY;
    }
    float tm = fmaxf(fmaxf(s[0], s[1]), s[2]);
#pragma unroll
    for (int r = 3; r < 15; r += 2) tm = fmaxf(fmaxf(tm, s[r]), s[r + 1]);
    tm = fmaxf(tm, s[15]);
    tm = fmaxf(tm, __shfl_xor(tm, 32));
    if (__any(tm > m)) {
        const float mn = fmaxf(m, tm), al = __builtin_amdgcn_exp2f(m - mn);
        l *= al; o[0] = o[0] * al; o[1] = o[1] * al; m = mn;
    }
    float ps = 0.f;
#pragma unroll
    for (int r = 0; r < 16; ++r) { s[r] = __builtin_amdgcn_exp2f(s[r] - m); ps += s[r]; }
    l += ps;
    v4u pw0, pw1;
    pw0.x = cvt_pk_bf16(s[0], s[1]); pw0.y = cvt_pk_bf16(s[2], s[3]); pw0.z = cvt_pk_bf16(s[4], s[5]); pw0.w = cvt_pk_bf16(s[6], s[7]);
    pw1.x = cvt_pk_bf16(s[8], s[9]); pw1.y = cvt_pk_bf16(s[10], s[11]); pw1.z = cvt_pk_bf16(s[12], s[13]); pw1.w = cvt_pk_bf16(s[14], s[15]);
    const bf16x8 pf0 = __builtin_bit_cast(bf16x8, pw0), pf1 = __builtin_bit_cast(bf16x8, pw1);
    LDS_WAIT(); asm volatile("" ::: "memory");
#pragma unroll
    for (int d0 = 0; d0 < 2; ++d0) {
        const s16x4 a0 = vtr(vrd + d0 * 2048), a1 = vtr(vrd + d0 * 2048 + 512), a2 = vtr(vrd + d0 * 2048 + 1024), a3 = vtr(vrd + d0 * 2048 + 1536);
        const bf16x8 vf0 = (bf16x8){a0[0], a0[1], a0[2], a0[3], a1[0], a1[1], a1[2], a1[3]};
        const bf16x8 vf1 = (bf16x8){a2[0], a2[1], a2[2], a2[3], a3[0], a3[1], a3[2], a3[3]};
        o[d0] = __builtin_amdgcn_mfma_f32_32x32x16_bf16(vf0, pf0, o[d0], 0, 0, 0);
        o[d0] = __builtin_amdgcn_mfma_f32_32x32x16_bf16(vf1, pf1, o[d0], 0, 0, 0);
    }
    asm volatile("" ::: "memory");
}

__global__ void __launch_bounds__(NWAVES * 64, 2) mega_fwd(Args args) {
    extern __shared__ __attribute__((aligned(16))) unsigned char lds_raw[];
    LAS unsigned char* lds = (LAS unsigned char*)lds_raw;
    const int tid = threadIdx.x, lane = tid & 63, wave = __builtin_amdgcn_readfirstlane(tid >> 6);
    const int G = gridDim.x; const int bx = blockIdx.x; const int vcu = (G % 8 == 0) ? (bx % 8) * (G / 8) + bx / 8 : bx;
    unsigned char* ws = args.ws;
    const float* x = args.in[0]; const float* cvec = args.in[1]; const float* w_ada = args.in[2]; const float* b_ada = args.in[3]; const float* norm_w = args.in[4];
    const float* w_in = args.in[5]; const float* b_gate = args.in[6]; const float* q_norm_w = args.in[7]; const float* k_norm_w = args.in[8]; const float* w_attn_proj = args.in[9];
    const float* conv_w = args.in[10]; const float* conv_b = args.in[11]; const float* conv_ln_w = args.in[12]; const float* conv_ln_b = args.in[13];
    const float* w_conv_proj = args.in[14]; const float* w_out = args.in[15];
    float* out = args.out;
    float* ADA = (float*)(ws + WS_ADA);
    bf16* WIN = (bf16*)(ws + WS_WIN); bf16* W2 = (bf16*)(ws + WS_WA); bf16* WO = (bf16*)(ws + WS_WO);
    float* LSE = (float*)(ws + WS_LSE);
    bf16* HB = (bf16*)(ws + WS_H); bf16* A2 = (bf16*)(ws + WS_A2A);
    bf16* QB = (bf16*)(ws + WS_Q); bf16* KB = (bf16*)(ws + WS_K); bf16* VB = (bf16*)(ws + WS_V);
    bf16* MG = (bf16*)(ws + WS_MG);
    bf16* ZA = (bf16*)(ws + WS_ZA); bf16* GLU = (bf16*)(ws + WS_GLU); bf16* ZC = (bf16*)(ws + WS_ZC);
    bf16* SG = (bf16*)out;

    if (tid < 32) ((LAS unsigned*)(lds + MISC_OFF))[tid] = 0u;
    __syncthreads();
    XcdBarrier bar = xcd_barrier_post((unsigned*)(ws + WS_CTL) + 4096, (volatile LAS unsigned*)(lds + MISC_OFF) + 8);
#define GRID_BAR(k) xcd_barrier(bar)
    const int lo = args.ph_lo, hi_ph = args.ph_hi;
#define IN(k) (lo <= (k) && (k) < hi_ph)
#define BOTH(k) (IN(k) && IN((k) + 1))
    const int gw = vcu * NWAVES + wave, NGW = G * NWAVES;

    if (IN(0)) {
        {
            LAS float* sc = (LAS float*)lds; LAS float* part = (LAS float*)(lds + 32768);
            if (bx < ADA_N / 64) {
                for (int i = tid; i < BATCH * DM; i += NWAVES * 64) { const float v = cvec[i]; sc[i] = v * sigmoidf_(v); }
                __syncthreads();
                for (int item = bx; item < ADA_N / 64; item += G) {
                    const int j = item * 64 + lane; float a[BATCH];
#pragma unroll
                    for (int b = 0; b < BATCH; ++b) a[b] = 0.f;
#pragma unroll 4
                    for (int kk = 0; kk < 128; ++kk) { const int k = wave * 128 + kk; const float w = __builtin_nontemporal_load(w_ada + (size_t)k * ADA_N + j);
#pragma unroll
                        for (int b = 0; b < BATCH; ++b) a[b] += sc[b * DM + k] * w; }
#pragma unroll
                    for (int b = 0; b < BATCH; ++b) part[(wave * BATCH + b) * 64 + lane] = a[b];
                    __syncthreads();
                    { float s = b_ada[j];
#pragma unroll
                      for (int w = 0; w < NWAVES; ++w) s += part[(w * BATCH + wave) * 64 + lane];
                      ADA[(size_t)wave * ADA_N + j] = s; }
                    __syncthreads();
                }
            }
        }
        if (bx >= ADA_N / 64 || G <= ADA_N / 64) {
            LAS float* scr = (LAS float*)(lds + RING_OFF + wave * 16384);
            constexpr int I_IN = (DM / 64) * (NIN / 32), I_A = (CW / 64) * (DM / 32), I_O = (DM / 64) * (DM / 32);
            constexpr int NITEMS = I_IN + 2 * I_A + I_O;
            const int nsk = G > ADA_N / 64 ? ADA_N / 64 : 0;
            for (int it = (bx - nsk) * NWAVES + wave; it < NITEMS; it += (G - nsk) * NWAVES) {
                int r = it;
                if (r < I_IN) { p0_transpose_item<true>(w_in, DM, NIN, WIN, scr, r, lane); continue; } r -= I_IN;
                if (r < I_A) { p0_transpose_item<false>(w_attn_proj, CW, DM, W2, scr, r, lane, DM); continue; } r -= I_A;
                if (r < I_A) { p0_transpose_item<false>(w_conv_proj, CW, DM, W2 + CW, scr, r, lane, DM); continue; } r -= I_A;
                p0_transpose_item<false>(w_out, DM, DM, WO, scr, r, lane);
            }
        }
        if (BOTH(0)) GRID_BAR(0);
    }

    if (IN(1)) {
        for (int rb = gw; rb < M / 16; rb += NGW) {
            const int row0 = rb * 16, b = row0 >> 12;
            f32x4 gm[4], ga[4];
#pragma unroll
            for (int j = 0; j < 4; ++j) { const int c = 4 * lane + 256 * j;
                const f32x4 nw = *(const f32x4*)(norm_w + c), sc = *(const f32x4*)(ADA + (size_t)b * ADA_N + DM + c);
                gm[j] = nw * (sc + 1.0f); ga[j] = *(const f32x4*)(ADA + (size_t)b * ADA_N + c); }
            for (int r = 0; r < 16; ++r) {
                const GAS f32x4* xr = (const GAS f32x4*)(x + (size_t)(row0 + r) * DM) + lane;
                f32x4 v[4]; float s2 = 0.f;
#pragma unroll
                for (int j = 0; j < 4; ++j) { v[j] = __builtin_nontemporal_load(xr + 64 * j); s2 += (v[j].x * v[j].x + v[j].y * v[j].y) + (v[j].z * v[j].z + v[j].w * v[j].w); }
                const float rstd = __builtin_amdgcn_rsqf(wave_sum(s2) * (1.f / DM) + pg8::NORM_EPS);
                GAS v2u* o8 = (GAS v2u*)(HB + (size_t)(row0 + r) * DM) + lane;
#pragma unroll
                for (int j = 0; j < 4; ++j) { const f32x4 y = v[j] * rstd * gm[j] + ga[j]; v2u w; w.x = cvt_pk_bf16(y.x, y.y); w.y = cvt_pk_bf16(y.z, y.w); o8[64 * j] = w; }
            }
        }
        if (BOTH(1)) GRID_BAR(1);
    }

    if (IN(2)) {
        pg8::Gemm g{HB, WIN, M, NIN, DM}; pg8::StaticOrder S; S.init(M, NIN, G, bx);
        pg8::EpiIn E{QB, (WS_K - WS_Q) / 2, ZA, (WS_ZC - WS_ZA) / 2, GLU, (unsigned char*)SG, q_norm_w, k_norm_w, b_gate, lds + RING_OFF + RING_BYTES + wave * 2048};
        pg8::gemm_phase<pg8::EpiIn, pg8::StaticOrder, true, true>(lds + RING_OFF, g, S, E);
        if (BOTH(2)) GRID_BAR(2);
    }

    if (IN(3)) {
        {
            LAS unsigned* in32 = (LAS unsigned*)lds;
            LAS float* ot = (LAS float*)(lds + 65536);
            const int cp = tid & 255, th = tid >> 8;
            float w0[CK], w1[CK];
#pragma unroll
            for (int j = 0; j < CK; ++j) { const f32x2 w = *(const f32x2*)(conv_w + j * CW + 2 * cp); w0[j] = w.x; w1[j] = w.y; }
            const f32x2 cb = *(const f32x2*)(conv_b + 2 * cp);
            v4u pf[8];
#define CONV_FETCH(TILE) { const int b_ = (TILE) >> 7, t0_ = ((TILE) & 127) * 32; \
                _Pragma("unroll") for (int i = 0; i < 8; ++i) { int c = tid + 512 * i; c = c < 62 * 64 ? c : 62 * 64 - 1; const int r = c >> 6, ch = c & 63, t = t0_ - 30 + r; \
                    v4u val = *(const GAS v4u*)(GLU + ((size_t)b_ * SEQ + (t < 0 ? 0 : t)) * CW + ch * 8); if (t < 0) val = (v4u){0u, 0u, 0u, 0u}; pf[i] = val; } }
            if (bx < M / 32) CONV_FETCH(bx)
            for (int tile = bx; tile < M / 32; tile += G) {
                const int b = tile >> 7, t0 = (tile & 127) * 32; const size_t row0 = (size_t)b * SEQ + t0;
#pragma unroll
                for (int i = 0; i < 8; ++i) { const int c = tid + 512 * i; if (c < 62 * 64) *(LAS v4u*)(lds + (size_t)c * 16) = pf[i]; }
                v4u zc[4];
#pragma unroll
                for (int q = 0; q < 4; ++q) zc[q] = *(const GAS v4u*)(ZC + (row0 + wave + 8 * q) * CW + lane * 8);
                __syncthreads();
                { const int nt_ = tile + G < M / 32 ? tile + G : tile; CONV_FETCH(nt_) }
                unsigned xs[46];
#pragma unroll
                for (int i = 0; i < 46; ++i) xs[i] = in32[(th * 16 + i) * 256 + cp];
#pragma unroll
                for (int tl = 0; tl < 16; ++tl) { float a0 = cb.x, a1 = cb.y;
#pragma unroll
                    for (int j = 0; j < CK; ++j) { const unsigned xv = xs[tl + j]; a0 += w0[j] * bf_lo(xv); a1 += w1[j] * bf_hi(xv); }
                    *(LAS f32x2*)(ot + (th * 16 + tl) * CW + 2 * cp) = (f32x2){a0, a1}; }
                __syncthreads();
                {
                    const f32x4 lw0 = *(const f32x4*)(conv_ln_w + lane * 8), lw1 = *(const f32x4*)(conv_ln_w + lane * 8 + 4);
                    const f32x4 lb0 = *(const f32x4*)(conv_ln_b + lane * 8), lb1 = *(const f32x4*)(conv_ln_b + lane * 8 + 4);
#pragma unroll
                    for (int q = 0; q < 4; ++q) { const int tl = wave + 8 * q;
                        f32x4 v0 = *(const LAS f32x4*)(ot + tl * CW + lane * 8), v1 = *(const LAS f32x4*)(ot + tl * CW + lane * 8 + 4);
                        const float mean = wave_sum((v0.x + v0.y) + (v0.z + v0.w) + (v1.x + v1.y) + (v1.z + v1.w)) * (1.f / CW);
                        v0 = v0 - mean; v1 = v1 - mean;
                        const float var = wave_sum((v0.x * v0.x + v0.y * v0.y) + (v0.z * v0.z + v0.w * v0.w) + (v1.x * v1.x + v1.y * v1.y) + (v1.z * v1.z + v1.w * v1.w)) * (1.f / CW);
                        const float rstd = __builtin_amdgcn_rsqf(var + pg8::NORM_EPS);
                        v0 = v0 * rstd * lw0 + lb0; v1 = v1 * rstd * lw1 + lb1;
                        const v4u zq = zc[q];
                        const float z[8] = {bf_lo(zq.x), bf_hi(zq.x), bf_lo(zq.y), bf_hi(zq.y), bf_lo(zq.z), bf_hi(zq.z), bf_lo(zq.w), bf_hi(zq.w)};
#pragma unroll
                        for (int i = 0; i < 4; ++i) { v0[i] = v0[i] * sigmoidf_(v0[i]) * z[i]; v1[i] = v1[i] * sigmoidf_(v1[i]) * z[4 + i]; }
                        *(GAS v4u*)(A2 + (row0 + tl) * DM + CW + lane * 8) = pg8::pack8(v0, v1); }
                }
                __syncthreads();
            }
#undef CONV_FETCH
        }
        {
            const int r32 = lane & 31, hi = lane >> 5;
            const int vrd_off = (4 * hi + ((lane & 15) >> 2)) * 64 + ((lane >> 4) & 1) * 32 + (lane & 3) * 8;
            const int piece = wave & 3, tsel = wave >> 2;
            bf16* PB = (bf16*)(ws + WS_PB); float* PL = (float*)(ws + WS_LSE);
            const unsigned lds0 = (unsigned)(uintptr_t)lds_raw;
            const unsigned voffK = (unsigned)(((8 * piece + (lane >> 3)) * HD + (((lane & 7) ^ (((8 * piece + (lane >> 3)) >> 1) & 7)) << 3)) * 2);
            const unsigned voffV = (unsigned)(((16 * (piece & 1) + (lane >> 2)) * HD + (piece >> 1) * 32 + (lane & 3) * 8) * 2);
#define ATT_BAR() do { asm volatile("s_waitcnt lgkmcnt(0)" ::: "memory"); __builtin_amdgcn_s_barrier(); asm volatile("" ::: "memory"); } while (0)
#define ATT_DMA(ISV, SRC, RROW, JSB, NT, LDSOFF, FORCE) do { \
                _Pragma("unroll") for (int m_ = 0; m_ < 6; ++m_) { const int kt_ = 2 * m_ + tsel; const int js_ = (JSB) + 32 * kt_; \
                    if (m_ < (NT) / 2 && ((FORCE) || js_ >= 0)) \
                        glds16s((SRC) + ((size_t)(RROW) + (js_ < 0 ? 0 : js_)) * HD, ISV ? voffV : voffK, (unsigned)__builtin_amdgcn_readfirstlane((int)(lds0 + (LDSOFF) + kt_ * 4096 + piece * 1024))); } } while (0)
#define ATT_ROUND(G_, RROW, IU0, JB, KTB, KBUF, TSH, TOK0, PBO, PBL, MROW0, NKN, QNP, QNROW) do { \
                    const int iq = (IU0) + r32; const int tq = (iq << (TSH)) + (TOK0); \
                    f32x16 S[5]; \
                    _Pragma("unroll") for (int tau = 0; tau < 5; ++tau) { \
                        _Pragma("unroll") for (int r = 0; r < 16; ++r) S[tau][r] = -INFINITY; \
                        if ((JB) + 32 * tau >= 0) { \
                            const LAS char* kp = (const LAS char*)(lds + (KBUF) + ((KTB) + tau) * 4096 + r32 * 128); \
                            f32x16 sacc = {}; \
                            _Pragma("unroll") for (int ks = 0; ks < 4; ++ks) { const bf16x8 kf = *(const LAS bf16x8*)(kp + (((2 * ks + hi) ^ ((r32 >> 1) & 7)) << 4)); \
                                sacc = __builtin_amdgcn_mfma_f32_32x32x16_bf16(kf, qf[ks], sacc, 0, 0, 0); } \
                            if (tau == 0) { _Pragma("unroll") for (int r = 0; r < 16; ++r) if (crow(r, hi) < r32) sacc[r] = -INFINITY; } \
                            if (tau == 4) { _Pragma("unroll") for (int r = 0; r < 16; ++r) if (crow(r, hi) > r32) sacc[r] = -INFINITY; } \
                            S[tau] = sacc; } } \
                    float mx = -INFINITY; \
                    _Pragma("unroll") for (int tau = 0; tau < 5; ++tau) _Pragma("unroll") for (int r = 0; r < 16; r += 2) mx = fmaxf(fmaxf(mx, S[tau][r]), S[tau][r + 1]); \
                    mx = fmaxf(mx, __shfl_xor(mx, 32)); \
                    float l = 0.f; v4u P[5][2]; \
                    _Pragma("unroll") for (int tau = 0; tau < 5; ++tau) { f32x16 p = S[tau]; float ps = 0.f; \
                        _Pragma("unroll") for (int r = 0; r < 16; ++r) { p[r] = __builtin_amdgcn_exp2f(p[r] - mx); ps += p[r]; } \
                        l += ps; \
                        P[tau][0].x = cvt_pk_bf16(p[0], p[1]); P[tau][0].y = cvt_pk_bf16(p[2], p[3]); P[tau][0].z = cvt_pk_bf16(p[4], p[5]); P[tau][0].w = cvt_pk_bf16(p[6], p[7]); \
                        P[tau][1].x = cvt_pk_bf16(p[8], p[9]); P[tau][1].y = cvt_pk_bf16(p[10], p[11]); P[tau][1].z = cvt_pk_bf16(p[12], p[13]); P[tau][1].w = cvt_pk_bf16(p[14], p[15]); } \
                    l += __shfl_xor(l, 32); \
                    asm volatile("s_waitcnt vmcnt(" #NKN ")" ::: "memory"); ATT_BAR();     \
                    ATT_LOAD_Q(qn, QNP, QNROW); \
                    if ((G_) < 2) ATT_LOAD_P(PBO, PBL, tq); \
                    f32x16 o[2]; o[0] = f32x16{}; o[1] = f32x16{}; \
                    _Pragma("unroll") for (int tau = 0; tau < 5; ++tau) { \
                        if ((JB) + 32 * tau >= 0) { \
                            const LAS char* vp = (const LAS char*)(lds + ATT_V + ((KTB) + tau) * 4096 + vrd_off); \
                            const bf16x8 pf0 = __builtin_bit_cast(bf16x8, P[tau][0]), pf1 = __builtin_bit_cast(bf16x8, P[tau][1]); \
                            _Pragma("unroll") for (int d0 = 0; d0 < 2; ++d0) { \
                                const s16x4 a0 = vtr(vp + d0 * 2048), a1 = vtr(vp + d0 * 2048 + 512), a2 = vtr(vp + d0 * 2048 + 1024), a3 = vtr(vp + d0 * 2048 + 1536); \
                                const bf16x8 vf0 = (bf16x8){a0[0], a0[1], a0[2], a0[3], a1[0], a1[1], a1[2], a1[3]}; \
                                const bf16x8 vf1 = (bf16x8){a2[0], a2[1], a2[2], a2[3], a3[0], a3[1], a3[2], a3[3]}; \
                                o[d0] = __builtin_amdgcn_mfma_f32_32x32x16_bf16(vf0, pf0, o[d0], 0, 0, 0); \
                                o[d0] = __builtin_amdgcn_mfma_f32_32x32x16_bf16(vf1, pf1, o[d0], 0, 0, 0); } } } \
                    float lse = mx + __builtin_amdgcn_logf(l), sc_own = __builtin_amdgcn_rcpf(l), sc_p = 0.f; \
                    if ((G_) < 2) { const float mx2 = fmaxf(lse, plse), a = __builtin_amdgcn_exp2f(lse - mx2), bq = __builtin_amdgcn_exp2f(plse - mx2), inv = __builtin_amdgcn_rcpf(a + bq); \
                        sc_own = sc_own * a * inv; sc_p = bq * inv; lse = mx2 + __builtin_amdgcn_logf(a + bq); } \
                    if ((G_) > 0) { \
                        _Pragma("unroll") for (int d0 = 0; d0 < 2; ++d0) _Pragma("unroll") for (int rg = 0; rg < 4; ++rg) { \
                            float e0 = o[d0][4 * rg] * sc_own, e1 = o[d0][4 * rg + 1] * sc_own, e2 = o[d0][4 * rg + 2] * sc_own, e3 = o[d0][4 * rg + 3] * sc_own; \
                            if ((G_) < 2) { const v2u pw = pp[d0 * 4 + rg]; e0 += sc_p * bf_lo(pw.x); e1 += sc_p * bf_hi(pw.x); e2 += sc_p * bf_lo(pw.y); e3 += sc_p * bf_hi(pw.y); } \
                            v2u w; w.x = cvt_pk_bf16(e0, e1); w.y = cvt_pk_bf16(e2, e3); \
                            *(GAS v2u*)((PBO) + (size_t)tq * HD + 32 * d0 + 8 * rg + 4 * hi) = w; } \
                        if (hi == 0) (PBL)[tq] = lse; \
                    } else { \
                        const size_t mrow = (size_t)(MROW0) + tq; \
                        v2u zz[8]; \
                        _Pragma("unroll") for (int d0 = 0; d0 < 2; ++d0) _Pragma("unroll") for (int rg = 0; rg < 4; ++rg) zz[d0 * 4 + rg] = *(const GAS v2u*)(ZA + mrow * CW + h * 64 + 32 * d0 + 8 * rg + 4 * hi); \
                        _Pragma("unroll") for (int d0 = 0; d0 < 2; ++d0) _Pragma("unroll") for (int rg = 0; rg < 4; ++rg) { const v2u pw = pp[d0 * 4 + rg]; const v2u zw = zz[d0 * 4 + rg]; \
                            const float e0 = (o[d0][4 * rg] * sc_own + sc_p * bf_lo(pw.x)) * bf_lo(zw.x), e1 = (o[d0][4 * rg + 1] * sc_own + sc_p * bf_hi(pw.x)) * bf_hi(zw.x); \
                            const float e2 = (o[d0][4 * rg + 2] * sc_own + sc_p * bf_lo(pw.y)) * bf_lo(zw.y), e3 = (o[d0][4 * rg + 3] * sc_own + sc_p * bf_hi(pw.y)) * bf_hi(zw.y); \
                            v2u w; w.x = cvt_pk_bf16(e0, e1); w.y = cvt_pk_bf16(e2, e3); \
                            *(GAS v2u*)(A2 + mrow * DM + h * 64 + 32 * d0 + 8 * rg + 4 * hi) = w; } } \
                } while (0)
#define ATT_LOAD_Q(DST, QP, ROW) do { _Pragma("unroll") for (int ks = 0; ks < 4; ++ks) DST[ks] = *(const GAS bf16x8*)((QP) + (size_t)(ROW) * HD + 16 * ks + 8 * hi); } while (0)
#define ATT_LOAD_P(PBO, PBL, TQ) do { _Pragma("unroll") for (int d0 = 0; d0 < 2; ++d0) _Pragma("unroll") for (int rg = 0; rg < 4; ++rg) pp[d0 * 4 + rg] = *(const GAS v2u*)((PBO) + (size_t)(TQ) * HD + 32 * d0 + 8 * rg + 4 * hi); \
                plse = (PBL)[TQ]; } while (0)
            bf16x8 qf[4], qn[4]; v2u pp[8]; float plse;
            {
                const int NCH = BATCH * HPG * 16;
                if (vcu < NCH) { const int bh = vcu >> 4, res = vcu & 15; const size_t base = (size_t)(((bh >> 3) * 3 + 2) * 8 + (bh & 7)) * SEQ * HD;
                    ATT_LOAD_Q(qf, QB + base, res * 256 + 32 * wave + r32);
                    asm volatile("s_waitcnt vmcnt(0)" ::: "memory"); ATT_BAR();
                    ATT_DMA(false, KB + base, res * 256, 0, 8, ATT_K0, false); }
                int kpar = 0;
                for (int ch = vcu; ch < NCH; ch += G, kpar ^= 1) {
                    const int bh = ch >> 4, res = ch & 15, b = bh >> 3, h = bh & 7; const size_t base = (size_t)((b * 3 + 2) * 8 + h) * SEQ * HD;
                    const int chn = ch + G < NCH ? ch + G : ch, bhn = chn >> 4, resn = chn & 15; const size_t basen = (size_t)(((bhn >> 3) * 3 + 2) * 8 + (bhn & 7)) * SEQ * HD;
                    const int kbuf = kpar ? ATT_K1 : ATT_K0, knext = kpar ? ATT_K0 : ATT_K1;
                    if (ch == vcu) asm volatile("s_waitcnt vmcnt(0)" ::: "memory");
                    asm volatile("" : "+v"(qf[0]), "+v"(qf[1]), "+v"(qf[2]), "+v"(qf[3]));
                    ATT_BAR();
                    ATT_DMA(true, VB + base, res * 256, 0, 8, ATT_V, false);
                    if (ch + G < NCH) { ATT_DMA(false, KB + basen, resn * 256, 0, 8, knext, true);
                        ATT_ROUND(2, res * 256, 32 * wave, 32 * wave - 128, wave - 4, kbuf, 4, res, PB + (size_t)bh * SEQ * HD, PL + (size_t)bh * SEQ, 0, 4, QB + basen, resn * 256 + 32 * wave + r32); }
                    else { ATT_ROUND(2, res * 256, 32 * wave, 32 * wave - 128, wave - 4, kbuf, 4, res, PB + (size_t)bh * SEQ * HD, PL + (size_t)bh * SEQ, 0, 0, QB + basen, resn * 256 + 32 * wave + r32); }
#pragma unroll
                    for (int ks = 0; ks < 4; ++ks) qf[ks] = qn[ks];
                }
                asm volatile("s_waitcnt vmcnt(0)" ::: "memory"); ATT_BAR();
            }
            GRID_BAR(6);
            for (int item = vcu; item < BATCH * HPG * 4; item += G) {
                const int span = item & 3, h = (item >> 2) & 7, b = item >> 5, bh = b * 8 + h;
                bf16* pbo = PB + (size_t)bh * SEQ * HD; float* pbl = PL + (size_t)bh * SEQ;
                const size_t base1 = (size_t)((b * 3 + 1) * 8 + h) * SEQ * HD, base0 = (size_t)((b * 3 + 0) * 8 + h) * SEQ * HD;
#define ITEM_RND(RD, G_, BASE_, RROW_, QB0_, TSH_, TOK0_) const int G_ = (RD) < 4 ? 1 : 0; const size_t BASE_ = (RD) < 4 ? base1 : base0; \
                const int RROW_ = (RD) < 4 ? (RD) * 1024 : 0, QB0_ = (RD) < 4 ? (span << 8) : (span << 10) + (((RD) - 4) << 8), TSH_ = (RD) < 4 ? 2 : 0, TOK0_ = (RD) < 4 ? (RD) : 0;
                { ITEM_RND(0, g_, base_, rrow_, qb0_, tsh_, tok0_)
                  ATT_LOAD_Q(qf, QB + base_, rrow_ + qb0_ + 32 * wave + r32);
                  asm volatile("s_waitcnt vmcnt(0)" ::: "memory"); ATT_BAR();
                  ATT_DMA(false, KB + base_, rrow_, qb0_ - 128, 12, ATT_K0, false); }
                for (int rd = 0; rd < 8; ++rd) {
                    ITEM_RND(rd, g, base, rrow, qb0, tsh, tok0)
                    const int rdn = rd + 1 < 8 ? rd + 1 : rd; ITEM_RND(rdn, gn, basen, rrown, qb0n, tshn, tok0n)
                    const int kbuf = (rd & 1) ? ATT_K1 : ATT_K0, knext = (rd & 1) ? ATT_K0 : ATT_K1;
                    if (rd == 0 || rd == 4) asm volatile("s_waitcnt vmcnt(0)" ::: "memory");
                    asm volatile("" : "+v"(qf[0]), "+v"(qf[1]), "+v"(qf[2]), "+v"(qf[3]));
                    ATT_BAR();
                    ATT_DMA(true, VB + base, rrow, qb0 - 128, 12, ATT_V, false);
                    if (rd + 1 < 8) { ATT_DMA(false, KB + basen, rrown, qb0n - 128, 12, knext, true);
                        ATT_ROUND(g, rrow, qb0 + 32 * wave, qb0 + 32 * wave - 128, wave, kbuf, tsh, tok0, pbo, pbl, (size_t)b * SEQ, 6, QB + basen, rrown + qb0n + 32 * wave + r32); }
                    else { ATT_ROUND(g, rrow, qb0 + 32 * wave, qb0 + 32 * wave - 128, wave, kbuf, tsh, tok0, pbo, pbl, (size_t)b * SEQ, 0, QB + basen, rrown + qb0n + 32 * wave + r32); }
#pragma unroll
                    for (int ks = 0; ks < 4; ++ks) qf[ks] = qn[ks];
                }
#undef ITEM_RND
            }
            asm volatile("s_waitcnt vmcnt(0)" ::: "memory"); ATT_BAR();
#undef ATT_BAR
#undef ATT_DMA
#undef ATT_ROUND
#undef ATT_LOAD_Q
#undef ATT_LOAD_P
        }
        if (BOTH(3)) GRID_BAR(3);
    }

    if (IN(4)) {
        { pg8::Gemm g{A2, W2, M, DM, DM}; pg8::StaticOrder S; S.init(M, DM, G, bx);
          pg8::EpiMerge2 E{(const unsigned char*)SG, MG, lds + RING_OFF + RING_BYTES + wave * 2048};
          pg8::gemm_phase<pg8::EpiMerge2, pg8::StaticOrder, true, true>(lds + RING_OFF, g, S, E); }
        if (BOTH(4)) GRID_BAR(4);
    }

    if (IN(5)) {
        pg8::Gemm g{MG, WO, M, DM, DM}; pg8::StaticOrder S; S.init(M, DM, G, bx);
        pg8::EpiOut E{x, out, ADA, lds + RING_OFF + RING_BYTES + wave * 2048};
        pg8::gemm_phase<pg8::EpiOut, pg8::StaticOrder, true, true>(lds + RING_OFF, g, S, E);
    }
#undef IN
#undef BOTH
}

extern "C" void kernel_launch(void* const* d_in, const int* in_sizes, int n_in, void* d_out, int out_size, void* d_ws, size_t ws_size, hipStream_t stream) {
    static int grid = 0;
    if (grid == 0) {
        if (n_in != 16 || in_sizes[0] != M * DM || out_size != M * DM || ws_size < WS_END) { fprintf(stderr, "kernel_launch: unexpected shapes (n_in %d, in0 %d, out %d, ws %zu)\n", n_in, n_in > 0 ? in_sizes[0] : -1, out_size, ws_size); grid = -1; return; }
        int dev = 0, cus = 0, per_cu = 0;
        if (hipGetDevice(&dev) != hipSuccess || hipDeviceGetAttribute(&cus, hipDeviceAttributeMultiprocessorCount, dev) != hipSuccess) { grid = -1; return; }
        if (hipFuncSetAttribute((const void*)mega_fwd, hipFuncAttributeMaxDynamicSharedMemorySize, LDS_BYTES) != hipSuccess) { fprintf(stderr, "kernel_launch: hipFuncSetAttribute failed\n"); grid = -1; return; }
        if (hipOccupancyMaxActiveBlocksPerMultiprocessor(&per_cu, (const void*)mega_fwd, NWAVES * 64, LDS_BYTES) != hipSuccess || per_cu < 1) { fprintf(stderr, "kernel_launch: occupancy query says %d\n", per_cu); (void)hipGetLastError(); per_cu = 1; }
        if (per_cu > 1) per_cu = 1;
        grid = cus * per_cu;
    }
    if (grid < 0) return;
    (void)hipMemsetAsync((char*)d_ws + WS_CTL, 0, CTL_ZERO_BYTES, stream);
    Args a{};
    for (int i = 0; i < 16; ++i) a.in[i] = (const float*)d_in[i];
    a.out = (float*)d_out; a.ws = (unsigned char*)d_ws;
    a.ph_lo = 0; a.ph_hi = N_PHASES;
    hipLaunchKernelGGL(mega_fwd, dim3(grid), dim3(NWAVES * 64), LDS_BYTES, stream, a);
}
```

```cpp
#include <hip/hip_runtime.h>
#include <cstdio>
#include <cstdint>

namespace pg8 {
#define PG8_LAS __attribute__((address_space(3)))
typedef unsigned short bf16_t;
typedef short bf16x8 __attribute__((ext_vector_type(8)));
typedef float f32x4 __attribute__((ext_vector_type(4)));
typedef unsigned u32x4 __attribute__((ext_vector_type(4)));
constexpr int BM = 256, BK = 64, HALF = 128, HTB = HALF * BK * 2, STAGE_BYTES = 8 * HTB, NXCD = 8, WGM = 8;

__host__ __device__ __forceinline__ int lds_byte(int r, int c) { const int st = (r >> 4) * 2 + (c >> 5), rr = r & 15, cc = c & 31, ob = rr * 64 + cc * 2; return st * 1024 + (ob ^ (((ob >> 9) & 1) << 5)); }
__host__ __device__ __forceinline__ void stage_rc(int b, int& R, int& C) { const int st = b / 1024, sb = b % 1024, swz = sb ^ (((sb >> 9) & 1) << 5); R = (st >> 1) * 16 + swz / 64; C = (st & 1) * 32 + (swz % 64) / 2; }
__host__ __device__ __forceinline__ int perm32(int rho) { const int n = rho >> 4, i = rho & 15; return 8 * (i >> 2) + 4 * n + (i & 3); }

struct Unit { int pm, pn; };
struct Gemm { const bf16_t* A; const bf16_t* Bt; int M, N, K; };

struct StaticOrder {
    int nM, nN, nwg, G, c;
    __host__ __device__ void init(int M, int N, int G_, int c_) { nM = M / BM; nN = N / BM; nwg = nM * nN; G = G_; c = c_; }
    __host__ __device__ bool next(int i, Unit& u) const {
        const long L = (long)i * G + c; if (L >= nwg) return false;
        int wgid = (int)L; { const int q = nwg / NXCD, r = nwg % NXCD, xcd = wgid % NXCD, off = wgid / NXCD; wgid = (xcd < r ? xcd * (q + 1) : r * (q + 1) + (xcd - r) * q) + off; }
        const int nig = WGM * nN, gid = wgid / nig, fm = gid * WGM, gsz = (nM - fm) < WGM ? (nM - fm) : WGM;
        u.pm = fm + ((wgid % nig) % gsz); u.pn = (wgid % nig) / gsz; return true;
    }
    __device__ __forceinline__ void a_ready(const Unit&) const {}
    __device__ __forceinline__ void done(const Unit&) const {}
};

typedef float f32x2_t __attribute__((ext_vector_type(2))); typedef __bf16 bf16x2_t __attribute__((ext_vector_type(2)));
__device__ __forceinline__ unsigned cvt_pk_bf16(float lo, float hi) { f32x2_t v = {lo, hi}; bf16x2_t b = __builtin_convertvector(v, bf16x2_t); return __builtin_bit_cast(unsigned, b); }
__device__ __forceinline__ float bf_lo(unsigned w) { return __uint_as_float(w << 16); }
__device__ __forceinline__ float bf_hi(unsigned w) { return __uint_as_float(w & 0xffff0000u); }
__device__ __forceinline__ float sigmoidf_(float x) { return __builtin_amdgcn_rcpf(1.0f + __builtin_amdgcn_exp2f(-1.4426950408889634f * x)); }
__device__ __forceinline__ u32x4 pack8(const f32x4& a, const f32x4& b) { u32x4 w; w.x = cvt_pk_bf16(a[0], a[1]); w.y = cvt_pk_bf16(a[2], a[3]); w.z = cvt_pk_bf16(b[0], b[1]); w.w = cvt_pk_bf16(b[2], b[3]); return w; }


constexpr float QSCALE = 0.125f * 1.4426950408889634f;
constexpr float NORM_EPS = 1e-6f;
#define PG8_XPOSE(P0, P1, T0, T1) do { *(PG8_LAS u32x4*)xw0 = (P0); *(PG8_LAS u32x4*)xw1 = (P1); T0 = *(const PG8_LAS u32x4*)xr0; T1 = *(const PG8_LAS u32x4*)(xr0 + 1024); } while (0)
#define PG8_XPOSE_ADDR PG8_LAS unsigned char* xw0 = scr + fr * 128 + 16 * (fq ^ (fr & 7)); PG8_LAS unsigned char* xw1 = scr + fr * 128 + 16 * ((4 + fq) ^ (fr & 7)); \
        const int r8 = 2 * fq + (fr >> 3), c8 = fr & 7; const PG8_LAS unsigned char* xr0 = scr + r8 * 128 + 16 * (c8 ^ (r8 & 7));
__device__ __forceinline__ size_t sg_frag(int pm, int t, int ai, int m, int wave, int lane) { return ((((((size_t)pm * 8 + t) * 2 + ai) * 4 + m) * 8 + wave) * 64 + lane) * 16; }
struct EpiIn {
    static constexpr bool PERM = true, AFTER_DRAIN = false; static constexpr int MIDK = 0;
    bf16_t *Q; size_t qkv_stride; bf16_t *ZA; size_t zc_off; bf16_t *GLU; unsigned char* SG; const float *qw, *kw, *bgate; PG8_LAS unsigned char* scr;
    __device__ __forceinline__ void operator()(const f32x4 (&acc)[2][2][4][2], const Unit& u, int wr, int wc, int fr, int fq) const {
        const int pn = u.pn;
        PG8_XPOSE_ADDR
        const int rown = u.pm * BM + wr * 64 + r8;
        if (pn < 18) {
            const int kind = pn / 6, rel = pn - kind * 6, g = rel >> 1, hb = ((rel & 1) << 2) + wc, sh = 2 * g;
            bf16_t* base = Q + (size_t)kind * qkv_stride;
            f32x4 wv[2][2];
            if (kind < 2) { const float* w = qw; if (kind == 1) w = kw; const float sc = kind == 0 ? QSCALE : 1.0f;
#pragma unroll
                for (int bj = 0; bj < 2; ++bj)
#pragma unroll
                    for (int n = 0; n < 2; ++n) wv[bj][n] = *(const f32x4*)(w + 32 * bj + 8 * fq + 4 * n) * sc; }
#pragma unroll
            for (int ai = 0; ai < 2; ++ai)
#pragma unroll
                for (int m = 0; m < 4; ++m) {
                    f32x4 v00 = acc[ai][0][m][0], v01 = acc[ai][0][m][1], v10 = acc[ai][1][m][0], v11 = acc[ai][1][m][1];
                    if (kind < 2) {
                        f32x4 q = v00 * v00 + v01 * v01 + v10 * v10 + v11 * v11; float ss = (q[0] + q[1]) + (q[2] + q[3]);
                        ss += __shfl_xor(ss, 16); ss += __shfl_xor(ss, 32);
                        const float rstd = __builtin_amdgcn_rsqf(ss * (1.0f / 64.0f) + NORM_EPS);
                        v00 = v00 * rstd * wv[0][0]; v01 = v01 * rstd * wv[0][1]; v10 = v10 * rstd * wv[1][0]; v11 = v11 * rstd * wv[1][1];
                    }
                    u32x4 t0, t1; PG8_XPOSE(pack8(v00, v01), pack8(v10, v11), t0, t1);
#pragma unroll
                    for (int h = 0; h < 2; ++h) { const int row = rown + ai * HALF + m * 16 + 8 * h, b = row >> 12, t = row & 4095;
                        const int tp = ((t & ((1 << sh) - 1)) << (12 - sh)) | (t >> sh);
                        __builtin_nontemporal_store(h ? t1 : t0, (u32x4*)(base + ((size_t)(((b * 3 + g) * 8 + hb) * 4096 + tp) * 64 + 8 * c8))); }
                }
        } else if (pn < 20 || (pn >= 24 && pn < 26)) {
            bf16_t* base = ZA + (pn < 20 ? (size_t)0 : zc_off); const int rel = pn < 20 ? pn - 18 : pn - 24; const int colN = rel * BM + wc * 32 + (c8 >> 2) * HALF + 8 * (c8 & 3);
#pragma unroll
            for (int ai = 0; ai < 2; ++ai)
#pragma unroll
                for (int m = 0; m < 4; ++m) { u32x4 p[2];
#pragma unroll
                    for (int bj = 0; bj < 2; ++bj) { f32x4 a = acc[ai][bj][m][0], b = acc[ai][bj][m][1];
#pragma unroll
                        for (int i = 0; i < 4; ++i) { a[i] = a[i] * sigmoidf_(a[i]); b[i] = b[i] * sigmoidf_(b[i]); }
                        p[bj] = pack8(a, b); }
                    u32x4 t0, t1; PG8_XPOSE(p[0], p[1], t0, t1);
                    bf16_t* dst = base + (size_t)(rown + ai * HALF + m * 16) * 512 + colN;
                    __builtin_nontemporal_store(t0, (u32x4*)dst); __builtin_nontemporal_store(t1, (u32x4*)(dst + 8 * 512)); }
        } else if (pn < 24) {
            const int colN = (pn - 20) * HALF + wc * 32 + 8 * (c8 & 3);
#pragma unroll
            for (int ai = 0; ai < 2; ++ai)
#pragma unroll
                for (int mp = 0; mp < 2; ++mp) { u32x4 p[2];
#pragma unroll
                    for (int q = 0; q < 2; ++q) { const int m = 2 * mp + q;
                        f32x4 a0 = acc[ai][0][m][0], a1 = acc[ai][0][m][1]; const f32x4 b0 = acc[ai][1][m][0], b1 = acc[ai][1][m][1];
#pragma unroll
                        for (int i = 0; i < 4; ++i) { a0[i] = a0[i] * sigmoidf_(b0[i]); a1[i] = a1[i] * sigmoidf_(b1[i]); }
                        p[q] = pack8(a0, a1); }
                    u32x4 t0, t1; PG8_XPOSE(p[0], p[1], t0, t1);
                    bf16_t* dst = GLU + (size_t)(rown + ai * HALF + (2 * mp + (c8 >> 2)) * 16) * 512 + colN;
                    __builtin_nontemporal_store(t0, (u32x4*)dst); __builtin_nontemporal_store(t1, (u32x4*)(dst + 8 * 512)); }
        } else {
            const int t = pn - 26; const int gc0 = t * BM + wc * 32 + 8 * fq;
            f32x4 bv[2][2];
#pragma unroll
            for (int bj = 0; bj < 2; ++bj)
#pragma unroll
                for (int n = 0; n < 2; ++n) bv[bj][n] = *(const f32x4*)(bgate + gc0 + HALF * bj + 4 * n);
#pragma unroll
            for (int ai = 0; ai < 2; ++ai)
#pragma unroll
                for (int m = 0; m < 4; ++m) {
                    u32x4 w;
#pragma unroll
                    for (int bj = 0; bj < 2; ++bj) { f32x4 a = acc[ai][bj][m][0] + bv[bj][0], b = acc[ai][bj][m][1] + bv[bj][1];
                        unsigned wa = 0u, wb = 0u;
#pragma unroll
                        for (int i = 0; i < 4; ++i) { wa = __builtin_amdgcn_cvt_pk_u8_f32(sigmoidf_(a[i]) * 255.0f, i, wa); wb = __builtin_amdgcn_cvt_pk_u8_f32(sigmoidf_(b[i]) * 255.0f, i, wb); }
                        if (bj == 0) { w.x = wa; w.y = wb; } else { w.z = wa; w.w = wb; } }
                    __builtin_nontemporal_store(w, (u32x4*)(SG + sg_frag(u.pm, t, ai, m, wr * 4 + wc, fq * 16 + fr))); }
        }
    }
};
struct EpiMerge2 {
    static constexpr bool PERM = true, AFTER_DRAIN = false; static constexpr int MIDK = 8;
    const unsigned char* SG; bf16_t* OUT; PG8_LAS unsigned char* scr;
    __device__ __forceinline__ void mid(f32x4 (&acc)[2][2][4][2], const Unit& u, int wr, int wc, int fr, int fq) const {
        asm volatile("" : "+v"(fr), "+v"(fq));
        const int wave = wr * 4 + wc, lane = fq * 16 + fr;
#pragma unroll
        for (int ai = 0; ai < 2; ++ai)
#pragma unroll
            for (int m = 0; m < 4; ++m) {
                const u32x4 ga = *(const u32x4*)(SG + sg_frag(u.pm, u.pn, ai, m, wave, lane)), gc = *(const u32x4*)(SG + sg_frag(u.pm, u.pn + 4, ai, m, wave, lane));
#pragma unroll
                for (int bj = 0; bj < 2; ++bj) {
                    const unsigned gax = bj ? ga.z : ga.x, gay = bj ? ga.w : ga.y, gcx = bj ? gc.z : gc.x, gcy = bj ? gc.w : gc.y;
                    f32x4& a = acc[ai][bj][m][0]; f32x4& b = acc[ai][bj][m][1];
#pragma unroll
                    for (int i = 0; i < 4; ++i) {
                        a[i] *= (float)((gax >> (8 * i)) & 255u) * __builtin_amdgcn_rcpf(fmaxf((float)((gcx >> (8 * i)) & 255u), 0.5f));
                        b[i] *= (float)((gay >> (8 * i)) & 255u) * __builtin_amdgcn_rcpf(fmaxf((float)((gcy >> (8 * i)) & 255u), 0.5f)); } }
                if (m & 1) asm volatile("" ::: "memory"); }
    }
    __device__ __forceinline__ void operator()(const f32x4 (&acc)[2][2][4][2], const Unit& u, int wr, int wc, int fr, int fq) const {
        asm volatile("" : "+v"(fr), "+v"(fq));
        const int wave = wr * 4 + wc, lane = fq * 16 + fr;
        PG8_XPOSE_ADDR
        const int rown = u.pm * BM + wr * 64 + r8, colN = u.pn * BM + wc * 32 + (c8 >> 2) * HALF + 8 * (c8 & 3);
#pragma unroll
        for (int ai = 0; ai < 2; ++ai) {
            u32x4 gw[4];
#pragma unroll
            for (int m = 0; m < 4; ++m) gw[m] = *(const u32x4*)(SG + sg_frag(u.pm, u.pn + 4, ai, m, wave, lane));
#pragma unroll
            for (int m = 0; m < 4; ++m) { u32x4 p[2];
#pragma unroll
                for (int bj = 0; bj < 2; ++bj) { const unsigned gx = bj ? gw[m].z : gw[m].x, gy = bj ? gw[m].w : gw[m].y;
                    f32x4 a = acc[ai][bj][m][0], b = acc[ai][bj][m][1];
#pragma unroll
                    for (int i = 0; i < 4; ++i) { a[i] *= fmaxf((float)((gx >> (8 * i)) & 255u), 0.5f) * (1.0f / 255.0f); b[i] *= fmaxf((float)((gy >> (8 * i)) & 255u), 0.5f) * (1.0f / 255.0f); }
                    p[bj] = pack8(a, b); }
                u32x4 t0, t1; PG8_XPOSE(p[0], p[1], t0, t1);
                bf16_t* dst = OUT + (size_t)(rown + ai * HALF + m * 16) * 1024 + colN;
                *(u32x4*)dst = t0; *(u32x4*)(dst + 8 * 1024) = t1; }
        }
    }
};
struct EpiOut {
    static constexpr bool PERM = true, AFTER_DRAIN = false; static constexpr int MIDK = 0;
    const float* X; float* OUT; const float* ADA; PG8_LAS unsigned char* scr;
    __device__ __forceinline__ void operator()(const f32x4 (&acc)[2][2][4][2], const Unit& u, int wr, int wc, int fr, int fq) const {
        asm volatile("" : "+v"(fr), "+v"(fq));
        const int r8 = 2 * fq + (fr >> 3), c8 = fr & 7;
        const int rowb = u.pm * BM + wr * 64 + r8, col0 = u.pn * BM + wc * 32 + 4 * c8; const int b = (u.pm * BM) >> 12;
        PG8_LAS unsigned char* w0 = scr + fr * 128 + 16 * ((2 * fq) ^ (fr & 7)); PG8_LAS unsigned char* w1 = scr + fr * 128 + 16 * ((2 * fq + 1) ^ (fr & 7));
        const PG8_LAS unsigned char* r0 = scr + r8 * 128 + 16 * (c8 ^ (r8 & 7)); const PG8_LAS unsigned char* r1 = r0 + 8 * 128;
        f32x4 gv[2];
#pragma unroll
        for (int bj = 0; bj < 2; ++bj) gv[bj] = *(const f32x4*)(ADA + (size_t)b * 3072 + 2048 + col0 + bj * HALF);
#pragma unroll
        for (int ai = 0; ai < 2; ++ai) {
            f32x4 xv[4][2][2];
#pragma unroll
            for (int m = 0; m < 4; ++m) { const size_t off = (size_t)(rowb + ai * HALF + m * 16) * 1024 + col0;
#pragma unroll
                for (int bj = 0; bj < 2; ++bj)
#pragma unroll
                    for (int h = 0; h < 2; ++h) xv[m][bj][h] = *(const f32x4*)(X + off + (size_t)h * 8 * 1024 + bj * HALF); }
#pragma unroll
            for (int m = 0; m < 4; ++m) { const size_t off = (size_t)(rowb + ai * HALF + m * 16) * 1024 + col0;
#pragma unroll
                for (int bj = 0; bj < 2; ++bj) {
                    *(PG8_LAS f32x4*)w0 = acc[ai][bj][m][0]; *(PG8_LAS f32x4*)w1 = acc[ai][bj][m][1];
                    const f32x4 t0 = *(const PG8_LAS f32x4*)r0, t1 = *(const PG8_LAS f32x4*)r1;
                    *(f32x4*)(OUT + off + bj * HALF) = xv[m][bj][0] + gv[bj] * t0;
                    *(f32x4*)(OUT + off + (size_t)8 * 1024 + bj * HALF) = xv[m][bj][1] + gv[bj] * t1; } }
        }
    }
};

template <class Epi, class Sched, bool ALIGN_EPI = false, bool SP2 = false>
__device__ __forceinline__ void gemm_phase(PG8_LAS unsigned char* lds, const Gemm g, const Sched& S, const Epi& E) {
    const int tid = threadIdx.x, wid = __builtin_amdgcn_readfirstlane(tid >> 6), lane = tid & 63, wr = wid >> 2, wc = wid & 3, fr = lane & 15, fq = lane >> 4;
    const int K = g.K, nt = K / BK;
    unsigned voffA[2], voffB[2];
#pragma unroll
    for (int i = 0; i < 2; ++i) { int R, C; stage_rc(tid * 16 + i * 8192, R, C); const int Rb = Epi::PERM ? ((R & ~31) + perm32(R & 31)) : R;
        voffA[i] = (unsigned)(R * K + C) * 2u; voffB[i] = (unsigned)(Rb * K + C) * 2u; }
    const size_t kstep = (size_t)(BK * 2);
    const size_t hstep = (size_t)HALF * K * 2;
    const size_t tstep = 2 * hstep;
    const unsigned ldsw = (unsigned)wid * 1024u;
    const int aoff = lds_byte(wr * 64 + fr, fq * 8), boff = lds_byte(wc * 32 + fr, fq * 8);
#define PG8_SA(b, h) (((b) * 2 + (h)) * HTB)
#define PG8_SB(b, h) ((4 + (b) * 2 + (h)) * HTB)
#define PG8_STAGE(bufoff, gbase, voff) do { _Pragma("unroll") for (int _i = 0; _i < 2; ++_i) \
        __builtin_amdgcn_global_load_lds((const unsigned*)((const char*)(gbase) + (voff)[_i]), (PG8_LAS unsigned*)(lds + (bufoff) + ldsw + _i * 8192), 16, 0, 0); } while (0)
#define PG8_LDA(dst, b, h) do { _Pragma("unroll") for (int m = 0; m < 4; ++m) _Pragma("unroll") for (int k = 0; k < 2; ++k) dst[m][k] = *(const PG8_LAS bf16x8*)(lds + PG8_SA(b, h) + aoff + m * 2048 + k * 1024); } while (0)
#define PG8_LDB(dst, b, h) do { _Pragma("unroll") for (int n = 0; n < 2; ++n) _Pragma("unroll") for (int k = 0; k < 2; ++k) dst[n][k] = *(const PG8_LAS bf16x8*)(lds + PG8_SB(b, h) + boff + n * 2048 + k * 1024); } while (0)
#define PG8_MMA(ai, bj, At, Bt) do { __builtin_amdgcn_s_setprio(1); _Pragma("unroll") for (int m = 0; m < 4; ++m) _Pragma("unroll") for (int n = 0; n < 2; ++n) _Pragma("unroll") for (int k = 0; k < 2; ++k) \
        acc[ai][bj][m][n] = __builtin_amdgcn_mfma_f32_16x16x32_bf16(Bt[n][k], At[m][k], acc[ai][bj][m][n], 0, 0, 0); __builtin_amdgcn_s_setprio(0); } while (0)
#define PG8_WAIT_V(n) asm volatile("s_waitcnt vmcnt(" #n ")" ::: "memory")
#define PG8_WAIT_L(n) asm volatile("s_waitcnt lgkmcnt(" #n ")" ::: "memory")
#define PG8_BAR __builtin_amdgcn_s_barrier()
#define PG8_SCHED __builtin_amdgcn_sched_barrier(0)
    Unit cur, nxt; int ui = 0;
    if (!S.next(0, cur)) return;
    f32x4 acc[2][2][4][2];
#pragma unroll
    for (int a = 0; a < 2; ++a)
#pragma unroll
        for (int b = 0; b < 2; ++b)
#pragma unroll
            for (int m = 0; m < 4; ++m)
#pragma unroll
                for (int n = 0; n < 2; ++n) acc[a][b][m][n] = (f32x4){0.f, 0.f, 0.f, 0.f};
    bf16x8 At[4][2], B0[2][2], B1[2][2];
    const char* cA = (const char*)g.A + (size_t)cur.pm * tstep; const char* cB = (const char*)g.Bt + (size_t)cur.pn * tstep;
    S.a_ready(cur);
    if constexpr (SP2) {
        PG8_STAGE(PG8_SB(0, 0), cB, voffB); PG8_STAGE(PG8_SB(0, 1), cB + hstep, voffB); PG8_STAGE(PG8_SA(0, 0), cA, voffA); PG8_STAGE(PG8_SA(0, 1), cA + hstep, voffA);
        if (wr == 1) PG8_BAR;
        PG8_WAIT_V(2); PG8_BAR;
        PG8_STAGE(PG8_SB(1, 0), cB + kstep, voffB); PG8_STAGE(PG8_SA(1, 0), cA + kstep, voffA); PG8_STAGE(PG8_SB(1, 1), cB + hstep + kstep, voffB);
        PG8_WAIT_V(6); PG8_BAR;
    } else {
        PG8_STAGE(PG8_SB(0, 0), cB, voffB); PG8_STAGE(PG8_SA(0, 0), cA, voffA); PG8_STAGE(PG8_SB(0, 1), cB + hstep, voffB); PG8_STAGE(PG8_SA(0, 1), cA + hstep, voffA);
        if (wr == 1) PG8_BAR;
        PG8_WAIT_V(4); PG8_BAR;
        PG8_STAGE(PG8_SB(1, 0), cB + kstep, voffB); PG8_STAGE(PG8_SA(1, 0), cA + kstep, voffA); PG8_STAGE(PG8_SB(1, 1), cB + hstep + kstep, voffB);
        PG8_WAIT_V(6); PG8_BAR;
    }
    for (;;) {
        const bool has_next = S.next(ui + 1, nxt);
        const char* nA = has_next ? (const char*)g.A + (size_t)nxt.pm * tstep : cA; const char* nB = has_next ? (const char*)g.Bt + (size_t)nxt.pn * tstep : cB;
        for (int t = 0; t < nt; t += 2) {
            const bool last = (t == nt - 2);
            const char* a1 = cA + (size_t)(t + 1) * kstep;
            const char* a2 = last ? nA : cA + (size_t)(t + 2) * kstep; const char* b2 = last ? nB : cB + (size_t)(t + 2) * kstep;
            const char* a3 = a2 + kstep; const char* b3 = b2 + kstep;
            if (last && has_next) S.a_ready(nxt);
            if constexpr (Epi::MIDK > 0) { if (t == Epi::MIDK) E.mid(acc, cur, wr, wc, fr, fq); }
            if constexpr (SP2) {
            PG8_LDB(B0, 0, 0); PG8_LDB(B1, 0, 1); PG8_SCHED; PG8_LDA(At, 0, 0); PG8_STAGE(PG8_SA(1, 1), a1 + hstep, voffA);
            PG8_WAIT_V(8); PG8_WAIT_L(0); PG8_BAR; PG8_MMA(0, 0, At, B0); PG8_MMA(0, 1, At, B1); PG8_BAR; PG8_SCHED;
            PG8_LDA(At, 0, 1); PG8_STAGE(PG8_SB(0, 0), b2, voffB); PG8_STAGE(PG8_SB(0, 1), b2 + hstep, voffB); PG8_STAGE(PG8_SA(0, 0), a2, voffA);
            PG8_WAIT_V(8); PG8_WAIT_L(0); PG8_BAR; PG8_MMA(1, 0, At, B0); PG8_MMA(1, 1, At, B1); PG8_BAR; PG8_SCHED;
            PG8_LDB(B0, 1, 0); PG8_LDB(B1, 1, 1); PG8_SCHED; PG8_LDA(At, 1, 0); PG8_STAGE(PG8_SA(0, 1), a2 + hstep, voffA);
            PG8_WAIT_V(8); PG8_WAIT_L(0); PG8_BAR; PG8_MMA(0, 0, At, B0); PG8_MMA(0, 1, At, B1); PG8_BAR; PG8_SCHED;
            PG8_LDA(At, 1, 1); PG8_STAGE(PG8_SB(1, 0), b3, voffB); PG8_STAGE(PG8_SB(1, 1), b3 + hstep, voffB); PG8_STAGE(PG8_SA(1, 0), a3, voffA);
            PG8_WAIT_V(8); PG8_WAIT_L(0); PG8_BAR; PG8_MMA(1, 0, At, B0); PG8_MMA(1, 1, At, B1); PG8_BAR; PG8_SCHED;
            } else {
            PG8_LDB(B0, 0, 0); PG8_SCHED; PG8_LDA(At, 0, 0); PG8_STAGE(PG8_SA(1, 1), a1 + hstep, voffA);
            PG8_WAIT_L(8); PG8_BAR; PG8_WAIT_L(0); PG8_MMA(0, 0, At, B0); PG8_BAR; PG8_SCHED;
            PG8_LDB(B1, 0, 1); PG8_STAGE(PG8_SB(0, 0), b2, voffB);
            PG8_BAR; PG8_WAIT_L(0); PG8_MMA(0, 1, At, B1); PG8_BAR;
            PG8_LDA(At, 0, 1); PG8_STAGE(PG8_SA(0, 0), a2, voffA);
            PG8_BAR; PG8_WAIT_L(0); PG8_MMA(1, 0, At, B0); PG8_BAR; PG8_SCHED;
            PG8_STAGE(PG8_SB(0, 1), b2 + hstep, voffB);
            PG8_WAIT_V(6); PG8_BAR; PG8_MMA(1, 1, At, B1); PG8_BAR;
            PG8_LDB(B0, 1, 0); PG8_SCHED; PG8_LDA(At, 1, 0); PG8_STAGE(PG8_SA(0, 1), a2 + hstep, voffA);
            PG8_WAIT_L(8); PG8_BAR; PG8_WAIT_L(0); PG8_MMA(0, 0, At, B0); PG8_BAR; PG8_SCHED;
            PG8_LDB(B1, 1, 1); PG8_STAGE(PG8_SB(1, 0), b3, voffB);
            PG8_BAR; PG8_WAIT_L(0); PG8_MMA(0, 1, At, B1); PG8_BAR;
            PG8_LDA(At, 1, 1); PG8_STAGE(PG8_SA(1, 0), a3, voffA);
            PG8_BAR; PG8_WAIT_L(0); PG8_MMA(1, 0, At, B0); PG8_BAR; PG8_SCHED;
            PG8_STAGE(PG8_SB(1, 1), b3 + hstep, voffB);
            PG8_WAIT_V(6); PG8_BAR; PG8_MMA(1, 1, At, B1); PG8_BAR;
            }
        }
        if constexpr (ALIGN_EPI) { if (wr == 0) PG8_BAR; }
        if constexpr (!Epi::AFTER_DRAIN) { E(acc, cur, wr, wc, fr, fq); S.done(cur); }
        if (!has_next) break;
#pragma unroll
        for (int a = 0; a < 2; ++a)
#pragma unroll
            for (int b = 0; b < 2; ++b)
#pragma unroll
                for (int m = 0; m < 4; ++m)
#pragma unroll
                    for (int n = 0; n < 2; ++n) acc[a][b][m][n] = (f32x4){0.f, 0.f, 0.f, 0.f};
        cur = nxt; cA = nA; cB = nB; ++ui;
        if constexpr (ALIGN_EPI) { if (wr == 1) PG8_BAR; }
    }
    PG8_WAIT_V(0);
    if constexpr (!ALIGN_EPI) { if (wr == 0) PG8_BAR; }
    PG8_BAR;
#undef PG8_SA
#undef PG8_SB
#undef PG8_STAGE
#undef PG8_LDA
#undef PG8_LDB
#undef PG8_MMA
#undef PG8_WAIT_V
#undef PG8_WAIT_L
#undef PG8_BAR
#undef PG8_SCHED
}
}

constexpr int NWAVES = 8;
constexpr int N_PHASES = 6;
constexpr int BATCH = 8, SEQ = 4096, DM = 1024, M = BATCH * SEQ;
constexpr int NIN = 8704, NHEAD = 24, NG = 3, HPG = 8, HD = 64, CW = 512, CK = 31;
constexpr int ADA_N = 3 * DM;

constexpr size_t MiB = 1u << 20;
constexpr size_t WS_CTL = 0, CTL_ZERO_BYTES = 64 * 1024;
constexpr size_t WS_ADA = 1 * MiB;
constexpr size_t WS_WIN = 422 * MiB;
constexpr size_t WS_WA = 440 * MiB, WS_WO = 442 * MiB;
constexpr size_t WS_LSE = 2 * MiB;
constexpr size_t WS_H = 448 * MiB;
constexpr size_t WS_A2A = 448 * MiB, WS_A2C = 480 * MiB;
constexpr size_t WS_Q = 38 * MiB, WS_K = 134 * MiB, WS_V = 230 * MiB;
constexpr size_t WS_T1 = 134 * MiB, WS_MG = 230 * MiB;
constexpr size_t WS_ZA = 326 * MiB, WS_GLU = 358 * MiB, WS_ZC = 390 * MiB;
constexpr size_t WS_PB = 6 * MiB;
constexpr size_t WS_END = 512 * MiB;

constexpr int RING_OFF = 0, RING_BYTES = 131072;
constexpr int ATT_K0 = 0, ATT_K1 = 49152, ATT_V = 98304, ATT_END = 147456;
constexpr int MISC_OFF = ATT_END;
constexpr int LDS_BYTES = 151552;

#define GAS __attribute__((address_space(1)))
#define LAS __attribute__((address_space(3)))
typedef unsigned short bf16;
typedef unsigned v4u __attribute__((ext_vector_type(4)));
typedef unsigned v2u __attribute__((ext_vector_type(2)));
typedef float f32x4 __attribute__((ext_vector_type(4)));
typedef float f32x2 __attribute__((ext_vector_type(2)));
typedef float f32x16 __attribute__((ext_vector_type(16)));
typedef short bf16x8 __attribute__((ext_vector_type(8)));
typedef short s16x4 __attribute__((ext_vector_type(4)));
#define RLX_AGENT __ATOMIC_RELAXED, __HIP_MEMORY_SCOPE_AGENT
#define LDS_WAIT() asm volatile("s_waitcnt lgkmcnt(0)" ::: "memory")
using pg8::cvt_pk_bf16; using pg8::bf_lo; using pg8::bf_hi; using pg8::sigmoidf_;

#define XB_TMO      128
#define XB_XCNT(j)  (256  + 64 * (j))
#define XB_XSUB(j)  (1280 + 64 * (j))
#define XB_XGEN(j)  (2304 + 64 * (j))
#define XB_TOP      3328
#define XB_TOPGEN   3392
#define XCD_BAR_WORDS 3456
#define XB_SPIN_CAP (1u << 18)
__device__ __forceinline__ unsigned xb_ld(unsigned* p)              { return __hip_atomic_load(p, __ATOMIC_RELAXED, __HIP_MEMORY_SCOPE_AGENT); }
__device__ __forceinline__ unsigned xb_add(unsigned* p, unsigned v) { return __hip_atomic_fetch_add(p, v, __ATOMIC_RELAXED, __HIP_MEMORY_SCOPE_AGENT); }
__device__ __forceinline__ unsigned xb_xcc_id() { return (unsigned)__builtin_amdgcn_s_getreg((3 << 11) | 20) & 0xFu; }
#define XB_SPIN(cond, bar) do { unsigned _sp = 0; while (cond) { __builtin_amdgcn_s_sleep(1); \
    if ((++_sp & 255u) == 0u) { if (xb_ld(&(bar)[XB_TMO])) break; if (_sp > XB_SPIN_CAP) { atomicAdd(&(bar)[XB_TMO], 1u); break; } } } } while (0)
struct XcdBarrier { unsigned* bar; unsigned x; volatile LAS unsigned* st; };
__device__ __forceinline__ XcdBarrier xcd_barrier_post(unsigned* bar, volatile LAS unsigned* st) {
    XcdBarrier b; b.bar = bar; b.x = xb_xcc_id(); b.st = st;
    if (threadIdx.x == 0) (void)xb_add(&bar[XB_XCNT(b.x)], 1u);
    return b;
}
__device__ __forceinline__ void xcd_barrier_complete(unsigned* bar, unsigned x, unsigned& nloc, unsigned& nx) {
    const unsigned G = gridDim.x * gridDim.y * gridDim.z;
    unsigned sum, cnt, mine, sp = 0u;
    for (;;) {
        sum = 0u; cnt = 0u; mine = 0u;
#pragma unroll
        for (unsigned j = 0; j < 16; ++j) { const unsigned c = xb_ld(&bar[XB_XCNT(j)]); sum += c; cnt += (c > 0u) ? 1u : 0u; mine = (j == x) ? c : mine; }
        if (sum == G) break;
        __builtin_amdgcn_s_sleep(1);
        if ((++sp & 255u) == 0u) { if (xb_ld(&bar[XB_TMO])) break; if (sp > XB_SPIN_CAP) { atomicAdd(&bar[XB_TMO], 1u); break; } }
    }
    nloc = mine > 0u ? mine : 1u; nx = cnt > 0u ? cnt : 1u;
}
__device__ __forceinline__ void xcd_barrier(const XcdBarrier& b) {
    asm volatile("s_waitcnt vmcnt(0)" ::: "memory");
    __syncthreads();
    if (threadIdx.x == 0) {
        unsigned* bar = b.bar;
        __builtin_amdgcn_s_waitcnt(0);
        unsigned nloc = b.st[0], nx = b.st[1];
        if (nloc == 0u) { xcd_barrier_complete(bar, b.x, nloc, nx); b.st[0] = nloc; b.st[1] = nx; }
        const unsigned old = xb_add(&bar[XB_XSUB(b.x)], 1u);
        const unsigned gen = old / nloc;
        if (old + 1u == (gen + 1u) * nloc) {
            __builtin_amdgcn_fence(__ATOMIC_RELEASE, "agent");
            asm volatile("s_waitcnt vmcnt(0)" ::: "memory");
            const unsigned og = xb_add(&bar[XB_TOP], 1u);
            const unsigned tg = og / nx;
            if (og + 1u == (tg + 1u) * nx) xb_add(&bar[XB_TOPGEN], 1u);
            else XB_SPIN(xb_ld(&bar[XB_TOPGEN]) == tg, bar);
            __builtin_amdgcn_fence(__ATOMIC_ACQUIRE, "agent");
            xb_add(&bar[XB_XGEN(b.x)], 1u);
            asm volatile("s_waitcnt vmcnt(0)" ::: "memory");
        } else {
            XB_SPIN(xb_ld(&bar[XB_XGEN(b.x)]) == gen, bar);
            __builtin_amdgcn_fence(__ATOMIC_ACQUIRE, "agent");
            asm volatile("s_waitcnt vmcnt(0)" ::: "memory");
        }
    }
    __syncthreads();
}

__device__ __forceinline__ float wave_sum(float v) {
#pragma unroll
    for (int o = 1; o < 64; o <<= 1) v += __shfl_xor(v, o);
    return v;
}
__device__ __forceinline__ unsigned f2bf(float f) { unsigned u = __builtin_bit_cast(unsigned, f); return (u + 0x7fffu + ((u >> 16) & 1u)) >> 16; }
__device__ __forceinline__ unsigned pk2(float lo, float hi) { return f2bf(lo) | (f2bf(hi) << 16); }

__device__ __forceinline__ int win_phys(int n0) {
    if (n0 < 4608) { const int reg = n0 / 1536, c = n0 - reg * 1536, head = c >> 6, dh = (c >> 5) & 1; return (reg * 6 + (head >> 2)) * 256 + 128 * dh + 32 * (head & 3); }
    if (n0 >= 5120 && n0 < 6144) { const int c = n0 - 5120, half = c >> 9, cc = c & 511; return (20 + (cc >> 7)) * 256 + 128 * half + (cc & 127); }
    return n0;
}
__device__ __forceinline__ int win_phys_g(int n) { return n; }
template <bool WIN>
__device__ __forceinline__ void p0_transpose_item(const float* W, int K, int N, bf16* WT, LAS float* scr, int item, int lane, int ldt = 0) {
    if (ldt == 0) ldt = K;
    const int nblk = N / 32, kb = item / nblk, nb = item % nblk, k0 = 64 * kb, n0 = 32 * nb;
    const int prow = WIN ? win_phys(n0) : n0;
#pragma unroll 8
    for (int i = 0; i < 32; ++i) { const int kk = 2 * i + (lane >> 5); scr[kk * 33 + (lane & 31)] = __builtin_nontemporal_load(W + (size_t)(k0 + kk) * N + n0 + (lane & 31)); }
    LDS_WAIT(); asm volatile("" ::: "memory");
    const int c = lane & 7;
#pragma unroll
    for (int j = 0; j < 4; ++j) { const int n = (lane >> 3) + 8 * j; const LAS float* s = scr + (8 * c) * 33 + n;
        v4u o; o.x = pk2(s[0 * 33], s[1 * 33]); o.y = pk2(s[2 * 33], s[3 * 33]); o.z = pk2(s[4 * 33], s[5 * 33]); o.w = pk2(s[6 * 33], s[7 * 33]);
        const int rown = (WIN && n0 >= 6656) ? win_phys_g(n0 + n) : prow + n;
        *(GAS v4u*)(WT + (size_t)rown * ldt + k0 + 8 * c) = o; }
    LDS_WAIT(); asm volatile("" ::: "memory");
}

struct Args { const float* in[16]; float* out; unsigned char* ws; int ph_lo, ph_hi; };
__device__ __forceinline__ int crow(int r, int hi) { return (r & 3) + 8 * (r >> 2) + 4 * hi; }
__device__ __forceinline__ s16x4 vtr(const LAS char* p) { typedef short v4i16_t __attribute__((ext_vector_type(4))); return __builtin_bit_cast(s16x4, __builtin_amdgcn_ds_read_tr16_b64_v4i16((LAS v4i16_t*)p)); }

__device__ __forceinline__ void glds16s(const void* sbase, unsigned voff, unsigned lds_dst) { unsigned keep;
    const unsigned long long sb = (unsigned long long)sbase;
    const unsigned lo = (unsigned)__builtin_amdgcn_readfirstlane((int)(unsigned)sb), hi = (unsigned)__builtin_amdgcn_readfirstlane((int)(unsigned)(sb >> 32));
    const unsigned long long sbu = ((unsigned long long)hi << 32) | lo;
    asm volatile("s_mov_b32 %0, m0\n\ts_mov_b32 m0, %3\n\ts_nop 4\n\tglobal_load_lds_dwordx4 %1, %2\n\ts_mov_b32 m0, %0" : "=&s"(keep) : "v"(voff), "s"(sbu), "s"(lds_dst) : "memory"); }
struct KTile { bf16x8 k[4]; };
struct VTile { v4u v[4]; };
__device__ __forceinline__ void load_k(KTile& T, const bf16* Kp, int row0, int r32, int hi) {
    const bf16* kr = Kp + (size_t)(row0 + r32) * HD + 8 * hi;
#pragma unroll
    for (int ks = 0; ks < 4; ++ks) T.k[ks] = *(const GAS bf16x8*)(kr + 16 * ks);
}
__device__ __forceinline__ void load_v(VTile& T, const bf16* Vp, int row0, int lane) {
#pragma unroll
    for (int i = 0; i < 4; ++i) { const int c = lane + 64 * i; T.v[i] = *(const GAS v4u*)(Vp + (size_t)(row0 + (c >> 3)) * HD + (c & 7) * 8); }
}
template <int TAU>
__device__ __forceinline__ void att_tile(const KTile& TK, const VTile& TV, const bf16x8 (&qf)[4], float& m, float& l, f32x16 (&o)[2], LAS char* vl, const LAS char* vrd, int lane, int r32, int hi) {
    f32x16 s = {};
#pragma unroll
    for (int ks = 0; ks < 4; ++ks) s = __builtin_amdgcn_mfma_f32_32x32x16_bf16(TK.k[ks], qf[ks], s, 0, 0, 0);
#pragma unroll
    for (int i = 0; i < 4; ++i) { const int c = lane + 64 * i, key = c >> 3, ch = c & 7; *(LAS v4u*)(vl + (ch >> 2) * 2048 + key * 64 + (ch & 3) * 16) = TV.v[i]; }
    if (TAU == 0) {
#pragma unroll
        for (int r = 0; r < 16; ++r) if (crow(r, hi) < r32) s[r] = -INFINITY;
    }
    if (TAU == 4) {
#pragma unroll
        for (int r = 0; r < 16; ++r) if (crow(r, hi) > r32) s[r] = -INFINITY;
    }
    float tm = fmaxf(fmaxf(s[0], s[1]), s[2]);
#pragma unroll
    for (int r = 3; r < 15; r += 2) tm = fmaxf(fmaxf(tm, s[r]), s[r + 1]);
    tm = fmaxf(tm, s[15]);
    tm = fmaxf(tm, __shfl_xor(tm, 32));
    if (__any(tm > m)) {
        const float mn = fmaxf(m, tm), al = __builtin_amdgcn_exp2f(m - mn);
        l *= al; o[0] = o[0] * al; o[1] = o[1] * al; m = mn;
    }
    float ps = 0.f;
#pragma unroll
    for (int r = 0; r < 16; ++r) { s[r] = __builtin_amdgcn_exp2f(s[r] - m); ps += s[r]; }
    l += ps;
    v4u pw0, pw1;
    pw0.x = cvt_pk_bf16(s[0], s[1]); pw0.y = cvt_pk_bf16(s[2], s[3]); pw0.z = cvt_pk_bf16(s[4], s[5]); pw0.w = cvt_pk_bf16(s[6], s[7]);
    pw1.x = cvt_pk_bf16(s[8], s[9]); pw1.y = cvt_pk_bf16(s[10], s[11]); pw1.z = cvt_pk_bf16(s[12], s[13]); pw1.w = cvt_pk_bf16(s[14], s[15]);
    const bf16x8 pf0 = __builtin_bit_cast(bf16x8, pw0), pf1 = __builtin_bit_cast(bf16x8, pw1);
    LDS_WAIT(); asm volatile("" ::: "memory");
#pragma unroll
    for (int d0 = 0; d0 < 2; ++d0) {
        const s16x4 a0 = vtr(vrd + d0 * 2048), a1 = vtr(vrd + d0 * 2048 + 512), a2 = vtr(vrd + d0 * 2048 + 1024), a3 = vtr(vrd + d0 * 2048 + 1536);
        const bf16x8 vf0 = (bf16x8){a0[0], a0[1], a0[2], a0[3], a1[0], a1[1], a1[2], a1[3]};
        const bf16x8 vf1 = (bf16x8){a2[0], a2[1], a2[2], a2[3], a3[0], a3[1], a3[2], a3[3]};
        o[d0] = __builtin_amdgcn_mfma_f32_32x32x16_bf16(vf0, pf0, o[d0], 0, 0, 0);
        o[d0] = __builtin_amdgcn_mfma_f32_32x32x16_bf16(vf1, pf1, o[d0], 0, 0, 0);
    }
    asm volatile("" ::: "memory");
}

__global__ void __launch_bounds__(NWAVES * 64, 2) mega_fwd(Args args) {
    extern __shared__ __attribute__((aligned(16))) unsigned char lds_raw[];
    LAS unsigned char* lds = (LAS unsigned char*)lds_raw;
    const int tid = threadIdx.x, lane = tid & 63, wave = __builtin_amdgcn_readfirstlane(tid >> 6);
    const int G = gridDim.x; const int bx = blockIdx.x; const int vcu = (G % 8 == 0) ? (bx % 8) * (G / 8) + bx / 8 : bx;
    unsigned char* ws = args.ws;
    const float* x = args.in[0]; const float* cvec = args.in[1]; const float* w_ada = args.in[2]; const float* b_ada = args.in[3]; const float* norm_w = args.in[4];
    const float* w_in = args.in[5]; const float* b_gate = args.in[6]; const float* q_norm_w = args.in[7]; const float* k_norm_w = args.in[8]; const float* w_attn_proj = args.in[9];
    const float* conv_w = args.in[10]; const float* conv_b = args.in[11]; const float* conv_ln_w = args.in[12]; const float* conv_ln_b = args.in[13];
    const float* w_conv_proj = args.in[14]; const float* w_out = args.in[15];
    float* out = args.out;
    float* ADA = (float*)(ws + WS_ADA);
    bf16* WIN = (bf16*)(ws + WS_WIN); bf16* W2 = (bf16*)(ws + WS_WA); bf16* WO = (bf16*)(ws + WS_WO);
    float* LSE = (float*)(ws + WS_LSE);
    bf16* HB = (bf16*)(ws + WS_H); bf16* A2 = (bf16*)(ws + WS_A2A);
    bf16* QB = (bf16*)(ws + WS_Q); bf16* KB = (bf16*)(ws + WS_K); bf16* VB = (bf16*)(ws + WS_V);
    bf16* MG = (bf16*)(ws + WS_MG);
    bf16* ZA = (bf16*)(ws + WS_ZA); bf16* GLU = (bf16*)(ws + WS_GLU); bf16* ZC = (bf16*)(ws + WS_ZC);
    bf16* SG = (bf16*)out;

    if (tid < 32) ((LAS unsigned*)(lds + MISC_OFF))[tid] = 0u;
    __syncthreads();
    XcdBarrier bar = xcd_barrier_post((unsigned*)(ws + WS_CTL) + 4096, (volatile LAS unsigned*)(lds + MISC_OFF) + 8);
#define GRID_BAR(k) xcd_barrier(bar)
    const int lo = args.ph_lo, hi_ph = args.ph_hi;
#define IN(k) (lo <= (k) && (k) < hi_ph)
#define BOTH(k) (IN(k) && IN((k) + 1))
    const int gw = vcu * NWAVES + wave, NGW = G * NWAVES;

    if (IN(0)) {
        {
            LAS float* sc = (LAS float*)lds; LAS float* part = (LAS float*)(lds + 32768);
            if (bx < ADA_N / 64) {
                for (int i = tid; i < BATCH * DM; i += NWAVES * 64) { const float v = cvec[i]; sc[i] = v * sigmoidf_(v); }
                __syncthreads();
                for (int item = bx; item < ADA_N / 64; item += G) {
                    const int j = item * 64 + lane; float a[BATCH];
#pragma unroll
                    for (int b = 0; b < BATCH; ++b) a[b] = 0.f;
#pragma unroll 4
                    for (int kk = 0; kk < 128; ++kk) { const int k = wave * 128 + kk; const float w = __builtin_nontemporal_load(w_ada + (size_t)k * ADA_N + j);
#pragma unroll
                        for (int b = 0; b < BATCH; ++b) a[b] += sc[b * DM + k] * w; }
#pragma unroll
                    for (int b = 0; b < BATCH; ++b) part[(wave * BATCH + b) * 64 + lane] = a[b];
                    __syncthreads();
                    { float s = b_ada[j];
#pragma unroll
                      for (int w = 0; w < NWAVES; ++w) s += part[(w * BATCH + wave) * 64 + lane];
                      ADA[(size_t)wave * ADA_N + j] = s; }
                    __syncthreads();
                }
            }
        }
        if (bx >= ADA_N / 64 || G <= ADA_N / 64) {
            LAS float* scr = (LAS float*)(lds + RING_OFF + wave * 16384);
            constexpr int I_IN = (DM / 64) * (NIN / 32), I_A = (CW / 64) * (DM / 32), I_O = (DM / 64) * (DM / 32);
            constexpr int NITEMS = I_IN + 2 * I_A + I_O;
            const int nsk = G > ADA_N / 64 ? ADA_N / 64 : 0;
            for (int it = (bx - nsk) * NWAVES + wave; it < NITEMS; it += (G - nsk) * NWAVES) {
                int r = it;
                if (r < I_IN) { p0_transpose_item<true>(w_in, DM, NIN, WIN, scr, r, lane); continue; } r -= I_IN;
                if (r < I_A) { p0_transpose_item<false>(w_attn_proj, CW, DM, W2, scr, r, lane, DM); continue; } r -= I_A;
                if (r < I_A) { p0_transpose_item<false>(w_conv_proj, CW, DM, W2 + CW, scr, r, lane, DM); continue; } r -= I_A;
                p0_transpose_item<false>(w_out, DM, DM, WO, scr, r, lane);
            }
        }
        if (BOTH(0)) GRID_BAR(0);
    }

    if (IN(1)) {
        for (int rb = gw; rb < M / 16; rb += NGW) {
            const int row0 = rb * 16, b = row0 >> 12;
            f32x4 gm[4], ga[4];
#pragma unroll
            for (int j = 0; j < 4; ++j) { const int c = 4 * lane + 256 * j;
                const f32x4 nw = *(const f32x4*)(norm_w + c), sc = *(const f32x4*)(ADA + (size_t)b * ADA_N + DM + c);
                gm[j] = nw * (sc + 1.0f); ga[j] = *(const f32x4*)(ADA + (size_t)b * ADA_N + c); }
            for (int r = 0; r < 16; ++r) {
                const GAS f32x4* xr = (const GAS f32x4*)(x + (size_t)(row0 + r) * DM) + lane;
                f32x4 v[4]; float s2 = 0.f;
#pragma unroll
                for (int j = 0; j < 4; ++j) { v[j] = __builtin_nontemporal_load(xr + 64 * j); s2 += (v[j].x * v[j].x + v[j].y * v[j].y) + (v[j].z * v[j].z + v[j].w * v[j].w); }
                const float rstd = __builtin_amdgcn_rsqf(wave_sum(s2) * (1.f / DM) + pg8::NORM_EPS);
                GAS v2u* o8 = (GAS v2u*)(HB + (size_t)(row0 + r) * DM) + lane;
#pragma unroll
                for (int j = 0; j < 4; ++j) { const f32x4 y = v[j] * rstd * gm[j] + ga[j]; v2u w; w.x = cvt_pk_bf16(y.x, y.y); w.y = cvt_pk_bf16(y.z, y.w); o8[64 * j] = w; }
            }
        }
        if (BOTH(1)) GRID_BAR(1);
    }

    if (IN(2)) {
        pg8::Gemm g{HB, WIN, M, NIN, DM}; pg8::StaticOrder S; S.init(M, NIN, G, bx);
        pg8::EpiIn E{QB, (WS_K - WS_Q) / 2, ZA, (WS_ZC - WS_ZA) / 2, GLU, (unsigned char*)SG, q_norm_w, k_norm_w, b_gate, lds + RING_OFF + RING_BYTES + wave * 2048};
        pg8::gemm_phase<pg8::EpiIn, pg8::StaticOrder, true, true>(lds + RING_OFF, g, S, E);
        if (BOTH(2)) GRID_BAR(2);
    }

    if (IN(3)) {
        {
            LAS unsigned* in32 = (LAS unsigned*)lds;
            LAS float* ot = (LAS float*)(lds + 65536);
            const int cp = tid & 255, th = tid >> 8;
            float w0[CK], w1[CK];
#pragma unroll
            for (int j = 0; j < CK; ++j) { const f32x2 w = *(const f32x2*)(conv_w + j * CW + 2 * cp); w0[j] = w.x; w1[j] = w.y; }
            const f32x2 cb = *(const f32x2*)(conv_b + 2 * cp);
            v4u pf[8];
#define CONV_FETCH(TILE) { const int b_ = (TILE) >> 7, t0_ = ((TILE) & 127) * 32; \
                _Pragma("unroll") for (int i = 0; i < 8; ++i) { int c = tid + 512 * i; c = c < 62 * 64 ? c : 62 * 64 - 1; const int r = c >> 6, ch = c & 63, t = t0_ - 30 + r; \
                    v4u val = *(const GAS v4u*)(GLU + ((size_t)b_ * SEQ + (t < 0 ? 0 : t)) * CW + ch * 8); if (t < 0) val = (v4u){0u, 0u, 0u, 0u}; pf[i] = val; } }
            if (bx < M / 32) CONV_FETCH(bx)
            for (int tile = bx; tile < M / 32; tile += G) {
                const int b = tile >> 7, t0 = (tile & 127) * 32; const size_t row0 = (size_t)b * SEQ + t0;
#pragma unroll
                for (int i = 0; i < 8; ++i) { const int c = tid + 512 * i; if (c < 62 * 64) *(LAS v4u*)(lds + (size_t)c * 16) = pf[i]; }
                v4u zc[4];
#pragma unroll
                for (int q = 0; q < 4; ++q) zc[q] = *(const GAS v4u*)(ZC + (row0 + wave + 8 * q) * CW + lane * 8);
                __syncthreads();
                { const int nt_ = tile + G < M / 32 ? tile + G : tile; CONV_FETCH(nt_) }
                unsigned xs[46];
#pragma unroll
                for (int i = 0; i < 46; ++i) xs[i] = in32[(th * 16 + i) * 256 + cp];
#pragma unroll
                for (int tl = 0; tl < 16; ++tl) { float a0 = cb.x, a1 = cb.y;
#pragma unroll
                    for (int j = 0; j < CK; ++j) { const unsigned xv = xs[tl + j]; a0 += w0[j] * bf_lo(xv); a1 += w1[j] * bf_hi(xv); }
                    *(LAS f32x2*)(ot + (th * 16 + tl) * CW + 2 * cp) = (f32x2){a0, a1}; }
                __syncthreads();
                {
                    const f32x4 lw0 = *(const f32x4*)(conv_ln_w + lane * 8), lw1 = *(const f32x4*)(conv_ln_w + lane * 8 + 4);
                    const f32x4 lb0 = *(const f32x4*)(conv_ln_b + lane * 8), lb1 = *(const f32x4*)(conv_ln_b + lane * 8 + 4);
#pragma unroll
                    for (int q = 0; q < 4; ++q) { const int tl = wave + 8 * q;
                        f32x4 v0 = *(const LAS f32x4*)(ot + tl * CW + lane * 8), v1 = *(const LAS f32x4*)(ot + tl * CW + lane * 8 + 4);
                        const float mean = wave_sum((v0.x + v0.y) + (v0.z + v0.w) + (v1.x + v1.y) + (v1.z + v1.w)) * (1.f / CW);
                        v0 = v0 - mean; v1 = v1 - mean;
                        const float var = wave_sum((v0.x * v0.x + v0.y * v0.y) + (v0.z * v0.z + v0.w * v0.w) + (v1.x * v1.x + v1.y * v1.y) + (v1.z * v1.z + v1.w * v1.w)) * (1.f / CW);
                        const float rstd = __builtin_amdgcn_rsqf(var + pg8::NORM_EPS);
                        v0 = v0 * rstd * lw0 + lb0; v1 = v1 * rstd * lw1 + lb1;
                        const v4u zq = zc[q];
                        const float z[8] = {bf_lo(zq.x), bf_hi(zq.x), bf_lo(zq.y), bf_hi(zq.y), bf_lo(zq.z), bf_hi(zq.z), bf_lo(zq.w), bf_hi(zq.w)};
#pragma unroll
                        for (int i = 0; i < 4; ++i) { v0[i] = v0[i] * sigmoidf_(v0[i]) * z[i]; v1[i] = v1[i] * sigmoidf_(v1[i]) * z[4 + i]; }
                        *(GAS v4u*)(A2 + (row0 + tl) * DM + CW + lane * 8) = pg8::pack8(v0, v1); }
                }
                __syncthreads();
            }
#undef CONV_FETCH
        }
        {
            const int r32 = lane & 31, hi = lane >> 5;
            const int vrd_off = (4 * hi + ((lane & 15) >> 2)) * 64 + ((lane >> 4) & 1) * 32 + (lane & 3) * 8;
            const int piece = wave & 3, tsel = wave >> 2;
            bf16* PB = (bf16*)(ws + WS_PB); float* PL = (float*)(ws + WS_LSE);
            const unsigned lds0 = (unsigned)(uintptr_t)lds_raw;
            const unsigned voffK = (unsigned)(((8 * piece + (lane >> 3)) * HD + (((lane & 7) ^ (((8 * piece + (lane >> 3)) >> 1) & 7)) << 3)) * 2);
            const unsigned voffV = (unsigned)(((16 * (piece & 1) + (lane >> 2)) * HD + (piece >> 1) * 32 + (lane & 3) * 8) * 2);
#define ATT_BAR() do { asm volatile("s_waitcnt lgkmcnt(0)" ::: "memory"); __builtin_amdgcn_s_barrier(); asm volatile("" ::: "memory"); } while (0)
#define ATT_DMA(ISV, SRC, RROW, JSB, NT, LDSOFF, FORCE) do { \
                _Pragma("unroll") for (int m_ = 0; m_ < 6; ++m_) { const int kt_ = 2 * m_ + tsel; const int js_ = (JSB) + 32 * kt_; \
                    if (m_ < (NT) / 2 && ((FORCE) || js_ >= 0)) \
                        glds16s((SRC) + ((size_t)(RROW) + (js_ < 0 ? 0 : js_)) * HD, ISV ? voffV : voffK, (unsigned)__builtin_amdgcn_readfirstlane((int)(lds0 + (LDSOFF) + kt_ * 4096 + piece * 1024))); } } while (0)
#define ATT_ROUND(G_, RROW, IU0, JB, KTB, KBUF, TSH, TOK0, PBO, PBL, MROW0, NKN, QNP, QNROW) do { \
                    const int iq = (IU0) + r32; const int tq = (iq << (TSH)) + (TOK0); \
                    f32x16 S[5]; \
                    _Pragma("unroll") for (int tau = 0; tau < 5; ++tau) { \
                        _Pragma("unroll") for (int r = 0; r < 16; ++r) S[tau][r] = -INFINITY; \
                        if ((JB) + 32 * tau >= 0) { \
                            const LAS char* kp = (const LAS char*)(lds + (KBUF) + ((KTB) + tau) * 4096 + r32 * 128); \
                            f32x16 sacc = {}; \
                            _Pragma("unroll") for (int ks = 0; ks < 4; ++ks) { const bf16x8 kf = *(const LAS bf16x8*)(kp + (((2 * ks + hi) ^ ((r32 >> 1) & 7)) << 4)); \
                                sacc = __builtin_amdgcn_mfma_f32_32x32x16_bf16(kf, qf[ks], sacc, 0, 0, 0); } \
                            if (tau == 0) { _Pragma("unroll") for (int r = 0; r < 16; ++r) if (crow(r, hi) < r32) sacc[r] = -INFINITY; } \
                            if (tau == 4) { _Pragma("unroll") for (int r = 0; r < 16; ++r) if (crow(r, hi) > r32) sacc[r] = -INFINITY; } \
                            S[tau] = sacc; } } \
                    float mx = -INFINITY; \
                    _Pragma("unroll") for (int tau = 0; tau < 5; ++tau) _Pragma("unroll") for (int r = 0; r < 16; r += 2) mx = fmaxf(fmaxf(mx, S[tau][r]), S[tau][r + 1]); \
                    mx = fmaxf(mx, __shfl_xor(mx, 32)); \
                    float l = 0.f; v4u P[5][2]; \
                    _Pragma("unroll") for (int tau = 0; tau < 5; ++tau) { f32x16 p = S[tau]; float ps = 0.f; \
                        _Pragma("unroll") for (int r = 0; r < 16; ++r) { p[r] = __builtin_amdgcn_exp2f(p[r] - mx); ps += p[r]; } \
                        l += ps; \
                        P[tau][0].x = cvt_pk_bf16(p[0], p[1]); P[tau][0].y = cvt_pk_bf16(p[2], p[3]); P[tau][0].z = cvt_pk_bf16(p[4], p[5]); P[tau][0].w = cvt_pk_bf16(p[6], p[7]); \
                        P[tau][1].x = cvt_pk_bf16(p[8], p[9]); P[tau][1].y = cvt_pk_bf16(p[10], p[11]); P[tau][1].z = cvt_pk_bf16(p[12], p[13]); P[tau][1].w = cvt_pk_bf16(p[14], p[15]); } \
                    l += __shfl_xor(l, 32); \
                    asm volatile("s_waitcnt vmcnt(" #NKN ")" ::: "memory"); ATT_BAR();     \
                    ATT_LOAD_Q(qn, QNP, QNROW); \
                    if ((G_) < 2) ATT_LOAD_P(PBO, PBL, tq); \
                    f32x16 o[2]; o[0] = f32x16{}; o[1] = f32x16{}; \
                    _Pragma("unroll") for (int tau = 0; tau < 5; ++tau) { \
                        if ((JB) + 32 * tau >= 0) { \
                            const LAS char* vp = (const LAS char*)(lds + ATT_V + ((KTB) + tau) * 4096 + vrd_off); \
                            const bf16x8 pf0 = __builtin_bit_cast(bf16x8, P[tau][0]), pf1 = __builtin_bit_cast(bf16x8, P[tau][1]); \
                            _Pragma("unroll") for (int d0 = 0; d0 < 2; ++d0) { \
                                const s16x4 a0 = vtr(vp + d0 * 2048), a1 = vtr(vp + d0 * 2048 + 512), a2 = vtr(vp + d0 * 2048 + 1024), a3 = vtr(vp + d0 * 2048 + 1536); \
                                const bf16x8 vf0 = (bf16x8){a0[0], a0[1], a0[2], a0[3], a1[0], a1[1], a1[2], a1[3]}; \
                                const bf16x8 vf1 = (bf16x8){a2[0], a2[1], a2[2], a2[3], a3[0], a3[1], a3[2], a3[3]}; \
                                o[d0] = __builtin_amdgcn_mfma_f32_32x32x16_bf16(vf0, pf0, o[d0], 0, 0, 0); \
                                o[d0] = __builtin_amdgcn_mfma_f32_32x32x16_bf16(vf1, pf1, o[d0], 0, 0, 0); } } } \
                    float lse = mx + __builtin_amdgcn_logf(l), sc_own = __builtin_amdgcn_rcpf(l), sc_p = 0.f; \
                    if ((G_) < 2) { const float mx2 = fmaxf(lse, plse), a = __builtin_amdgcn_exp2f(lse - mx2), bq = __builtin_amdgcn_exp2f(plse - mx2), inv = __builtin_amdgcn_rcpf(a + bq); \
                        sc_own = sc_own * a * inv; sc_p = bq * inv; lse = mx2 + __builtin_amdgcn_logf(a + bq); } \
                      \
                    if ((G_) < 2) { _Pragma("unroll") for (int c = 0; c < 4; ++c) { const auto rx = __builtin_amdgcn_permlane32_swap(pq[c].x, pq[c].z, false, false); const auto ry = __builtin_amdgcn_permlane32_swap(pq[c].y, pq[c].w, false, false); \
                        pp[2 * c] = (v2u){rx[0], ry[0]}; pp[2 * c + 1] = (v2u){rx[1], ry[1]}; } } \
                    if ((G_) > 0) { \
                        _Pragma("unroll") for (int d0 = 0; d0 < 2; ++d0) _Pragma("unroll") for (int j = 0; j < 2; ++j) { v2u w[2]; \
                            _Pragma("unroll") for (int q = 0; q < 2; ++q) { const int rg = 2 * j + q; \
                                float e0 = o[d0][4 * rg] * sc_own, e1 = o[d0][4 * rg + 1] * sc_own, e2 = o[d0][4 * rg + 2] * sc_own, e3 = o[d0][4 * rg + 3] * sc_own; \
                                if ((G_) < 2) { const v2u pw = pp[d0 * 4 + rg]; e0 += sc_p * bf_lo(pw.x); e1 += sc_p * bf_hi(pw.x); e2 += sc_p * bf_lo(pw.y); e3 += sc_p * bf_hi(pw.y); } \
                                w[q].x = cvt_pk_bf16(e0, e1); w[q].y = cvt_pk_bf16(e2, e3); } \
                            const auto rx = __builtin_amdgcn_permlane32_swap(w[0].x, w[1].x, false, false); const auto ry = __builtin_amdgcn_permlane32_swap(w[0].y, w[1].y, false, false); \
                            *(GAS v4u*)((PBO) + (size_t)tq * HD + 32 * d0 + 16 * j + 8 * hi) = (v4u){rx[0], ry[0], rx[1], ry[1]}; } \
                        if (hi == 0) (PBL)[tq] = lse; \
                    } else { \
                        const size_t mrow = (size_t)(MROW0) + tq; \
                        v4u zq[4]; v2u zz[8]; \
                        _Pragma("unroll") for (int d0 = 0; d0 < 2; ++d0) _Pragma("unroll") for (int j = 0; j < 2; ++j) zq[d0 * 2 + j] = *(const GAS v4u*)(ZA + mrow * CW + h * 64 + 32 * d0 + 16 * j + 8 * hi); \
                        _Pragma("unroll") for (int c = 0; c < 4; ++c) { const auto rx = __builtin_amdgcn_permlane32_swap(zq[c].x, zq[c].z, false, false); const auto ry = __builtin_amdgcn_permlane32_swap(zq[c].y, zq[c].w, false, false); \
                            zz[2 * c] = (v2u){rx[0], ry[0]}; zz[2 * c + 1] = (v2u){rx[1], ry[1]}; } \
                        _Pragma("unroll") for (int d0 = 0; d0 < 2; ++d0) _Pragma("unroll") for (int j = 0; j < 2; ++j) { v2u w[2]; \
                            _Pragma("unroll") for (int q = 0; q < 2; ++q) { const int rg = 2 * j + q; const v2u pw = pp[d0 * 4 + rg]; const v2u zw = zz[d0 * 4 + rg]; \
                                const float e0 = (o[d0][4 * rg] * sc_own + sc_p * bf_lo(pw.x)) * bf_lo(zw.x), e1 = (o[d0][4 * rg + 1] * sc_own + sc_p * bf_hi(pw.x)) * bf_hi(zw.x); \
                                const float e2 = (o[d0][4 * rg + 2] * sc_own + sc_p * bf_lo(pw.y)) * bf_lo(zw.y), e3 = (o[d0][4 * rg + 3] * sc_own + sc_p * bf_hi(pw.y)) * bf_hi(zw.y); \
                                w[q].x = cvt_pk_bf16(e0, e1); w[q].y = cvt_pk_bf16(e2, e3); } \
                            const auto rx = __builtin_amdgcn_permlane32_swap(w[0].x, w[1].x, false, false); const auto ry = __builtin_amdgcn_permlane32_swap(w[0].y, w[1].y, false, false); \
                            *(GAS v4u*)(A2 + mrow * DM + h * 64 + 32 * d0 + 16 * j + 8 * hi) = (v4u){rx[0], ry[0], rx[1], ry[1]}; } } \
                } while (0)
#define ATT_LOAD_Q(DST, QP, ROW) do { _Pragma("unroll") for (int ks = 0; ks < 4; ++ks) DST[ks] = *(const GAS bf16x8*)((QP) + (size_t)(ROW) * HD + 16 * ks + 8 * hi); } while (0)
#define ATT_LOAD_P(PBO, PBL, TQ) do { _Pragma("unroll") for (int d0 = 0; d0 < 2; ++d0) _Pragma("unroll") for (int j = 0; j < 2; ++j) pq[d0 * 2 + j] = *(const GAS v4u*)((PBO) + (size_t)(TQ) * HD + 32 * d0 + 16 * j + 8 * hi); \
                plse = (PBL)[TQ]; } while (0)
            bf16x8 qf[4], qn[4]; v4u pq[4]; v2u pp[8]; float plse;
            {
                const int NCH = BATCH * HPG * 16;
                if (vcu < NCH) { const int bh = vcu >> 4, res = vcu & 15; const size_t base = (size_t)(((bh >> 3) * 3 + 2) * 8 + (bh & 7)) * SEQ * HD;
                    ATT_LOAD_Q(qf, QB + base, res * 256 + 32 * wave + r32);
                    asm volatile("s_waitcnt vmcnt(0)" ::: "memory"); ATT_BAR();
                    ATT_DMA(false, KB + base, res * 256, 0, 8, ATT_K0, false); }
                int kpar = 0;
                for (int ch = vcu; ch < NCH; ch += G, kpar ^= 1) {
                    const int bh = ch >> 4, res = ch & 15, b = bh >> 3, h = bh & 7; const size_t base = (size_t)((b * 3 + 2) * 8 + h) * SEQ * HD;
                    const int chn = ch + G < NCH ? ch + G : ch, bhn = chn >> 4, resn = chn & 15; const size_t basen = (size_t)(((bhn >> 3) * 3 + 2) * 8 + (bhn & 7)) * SEQ * HD;
                    const int kbuf = kpar ? ATT_K1 : ATT_K0, knext = kpar ? ATT_K0 : ATT_K1;
                    if (ch == vcu) asm volatile("s_waitcnt vmcnt(0)" ::: "memory");
                    asm volatile("" : "+v"(qf[0]), "+v"(qf[1]), "+v"(qf[2]), "+v"(qf[3]));
                    ATT_BAR();
                    ATT_DMA(true, VB + base, res * 256, 0, 8, ATT_V, false);
                    if (ch + G < NCH) { ATT_DMA(false, KB + basen, resn * 256, 0, 8, knext, true);
                        ATT_ROUND(2, res * 256, 32 * wave, 32 * wave - 128, wave - 4, kbuf, 4, res, PB + (size_t)bh * SEQ * HD, PL + (size_t)bh * SEQ, 0, 4, QB + basen, resn * 256 + 32 * wave + r32); }
                    else { ATT_ROUND(2, res * 256, 32 * wave, 32 * wave - 128, wave - 4, kbuf, 4, res, PB + (size_t)bh * SEQ * HD, PL + (size_t)bh * SEQ, 0, 0, QB + basen, resn * 256 + 32 * wave + r32); }
#pragma unroll
                    for (int ks = 0; ks < 4; ++ks) qf[ks] = qn[ks];
                }
                asm volatile("s_waitcnt vmcnt(0)" ::: "memory"); ATT_BAR();
            }
            GRID_BAR(6);
            for (int item = vcu; item < BATCH * HPG * 4; item += G) {
                const int span = item & 3, h = (item >> 2) & 7, b = item >> 5, bh = b * 8 + h;
                bf16* pbo = PB + (size_t)bh * SEQ * HD; float* pbl = PL + (size_t)bh * SEQ;
                const size_t base1 = (size_t)((b * 3 + 1) * 8 + h) * SEQ * HD, base0 = (size_t)((b * 3 + 0) * 8 + h) * SEQ * HD;
#define ITEM_RND(RD, G_, BASE_, RROW_, QB0_, TSH_, TOK0_) const int G_ = (RD) < 4 ? 1 : 0; const size_t BASE_ = (RD) < 4 ? base1 : base0; \
                const int RROW_ = (RD) < 4 ? (RD) * 1024 : 0, QB0_ = (RD) < 4 ? (span << 8) : (span << 10) + (((RD) - 4) << 8), TSH_ = (RD) < 4 ? 2 : 0, TOK0_ = (RD) < 4 ? (RD) : 0;
                { ITEM_RND(0, g_, base_, rrow_, qb0_, tsh_, tok0_)
                  ATT_LOAD_Q(qf, QB + base_, rrow_ + qb0_ + 32 * wave + r32);
                  asm volatile("s_waitcnt vmcnt(0)" ::: "memory"); ATT_BAR();
                  ATT_DMA(false, KB + base_, rrow_, qb0_ - 128, 12, ATT_K0, false); }
                for (int rd = 0; rd < 8; ++rd) {
                    ITEM_RND(rd, g, base, rrow, qb0, tsh, tok0)
                    const int rdn = rd + 1 < 8 ? rd + 1 : rd; ITEM_RND(rdn, gn, basen, rrown, qb0n, tshn, tok0n)
                    const int kbuf = (rd & 1) ? ATT_K1 : ATT_K0, knext = (rd & 1) ? ATT_K0 : ATT_K1;
                    if (rd == 0 || rd == 4) asm volatile("s_waitcnt vmcnt(0)" ::: "memory");
                    asm volatile("" : "+v"(qf[0]), "+v"(qf[1]), "+v"(qf[2]), "+v"(qf[3]));
                    ATT_BAR();
                    ATT_DMA(true, VB + base, rrow, qb0 - 128, 12, ATT_V, false);
                    if (rd + 1 < 8) { ATT_DMA(false, KB + basen, rrown, qb0n - 128, 12, knext, true);
                        ATT_ROUND(g, rrow, qb0 + 32 * wave, qb0 + 32 * wave - 128, wave, kbuf, tsh, tok0, pbo, pbl, (size_t)b * SEQ, 6, QB + basen, rrown + qb0n + 32 * wave + r32); }
                    else { ATT_ROUND(g, rrow, qb0 + 32 * wave, qb0 + 32 * wave - 128, wave, kbuf, tsh, tok0, pbo, pbl, (size_t)b * SEQ, 0, QB + basen, rrown + qb0n + 32 * wave + r32); }
#pragma unroll
                    for (int ks = 0; ks < 4; ++ks) qf[ks] = qn[ks];
                }
#undef ITEM_RND
            }
            asm volatile("s_waitcnt vmcnt(0)" ::: "memory"); ATT_BAR();
#undef ATT_BAR
#undef ATT_DMA
#undef ATT_ROUND
#undef ATT_LOAD_Q
#undef ATT_LOAD_P
        }
        if (BOTH(3)) GRID_BAR(3);
    }

    if (IN(4)) {
        { pg8::Gemm g{A2, W2, M, DM, DM}; pg8::StaticOrder S; S.init(M, DM, G, bx);
          pg8::EpiMerge2 E{(const unsigned char*)SG, MG, lds + RING_OFF + RING_BYTES + wave * 2048};
          pg8::gemm_phase<pg8::EpiMerge2, pg8::StaticOrder, true, true>(lds + RING_OFF, g, S, E); }
        if (BOTH(4)) GRID_BAR(4);
    }

    if (IN(5)) {
        pg8::Gemm g{MG, WO, M, DM, DM}; pg8::StaticOrder S; S.init(M, DM, G, bx);
        pg8::EpiOut E{x, out, ADA, lds + RING_OFF + RING_BYTES + wave * 2048};
        pg8::gemm_phase<pg8::EpiOut, pg8::StaticOrder, true, true>(lds + RING_OFF, g, S, E);
    }
#undef IN
#undef BOTH
}

extern "C" void kernel_launch(void* const* d_in, const int* in_sizes, int n_in, void* d_out, int out_size, void* d_ws, size_t ws_size, hipStream_t stream) {
    static int grid = 0;
    if (grid == 0) {
        if (n_in != 16 || in_sizes[0] != M * DM || out_size != M * DM || ws_size < WS_END) { fprintf(stderr, "kernel_launch: unexpected shapes (n_in %d, in0 %d, out %d, ws %zu)\n", n_in, n_in > 0 ? in_sizes[0] : -1, out_size, ws_size); grid = -1; return; }
        int dev = 0, cus = 0, per_cu = 0;
        if (hipGetDevice(&dev) != hipSuccess || hipDeviceGetAttribute(&cus, hipDeviceAttributeMultiprocessorCount, dev) != hipSuccess) { grid = -1; return; }
        if (hipFuncSetAttribute((const void*)mega_fwd, hipFuncAttributeMaxDynamicSharedMemorySize, LDS_BYTES) != hipSuccess) { fprintf(stderr, "kernel_launch: hipFuncSetAttribute failed\n"); grid = -1; return; }
        if (hipOccupancyMaxActiveBlocksPerMultiprocessor(&per_cu, (const void*)mega_fwd, NWAVES * 64, LDS_BYTES) != hipSuccess || per_cu < 1) { fprintf(stderr, "kernel_launch: occupancy query says %d\n", per_cu); (void)hipGetLastError(); per_cu = 1; }
        if (per_cu > 1) per_cu = 1;
        grid = cus * per_cu;
    }
    if (grid < 0) return;
    (void)hipMemsetAsync((char*)d_ws + WS_CTL, 0, CTL_ZERO_BYTES, stream);
    Args a{};
    for (int i = 0; i < 16; ++i) a.in[i] = (const float*)d_in[i];
    a.out = (float*)d_out; a.ws = (unsigned char*)d_ws;
    a.ph_lo = 0; a.ph_hi = N_PHASES;
    hipLaunchKernelGGL(mega_fwd, dim3(grid), dim3(NWAVES * 64), LDS_BYTES, stream, a);
}
```

```cpp
#include <hip/hip_runtime.h>
#include <cstdio>
#include <cstdint>

namespace pg8 {
#define PG8_LAS __attribute__((address_space(3)))
typedef unsigned short bf16_t;
typedef short bf16x8 __attribute__((ext_vector_type(8)));
typedef float f32x4 __attribute__((ext_vector_type(4)));
typedef unsigned u32x4 __attribute__((ext_vector_type(4)));
constexpr int BM = 256, BK = 64, HALF = 128, HTB = HALF * BK * 2, STAGE_BYTES = 8 * HTB, NXCD = 8, WGM = 8;

__host__ __device__ __forceinline__ int lds_byte(int r, int c) { const int st = (r >> 4) * 2 + (c >> 5), rr = r & 15, cc = c & 31, ob = rr * 64 + cc * 2; return st * 1024 + (ob ^ (((ob >> 9) & 1) << 5)); }
__host__ __device__ __forceinline__ void stage_rc(int b, int& R, int& C) { const int st = b / 1024, sb = b % 1024, swz = sb ^ (((sb >> 9) & 1) << 5); R = (st >> 1) * 16 + swz / 64; C = (st & 1) * 32 + (swz % 64) / 2; }
__host__ __device__ __forceinline__ int perm32(int rho) { const int n = rho >> 4, i = rho & 15; return 8 * (i >> 2) + 4 * n + (i & 3); }

struct Unit { int pm, pn; };
struct Gemm { const bf16_t* A; const bf16_t* Bt; int M, N, K; };

struct StaticOrder {
    int nM, nN, nwg, G, c;
    __host__ __device__ void init(int M, int N, int G_, int c_) { nM = M / BM; nN = N / BM; nwg = nM * nN; G = G_; c = c_; }
    __host__ __device__ bool next(int i, Unit& u) const {
        const long L = (long)i * G + c; if (L >= nwg) return false;
        int wgid = (int)L; { const int q = nwg / NXCD, r = nwg % NXCD, xcd = wgid % NXCD, off = wgid / NXCD; wgid = (xcd < r ? xcd * (q + 1) : r * (q + 1) + (xcd - r) * q) + off; }
        const int nig = WGM * nN, gid = wgid / nig, fm = gid * WGM, gsz = (nM - fm) < WGM ? (nM - fm) : WGM;
        u.pm = fm + ((wgid % nig) % gsz); u.pn = (wgid % nig) / gsz; return true;
    }
    __device__ __forceinline__ void a_ready(const Unit&) const {}
    __device__ __forceinline__ void done(const Unit&) const {}
};

typedef float f32x2_t __attribute__((ext_vector_type(2))); typedef __bf16 bf16x2_t __attribute__((ext_vector_type(2)));
__device__ __forceinline__ unsigned cvt_pk_bf16(float lo, float hi) { f32x2_t v = {lo, hi}; bf16x2_t b = __builtin_convertvector(v, bf16x2_t); return __builtin_bit_cast(unsigned, b); }
__device__ __forceinline__ float bf_lo(unsigned w) { return __uint_as_float(w << 16); }
__device__ __forceinline__ float bf_hi(unsigned w) { return __uint_as_float(w & 0xffff0000u); }
__device__ __forceinline__ float sigmoidf_(float x) { return __builtin_amdgcn_rcpf(1.0f + __builtin_amdgcn_exp2f(-1.4426950408889634f * x)); }
__device__ __forceinline__ u32x4 pack8(const f32x4& a, const f32x4& b) { u32x4 w; w.x = cvt_pk_bf16(a[0], a[1]); w.y = cvt_pk_bf16(a[2], a[3]); w.z = cvt_pk_bf16(b[0], b[1]); w.w = cvt_pk_bf16(b[2], b[3]); return w; }


constexpr float QSCALE = 0.125f * 1.4426950408889634f;
constexpr float NORM_EPS = 1e-6f;
#define PG8_XPOSE(P0, P1, T0, T1) do { *(PG8_LAS u32x4*)xw0 = (P0); *(PG8_LAS u32x4*)xw1 = (P1); T0 = *(const PG8_LAS u32x4*)xr0; T1 = *(const PG8_LAS u32x4*)(xr0 + 1024); } while (0)
#define PG8_XPOSE_ADDR PG8_LAS unsigned char* xw0 = scr + fr * 128 + 16 * (fq ^ (fr & 7)); PG8_LAS unsigned char* xw1 = scr + fr * 128 + 16 * ((4 + fq) ^ (fr & 7)); \
        const int r8 = 2 * fq + (fr >> 3), c8 = fr & 7; const PG8_LAS unsigned char* xr0 = scr + r8 * 128 + 16 * (c8 ^ (r8 & 7));
__device__ __forceinline__ size_t sg_frag(int pm, int t, int ai, int m, int wave, int lane) { return ((((((size_t)pm * 8 + t) * 2 + ai) * 4 + m) * 8 + wave) * 64 + lane) * 16; }
struct EpiIn {
    static constexpr bool PERM = true, AFTER_DRAIN = false; static constexpr int MIDK = 0;
    bf16_t *Q; size_t qkv_stride; bf16_t *ZA; size_t zc_off; bf16_t *GLU; unsigned char* SG; const float *qw, *kw, *bgate; PG8_LAS unsigned char* scr;
    __device__ __forceinline__ void operator()(const f32x4 (&acc)[2][2][4][2], const Unit& u, int wr, int wc, int fr, int fq) const {
        const int pn = u.pn;
        PG8_XPOSE_ADDR
        const int rown = u.pm * BM + wr * 64 + r8;
        if (pn < 18) {
            const int kind = pn / 6, rel = pn - kind * 6, g = rel >> 1, hb = ((rel & 1) << 2) + wc, sh = 2 * g;
            bf16_t* base = Q + (size_t)kind * qkv_stride;
            f32x4 wv[2][2];
            if (kind < 2) { const float* w = qw; if (kind == 1) w = kw; const float sc = kind == 0 ? QSCALE : 1.0f;
#pragma unroll
                for (int bj = 0; bj < 2; ++bj)
#pragma unroll
                    for (int n = 0; n < 2; ++n) wv[bj][n] = *(const f32x4*)(w + 32 * bj + 8 * fq + 4 * n) * sc; }
#pragma unroll
            for (int ai = 0; ai < 2; ++ai)
#pragma unroll
                for (int m = 0; m < 4; ++m) {
                    f32x4 v00 = acc[ai][0][m][0], v01 = acc[ai][0][m][1], v10 = acc[ai][1][m][0], v11 = acc[ai][1][m][1];
                    if (kind < 2) {
                        f32x4 q = v00 * v00 + v01 * v01 + v10 * v10 + v11 * v11; float ss = (q[0] + q[1]) + (q[2] + q[3]);
                        ss += __shfl_xor(ss, 16); ss += __shfl_xor(ss, 32);
                        const float rstd = __builtin_amdgcn_rsqf(ss * (1.0f / 64.0f) + NORM_EPS);
                        v00 = v00 * rstd * wv[0][0]; v01 = v01 * rstd * wv[0][1]; v10 = v10 * rstd * wv[1][0]; v11 = v11 * rstd * wv[1][1];
                    }
                    u32x4 t0, t1; PG8_XPOSE(pack8(v00, v01), pack8(v10, v11), t0, t1);
#pragma unroll
                    for (int h = 0; h < 2; ++h) { const int row = rown + ai * HALF + m * 16 + 8 * h, b = row >> 12, t = row & 4095;
                        const int tp = ((t & ((1 << sh) - 1)) << (12 - sh)) | (t >> sh);
                        __builtin_nontemporal_store(h ? t1 : t0, (u32x4*)(base + ((size_t)(((b * 3 + g) * 8 + hb) * 4096 + tp) * 64 + 8 * c8))); }
                }
        } else if (pn < 20 || (pn >= 24 && pn < 26)) {
            bf16_t* base = ZA + (pn < 20 ? (size_t)0 : zc_off); const int rel = pn < 20 ? pn - 18 : pn - 24; const int colN = rel * BM + wc * 32 + (c8 >> 2) * HALF + 8 * (c8 & 3);
#pragma unroll
            for (int ai = 0; ai < 2; ++ai)
#pragma unroll
                for (int m = 0; m < 4; ++m) { u32x4 p[2];
#pragma unroll
                    for (int bj = 0; bj < 2; ++bj) { f32x4 a = acc[ai][bj][m][0], b = acc[ai][bj][m][1];
#pragma unroll
                        for (int i = 0; i < 4; ++i) { a[i] = a[i] * sigmoidf_(a[i]); b[i] = b[i] * sigmoidf_(b[i]); }
                        p[bj] = pack8(a, b); }
                    u32x4 t0, t1; PG8_XPOSE(p[0], p[1], t0, t1);
                    bf16_t* dst = base + (size_t)(rown + ai * HALF + m * 16) * 512 + colN;
                    __builtin_nontemporal_store(t0, (u32x4*)dst); __builtin_nontemporal_store(t1, (u32x4*)(dst + 8 * 512)); }
        } else if (pn < 24) {
            const int colN = (pn - 20) * HALF + wc * 32 + 8 * (c8 & 3);
#pragma unroll
            for (int ai = 0; ai < 2; ++ai)
#pragma unroll
                for (int mp = 0; mp < 2; ++mp) { u32x4 p[2];
#pragma unroll
                    for (int q = 0; q < 2; ++q) { const int m = 2 * mp + q;
                        f32x4 a0 = acc[ai][0][m][0], a1 = acc[ai][0][m][1]; const f32x4 b0 = acc[ai][1][m][0], b1 = acc[ai][1][m][1];
#pragma unroll
                        for (int i = 0; i < 4; ++i) { a0[i] = a0[i] * sigmoidf_(b0[i]); a1[i] = a1[i] * sigmoidf_(b1[i]); }
                        p[q] = pack8(a0, a1); }
                    u32x4 t0, t1; PG8_XPOSE(p[0], p[1], t0, t1);
                    bf16_t* dst = GLU + (size_t)(rown + ai * HALF + (2 * mp + (c8 >> 2)) * 16) * 512 + colN;
                    __builtin_nontemporal_store(t0, (u32x4*)dst); __builtin_nontemporal_store(t1, (u32x4*)(dst + 8 * 512)); }
        } else {
            const int t = pn - 26; const int gc0 = t * BM + wc * 32 + 8 * fq;
            f32x4 bv[2][2];
#pragma unroll
            for (int bj = 0; bj < 2; ++bj)
#pragma unroll
                for (int n = 0; n < 2; ++n) bv[bj][n] = *(const f32x4*)(bgate + gc0 + HALF * bj + 4 * n);
#pragma unroll
            for (int ai = 0; ai < 2; ++ai)
#pragma unroll
                for (int m = 0; m < 4; ++m) {
                    u32x4 w;
#pragma unroll
                    for (int bj = 0; bj < 2; ++bj) { f32x4 a = acc[ai][bj][m][0] + bv[bj][0], b = acc[ai][bj][m][1] + bv[bj][1];
                        unsigned wa = 0u, wb = 0u;
#pragma unroll
                        for (int i = 0; i < 4; ++i) { wa = __builtin_amdgcn_cvt_pk_u8_f32(sigmoidf_(a[i]) * 255.0f, i, wa); wb = __builtin_amdgcn_cvt_pk_u8_f32(sigmoidf_(b[i]) * 255.0f, i, wb); }
                        if (bj == 0) { w.x = wa; w.y = wb; } else { w.z = wa; w.w = wb; } }
                    __builtin_nontemporal_store(w, (u32x4*)(SG + sg_frag(u.pm, t, ai, m, wr * 4 + wc, fq * 16 + fr))); }
        }
    }
};
struct EpiMerge2 {
    static constexpr bool PERM = true, AFTER_DRAIN = false; static constexpr int MIDK = 8;
    const unsigned char* SG; bf16_t* OUT; PG8_LAS unsigned char* scr;
    __device__ __forceinline__ void mid(f32x4 (&acc)[2][2][4][2], const Unit& u, int wr, int wc, int fr, int fq) const {
        asm volatile("" : "+v"(fr), "+v"(fq));
        const int wave = wr * 4 + wc, lane = fq * 16 + fr;
#pragma unroll
        for (int ai = 0; ai < 2; ++ai)
#pragma unroll
            for (int m = 0; m < 4; ++m) {
                const u32x4 ga = *(const u32x4*)(SG + sg_frag(u.pm, u.pn, ai, m, wave, lane)), gc = *(const u32x4*)(SG + sg_frag(u.pm, u.pn + 4, ai, m, wave, lane));
#pragma unroll
                for (int bj = 0; bj < 2; ++bj) {
                    const unsigned gax = bj ? ga.z : ga.x, gay = bj ? ga.w : ga.y, gcx = bj ? gc.z : gc.x, gcy = bj ? gc.w : gc.y;
                    f32x4& a = acc[ai][bj][m][0]; f32x4& b = acc[ai][bj][m][1];
#pragma unroll
                    for (int i = 0; i < 4; ++i) {
                        a[i] *= (float)((gax >> (8 * i)) & 255u) * __builtin_amdgcn_rcpf(fmaxf((float)((gcx >> (8 * i)) & 255u), 0.5f));
                        b[i] *= (float)((gay >> (8 * i)) & 255u) * __builtin_amdgcn_rcpf(fmaxf((float)((gcy >> (8 * i)) & 255u), 0.5f)); } }
                if (m & 1) asm volatile("" ::: "memory"); }
    }
    __device__ __forceinline__ void operator()(const f32x4 (&acc)[2][2][4][2], const Unit& u, int wr, int wc, int fr, int fq) const {
        asm volatile("" : "+v"(fr), "+v"(fq));
        const int wave = wr * 4 + wc, lane = fq * 16 + fr;
        PG8_XPOSE_ADDR
        const int rown = u.pm * BM + wr * 64 + r8, colN = u.pn * BM + wc * 32 + (c8 >> 2) * HALF + 8 * (c8 & 3);
#pragma unroll
        for (int ai = 0; ai < 2; ++ai) {
            u32x4 gw[4];
#pragma unroll
            for (int m = 0; m < 4; ++m) gw[m] = *(const u32x4*)(SG + sg_frag(u.pm, u.pn + 4, ai, m, wave, lane));
#pragma unroll
            for (int m = 0; m < 4; ++m) { u32x4 p[2];
#pragma unroll
                for (int bj = 0; bj < 2; ++bj) { const unsigned gx = bj ? gw[m].z : gw[m].x, gy = bj ? gw[m].w : gw[m].y;
                    f32x4 a = acc[ai][bj][m][0], b = acc[ai][bj][m][1];
#pragma unroll
                    for (int i = 0; i < 4; ++i) { a[i] *= fmaxf((float)((gx >> (8 * i)) & 255u), 0.5f) * (1.0f / 255.0f); b[i] *= fmaxf((float)((gy >> (8 * i)) & 255u), 0.5f) * (1.0f / 255.0f); }
                    p[bj] = pack8(a, b); }
                u32x4 t0, t1; PG8_XPOSE(p[0], p[1], t0, t1);
                bf16_t* dst = OUT + (size_t)(rown + ai * HALF + m * 16) * 1024 + colN;
                *(u32x4*)dst = t0; *(u32x4*)(dst + 8 * 1024) = t1; }
        }
    }
};
struct EpiOut {
    static constexpr bool PERM = true, AFTER_DRAIN = false; static constexpr int MIDK = 0;
    const float* X; float* OUT; const float* ADA; PG8_LAS unsigned char* scr;
    __device__ __forceinline__ void operator()(const f32x4 (&acc)[2][2][4][2], const Unit& u, int wr, int wc, int fr, int fq) const {
        asm volatile("" : "+v"(fr), "+v"(fq));
        const int r8 = 2 * fq + (fr >> 3), c8 = fr & 7;
        const int rowb = u.pm * BM + wr * 64 + r8, col0 = u.pn * BM + wc * 32 + 4 * c8; const int b = (u.pm * BM) >> 12;
        PG8_LAS unsigned char* w0 = scr + fr * 128 + 16 * ((2 * fq) ^ (fr & 7)); PG8_LAS unsigned char* w1 = scr + fr * 128 + 16 * ((2 * fq + 1) ^ (fr & 7));
        const PG8_LAS unsigned char* r0 = scr + r8 * 128 + 16 * (c8 ^ (r8 & 7)); const PG8_LAS unsigned char* r1 = r0 + 8 * 128;
        f32x4 gv[2];
#pragma unroll
        for (int bj = 0; bj < 2; ++bj) gv[bj] = *(const f32x4*)(ADA + (size_t)b * 3072 + 2048 + col0 + bj * HALF);
#pragma unroll
        for (int ai = 0; ai < 2; ++ai) {
            f32x4 xv[4][2][2];
#pragma unroll
            for (int m = 0; m < 4; ++m) { const size_t off = (size_t)(rowb + ai * HALF + m * 16) * 1024 + col0;
#pragma unroll
                for (int bj = 0; bj < 2; ++bj)
#pragma unroll
                    for (int h = 0; h < 2; ++h) xv[m][bj][h] = *(const f32x4*)(X + off + (size_t)h * 8 * 1024 + bj * HALF); }
#pragma unroll
            for (int m = 0; m < 4; ++m) { const size_t off = (size_t)(rowb + ai * HALF + m * 16) * 1024 + col0;
#pragma unroll
                for (int bj = 0; bj < 2; ++bj) {
                    *(PG8_LAS f32x4*)w0 = acc[ai][bj][m][0]; *(PG8_LAS f32x4*)w1 = acc[ai][bj][m][1];
                    const f32x4 t0 = *(const PG8_LAS f32x4*)r0, t1 = *(const PG8_LAS f32x4*)r1;
                    *(f32x4*)(OUT + off + bj * HALF) = xv[m][bj][0] + gv[bj] * t0;
                    *(f32x4*)(OUT + off + (size_t)8 * 1024 + bj * HALF) = xv[m][bj][1] + gv[bj] * t1; } }
        }
    }
};

template <class Epi, class Sched, bool ALIGN_EPI = false, bool SP2 = false>
__device__ __forceinline__ void gemm_phase(PG8_LAS unsigned char* lds, const Gemm g, const Sched& S, const Epi& E) {
    const int tid = threadIdx.x, wid = __builtin_amdgcn_readfirstlane(tid >> 6), lane = tid & 63, wr = wid >> 2, wc = wid & 3, fr = lane & 15, fq = lane >> 4;
    const int K = g.K, nt = K / BK;
    unsigned voffA[2], voffB[2];
#pragma unroll
    for (int i = 0; i < 2; ++i) { int R, C; stage_rc(tid * 16 + i * 8192, R, C); const int Rb = Epi::PERM ? ((R & ~31) + perm32(R & 31)) : R;
        voffA[i] = (unsigned)(R * K + C) * 2u; voffB[i] = (unsigned)(Rb * K + C) * 2u; }
    const size_t kstep = (size_t)(BK * 2);
    const size_t hstep = (size_t)HALF * K * 2;
    const size_t tstep = 2 * hstep;
    const unsigned ldsw = (unsigned)wid * 1024u;
    const int aoff = lds_byte(wr * 64 + fr, fq * 8), boff = lds_byte(wc * 32 + fr, fq * 8);
#define PG8_SA(b, h) (((b) * 2 + (h)) * HTB)
#define PG8_SB(b, h) ((4 + (b) * 2 + (h)) * HTB)
#define PG8_STAGE(bufoff, gbase, voff) do { _Pragma("unroll") for (int _i = 0; _i < 2; ++_i) \
        __builtin_amdgcn_global_load_lds((const unsigned*)((const char*)(gbase) + (voff)[_i]), (PG8_LAS unsigned*)(lds + (bufoff) + ldsw + _i * 8192), 16, 0, 0); } while (0)
#define PG8_LDA(dst, b, h) do { _Pragma("unroll") for (int m = 0; m < 4; ++m) _Pragma("unroll") for (int k = 0; k < 2; ++k) dst[m][k] = *(const PG8_LAS bf16x8*)(lds + PG8_SA(b, h) + aoff + m * 2048 + k * 1024); } while (0)
#define PG8_LDB(dst, b, h) do { _Pragma("unroll") for (int n = 0; n < 2; ++n) _Pragma("unroll") for (int k = 0; k < 2; ++k) dst[n][k] = *(const PG8_LAS bf16x8*)(lds + PG8_SB(b, h) + boff + n * 2048 + k * 1024); } while (0)
#define PG8_MMA(ai, bj, At, Bt) do { __builtin_amdgcn_s_setprio(1); _Pragma("unroll") for (int m = 0; m < 4; ++m) _Pragma("unroll") for (int n = 0; n < 2; ++n) _Pragma("unroll") for (int k = 0; k < 2; ++k) \
        acc[ai][bj][m][n] = __builtin_amdgcn_mfma_f32_16x16x32_bf16(Bt[n][k], At[m][k], acc[ai][bj][m][n], 0, 0, 0); __builtin_amdgcn_s_setprio(0); } while (0)
#define PG8_WAIT_V(n) asm volatile("s_waitcnt vmcnt(" #n ")" ::: "memory")
#define PG8_WAIT_L(n) asm volatile("s_waitcnt lgkmcnt(" #n ")" ::: "memory")
#define PG8_BAR __builtin_amdgcn_s_barrier()
#define PG8_SCHED __builtin_amdgcn_sched_barrier(0)
    Unit cur, nxt; int ui = 0;
    if (!S.next(0, cur)) return;
    f32x4 acc[2][2][4][2];
#pragma unroll
    for (int a = 0; a < 2; ++a)
#pragma unroll
        for (int b = 0; b < 2; ++b)
#pragma unroll
            for (int m = 0; m < 4; ++m)
#pragma unroll
                for (int n = 0; n < 2; ++n) acc[a][b][m][n] = (f32x4){0.f, 0.f, 0.f, 0.f};
    bf16x8 At[4][2], B0[2][2], B1[2][2];
    const char* cA = (const char*)g.A + (size_t)cur.pm * tstep; const char* cB = (const char*)g.Bt + (size_t)cur.pn * tstep;
    S.a_ready(cur);
    if constexpr (SP2) {
        PG8_STAGE(PG8_SB(0, 0), cB, voffB); PG8_STAGE(PG8_SB(0, 1), cB + hstep, voffB); PG8_STAGE(PG8_SA(0, 0), cA, voffA); PG8_STAGE(PG8_SA(0, 1), cA + hstep, voffA);
        if (wr == 1) PG8_BAR;
        PG8_WAIT_V(2); PG8_BAR;
        PG8_STAGE(PG8_SB(1, 0), cB + kstep, voffB); PG8_STAGE(PG8_SA(1, 0), cA + kstep, voffA); PG8_STAGE(PG8_SB(1, 1), cB + hstep + kstep, voffB);
        PG8_WAIT_V(6); PG8_BAR;
    } else {
        PG8_STAGE(PG8_SB(0, 0), cB, voffB); PG8_STAGE(PG8_SA(0, 0), cA, voffA); PG8_STAGE(PG8_SB(0, 1), cB + hstep, voffB); PG8_STAGE(PG8_SA(0, 1), cA + hstep, voffA);
        if (wr == 1) PG8_BAR;
        PG8_WAIT_V(4); PG8_BAR;
        PG8_STAGE(PG8_SB(1, 0), cB + kstep, voffB); PG8_STAGE(PG8_SA(1, 0), cA + kstep, voffA); PG8_STAGE(PG8_SB(1, 1), cB + hstep + kstep, voffB);
        PG8_WAIT_V(6); PG8_BAR;
    }
    for (;;) {
        const bool has_next = S.next(ui + 1, nxt);
        const char* nA = has_next ? (const char*)g.A + (size_t)nxt.pm * tstep : cA; const char* nB = has_next ? (const char*)g.Bt + (size_t)nxt.pn * tstep : cB;
        for (int t = 0; t < nt; t += 2) {
            const bool last = (t == nt - 2);
            const char* a1 = cA + (size_t)(t + 1) * kstep;
            const char* a2 = last ? nA : cA + (size_t)(t + 2) * kstep; const char* b2 = last ? nB : cB + (size_t)(t + 2) * kstep;
            const char* a3 = a2 + kstep; const char* b3 = b2 + kstep;
            if (last && has_next) S.a_ready(nxt);
            if constexpr (Epi::MIDK > 0) { if (t == Epi::MIDK) E.mid(acc, cur, wr, wc, fr, fq); }
            if constexpr (SP2) {
            PG8_LDB(B0, 0, 0); PG8_LDB(B1, 0, 1); PG8_SCHED; PG8_LDA(At, 0, 0); PG8_STAGE(PG8_SA(1, 1), a1 + hstep, voffA);
            PG8_WAIT_V(8); PG8_WAIT_L(0); PG8_BAR; PG8_MMA(0, 0, At, B0); PG8_MMA(0, 1, At, B1); PG8_BAR; PG8_SCHED;
            PG8_LDA(At, 0, 1); PG8_STAGE(PG8_SB(0, 0), b2, voffB); PG8_STAGE(PG8_SB(0, 1), b2 + hstep, voffB); PG8_STAGE(PG8_SA(0, 0), a2, voffA);
            PG8_WAIT_V(8); PG8_WAIT_L(0); PG8_BAR; PG8_MMA(1, 0, At, B0); PG8_MMA(1, 1, At, B1); PG8_BAR; PG8_SCHED;
            PG8_LDB(B0, 1, 0); PG8_LDB(B1, 1, 1); PG8_SCHED; PG8_LDA(At, 1, 0); PG8_STAGE(PG8_SA(0, 1), a2 + hstep, voffA);
            PG8_WAIT_V(8); PG8_WAIT_L(0); PG8_BAR; PG8_MMA(0, 0, At, B0); PG8_MMA(0, 1, At, B1); PG8_BAR; PG8_SCHED;
            PG8_LDA(At, 1, 1); PG8_STAGE(PG8_SB(1, 0), b3, voffB); PG8_STAGE(PG8_SB(1, 1), b3 + hstep, voffB); PG8_STAGE(PG8_SA(1, 0), a3, voffA);
            PG8_WAIT_V(8); PG8_WAIT_L(0); PG8_BAR; PG8_MMA(1, 0, At, B0); PG8_MMA(1, 1, At, B1); PG8_BAR; PG8_SCHED;
            } else {
            PG8_LDB(B0, 0, 0); PG8_SCHED; PG8_LDA(At, 0, 0); PG8_STAGE(PG8_SA(1, 1), a1 + hstep, voffA);
            PG8_WAIT_L(8); PG8_BAR; PG8_WAIT_L(0); PG8_MMA(0, 0, At, B0); PG8_BAR; PG8_SCHED;
            PG8_LDB(B1, 0, 1); PG8_STAGE(PG8_SB(0, 0), b2, voffB);
            PG8_BAR; PG8_WAIT_L(0); PG8_MMA(0, 1, At, B1); PG8_BAR;
            PG8_LDA(At, 0, 1); PG8_STAGE(PG8_SA(0, 0), a2, voffA);
            PG8_BAR; PG8_WAIT_L(0); PG8_MMA(1, 0, At, B0); PG8_BAR; PG8_SCHED;
            PG8_STAGE(PG8_SB(0, 1), b2 + hstep, voffB);
            PG8_WAIT_V(6); PG8_BAR; PG8_MMA(1, 1, At, B1); PG8_BAR;
            PG8_LDB(B0, 1, 0); PG8_SCHED; PG8_LDA(At, 1, 0); PG8_STAGE(PG8_SA(0, 1), a2 + hstep, voffA);
            PG8_WAIT_L(8); PG8_BAR; PG8_WAIT_L(0); PG8_MMA(0, 0, At, B0); PG8_BAR; PG8_SCHED;
            PG8_LDB(B1, 1, 1); PG8_STAGE(PG8_SB(1, 0), b3, voffB);
            PG8_BAR; PG8_WAIT_L(0); PG8_MMA(0, 1, At, B1); PG8_BAR;
            PG8_LDA(At, 1, 1); PG8_STAGE(PG8_SA(1, 0), a3, voffA);
            PG8_BAR; PG8_WAIT_L(0); PG8_MMA(1, 0, At, B0); PG8_BAR; PG8_SCHED;
            PG8_STAGE(PG8_SB(1, 1), b3 + hstep, voffB);
            PG8_WAIT_V(6); PG8_BAR; PG8_MMA(1, 1, At, B1); PG8_BAR;
            }
        }
        if constexpr (ALIGN_EPI) { if (wr == 0) PG8_BAR; }
        if constexpr (!Epi::AFTER_DRAIN) { E(acc, cur, wr, wc, fr, fq); S.done(cur); }
        if (!has_next) break;
#pragma unroll
        for (int a = 0; a < 2; ++a)
#pragma unroll
            for (int b = 0; b < 2; ++b)
#pragma unroll
                for (int m = 0; m < 4; ++m)
#pragma unroll
                    for (int n = 0; n < 2; ++n) acc[a][b][m][n] = (f32x4){0.f, 0.f, 0.f, 0.f};
        cur = nxt; cA = nA; cB = nB; ++ui;
        if constexpr (ALIGN_EPI) { if (wr == 1) PG8_BAR; }
    }
    PG8_WAIT_V(0);
    if constexpr (!ALIGN_EPI) { if (wr == 0) PG8_BAR; }
    PG8_BAR;
#undef PG8_SA
#undef PG8_SB
#undef PG8_STAGE
#undef PG8_LDA
#undef PG8_LDB
#undef PG8_MMA
#undef PG8_WAIT_V
#undef PG8_WAIT_L
#undef PG8_BAR
#undef PG8_SCHED
}
}

constexpr int NWAVES = 8;
constexpr int N_PHASES = 6;
constexpr int BATCH = 8, SEQ = 4096, DM = 1024, M = BATCH * SEQ;
constexpr int NIN = 8704, NHEAD = 24, NG = 3, HPG = 8, HD = 64, CW = 512, CK = 31;
constexpr int ADA_N = 3 * DM;

constexpr size_t MiB = 1u << 20;
constexpr size_t WS_CTL = 0, CTL_ZERO_BYTES = 64 * 1024;
constexpr size_t WS_ADA = 1 * MiB;
constexpr size_t WS_WIN = 422 * MiB;
constexpr size_t WS_WA = 440 * MiB, WS_WO = 442 * MiB;
constexpr size_t WS_LSE = 2 * MiB;
constexpr size_t WS_H = 448 * MiB;
constexpr size_t WS_A2A = 448 * MiB, WS_A2C = 480 * MiB;
constexpr size_t WS_Q = 38 * MiB, WS_K = 134 * MiB, WS_V = 230 * MiB;
constexpr size_t WS_T1 = 134 * MiB, WS_MG = 230 * MiB;
constexpr size_t WS_ZA = 326 * MiB, WS_GLU = 358 * MiB, WS_ZC = 390 * MiB;
constexpr size_t WS_PB = 6 * MiB;
constexpr size_t WS_END = 512 * MiB;

constexpr int RING_OFF = 0, RING_BYTES = 131072;
constexpr int ATT_K0 = 0, ATT_K1 = 49152, ATT_V = 98304, ATT_END = 147456;
constexpr int MISC_OFF = ATT_END;
constexpr int LDS_BYTES = 151552;

#define GAS __attribute__((address_space(1)))
#define LAS __attribute__((address_space(3)))
typedef unsigned short bf16;
typedef unsigned v4u __attribute__((ext_vector_type(4)));
typedef unsigned v2u __attribute__((ext_vector_type(2)));
typedef float f32x4 __attribute__((ext_vector_type(4)));
typedef float f32x2 __attribute__((ext_vector_type(2)));
typedef float f32x16 __attribute__((ext_vector_type(16)));
typedef short bf16x8 __attribute__((ext_vector_type(8)));
typedef short s16x4 __attribute__((ext_vector_type(4)));
#define RLX_AGENT __ATOMIC_RELAXED, __HIP_MEMORY_SCOPE_AGENT
#define LDS_WAIT() asm volatile("s_waitcnt lgkmcnt(0)" ::: "memory")
using pg8::cvt_pk_bf16; using pg8::bf_lo; using pg8::bf_hi; using pg8::sigmoidf_;

#define XB_TMO      128
#define XB_XCNT(j)  (256  + 64 * (j))
#define XB_XSUB(j)  (1280 + 64 * (j))
#define XB_XGEN(j)  (2304 + 64 * (j))
#define XB_TOP      3328
#define XB_TOPGEN   3392
#define XCD_BAR_WORDS 3456
#define XB_SPIN_CAP (1u << 18)
__device__ __forceinline__ unsigned xb_ld(unsigned* p)              { return __hip_atomic_load(p, __ATOMIC_RELAXED, __HIP_MEMORY_SCOPE_AGENT); }
__device__ __forceinline__ unsigned xb_add(unsigned* p, unsigned v) { return __hip_atomic_fetch_add(p, v, __ATOMIC_RELAXED, __HIP_MEMORY_SCOPE_AGENT); }
__device__ __forceinline__ unsigned xb_xcc_id() { return (unsigned)__builtin_amdgcn_s_getreg((3 << 11) | 20) & 0xFu; }
#define XB_SPIN(cond, bar) do { unsigned _sp = 0; while (cond) { __builtin_amdgcn_s_sleep(1); \
    if ((++_sp & 255u) == 0u) { if (xb_ld(&(bar)[XB_TMO])) break; if (_sp > XB_SPIN_CAP) { atomicAdd(&(bar)[XB_TMO], 1u); break; } } } } while (0)
struct XcdBarrier { unsigned* bar; unsigned x; volatile LAS unsigned* st; };
__device__ __forceinline__ XcdBarrier xcd_barrier_post(unsigned* bar, volatile LAS unsigned* st) {
    XcdBarrier b; b.bar = bar; b.x = xb_xcc_id(); b.st = st;
    if (threadIdx.x == 0) (void)xb_add(&bar[XB_XCNT(b.x)], 1u);
    return b;
}
__device__ __forceinline__ void xcd_barrier_complete(unsigned* bar, unsigned x, unsigned& nloc, unsigned& nx) {
    const unsigned G = gridDim.x * gridDim.y * gridDim.z;
    unsigned sum, cnt, mine, sp = 0u;
    for (;;) {
        sum = 0u; cnt = 0u; mine = 0u;
#pragma unroll
        for (unsigned j = 0; j < 16; ++j) { const unsigned c = xb_ld(&bar[XB_XCNT(j)]); sum += c; cnt += (c > 0u) ? 1u : 0u; mine = (j == x) ? c : mine; }
        if (sum == G) break;
        __builtin_amdgcn_s_sleep(1);
        if ((++sp & 255u) == 0u) { if (xb_ld(&bar[XB_TMO])) break; if (sp > XB_SPIN_CAP) { atomicAdd(&bar[XB_TMO], 1u); break; } }
    }
    nloc = mine > 0u ? mine : 1u; nx = cnt > 0u ? cnt : 1u;
}
__device__ __forceinline__ void xcd_barrier(const XcdBarrier& b) {
    asm volatile("s_waitcnt vmcnt(0)" ::: "memory");
    __syncthreads();
    if (threadIdx.x == 0) {
        unsigned* bar = b.bar;
        __builtin_amdgcn_s_waitcnt(0);
        unsigned nloc = b.st[0], nx = b.st[1];
        if (nloc == 0u) { xcd_barrier_complete(bar, b.x, nloc, nx); b.st[0] = nloc; b.st[1] = nx; }
        const unsigned old = xb_add(&bar[XB_XSUB(b.x)], 1u);
        const unsigned gen = old / nloc;
        if (old + 1u == (gen + 1u) * nloc) {
            __builtin_amdgcn_fence(__ATOMIC_RELEASE, "agent");
            asm volatile("s_waitcnt vmcnt(0)" ::: "memory");
            const unsigned og = xb_add(&bar[XB_TOP], 1u);
            const unsigned tg = og / nx;
            if (og + 1u == (tg + 1u) * nx) xb_add(&bar[XB_TOPGEN], 1u);
            else XB_SPIN(xb_ld(&bar[XB_TOPGEN]) == tg, bar);
            __builtin_amdgcn_fence(__ATOMIC_ACQUIRE, "agent");
            xb_add(&bar[XB_XGEN(b.x)], 1u);
            asm volatile("s_waitcnt vmcnt(0)" ::: "memory");
        } else {
            XB_SPIN(xb_ld(&bar[XB_XGEN(b.x)]) == gen, bar);
            __builtin_amdgcn_fence(__ATOMIC_ACQUIRE, "agent");
            asm volatile("s_waitcnt vmcnt(0)" ::: "memory");
        }
    }
    __syncthreads();
}

__device__ __forceinline__ float wave_sum(float v) {
#pragma unroll
    for (int o = 1; o < 64; o <<= 1) v += __shfl_xor(v, o);
    return v;
}
__device__ __forceinline__ unsigned f2bf(float f) { unsigned u = __builtin_bit_cast(unsigned, f); return (u + 0x7fffu + ((u >> 16) & 1u)) >> 16; }
__device__ __forceinline__ unsigned pk2(float lo, float hi) { return f2bf(lo) | (f2bf(hi) << 16); }

__device__ __forceinline__ int win_phys(int n0) {
    if (n0 < 4608) { const int reg = n0 / 1536, c = n0 - reg * 1536, head = c >> 6, dh = (c >> 5) & 1; return (reg * 6 + (head >> 2)) * 256 + 128 * dh + 32 * (head & 3); }
    if (n0 >= 5120 && n0 < 6144) { const int c = n0 - 5120, half = c >> 9, cc = c & 511; return (20 + (cc >> 7)) * 256 + 128 * half + (cc & 127); }
    return n0;
}
__device__ __forceinline__ int win_phys_g(int n) { return n; }
template <bool WIN>
__device__ __forceinline__ void p0_transpose_item(const float* W, int K, int N, bf16* WT, LAS float* scr, int item, int lane, int ldt = 0) {
    if (ldt == 0) ldt = K;
    const int nblk = N / 32, kb = item / nblk, nb = item % nblk, k0 = 64 * kb, n0 = 32 * nb;
    const int prow = WIN ? win_phys(n0) : n0;
#pragma unroll 8
    for (int i = 0; i < 32; ++i) { const int kk = 2 * i + (lane >> 5); scr[kk * 33 + (lane & 31)] = __builtin_nontemporal_load(W + (size_t)(k0 + kk) * N + n0 + (lane & 31)); }
    LDS_WAIT(); asm volatile("" ::: "memory");
    const int c = lane & 7;
#pragma unroll
    for (int j = 0; j < 4; ++j) { const int n = (lane >> 3) + 8 * j; const LAS float* s = scr + (8 * c) * 33 + n;
        v4u o; o.x = pk2(s[0 * 33], s[1 * 33]); o.y = pk2(s[2 * 33], s[3 * 33]); o.z = pk2(s[4 * 33], s[5 * 33]); o.w = pk2(s[6 * 33], s[7 * 33]);
        const int rown = (WIN && n0 >= 6656) ? win_phys_g(n0 + n) : prow + n;
        *(GAS v4u*)(WT + (size_t)rown * ldt + k0 + 8 * c) = o; }
    LDS_WAIT(); asm volatile("" ::: "memory");
}

struct Args { const float* in[16]; float* out; unsigned char* ws; int ph_lo, ph_hi; };
__device__ __forceinline__ int crow(int r, int hi) { return (r & 3) + 8 * (r >> 2) + 4 * hi; }
__device__ __forceinline__ s16x4 vtr(const LAS char* p) { typedef short v4i16_t __attribute__((ext_vector_type(4))); return __builtin_bit_cast(s16x4, __builtin_amdgcn_ds_read_tr16_b64_v4i16((LAS v4i16_t*)p)); }

__device__ __forceinline__ void glds16s(const void* sbase, unsigned voff, unsigned lds_dst) { unsigned keep;
    const unsigned long long sb = (unsigned long long)sbase;
    const unsigned lo = (unsigned)__builtin_amdgcn_readfirstlane((int)(unsigned)sb), hi = (unsigned)__builtin_amdgcn_readfirstlane((int)(unsigned)(sb >> 32));
    const unsigned long long sbu = ((unsigned long long)hi << 32) | lo;
    asm volatile("s_mov_b32 %0, m0\n\ts_mov_b32 m0, %3\n\ts_nop 4\n\tglobal_load_lds_dwordx4 %1, %2\n\ts_mov_b32 m0, %0" : "=&s"(keep) : "v"(voff), "s"(sbu), "s"(lds_dst) : "memory"); }
struct KTile { bf16x8 k[4]; };
struct VTile { v4u v[4]; };
__device__ __forceinline__ void load_k(KTile& T, const bf16* Kp, int row0, int r32, int hi) {
    const bf16* kr = Kp + (size_t)(row0 + r32) * HD + 8 * hi;
#pragma unroll
    for (int ks = 0; ks < 4; ++ks) T.k[ks] = *(const GAS bf16x8*)(kr + 16 * ks);
}
__device__ __forceinline__ void load_v(VTile& T, const bf16* Vp, int row0, int lane) {
#pragma unroll
    for (int i = 0; i < 4; ++i) { const int c = lane + 64 * i; T.v[i] = *(const GAS v4u*)(Vp + (size_t)(row0 + (c >> 3)) * HD + (c & 7) * 8); }
}
template <int TAU>
__device__ __forceinline__ void att_tile(const KTile& TK, const VTile& TV, const bf16x8 (&qf)[4], float& m, float& l, f32x16 (&o)[2], LAS char* vl, const LAS char* vrd, int lane, int r32, int hi) {
    f32x16 s = {};
#pragma unroll
    for (int ks = 0; ks < 4; ++ks) s = __builtin_amdgcn_mfma_f32_32x32x16_bf16(TK.k[ks], qf[ks], s, 0, 0, 0);
#pragma unroll
    for (int i = 0; i < 4; ++i) { const int c = lane + 64 * i, key = c >> 3, ch = c & 7; *(LAS v4u*)(vl + (ch >> 2) * 2048 + key * 64 + (ch & 3) * 16) = TV.v[i]; }
    if (TAU == 0) {
#pragma unroll
        for (int r = 0; r < 16; ++r) if (crow(r, hi) < r32) s[r] = -INFINITY;
    }
    if (TAU == 4) {
#pragma unroll
        for (int r = 0; r < 16; ++r) if (crow(r, hi) > r32) s[r] = -INFINITY;
    }
    float tm = fmaxf(fmaxf(s[0], s[1]), s[2]);
#pragma unroll
    for (int r = 3; r < 15; r += 2) tm = fmaxf(fmaxf(tm, s[r]), s[r + 1]);
    tm = fmaxf(tm, s[15]);
    tm = fmaxf(tm, __shfl_xor(tm, 32));
    if (__any(tm > m)) {
        const float mn = fmaxf(m, tm), al = __builtin_amdgcn_exp2f(m - mn);
        l *= al; o[0] = o[0] * al; o[1] = o[1] * al; m = mn;
    }
    float ps = 0.f;
#pragma unroll
    for (int r = 0; r < 16; ++r) { s[r] = __builtin_amdgcn_exp2f(s[r] - m); ps += s[r]; }
    l += ps;
    v4u pw0, pw1;
    pw0.x = cvt_pk_bf16(s[0], s[1]); pw0.y = cvt_pk_bf16(s[2], s[3]); pw0.z = cvt_pk_bf16(s[4], s[5]); pw0.w = cvt_pk_bf16(s[6], s[7]);
    pw1.x = cvt_pk_bf16(s[8], s[9]); pw1.y = cvt_pk_bf16(s[10], s[11]); pw1.z = cvt_pk_bf16(s[12], s[13]); pw1.w = cvt_pk_bf16(s[14], s[15]);
    const bf16x8 pf0 = __builtin_bit_cast(bf16x8, pw0), pf1 = __builtin_bit_cast(bf16x8, pw1);
    LDS_WAIT(); asm volatile("" ::: "memory");
#pragma unroll
    for (int d0 = 0; d0 < 2; ++d0) {
        const s16x4 a0 = vtr(vrd + d0 * 2048), a1 = vtr(vrd + d0 * 2048 + 512), a2 = vtr(vrd + d0 * 2048 + 1024), a3 = vtr(vrd + d0 * 2048 + 1536);
        const bf16x8 vf0 = (bf16x8){a0[0], a0[1], a0[2], a0[3], a1[0], a1[1], a1[2], a1[3]};
        const bf16x8 vf1 = (bf16x8){a2[0], a2[1], a2[2], a2[3], a3[0], a3[1], a3[2], a3[3]};
        o[d0] = __builtin_amdgcn_mfma_f32_32x32x16_bf16(vf0, pf0, o[d0], 0, 0, 0);
        o[d0] = __builtin_amdgcn_mfma_f32_32x32x16_bf16(vf1, pf1, o[d0], 0, 0, 0);
    }
    asm volatile("" ::: "memory");
}

__global__ void __launch_bounds__(NWAVES * 64, 2) mega_fwd(Args args) {
    extern __shared__ __attribute__((aligned(16))) unsigned char lds_raw[];
    LAS unsigned char* lds = (LAS unsigned char*)lds_raw;
    const int tid = threadIdx.x, lane = tid & 63, wave = __builtin_amdgcn_readfirstlane(tid >> 6);
    const int G = gridDim.x; const int bx = blockIdx.x; const int vcu = (G % 8 == 0) ? (bx % 8) * (G / 8) + bx / 8 : bx;
    unsigned char* ws = args.ws;
    const float* x = args.in[0]; const float* cvec = args.in[1]; const float* w_ada = args.in[2]; const float* b_ada = args.in[3]; const float* norm_w = args.in[4];
    const float* w_in = args.in[5]; const float* b_gate = args.in[6]; const float* q_norm_w = args.in[7]; const float* k_norm_w = args.in[8]; const float* w_attn_proj = args.in[9];
    const float* conv_w = args.in[10]; const float* conv_b = args.in[11]; const float* conv_ln_w = args.in[12]; const float* conv_ln_b = args.in[13];
    const float* w_conv_proj = args.in[14]; const float* w_out = args.in[15];
    float* out = args.out;
    float* ADA = (float*)(ws + WS_ADA);
    bf16* WIN = (bf16*)(ws + WS_WIN); bf16* W2 = (bf16*)(ws + WS_WA); bf16* WO = (bf16*)(ws + WS_WO);
    float* LSE = (float*)(ws + WS_LSE);
    bf16* HB = (bf16*)(ws + WS_H); bf16* A2 = (bf16*)(ws + WS_A2A);
    bf16* QB = (bf16*)(ws + WS_Q); bf16* KB = (bf16*)(ws + WS_K); bf16* VB = (bf16*)(ws + WS_V);
    bf16* MG = (bf16*)(ws + WS_MG);
    bf16* ZA = (bf16*)(ws + WS_ZA); bf16* GLU = (bf16*)(ws + WS_GLU); bf16* ZC = (bf16*)(ws + WS_ZC);
    bf16* SG = (bf16*)out;

    if (tid < 32) ((LAS unsigned*)(lds + MISC_OFF))[tid] = 0u;
    __syncthreads();
    XcdBarrier bar = xcd_barrier_post((unsigned*)(ws + WS_CTL) + 4096, (volatile LAS unsigned*)(lds + MISC_OFF) + 8);
#define GRID_BAR(k) xcd_barrier(bar)
    const int lo = args.ph_lo, hi_ph = args.ph_hi;
#define IN(k) (lo <= (k) && (k) < hi_ph)
#define BOTH(k) (IN(k) && IN((k) + 1))
    const int gw = vcu * NWAVES + wave, NGW = G * NWAVES;

    if (IN(0)) {
        {
            LAS float* sc = (LAS float*)lds; LAS float* part = (LAS float*)(lds + 32768);
            if (bx < ADA_N / 64) {
                for (int i = tid; i < BATCH * DM; i += NWAVES * 64) { const float v = cvec[i]; sc[i] = v * sigmoidf_(v); }
                __syncthreads();
                for (int item = bx; item < ADA_N / 64; item += G) {
                    const int j = item * 64 + lane; float a[BATCH];
#pragma unroll
                    for (int b = 0; b < BATCH; ++b) a[b] = 0.f;
#pragma unroll 4
                    for (int kk = 0; kk < 128; ++kk) { const int k = wave * 128 + kk; const float w = __builtin_nontemporal_load(w_ada + (size_t)k * ADA_N + j);
#pragma unroll
                        for (int b = 0; b < BATCH; ++b) a[b] += sc[b * DM + k] * w; }
#pragma unroll
                    for (int b = 0; b < BATCH; ++b) part[(wave * BATCH + b) * 64 + lane] = a[b];
                    __syncthreads();
                    { float s = b_ada[j];
#pragma unroll
                      for (int w = 0; w < NWAVES; ++w) s += part[(w * BATCH + wave) * 64 + lane];
                      ADA[(size_t)wave * ADA_N + j] = s; }
                    __syncthreads();
                }
            }
        }
        if (bx >= ADA_N / 64 || G <= ADA_N / 64) {
            LAS float* scr = (LAS float*)(lds + RING_OFF + wave * 16384);
            constexpr int I_IN = (DM / 64) * (NIN / 32), I_A = (CW / 64) * (DM / 32), I_O = (DM / 64) * (DM / 32);
            constexpr int NITEMS = I_IN + 2 * I_A + I_O;
            const int nsk = G > ADA_N / 64 ? ADA_N / 64 : 0;
            for (int it = (bx - nsk) * NWAVES + wave; it < NITEMS; it += (G - nsk) * NWAVES) {
                int r = it;
                if (r < I_IN) { p0_transpose_item<true>(w_in, DM, NIN, WIN, scr, r, lane); continue; } r -= I_IN;
                if (r < I_A) { p0_transpose_item<false>(w_attn_proj, CW, DM, W2, scr, r, lane, DM); continue; } r -= I_A;
                if (r < I_A) { p0_transpose_item<false>(w_conv_proj, CW, DM, W2 + CW, scr, r, lane, DM); continue; } r -= I_A;
                p0_transpose_item<false>(w_out, DM, DM, WO, scr, r, lane);
            }
        }
        if (BOTH(0)) GRID_BAR(0);
    }

    if (IN(1)) {
        for (int rb = gw; rb < M / 16; rb += NGW) {
            const int row0 = rb * 16, b = row0 >> 12;
            f32x4 gm[4], ga[4];
#pragma unroll
            for (int j = 0; j < 4; ++j) { const int c = 4 * lane + 256 * j;
                const f32x4 nw = *(const f32x4*)(norm_w + c), sc = *(const f32x4*)(ADA + (size_t)b * ADA_N + DM + c);
                gm[j] = nw * (sc + 1.0f); ga[j] = *(const f32x4*)(ADA + (size_t)b * ADA_N + c); }
            for (int r = 0; r < 16; ++r) {
                const GAS f32x4* xr = (const GAS f32x4*)(x + (size_t)(row0 + r) * DM) + lane;
                f32x4 v[4]; float s2 = 0.f;
#pragma unroll
                for (int j = 0; j < 4; ++j) { v[j] = __builtin_nontemporal_load(xr + 64 * j); s2 += (v[j].x * v[j].x + v[j].y * v[j].y) + (v[j].z * v[j].z + v[j].w * v[j].w); }
                const float rstd = __builtin_amdgcn_rsqf(wave_sum(s2) * (1.f / DM) + pg8::NORM_EPS);
                GAS v2u* o8 = (GAS v2u*)(HB + (size_t)(row0 + r) * DM) + lane;
#pragma unroll
                for (int j = 0; j < 4; ++j) { const f32x4 y = v[j] * rstd * gm[j] + ga[j]; v2u w; w.x = cvt_pk_bf16(y.x, y.y); w.y = cvt_pk_bf16(y.z, y.w); o8[64 * j] = w; }
            }
        }
        if (BOTH(1)) GRID_BAR(1);
    }

    if (IN(2)) {
        pg8::Gemm g{HB, WIN, M, NIN, DM}; pg8::StaticOrder S; S.init(M, NIN, G, bx);
        pg8::EpiIn E{QB, (WS_K - WS_Q) / 2, ZA, (WS_ZC - WS_ZA) / 2, GLU, (unsigned char*)SG, q_norm_w, k_norm_w, b_gate, lds + RING_OFF + RING_BYTES + wave * 2048};
        pg8::gemm_phase<pg8::EpiIn, pg8::StaticOrder, true, true>(lds + RING_OFF, g, S, E);
        if (BOTH(2)) GRID_BAR(2);
    }

    if (IN(3)) {
        {
            LAS unsigned* in32 = (LAS unsigned*)lds;
            LAS float* ot = (LAS float*)(lds + 65536);
            const int cp = tid & 255, th = tid >> 8;
            float w0[CK], w1[CK];
#pragma unroll
            for (int j = 0; j < CK; ++j) { const f32x2 w = *(const f32x2*)(conv_w + j * CW + 2 * cp); w0[j] = w.x; w1[j] = w.y; }
            const f32x2 cb = *(const f32x2*)(conv_b + 2 * cp);
            v4u pf[8];
#define CONV_FETCH(TILE) { const int b_ = (TILE) >> 7, t0_ = ((TILE) & 127) * 32; \
                _Pragma("unroll") for (int i = 0; i < 8; ++i) { int c = tid + 512 * i; c = c < 62 * 64 ? c : 62 * 64 - 1; const int r = c >> 6, ch = c & 63, t = t0_ - 30 + r; \
                    v4u val = *(const GAS v4u*)(GLU + ((size_t)b_ * SEQ + (t < 0 ? 0 : t)) * CW + ch * 8); if (t < 0) val = (v4u){0u, 0u, 0u, 0u}; pf[i] = val; } }
            if (bx < M / 32) CONV_FETCH(bx)
            for (int tile = bx; tile < M / 32; tile += G) {
                const int b = tile >> 7, t0 = (tile & 127) * 32; const size_t row0 = (size_t)b * SEQ + t0;
#pragma unroll
                for (int i = 0; i < 8; ++i) { const int c = tid + 512 * i; if (c < 62 * 64) *(LAS v4u*)(lds + (size_t)c * 16) = pf[i]; }
                v4u zc[4];
#pragma unroll
                for (int q = 0; q < 4; ++q) zc[q] = *(const GAS v4u*)(ZC + (row0 + wave + 8 * q) * CW + lane * 8);
                __syncthreads();
                { const int nt_ = tile + G < M / 32 ? tile + G : tile; CONV_FETCH(nt_) }
                unsigned xs[46];
#pragma unroll
                for (int i = 0; i < 46; ++i) xs[i] = in32[(th * 16 + i) * 256 + cp];
#pragma unroll
                for (int tl = 0; tl < 16; ++tl) { float a0 = cb.x, a1 = cb.y;
#pragma unroll
                    for (int j = 0; j < CK; ++j) { const unsigned xv = xs[tl + j]; a0 += w0[j] * bf_lo(xv); a1 += w1[j] * bf_hi(xv); }
                    *(LAS f32x2*)(ot + (th * 16 + tl) * CW + 2 * cp) = (f32x2){a0, a1}; }
                __syncthreads();
                {
                    const f32x4 lw0 = *(const f32x4*)(conv_ln_w + lane * 8), lw1 = *(const f32x4*)(conv_ln_w + lane * 8 + 4);
                    const f32x4 lb0 = *(const f32x4*)(conv_ln_b + lane * 8), lb1 = *(const f32x4*)(conv_ln_b + lane * 8 + 4);
#pragma unroll
                    for (int q = 0; q < 4; ++q) { const int tl = wave + 8 * q;
                        f32x4 v0 = *(const LAS f32x4*)(ot + tl * CW + lane * 8), v1 = *(const LAS f32x4*)(ot + tl * CW + lane * 8 + 4);
                        const float mean = wave_sum((v0.x + v0.y) + (v0.z + v0.w) + (v1.x + v1.y) + (v1.z + v1.w)) * (1.f / CW);
                        v0 = v0 - mean; v1 = v1 - mean;
                        const float var = wave_sum((v0.x * v0.x + v0.y * v0.y) + (v0.z * v0.z + v0.w * v0.w) + (v1.x * v1.x + v1.y * v1.y) + (v1.z * v1.z + v1.w * v1.w)) * (1.f / CW);
                        const float rstd = __builtin_amdgcn_rsqf(var + pg8::NORM_EPS);
                        v0 = v0 * rstd * lw0 + lb0; v1 = v1 * rstd * lw1 + lb1;
                        const v4u zq = zc[q];
                        const float z[8] = {bf_lo(zq.x), bf_hi(zq.x), bf_lo(zq.y), bf_hi(zq.y), bf_lo(zq.z), bf_hi(zq.z), bf_lo(zq.w), bf_hi(zq.w)};
#pragma unroll
                        for (int i = 0; i < 4; ++i) { v0[i] = v0[i] * sigmoidf_(v0[i]) * z[i]; v1[i] = v1[i] * sigmoidf_(v1[i]) * z[4 + i]; }
                        *(GAS v4u*)(A2 + (row0 + tl) * DM + CW + lane * 8) = pg8::pack8(v0, v1); }
                }
                __syncthreads();
            }
#undef CONV_FETCH
        }
        {
            const int r32 = lane & 31, hi = lane >> 5;
            const int vrd_off = (4 * hi + ((lane & 15) >> 2)) * 64 + ((lane >> 4) & 1) * 32 + (lane & 3) * 8;
            const int piece = wave & 3, tsel = wave >> 2;
            bf16* PB = (bf16*)(ws + WS_PB); float* PL = (float*)(ws + WS_LSE);
            const unsigned lds0 = (unsigned)(uintptr_t)lds_raw;
            const unsigned voffK = (unsigned)(((8 * piece + (lane >> 3)) * HD + (((lane & 7) ^ (((8 * piece + (lane >> 3)) >> 1) & 7)) << 3)) * 2);
            const unsigned voffV = (unsigned)(((16 * (piece & 1) + (lane >> 2)) * HD + (piece >> 1) * 32 + (lane & 3) * 8) * 2);
#define XT_CONST int xln_ = lane; asm volatile("" : "+v"(xln_)); const int xl_r = xln_ >> 3, xc0 = (xln_ & 7) ^ (xln_ >> 4);     \
            const unsigned xb_off = (unsigned)(xl_r * 128 + (xln_ & 7) * 16), xa_off = (unsigned)((xln_ & 31) * 128), xa_f = (unsigned)(((xln_ & 31) >> 1) & 7);
#define XT_B(T, I) (*(LAS v4u*)((T) + xb_off + (I) * 1024))
#define XT_A(T, CH) (*(LAS v4u*)((T) + xa_off + ((((unsigned)(CH)) ^ xa_f) << 4)))
#define ATT_BAR() do { asm volatile("s_waitcnt lgkmcnt(0)" ::: "memory"); __builtin_amdgcn_s_barrier(); asm volatile("" ::: "memory"); } while (0)
#define ATT_DMA(ISV, SRC, RROW, JSB, NT, LDSOFF, FORCE) do { \
                _Pragma("unroll") for (int m_ = 0; m_ < 6; ++m_) { const int kt_ = 2 * m_ + tsel; const int js_ = (JSB) + 32 * kt_; \
                    if (m_ < (NT) / 2 && ((FORCE) || js_ >= 0)) \
                        glds16s((SRC) + ((size_t)(RROW) + (js_ < 0 ? 0 : js_)) * HD, ISV ? voffV : voffK, (unsigned)__builtin_amdgcn_readfirstlane((int)(lds0 + (LDSOFF) + kt_ * 4096 + piece * 1024))); } } while (0)
#define ATT_ROUND(G_, RROW, IU0, JB, KTB, KBUF, TSH, TOK0, PBO, PBL, MROW0, NKN, QNP, QNROW) do { \
                    const int iq = (IU0) + r32; const int tq = (iq << (TSH)) + (TOK0); \
                    f32x16 S[5]; \
                    _Pragma("unroll") for (int tau = 0; tau < 5; ++tau) { \
                        _Pragma("unroll") for (int r = 0; r < 16; ++r) S[tau][r] = -INFINITY; \
                        if ((JB) + 32 * tau >= 0) { \
                            const LAS char* kp = (const LAS char*)(lds + (KBUF) + ((KTB) + tau) * 4096 + r32 * 128); \
                            f32x16 sacc = {}; \
                            _Pragma("unroll") for (int ks = 0; ks < 4; ++ks) { const bf16x8 kf = *(const LAS bf16x8*)(kp + (((2 * ks + hi) ^ ((r32 >> 1) & 7)) << 4)); \
                                sacc = __builtin_amdgcn_mfma_f32_32x32x16_bf16(kf, qf[ks], sacc, 0, 0, 0); } \
                            if (tau == 0) { _Pragma("unroll") for (int r = 0; r < 16; ++r) if (crow(r, hi) < r32) sacc[r] = -INFINITY; } \
                            if (tau == 4) { _Pragma("unroll") for (int r = 0; r < 16; ++r) if (crow(r, hi) > r32) sacc[r] = -INFINITY; } \
                            S[tau] = sacc; } } \
                    float mx = -INFINITY; \
                    _Pragma("unroll") for (int tau = 0; tau < 5; ++tau) _Pragma("unroll") for (int r = 0; r < 16; r += 2) mx = fmaxf(fmaxf(mx, S[tau][r]), S[tau][r + 1]); \
                    mx = fmaxf(mx, __shfl_xor(mx, 32)); \
                    float l = 0.f; v4u P[5][2]; \
                    _Pragma("unroll") for (int tau = 0; tau < 5; ++tau) { f32x16 p = S[tau]; float ps = 0.f; \
                        _Pragma("unroll") for (int r = 0; r < 16; ++r) { p[r] = __builtin_amdgcn_exp2f(p[r] - mx); ps += p[r]; } \
                        l += ps; \
                        P[tau][0].x = cvt_pk_bf16(p[0], p[1]); P[tau][0].y = cvt_pk_bf16(p[2], p[3]); P[tau][0].z = cvt_pk_bf16(p[4], p[5]); P[tau][0].w = cvt_pk_bf16(p[6], p[7]); \
                        P[tau][1].x = cvt_pk_bf16(p[8], p[9]); P[tau][1].y = cvt_pk_bf16(p[10], p[11]); P[tau][1].z = cvt_pk_bf16(p[12], p[13]); P[tau][1].w = cvt_pk_bf16(p[14], p[15]); } \
                    l += __shfl_xor(l, 32); \
                    asm volatile("s_waitcnt vmcnt(" #NKN ")" ::: "memory"); ATT_BAR();     \
                    XT_CONST LAS char* const xt = (LAS char*)(lds + (KBUF) + wave * 4096); \
                    ATT_LOAD_Q(qn, QNP, QNROW); \
                    if ((G_) < 2) ATT_LOAD_P(PBO, PBL, tq, IU0, TSH, TOK0); \
                    f32x16 o[2]; o[0] = f32x16{}; o[1] = f32x16{}; \
                    _Pragma("unroll") for (int tau = 0; tau < 5; ++tau) { \
                        if ((JB) + 32 * tau >= 0) { \
                            const LAS char* vp = (const LAS char*)(lds + ATT_V + ((KTB) + tau) * 4096 + vrd_off); \
                            const bf16x8 pf0 = __builtin_bit_cast(bf16x8, P[tau][0]), pf1 = __builtin_bit_cast(bf16x8, P[tau][1]); \
                            _Pragma("unroll") for (int d0 = 0; d0 < 2; ++d0) { \
                                const s16x4 a0 = vtr(vp + d0 * 2048), a1 = vtr(vp + d0 * 2048 + 512), a2 = vtr(vp + d0 * 2048 + 1024), a3 = vtr(vp + d0 * 2048 + 1536); \
                                const bf16x8 vf0 = (bf16x8){a0[0], a0[1], a0[2], a0[3], a1[0], a1[1], a1[2], a1[3]}; \
                                const bf16x8 vf1 = (bf16x8){a2[0], a2[1], a2[2], a2[3], a3[0], a3[1], a3[2], a3[3]}; \
                                o[d0] = __builtin_amdgcn_mfma_f32_32x32x16_bf16(vf0, pf0, o[d0], 0, 0, 0); \
                                o[d0] = __builtin_amdgcn_mfma_f32_32x32x16_bf16(vf1, pf1, o[d0], 0, 0, 0); } } } \
                    float lse = mx + __builtin_amdgcn_logf(l), sc_own = __builtin_amdgcn_rcpf(l), sc_p = 0.f; \
                    if ((G_) < 2) { const float mx2 = fmaxf(lse, plse), a = __builtin_amdgcn_exp2f(lse - mx2), bq = __builtin_amdgcn_exp2f(plse - mx2), inv = __builtin_amdgcn_rcpf(a + bq); \
                        sc_own = sc_own * a * inv; sc_p = bq * inv; lse = mx2 + __builtin_amdgcn_logf(a + bq); } \
                      \
                    if ((G_) < 2) { _Pragma("unroll") for (int i = 0; i < 4; ++i) XT_B(xt, i) = pq[i]; _Pragma("unroll") for (int c = 0; c < 4; ++c) pq[c] = XT_A(xt, 2 * c + hi); } \
                    if ((G_) < 2) { _Pragma("unroll") for (int c = 0; c < 4; ++c) { const auto rx = __builtin_amdgcn_permlane32_swap(pq[c].x, pq[c].z, false, false); const auto ry = __builtin_amdgcn_permlane32_swap(pq[c].y, pq[c].w, false, false); \
                        pp[2 * c] = (v2u){rx[0], ry[0]}; pp[2 * c + 1] = (v2u){rx[1], ry[1]}; } } \
                    if ((G_) > 0) { \
                        _Pragma("unroll") for (int d0 = 0; d0 < 2; ++d0) _Pragma("unroll") for (int j = 0; j < 2; ++j) { v2u w[2]; \
                            _Pragma("unroll") for (int q = 0; q < 2; ++q) { const int rg = 2 * j + q; \
                                float e0 = o[d0][4 * rg] * sc_own, e1 = o[d0][4 * rg + 1] * sc_own, e2 = o[d0][4 * rg + 2] * sc_own, e3 = o[d0][4 * rg + 3] * sc_own; \
                                if ((G_) < 2) { const v2u pw = pp[d0 * 4 + rg]; e0 += sc_p * bf_lo(pw.x); e1 += sc_p * bf_hi(pw.x); e2 += sc_p * bf_lo(pw.y); e3 += sc_p * bf_hi(pw.y); } \
                                w[q].x = cvt_pk_bf16(e0, e1); w[q].y = cvt_pk_bf16(e2, e3); } \
                            const auto rx = __builtin_amdgcn_permlane32_swap(w[0].x, w[1].x, false, false); const auto ry = __builtin_amdgcn_permlane32_swap(w[0].y, w[1].y, false, false); \
                            XT_A(xt, 2 * (d0 * 2 + j) + hi) = (v4u){rx[0], ry[0], rx[1], ry[1]}; } \
                        _Pragma("unroll") for (int i = 0; i < 4; ++i) *(GAS v4u*)((PBO) + (size_t)((((IU0) + xl_r + 8 * i) << (TSH)) + (TOK0)) * HD + 8 * (xc0 ^ (4 * (i & 1)))) = XT_B(xt, i); \
                        if (hi == 0) (PBL)[tq] = lse; \
                    } else { \
                        const size_t mrow = (size_t)(MROW0) + tq; \
                        v4u zq[4]; v2u zz[8]; \
                        _Pragma("unroll") for (int i = 0; i < 4; ++i) zq[i] = *(const GAS v4u*)(ZA + ((size_t)(MROW0) + ((((IU0) + xl_r + 8 * i) << (TSH)) + (TOK0))) * CW + h * 64 + 8 * (xc0 ^ (4 * (i & 1)))); \
                        _Pragma("unroll") for (int i = 0; i < 4; ++i) XT_B(xt, i) = zq[i]; _Pragma("unroll") for (int c = 0; c < 4; ++c) zq[c] = XT_A(xt, 2 * c + hi); \
                        _Pragma("unroll") for (int c = 0; c < 4; ++c) { const auto rx = __builtin_amdgcn_permlane32_swap(zq[c].x, zq[c].z, false, false); const auto ry = __builtin_amdgcn_permlane32_swap(zq[c].y, zq[c].w, false, false); \
                            zz[2 * c] = (v2u){rx[0], ry[0]}; zz[2 * c + 1] = (v2u){rx[1], ry[1]}; } \
                        _Pragma("unroll") for (int d0 = 0; d0 < 2; ++d0) _Pragma("unroll") for (int j = 0; j < 2; ++j) { v2u w[2]; \
                            _Pragma("unroll") for (int q = 0; q < 2; ++q) { const int rg = 2 * j + q; const v2u pw = pp[d0 * 4 + rg]; const v2u zw = zz[d0 * 4 + rg]; \
                                const float e0 = (o[d0][4 * rg] * sc_own + sc_p * bf_lo(pw.x)) * bf_lo(zw.x), e1 = (o[d0][4 * rg + 1] * sc_own + sc_p * bf_hi(pw.x)) * bf_hi(zw.x); \
                                const float e2 = (o[d0][4 * rg + 2] * sc_own + sc_p * bf_lo(pw.y)) * bf_lo(zw.y), e3 = (o[d0][4 * rg + 3] * sc_own + sc_p * bf_hi(pw.y)) * bf_hi(zw.y); \
                                w[q].x = cvt_pk_bf16(e0, e1); w[q].y = cvt_pk_bf16(e2, e3); } \
                            const auto rx = __builtin_amdgcn_permlane32_swap(w[0].x, w[1].x, false, false); const auto ry = __builtin_amdgcn_permlane32_swap(w[0].y, w[1].y, false, false); \
                            XT_A(xt, 2 * (d0 * 2 + j) + hi) = (v4u){rx[0], ry[0], rx[1], ry[1]}; } \
                        _Pragma("unroll") for (int i = 0; i < 4; ++i) *(GAS v4u*)(A2 + ((size_t)(MROW0) + ((((IU0) + xl_r + 8 * i) << (TSH)) + (TOK0))) * DM + h * 64 + 8 * (xc0 ^ (4 * (i & 1)))) = XT_B(xt, i); } \
                    ATT_XCH_Q(xt); \
                } while (0)
#define ATT_LOAD_Q(DST, QP, ROW0) do { _Pragma("unroll") for (int i = 0; i < 4; ++i) DST[i] = *(const GAS v4u*)((QP) + (size_t)((ROW0) + xl_r + 8 * i) * HD + 8 * (xc0 ^ (4 * (i & 1)))); } while (0)
#define ATT_XCH_Q(T) do { _Pragma("unroll") for (int i = 0; i < 4; ++i) XT_B(T, i) = qn[i]; _Pragma("unroll") for (int ks = 0; ks < 4; ++ks) qf[ks] = __builtin_bit_cast(bf16x8, XT_A(T, 2 * ks + hi)); } while (0)
#define ATT_LOAD_P(PBO, PBL, TQ, IU0, TSH, TOK0) do { _Pragma("unroll") for (int i = 0; i < 4; ++i) pq[i] = *(const GAS v4u*)((PBO) + (size_t)((((IU0) + xl_r + 8 * i) << (TSH)) + (TOK0)) * HD + 8 * (xc0 ^ (4 * (i & 1)))); \
                plse = (PBL)[TQ]; } while (0)
            bf16x8 qf[4]; v4u qn[4], pq[4]; v2u pp[8]; float plse;
            {
                const int NCH = BATCH * HPG * 16;
                if (vcu < NCH) { const int bh = vcu >> 4, res = vcu & 15; const size_t base = (size_t)(((bh >> 3) * 3 + 2) * 8 + (bh & 7)) * SEQ * HD;
                    { XT_CONST ATT_LOAD_Q(qn, QB + base, res * 256 + 32 * wave); ATT_XCH_Q((LAS char*)(lds + ATT_K1 + wave * 4096)); }
                    asm volatile("s_waitcnt vmcnt(0)" ::: "memory"); ATT_BAR();
                    ATT_DMA(false, KB + base, res * 256, 0, 8, ATT_K0, false); }
                int kpar = 0;
                for (int ch = vcu; ch < NCH; ch += G, kpar ^= 1) {
                    const int bh = ch >> 4, res = ch & 15, b = bh >> 3, h = bh & 7; const size_t base = (size_t)((b * 3 + 2) * 8 + h) * SEQ * HD;
                    const int chn = ch + G < NCH ? ch + G : ch, bhn = chn >> 4, resn = chn & 15; const size_t basen = (size_t)(((bhn >> 3) * 3 + 2) * 8 + (bhn & 7)) * SEQ * HD;
                    const int kbuf = kpar ? ATT_K1 : ATT_K0, knext = kpar ? ATT_K0 : ATT_K1;
                    if (ch == vcu) asm volatile("s_waitcnt vmcnt(0)" ::: "memory");
                    asm volatile("" : "+v"(qf[0]), "+v"(qf[1]), "+v"(qf[2]), "+v"(qf[3]));
                    ATT_BAR();
                    ATT_DMA(true, VB + base, res * 256, 0, 8, ATT_V, false);
                    if (ch + G < NCH) { ATT_DMA(false, KB + basen, resn * 256, 0, 8, knext, true);
                        ATT_ROUND(2, res * 256, 32 * wave, 32 * wave - 128, wave - 4, kbuf, 4, res, PB + (size_t)bh * SEQ * HD, PL + (size_t)bh * SEQ, 0, 4, QB + basen, resn * 256 + 32 * wave); }
                    else { ATT_ROUND(2, res * 256, 32 * wave, 32 * wave - 128, wave - 4, kbuf, 4, res, PB + (size_t)bh * SEQ * HD, PL + (size_t)bh * SEQ, 0, 0, QB + basen, resn * 256 + 32 * wave); }
                }
                asm volatile("s_waitcnt vmcnt(0)" ::: "memory"); ATT_BAR();
            }
            GRID_BAR(6);
            for (int item = vcu; item < BATCH * HPG * 4; item += G) {
                const int span = item & 3, h = (item >> 2) & 7, b = item >> 5, bh = b * 8 + h;
                bf16* pbo = PB + (size_t)bh * SEQ * HD; float* pbl = PL + (size_t)bh * SEQ;
                const size_t base1 = (size_t)((b * 3 + 1) * 8 + h) * SEQ * HD, base0 = (size_t)((b * 3 + 0) * 8 + h) * SEQ * HD;
#define ITEM_RND(RD, G_, BASE_, RROW_, QB0_, TSH_, TOK0_) const int G_ = (RD) < 4 ? 1 : 0; const size_t BASE_ = (RD) < 4 ? base1 : base0; \
                const int RROW_ = (RD) < 4 ? (RD) * 1024 : 0, QB0_ = (RD) < 4 ? (span << 8) : (span << 10) + (((RD) - 4) << 8), TSH_ = (RD) < 4 ? 2 : 0, TOK0_ = (RD) < 4 ? (RD) : 0;
                { ITEM_RND(0, g_, base_, rrow_, qb0_, tsh_, tok0_)
                  { XT_CONST ATT_LOAD_Q(qn, QB + base_, rrow_ + qb0_ + 32 * wave); ATT_XCH_Q((LAS char*)(lds + ATT_K1 + wave * 4096)); }
                  asm volatile("s_waitcnt vmcnt(0)" ::: "memory"); ATT_BAR();
                  ATT_DMA(false, KB + base_, rrow_, qb0_ - 128, 12, ATT_K0, false); }
                for (int rd = 0; rd < 8; ++rd) {
                    ITEM_RND(rd, g, base, rrow, qb0, tsh, tok0)
                    const int rdn = rd + 1 < 8 ? rd + 1 : rd; ITEM_RND(rdn, gn, basen, rrown, qb0n, tshn, tok0n)
                    const int kbuf = (rd & 1) ? ATT_K1 : ATT_K0, knext = (rd & 1) ? ATT_K0 : ATT_K1;
                    if (rd == 0 || rd == 4) asm volatile("s_waitcnt vmcnt(0)" ::: "memory");
                    asm volatile("" : "+v"(qf[0]), "+v"(qf[1]), "+v"(qf[2]), "+v"(qf[3]));
                    ATT_BAR();
                    ATT_DMA(true, VB + base, rrow, qb0 - 128, 12, ATT_V, false);
                    if (rd + 1 < 8) { ATT_DMA(false, KB + basen, rrown, qb0n - 128, 12, knext, true);
                        ATT_ROUND(g, rrow, qb0 + 32 * wave, qb0 + 32 * wave - 128, wave, kbuf, tsh, tok0, pbo, pbl, (size_t)b * SEQ, 6, QB + basen, rrown + qb0n + 32 * wave); }
                    else { ATT_ROUND(g, rrow, qb0 + 32 * wave, qb0 + 32 * wave - 128, wave, kbuf, tsh, tok0, pbo, pbl, (size_t)b * SEQ, 0, QB + basen, rrown + qb0n + 32 * wave); }
                }
#undef ITEM_RND
            }
            asm volatile("s_waitcnt vmcnt(0)" ::: "memory"); ATT_BAR();
#undef ATT_BAR
#undef ATT_DMA
#undef ATT_ROUND
#undef ATT_LOAD_Q
#undef ATT_XCH_Q
#undef XT_CONST
#undef XT_A
#undef XT_B
#undef ATT_LOAD_P
        }
        if (BOTH(3)) GRID_BAR(3);
    }

    if (IN(4)) {
        { pg8::Gemm g{A2, W2, M, DM, DM}; pg8::StaticOrder S; S.init(M, DM, G, bx);
          pg8::EpiMerge2 E{(const unsigned char*)SG, MG, lds + RING_OFF + RING_BYTES + wave * 2048};
          pg8::gemm_phase<pg8::EpiMerge2, pg8::StaticOrder, true, true>(lds + RING_OFF, g, S, E); }
        if (BOTH(4)) GRID_BAR(4);
    }

    if (IN(5)) {
        pg8::Gemm g{MG, WO, M, DM, DM}; pg8::StaticOrder S; S.init(M, DM, G, bx);
        pg8::EpiOut E{x, out, ADA, lds + RING_OFF + RING_BYTES + wave * 2048};
        pg8::gemm_phase<pg8::EpiOut, pg8::StaticOrder, true, true>(lds + RING_OFF, g, S, E);
    }
#undef IN
#undef BOTH
}

extern "C" void kernel_launch(void* const* d_in, const int* in_sizes, int n_in, void* d_out, int out_size, void* d_ws, size_t ws_size, hipStream_t stream) {
    static int grid = 0;
    if (grid == 0) {
        if (n_in != 16 || in_sizes[0] != M * DM || out_size != M * DM || ws_size < WS_END) { fprintf(stderr, "kernel_launch: unexpected shapes (n_in %d, in0 %d, out %d, ws %zu)\n", n_in, n_in > 0 ? in_sizes[0] : -1, out_size, ws_size); grid = -1; return; }
        int dev = 0, cus = 0, per_cu = 0;
        if (hipGetDevice(&dev) != hipSuccess || hipDeviceGetAttribute(&cus, hipDeviceAttributeMultiprocessorCount, dev) != hipSuccess) { grid = -1; return; }
        if (hipFuncSetAttribute((const void*)mega_fwd, hipFuncAttributeMaxDynamicSharedMemorySize, LDS_BYTES) != hipSuccess) { fprintf(stderr, "kernel_launch: hipFuncSetAttribute failed\n"); grid = -1; return; }
        if (hipOccupancyMaxActiveBlocksPerMultiprocessor(&per_cu, (const void*)mega_fwd, NWAVES * 64, LDS_BYTES) != hipSuccess || per_cu < 1) { fprintf(stderr, "kernel_launch: occupancy query says %d\n", per_cu); (void)hipGetLastError(); per_cu = 1; }
        if (per_cu > 1) per_cu = 1;
        grid = cus * per_cu;
    }
    if (grid < 0) return;
    (void)hipMemsetAsync((char*)d_ws + WS_CTL, 0, CTL_ZERO_BYTES, stream);
    Args a{};
    for (int i = 0; i < 16; ++i) a.in[i] = (const float*)d_in[i];
    a.out = (float*)d_out; a.ws = (unsigned char*)d_ws;
    a.ph_lo = 0; a.ph_hi = N_PHASES;
    hipLaunchKernelGGL(mega_fwd, dim3(grid), dim3(NWAVES * 64), LDS_BYTES, stream, a);
}
```

```cpp
#include <hip/hip_runtime.h>
#include <cstdio>
#include <cstdint>

namespace pg8 {
#define PG8_LAS __attribute__((address_space(3)))
typedef unsigned short bf16_t;
typedef short bf16x8 __attribute__((ext_vector_type(8)));
typedef float f32x4 __attribute__((ext_vector_type(4)));
typedef unsigned u32x4 __attribute__((ext_vector_type(4)));
constexpr int BM = 256, BK = 64, HALF = 128, HTB = HALF * BK * 2, STAGE_BYTES = 8 * HTB, NXCD = 8, WGM = 8;

__host__ __device__ __forceinline__ int lds_byte(int r, int c) { const int st = (r >> 4) * 2 + (c >> 5), rr = r & 15, cc = c & 31, ob = rr * 64 + cc * 2; return st * 1024 + (ob ^ (((ob >> 9) & 1) << 5)); }
__host__ __device__ __forceinline__ void stage_rc(int b, int& R, int& C) { const int st = b / 1024, sb = b % 1024, swz = sb ^ (((sb >> 9) & 1) << 5); R = (st >> 1) * 16 + swz / 64; C = (st & 1) * 32 + (swz % 64) / 2; }
__host__ __device__ __forceinline__ int perm32(int rho) { const int n = rho >> 4, i = rho & 15; return 8 * (i >> 2) + 4 * n + (i & 3); }

struct Unit { int pm, pn; };
struct Gemm { const bf16_t* A; const bf16_t* Bt; int M, N, K; };

struct StaticOrder {
    int nM, nN, nwg, G, c;
    __host__ __device__ void init(int M, int N, int G_, int c_) { nM = M / BM; nN = N / BM; nwg = nM * nN; G = G_; c = c_; }
    __host__ __device__ bool next(int i, Unit& u) const {
        const long L = (long)i * G + c; if (L >= nwg) return false;
        int wgid = (int)L; { const int q = nwg / NXCD, r = nwg % NXCD, xcd = wgid % NXCD, off = wgid / NXCD; wgid = (xcd < r ? xcd * (q + 1) : r * (q + 1) + (xcd - r) * q) + off; }
        const int nig = WGM * nN, gid = wgid / nig, fm = gid * WGM, gsz = (nM - fm) < WGM ? (nM - fm) : WGM;
        u.pm = fm + ((wgid % nig) % gsz); u.pn = (wgid % nig) / gsz; return true;
    }
    __device__ __forceinline__ void a_ready(const Unit&) const {}
    __device__ __forceinline__ void done(const Unit&) const {}
};

typedef float f32x2_t __attribute__((ext_vector_type(2))); typedef __bf16 bf16x2_t __attribute__((ext_vector_type(2)));
__device__ __forceinline__ unsigned cvt_pk_bf16(float lo, float hi) { f32x2_t v = {lo, hi}; bf16x2_t b = __builtin_convertvector(v, bf16x2_t); return __builtin_bit_cast(unsigned, b); }
__device__ __forceinline__ float bf_lo(unsigned w) { return __uint_as_float(w << 16); }
__device__ __forceinline__ float bf_hi(unsigned w) { return __uint_as_float(w & 0xffff0000u); }
__device__ __forceinline__ float sigmoidf_(float x) { return __builtin_amdgcn_rcpf(1.0f + __builtin_amdgcn_exp2f(-1.4426950408889634f * x)); }
__device__ __forceinline__ u32x4 pack8(const f32x4& a, const f32x4& b) { u32x4 w; w.x = cvt_pk_bf16(a[0], a[1]); w.y = cvt_pk_bf16(a[2], a[3]); w.z = cvt_pk_bf16(b[0], b[1]); w.w = cvt_pk_bf16(b[2], b[3]); return w; }


constexpr float QSCALE = 0.125f * 1.4426950408889634f;
constexpr float NORM_EPS = 1e-6f;
#define PG8_XPOSE(P0, P1, T0, T1) do { *(PG8_LAS u32x4*)xw0 = (P0); *(PG8_LAS u32x4*)xw1 = (P1); T0 = *(const PG8_LAS u32x4*)xr0; T1 = *(const PG8_LAS u32x4*)(xr0 + 1024); } while (0)
#define PG8_XPOSE_ADDR PG8_LAS unsigned char* xw0 = scr + fr * 128 + 16 * (fq ^ (fr & 7)); PG8_LAS unsigned char* xw1 = scr + fr * 128 + 16 * ((4 + fq) ^ (fr & 7)); \
        const int r8 = 2 * fq + (fr >> 3), c8 = fr & 7; const PG8_LAS unsigned char* xr0 = scr + r8 * 128 + 16 * (c8 ^ (r8 & 7));
__device__ __forceinline__ size_t sg_frag(int pm, int t, int ai, int m, int wave, int lane) { return ((((((size_t)pm * 8 + t) * 2 + ai) * 4 + m) * 8 + wave) * 64 + lane) * 16; }
struct EpiIn {
    static constexpr bool PERM = true, AFTER_DRAIN = false; static constexpr int MIDK = 0;
    bf16_t *Q; size_t qkv_stride; bf16_t *ZA; size_t zc_off; bf16_t *GLU; unsigned char* SG; const float *qw, *kw, *bgate; PG8_LAS unsigned char* scr;
    __device__ __forceinline__ void operator()(const f32x4 (&acc)[2][2][4][2], const Unit& u, int wr, int wc, int fr, int fq) const {
        const int pn = u.pn;
        PG8_XPOSE_ADDR
        const int rown = u.pm * BM + wr * 64 + r8;
        if (pn < 18) {
            const int kind = pn / 6, rel = pn - kind * 6, g = rel >> 1, hb = ((rel & 1) << 2) + wc, sh = 2 * g;
            bf16_t* base = Q + (size_t)kind * qkv_stride;
            f32x4 wv[2][2];
            if (kind < 2) { const float* w = qw; if (kind == 1) w = kw; const float sc = kind == 0 ? QSCALE : 1.0f;
#pragma unroll
                for (int bj = 0; bj < 2; ++bj)
#pragma unroll
                    for (int n = 0; n < 2; ++n) wv[bj][n] = *(const f32x4*)(w + 32 * bj + 8 * fq + 4 * n) * sc; }
#pragma unroll
            for (int ai = 0; ai < 2; ++ai)
#pragma unroll
                for (int m = 0; m < 4; ++m) {
                    f32x4 v00 = acc[ai][0][m][0], v01 = acc[ai][0][m][1], v10 = acc[ai][1][m][0], v11 = acc[ai][1][m][1];
                    if (kind < 2) {
                        f32x4 q = v00 * v00 + v01 * v01 + v10 * v10 + v11 * v11; float ss = (q[0] + q[1]) + (q[2] + q[3]);
                        ss += __shfl_xor(ss, 16); ss += __shfl_xor(ss, 32);
                        const float rstd = __builtin_amdgcn_rsqf(ss * (1.0f / 64.0f) + NORM_EPS);
                        v00 = v00 * rstd * wv[0][0]; v01 = v01 * rstd * wv[0][1]; v10 = v10 * rstd * wv[1][0]; v11 = v11 * rstd * wv[1][1];
                    }
                    u32x4 t0, t1; PG8_XPOSE(pack8(v00, v01), pack8(v10, v11), t0, t1);
#pragma unroll
                    for (int h = 0; h < 2; ++h) { const int row = rown + ai * HALF + m * 16 + 8 * h, b = row >> 12, t = row & 4095;
                        const int tp = ((t & ((1 << sh) - 1)) << (12 - sh)) | (t >> sh);
                        __builtin_nontemporal_store(h ? t1 : t0, (u32x4*)(base + ((size_t)(((b * 3 + g) * 8 + hb) * 4096 + tp) * 64 + 8 * c8))); }
                }
        } else if (pn < 20 || (pn >= 24 && pn < 26)) {
            bf16_t* base = ZA + (pn < 20 ? (size_t)0 : zc_off); const int rel = pn < 20 ? pn - 18 : pn - 24; const int colN = rel * BM + wc * 32 + (c8 >> 2) * HALF + 8 * (c8 & 3);
#pragma unroll
            for (int ai = 0; ai < 2; ++ai)
#pragma unroll
                for (int m = 0; m < 4; ++m) { u32x4 p[2];
#pragma unroll
                    for (int bj = 0; bj < 2; ++bj) { f32x4 a = acc[ai][bj][m][0], b = acc[ai][bj][m][1];
#pragma unroll
                        for (int i = 0; i < 4; ++i) { a[i] = a[i] * sigmoidf_(a[i]); b[i] = b[i] * sigmoidf_(b[i]); }
                        p[bj] = pack8(a, b); }
                    u32x4 t0, t1; PG8_XPOSE(p[0], p[1], t0, t1);
                    bf16_t* dst = base + (size_t)(rown + ai * HALF + m * 16) * 512 + colN;
                    __builtin_nontemporal_store(t0, (u32x4*)dst); __builtin_nontemporal_store(t1, (u32x4*)(dst + 8 * 512)); }
        } else if (pn < 24) {
            const int colN = (pn - 20) * HALF + wc * 32 + 8 * (c8 & 3);
#pragma unroll
            for (int ai = 0; ai < 2; ++ai)
#pragma unroll
                for (int mp = 0; mp < 2; ++mp) { u32x4 p[2];
#pragma unroll
                    for (int q = 0; q < 2; ++q) { const int m = 2 * mp + q;
                        f32x4 a0 = acc[ai][0][m][0], a1 = acc[ai][0][m][1]; const f32x4 b0 = acc[ai][1][m][0], b1 = acc[ai][1][m][1];
#pragma unroll
                        for (int i = 0; i < 4; ++i) { a0[i] = a0[i] * sigmoidf_(b0[i]); a1[i] = a1[i] * sigmoidf_(b1[i]); }
                        p[q] = pack8(a0, a1); }
                    u32x4 t0, t1; PG8_XPOSE(p[0], p[1], t0, t1);
                    bf16_t* dst = GLU + (size_t)(rown + ai * HALF + (2 * mp + (c8 >> 2)) * 16) * 512 + colN;
                    __builtin_nontemporal_store(t0, (u32x4*)dst); __builtin_nontemporal_store(t1, (u32x4*)(dst + 8 * 512)); }
        } else {
            const int t = pn - 26; const int gc0 = t * BM + wc * 32 + 8 * fq;
            f32x4 bv[2][2];
#pragma unroll
            for (int bj = 0; bj < 2; ++bj)
#pragma unroll
                for (int n = 0; n < 2; ++n) bv[bj][n] = *(const f32x4*)(bgate + gc0 + HALF * bj + 4 * n);
#pragma unroll
            for (int ai = 0; ai < 2; ++ai)
#pragma unroll
                for (int m = 0; m < 4; ++m) {
                    u32x4 w;
#pragma unroll
                    for (int bj = 0; bj < 2; ++bj) { f32x4 a = acc[ai][bj][m][0] + bv[bj][0], b = acc[ai][bj][m][1] + bv[bj][1];
                        unsigned wa = 0u, wb = 0u;
#pragma unroll
                        for (int i = 0; i < 4; ++i) { wa = __builtin_amdgcn_cvt_pk_u8_f32(sigmoidf_(a[i]) * 255.0f, i, wa); wb = __builtin_amdgcn_cvt_pk_u8_f32(sigmoidf_(b[i]) * 255.0f, i, wb); }
                        if (bj == 0) { w.x = wa; w.y = wb; } else { w.z = wa; w.w = wb; } }
                    __builtin_nontemporal_store(w, (u32x4*)(SG + sg_frag(u.pm, t, ai, m, wr * 4 + wc, fq * 16 + fr))); }
        }
    }
};
struct EpiMerge2 {
    static constexpr bool PERM = true, AFTER_DRAIN = false; static constexpr int MIDK = 8;
    const unsigned char* SG; bf16_t* OUT; PG8_LAS unsigned char* scr;
    __device__ __forceinline__ void mid(f32x4 (&acc)[2][2][4][2], const Unit& u, int wr, int wc, int fr, int fq) const {
        asm volatile("" : "+v"(fr), "+v"(fq));
        const int wave = wr * 4 + wc, lane = fq * 16 + fr;
#pragma unroll
        for (int ai = 0; ai < 2; ++ai)
#pragma unroll
            for (int m = 0; m < 4; ++m) {
                const u32x4 ga = *(const u32x4*)(SG + sg_frag(u.pm, u.pn, ai, m, wave, lane)), gc = *(const u32x4*)(SG + sg_frag(u.pm, u.pn + 4, ai, m, wave, lane));
#pragma unroll
                for (int bj = 0; bj < 2; ++bj) {
                    const unsigned gax = bj ? ga.z : ga.x, gay = bj ? ga.w : ga.y, gcx = bj ? gc.z : gc.x, gcy = bj ? gc.w : gc.y;
                    f32x4& a = acc[ai][bj][m][0]; f32x4& b = acc[ai][bj][m][1];
#pragma unroll
                    for (int i = 0; i < 4; ++i) {
                        a[i] *= (float)((gax >> (8 * i)) & 255u) * __builtin_amdgcn_rcpf(fmaxf((float)((gcx >> (8 * i)) & 255u), 0.5f));
                        b[i] *= (float)((gay >> (8 * i)) & 255u) * __builtin_amdgcn_rcpf(fmaxf((float)((gcy >> (8 * i)) & 255u), 0.5f)); } }
                if (m & 1) asm volatile("" ::: "memory"); }
    }
    __device__ __forceinline__ void operator()(const f32x4 (&acc)[2][2][4][2], const Unit& u, int wr, int wc, int fr, int fq) const {
        asm volatile("" : "+v"(fr), "+v"(fq));
        const int wave = wr * 4 + wc, lane = fq * 16 + fr;
        PG8_XPOSE_ADDR
        const int rown = u.pm * BM + wr * 64 + r8, colN = u.pn * BM + wc * 32 + (c8 >> 2) * HALF + 8 * (c8 & 3);
#pragma unroll
        for (int ai = 0; ai < 2; ++ai) {
            u32x4 gw[4];
#pragma unroll
            for (int m = 0; m < 4; ++m) gw[m] = *(const u32x4*)(SG + sg_frag(u.pm, u.pn + 4, ai, m, wave, lane));
#pragma unroll
            for (int m = 0; m < 4; ++m) { u32x4 p[2];
#pragma unroll
                for (int bj = 0; bj < 2; ++bj) { const unsigned gx = bj ? gw[m].z : gw[m].x, gy = bj ? gw[m].w : gw[m].y;
                    f32x4 a = acc[ai][bj][m][0], b = acc[ai][bj][m][1];
#pragma unroll
                    for (int i = 0; i < 4; ++i) { a[i] *= fmaxf((float)((gx >> (8 * i)) & 255u), 0.5f) * (1.0f / 255.0f); b[i] *= fmaxf((float)((gy >> (8 * i)) & 255u), 0.5f) * (1.0f / 255.0f); }
                    p[bj] = pack8(a, b); }
                u32x4 t0, t1; PG8_XPOSE(p[0], p[1], t0, t1);
                bf16_t* dst = OUT + (size_t)(rown + ai * HALF + m * 16) * 1024 + colN;
                *(u32x4*)dst = t0; *(u32x4*)(dst + 8 * 1024) = t1; }
        }
    }
};
struct EpiOut {
    static constexpr bool PERM = true, AFTER_DRAIN = false; static constexpr int MIDK = 0;
    const float* X; float* OUT; const float* ADA; PG8_LAS unsigned char* scr;
    __device__ __forceinline__ void operator()(const f32x4 (&acc)[2][2][4][2], const Unit& u, int wr, int wc, int fr, int fq) const {
        asm volatile("" : "+v"(fr), "+v"(fq));
        const int r8 = 2 * fq + (fr >> 3), c8 = fr & 7;
        const int rowb = u.pm * BM + wr * 64 + r8, col0 = u.pn * BM + wc * 32 + 4 * c8; const int b = (u.pm * BM) >> 12;
        PG8_LAS unsigned char* w0 = scr + fr * 128 + 16 * ((2 * fq) ^ (fr & 7)); PG8_LAS unsigned char* w1 = scr + fr * 128 + 16 * ((2 * fq + 1) ^ (fr & 7));
        const PG8_LAS unsigned char* r0 = scr + r8 * 128 + 16 * (c8 ^ (r8 & 7)); const PG8_LAS unsigned char* r1 = r0 + 8 * 128;
        f32x4 gv[2];
#pragma unroll
        for (int bj = 0; bj < 2; ++bj) gv[bj] = *(const f32x4*)(ADA + (size_t)b * 3072 + 2048 + col0 + bj * HALF);
#pragma unroll
        for (int ai = 0; ai < 2; ++ai) {
            f32x4 xv[4][2][2];
#pragma unroll
            for (int m = 0; m < 4; ++m) { const size_t off = (size_t)(rowb + ai * HALF + m * 16) * 1024 + col0;
#pragma unroll
                for (int bj = 0; bj < 2; ++bj)
#pragma unroll
                    for (int h = 0; h < 2; ++h) xv[m][bj][h] = *(const f32x4*)(X + off + (size_t)h * 8 * 1024 + bj * HALF); }
#pragma unroll
            for (int m = 0; m < 4; ++m) { const size_t off = (size_t)(rowb + ai * HALF + m * 16) * 1024 + col0;
#pragma unroll
                for (int bj = 0; bj < 2; ++bj) {
                    *(PG8_LAS f32x4*)w0 = acc[ai][bj][m][0]; *(PG8_LAS f32x4*)w1 = acc[ai][bj][m][1];
                    const f32x4 t0 = *(const PG8_LAS f32x4*)r0, t1 = *(const PG8_LAS f32x4*)r1;
                    *(f32x4*)(OUT + off + bj * HALF) = xv[m][bj][0] + gv[bj] * t0;
                    *(f32x4*)(OUT + off + (size_t)8 * 1024 + bj * HALF) = xv[m][bj][1] + gv[bj] * t1; } }
        }
    }
};

template <class Epi, class Sched, bool ALIGN_EPI = false, bool SP2 = false>
__device__ __forceinline__ void gemm_phase(PG8_LAS unsigned char* lds, const Gemm g, const Sched& S, const Epi& E) {
    const int tid = threadIdx.x, wid = __builtin_amdgcn_readfirstlane(tid >> 6), lane = tid & 63, wr = wid >> 2, wc = wid & 3, fr = lane & 15, fq = lane >> 4;
    const int K = g.K, nt = K / BK;
    unsigned voffA[2], voffB[2];
#pragma unroll
    for (int i = 0; i < 2; ++i) { int R, C; stage_rc(tid * 16 + i * 8192, R, C); const int Rb = Epi::PERM ? ((R & ~31) + perm32(R & 31)) : R;
        voffA[i] = (unsigned)(R * K + C) * 2u; voffB[i] = (unsigned)(Rb * K + C) * 2u; }
    const size_t kstep = (size_t)(BK * 2);
    const size_t hstep = (size_t)HALF * K * 2;
    const size_t tstep = 2 * hstep;
    const unsigned ldsw = (unsigned)wid * 1024u;
    const int aoff = lds_byte(wr * 64 + fr, fq * 8), boff = lds_byte(wc * 32 + fr, fq * 8);
#define PG8_SA(b, h) (((b) * 2 + (h)) * HTB)
#define PG8_SB(b, h) ((4 + (b) * 2 + (h)) * HTB)
#define PG8_STAGE(bufoff, gbase, voff) do { _Pragma("unroll") for (int _i = 0; _i < 2; ++_i) \
        __builtin_amdgcn_global_load_lds((const unsigned*)((const char*)(gbase) + (voff)[_i]), (PG8_LAS unsigned*)(lds + (bufoff) + ldsw + _i * 8192), 16, 0, 0); } while (0)
#define PG8_LDA(dst, b, h) do { _Pragma("unroll") for (int m = 0; m < 4; ++m) _Pragma("unroll") for (int k = 0; k < 2; ++k) dst[m][k] = *(const PG8_LAS bf16x8*)(lds + PG8_SA(b, h) + aoff + m * 2048 + k * 1024); } while (0)
#define PG8_LDB(dst, b, h) do { _Pragma("unroll") for (int n = 0; n < 2; ++n) _Pragma("unroll") for (int k = 0; k < 2; ++k) dst[n][k] = *(const PG8_LAS bf16x8*)(lds + PG8_SB(b, h) + boff + n * 2048 + k * 1024); } while (0)
#define PG8_MMA(ai, bj, At, Bt) do { __builtin_amdgcn_s_setprio(1); _Pragma("unroll") for (int m = 0; m < 4; ++m) _Pragma("unroll") for (int n = 0; n < 2; ++n) _Pragma("unroll") for (int k = 0; k < 2; ++k) \
        acc[ai][bj][m][n] = __builtin_amdgcn_mfma_f32_16x16x32_bf16(Bt[n][k], At[m][k], acc[ai][bj][m][n], 0, 0, 0); __builtin_amdgcn_s_setprio(0); } while (0)
#define PG8_WAIT_V(n) asm volatile("s_waitcnt vmcnt(" #n ")" ::: "memory")
#define PG8_WAIT_L(n) asm volatile("s_waitcnt lgkmcnt(" #n ")" ::: "memory")
#define PG8_BAR __builtin_amdgcn_s_barrier()
#define PG8_SCHED __builtin_amdgcn_sched_barrier(0)
    Unit cur, nxt; int ui = 0;
    if (!S.next(0, cur)) return;
    f32x4 acc[2][2][4][2];
#pragma unroll
    for (int a = 0; a < 2; ++a)
#pragma unroll
        for (int b = 0; b < 2; ++b)
#pragma unroll
            for (int m = 0; m < 4; ++m)
#pragma unroll
                for (int n = 0; n < 2; ++n) acc[a][b][m][n] = (f32x4){0.f, 0.f, 0.f, 0.f};
    bf16x8 At[4][2], B0[2][2], B1[2][2];
    const char* cA = (const char*)g.A + (size_t)cur.pm * tstep; const char* cB = (const char*)g.Bt + (size_t)cur.pn * tstep;
    S.a_ready(cur);
    if constexpr (SP2) {
        PG8_STAGE(PG8_SB(0, 0), cB, voffB); PG8_STAGE(PG8_SB(0, 1), cB + hstep, voffB); PG8_STAGE(PG8_SA(0, 0), cA, voffA); PG8_STAGE(PG8_SA(0, 1), cA + hstep, voffA);
        if (wr == 1) PG8_BAR;
        PG8_WAIT_V(2); PG8_BAR;
        PG8_STAGE(PG8_SB(1, 0), cB + kstep, voffB); PG8_STAGE(PG8_SA(1, 0), cA + kstep, voffA); PG8_STAGE(PG8_SB(1, 1), cB + hstep + kstep, voffB);
        PG8_WAIT_V(6); PG8_BAR;
    } else {
        PG8_STAGE(PG8_SB(0, 0), cB, voffB); PG8_STAGE(PG8_SA(0, 0), cA, voffA); PG8_STAGE(PG8_SB(0, 1), cB + hstep, voffB); PG8_STAGE(PG8_SA(0, 1), cA + hstep, voffA);
        if (wr == 1) PG8_BAR;
        PG8_WAIT_V(4); PG8_BAR;
        PG8_STAGE(PG8_SB(1, 0), cB + kstep, voffB); PG8_STAGE(PG8_SA(1, 0), cA + kstep, voffA); PG8_STAGE(PG8_SB(1, 1), cB + hstep + kstep, voffB);
        PG8_WAIT_V(6); PG8_BAR;
    }
    for (;;) {
        const bool has_next = S.next(ui + 1, nxt);
        const char* nA = has_next ? (const char*)g.A + (size_t)nxt.pm * tstep : cA; const char* nB = has_next ? (const char*)g.Bt + (size_t)nxt.pn * tstep : cB;
        for (int t = 0; t < nt; t += 2) {
            const bool last = (t == nt - 2);
            const char* a1 = cA + (size_t)(t + 1) * kstep;
            const char* a2 = last ? nA : cA + (size_t)(t + 2) * kstep; const char* b2 = last ? nB : cB + (size_t)(t + 2) * kstep;
            const char* a3 = a2 + kstep; const char* b3 = b2 + kstep;
            if (last && has_next) S.a_ready(nxt);
            if constexpr (Epi::MIDK > 0) { if (t == Epi::MIDK) E.mid(acc, cur, wr, wc, fr, fq); }
            if constexpr (SP2) {
            PG8_LDB(B0, 0, 0); PG8_LDB(B1, 0, 1); PG8_SCHED; PG8_LDA(At, 0, 0); PG8_STAGE(PG8_SA(1, 1), a1 + hstep, voffA);
            PG8_WAIT_V(8); PG8_WAIT_L(0); PG8_BAR; PG8_MMA(0, 0, At, B0); PG8_MMA(0, 1, At, B1); PG8_BAR; PG8_SCHED;
            PG8_LDA(At, 0, 1); PG8_STAGE(PG8_SB(0, 0), b2, voffB); PG8_STAGE(PG8_SB(0, 1), b2 + hstep, voffB); PG8_STAGE(PG8_SA(0, 0), a2, voffA);
            PG8_WAIT_V(8); PG8_WAIT_L(0); PG8_BAR; PG8_MMA(1, 0, At, B0); PG8_MMA(1, 1, At, B1); PG8_BAR; PG8_SCHED;
            PG8_LDB(B0, 1, 0); PG8_LDB(B1, 1, 1); PG8_SCHED; PG8_LDA(At, 1, 0); PG8_STAGE(PG8_SA(0, 1), a2 + hstep, voffA);
            PG8_WAIT_V(8); PG8_WAIT_L(0); PG8_BAR; PG8_MMA(0, 0, At, B0); PG8_MMA(0, 1, At, B1); PG8_BAR; PG8_SCHED;
            PG8_LDA(At, 1, 1); PG8_STAGE(PG8_SB(1, 0), b3, voffB); PG8_STAGE(PG8_SB(1, 1), b3 + hstep, voffB); PG8_STAGE(PG8_SA(1, 0), a3, voffA);
            PG8_WAIT_V(8); PG8_WAIT_L(0); PG8_BAR; PG8_MMA(1, 0, At, B0); PG8_MMA(1, 1, At, B1); PG8_BAR; PG8_SCHED;
            } else {
            PG8_LDB(B0, 0, 0); PG8_SCHED; PG8_LDA(At, 0, 0); PG8_STAGE(PG8_SA(1, 1), a1 + hstep, voffA);
            PG8_WAIT_L(8); PG8_BAR; PG8_WAIT_L(0); PG8_MMA(0, 0, At, B0); PG8_BAR; PG8_SCHED;
            PG8_LDB(B1, 0, 1); PG8_STAGE(PG8_SB(0, 0), b2, voffB);
            PG8_BAR; PG8_WAIT_L(0); PG8_MMA(0, 1, At, B1); PG8_BAR;
            PG8_LDA(At, 0, 1); PG8_STAGE(PG8_SA(0, 0), a2, voffA);
            PG8_BAR; PG8_WAIT_L(0); PG8_MMA(1, 0, At, B0); PG8_BAR; PG8_SCHED;
            PG8_STAGE(PG8_SB(0, 1), b2 + hstep, voffB);
            PG8_WAIT_V(6); PG8_BAR; PG8_MMA(1, 1, At, B1); PG8_BAR;
            PG8_LDB(B0, 1, 0); PG8_SCHED; PG8_LDA(At, 1, 0); PG8_STAGE(PG8_SA(0, 1), a2 + hstep, voffA);
            PG8_WAIT_L(8); PG8_BAR; PG8_WAIT_L(0); PG8_MMA(0, 0, At, B0); PG8_BAR; PG8_SCHED;
            PG8_LDB(B1, 1, 1); PG8_STAGE(PG8_SB(1, 0), b3, voffB);
            PG8_BAR; PG8_WAIT_L(0); PG8_MMA(0, 1, At, B1); PG8_BAR;
            PG8_LDA(At, 1, 1); PG8_STAGE(PG8_SA(1, 0), a3, voffA);
            PG8_BAR; PG8_WAIT_L(0); PG8_MMA(1, 0, At, B0); PG8_BAR; PG8_SCHED;
            PG8_STAGE(PG8_SB(1, 1), b3 + hstep, voffB);
            PG8_WAIT_V(6); PG8_BAR; PG8_MMA(1, 1, At, B1); PG8_BAR;
            }
        }
        if constexpr (ALIGN_EPI) { if (wr == 0) PG8_BAR; }
        if constexpr (!Epi::AFTER_DRAIN) { E(acc, cur, wr, wc, fr, fq); S.done(cur); }
        if (!has_next) break;
#pragma unroll
        for (int a = 0; a < 2; ++a)
#pragma unroll
            for (int b = 0; b < 2; ++b)
#pragma unroll
                for (int m = 0; m < 4; ++m)
#pragma unroll
                    for (int n = 0; n < 2; ++n) acc[a][b][m][n] = (f32x4){0.f, 0.f, 0.f, 0.f};
        cur = nxt; cA = nA; cB = nB; ++ui;
        if constexpr (ALIGN_EPI) { if (wr == 1) PG8_BAR; }
    }
    PG8_WAIT_V(0);
    if constexpr (!ALIGN_EPI) { if (wr == 0) PG8_BAR; }
    PG8_BAR;
#undef PG8_SA
#undef PG8_SB
#undef PG8_STAGE
#undef PG8_LDA
#undef PG8_LDB
#undef PG8_MMA
#undef PG8_WAIT_V
#undef PG8_WAIT_L
#undef PG8_BAR
#undef PG8_SCHED
}
}

constexpr int NWAVES = 8;
constexpr int N_PHASES = 6;
constexpr int BATCH = 8, SEQ = 4096, DM = 1024, M = BATCH * SEQ;
constexpr int NIN = 8704, NHEAD = 24, NG = 3, HPG = 8, HD = 64, CW = 512, CK = 31;
constexpr int ADA_N = 3 * DM;

constexpr size_t MiB = 1u << 20;
constexpr size_t WS_CTL = 0, CTL_ZERO_BYTES = 64 * 1024;
constexpr size_t WS_ADA = 1 * MiB;
constexpr size_t WS_WIN = 422 * MiB;
constexpr size_t WS_WA = 440 * MiB, WS_WO = 442 * MiB;
constexpr size_t WS_LSE = 2 * MiB;
constexpr size_t WS_H = 448 * MiB;
constexpr size_t WS_A2A = 448 * MiB, WS_A2C = 480 * MiB;
constexpr size_t WS_Q = 38 * MiB, WS_K = 134 * MiB, WS_V = 230 * MiB;
constexpr size_t WS_T1 = 134 * MiB, WS_MG = 230 * MiB;
constexpr size_t WS_ZA = 326 * MiB, WS_GLU = 358 * MiB, WS_ZC = 390 * MiB;
constexpr size_t WS_PB = 6 * MiB;
constexpr size_t WS_END = 512 * MiB;

constexpr int RING_OFF = 0, RING_BYTES = 131072;
constexpr int ATT_K0 = 0, ATT_K1 = 49152, ATT_V = 98304, ATT_END = 147456;
constexpr int MISC_OFF = ATT_END;
constexpr int LDS_BYTES = 151552;

#define GAS __attribute__((address_space(1)))
#define LAS __attribute__((address_space(3)))
typedef unsigned short bf16;
typedef unsigned v4u __attribute__((ext_vector_type(4)));
typedef unsigned v2u __attribute__((ext_vector_type(2)));
typedef float f32x4 __attribute__((ext_vector_type(4)));
typedef float f32x2 __attribute__((ext_vector_type(2)));
typedef float f32x16 __attribute__((ext_vector_type(16)));
typedef short bf16x8 __attribute__((ext_vector_type(8)));
typedef short s16x4 __attribute__((ext_vector_type(4)));
#define RLX_AGENT __ATOMIC_RELAXED, __HIP_MEMORY_SCOPE_AGENT
#define LDS_WAIT() asm volatile("s_waitcnt lgkmcnt(0)" ::: "memory")
using pg8::cvt_pk_bf16; using pg8::bf_lo; using pg8::bf_hi; using pg8::sigmoidf_;

#define XB_TMO      128
#define XB_XCNT(j)  (256  + 64 * (j))
#define XB_XSUB(j)  (1280 + 64 * (j))
#define XB_XGEN(j)  (2304 + 64 * (j))
#define XB_TOP      3328
#define XB_TOPGEN   3392
#define XCD_BAR_WORDS 3456
#define XB_SPIN_CAP (1u << 18)
__device__ __forceinline__ unsigned xb_ld(unsigned* p)              { return __hip_atomic_load(p, __ATOMIC_RELAXED, __HIP_MEMORY_SCOPE_AGENT); }
__device__ __forceinline__ unsigned xb_add(unsigned* p, unsigned v) { return __hip_atomic_fetch_add(p, v, __ATOMIC_RELAXED, __HIP_MEMORY_SCOPE_AGENT); }
__device__ __forceinline__ unsigned xb_xcc_id() { return (unsigned)__builtin_amdgcn_s_getreg((3 << 11) | 20) & 0xFu; }
#define XB_SPIN(cond, bar) do { unsigned _sp = 0; while (cond) { __builtin_amdgcn_s_sleep(1); \
    if ((++_sp & 255u) == 0u) { if (xb_ld(&(bar)[XB_TMO])) break; if (_sp > XB_SPIN_CAP) { atomicAdd(&(bar)[XB_TMO], 1u); break; } } } } while (0)
struct XcdBarrier { unsigned* bar; unsigned x; volatile LAS unsigned* st; };
__device__ __forceinline__ XcdBarrier xcd_barrier_post(unsigned* bar, volatile LAS unsigned* st) {
    XcdBarrier b; b.bar = bar; b.x = xb_xcc_id(); b.st = st;
    if (threadIdx.x == 0) (void)xb_add(&bar[XB_XCNT(b.x)], 1u);
    return b;
}
__device__ __forceinline__ void xcd_barrier_complete(unsigned* bar, unsigned x, unsigned& nloc, unsigned& nx) {
    const unsigned G = gridDim.x * gridDim.y * gridDim.z;
    unsigned sum, cnt, mine, sp = 0u;
    for (;;) {
        sum = 0u; cnt = 0u; mine = 0u;
#pragma unroll
        for (unsigned j = 0; j < 16; ++j) { const unsigned c = xb_ld(&bar[XB_XCNT(j)]); sum += c; cnt += (c > 0u) ? 1u : 0u; mine = (j == x) ? c : mine; }
        if (sum == G) break;
        __builtin_amdgcn_s_sleep(1);
        if ((++sp & 255u) == 0u) { if (xb_ld(&bar[XB_TMO])) break; if (sp > XB_SPIN_CAP) { atomicAdd(&bar[XB_TMO], 1u); break; } }
    }
    nloc = mine > 0u ? mine : 1u; nx = cnt > 0u ? cnt : 1u;
}
__device__ __forceinline__ void xcd_barrier(const XcdBarrier& b) {
    asm volatile("s_waitcnt vmcnt(0)" ::: "memory");
    __syncthreads();
    if (threadIdx.x == 0) {
        unsigned* bar = b.bar;
        __builtin_amdgcn_s_waitcnt(0);
        unsigned nloc = b.st[0], nx = b.st[1];
        if (nloc == 0u) { xcd_barrier_complete(bar, b.x, nloc, nx); b.st[0] = nloc; b.st[1] = nx; }
        const unsigned old = xb_add(&bar[XB_XSUB(b.x)], 1u);
        const unsigned gen = old / nloc;
        if (old + 1u == (gen + 1u) * nloc) {
            __builtin_amdgcn_fence(__ATOMIC_RELEASE, "agent");
            asm volatile("s_waitcnt vmcnt(0)" ::: "memory");
            const unsigned og = xb_add(&bar[XB_TOP], 1u);
            const unsigned tg = og / nx;
            if (og + 1u == (tg + 1u) * nx) xb_add(&bar[XB_TOPGEN], 1u);
            else XB_SPIN(xb_ld(&bar[XB_TOPGEN]) == tg, bar);
            __builtin_amdgcn_fence(__ATOMIC_ACQUIRE, "agent");
            xb_add(&bar[XB_XGEN(b.x)], 1u);
            asm volatile("s_waitcnt vmcnt(0)" ::: "memory");
        } else {
            XB_SPIN(xb_ld(&bar[XB_XGEN(b.x)]) == gen, bar);
            __builtin_amdgcn_fence(__ATOMIC_ACQUIRE, "agent");
            asm volatile("s_waitcnt vmcnt(0)" ::: "memory");
        }
    }
    __syncthreads();
}

__device__ __forceinline__ float wave_sum(float v) {
#pragma unroll
    for (int o = 1; o < 64; o <<= 1) v += __shfl_xor(v, o);
    return v;
}
__device__ __forceinline__ unsigned f2bf(float f) { unsigned u = __builtin_bit_cast(unsigned, f); return (u + 0x7fffu + ((u >> 16) & 1u)) >> 16; }
__device__ __forceinline__ unsigned pk2(float lo, float hi) { return f2bf(lo) | (f2bf(hi) << 16); }

__device__ __forceinline__ int win_phys(int n0) {
    if (n0 < 4608) { const int reg = n0 / 1536, c = n0 - reg * 1536, head = c >> 6, dh = (c >> 5) & 1; return (reg * 6 + (head >> 2)) * 256 + 128 * dh + 32 * (head & 3); }
    if (n0 >= 5120 && n0 < 6144) { const int c = n0 - 5120, half = c >> 9, cc = c & 511; return (20 + (cc >> 7)) * 256 + 128 * half + (cc & 127); }
    return n0;
}
__device__ __forceinline__ int win_phys_g(int n) { return n; }
template <bool WIN>
__device__ __forceinline__ void p0_transpose_item(const float* W, int K, int N, bf16* WT, LAS float* scr, int item, int lane, int ldt = 0) {
    if (ldt == 0) ldt = K;
    const int nblk = N / 32, kb = item / nblk, nb = item % nblk, k0 = 64 * kb, n0 = 32 * nb;
    const int prow = WIN ? win_phys(n0) : n0;
#pragma unroll 8
    for (int i = 0; i < 32; ++i) { const int kk = 2 * i + (lane >> 5); scr[kk * 33 + (lane & 31)] = __builtin_nontemporal_load(W + (size_t)(k0 + kk) * N + n0 + (lane & 31)); }
    LDS_WAIT(); asm volatile("" ::: "memory");
    const int c = lane & 7;
#pragma unroll
    for (int j = 0; j < 4; ++j) { const int n = (lane >> 3) + 8 * j; const LAS float* s = scr + (8 * c) * 33 + n;
        v4u o; o.x = pk2(s[0 * 33], s[1 * 33]); o.y = pk2(s[2 * 33], s[3 * 33]); o.z = pk2(s[4 * 33], s[5 * 33]); o.w = pk2(s[6 * 33], s[7 * 33]);
        const int rown = (WIN && n0 >= 6656) ? win_phys_g(n0 + n) : prow + n;
        *(GAS v4u*)(WT + (size_t)rown * ldt + k0 + 8 * c) = o; }
    LDS_WAIT(); asm volatile("" ::: "memory");
}

struct Args { const float* in[16]; float* out; unsigned char* ws; int ph_lo, ph_hi; };
__device__ __forceinline__ int crow(int r, int hi) { return (r & 3) + 8 * (r >> 2) + 4 * hi; }
__device__ __forceinline__ s16x4 vtr(const LAS char* p) { typedef short v4i16_t __attribute__((ext_vector_type(4))); return __builtin_bit_cast(s16x4, __builtin_amdgcn_ds_read_tr16_b64_v4i16((LAS v4i16_t*)p)); }

__device__ __forceinline__ void glds16s(const void* sbase, unsigned voff, unsigned lds_dst) { unsigned keep;
    const unsigned long long sb = (unsigned long long)sbase;
    const unsigned lo = (unsigned)__builtin_amdgcn_readfirstlane((int)(unsigned)sb), hi = (unsigned)__builtin_amdgcn_readfirstlane((int)(unsigned)(sb >> 32));
    const unsigned long long sbu = ((unsigned long long)hi << 32) | lo;
    asm volatile("s_mov_b32 %0, m0\n\ts_mov_b32 m0, %3\n\ts_nop 4\n\tglobal_load_lds_dwordx4 %1, %2\n\ts_mov_b32 m0, %0" : "=&s"(keep) : "v"(voff), "s"(sbu), "s"(lds_dst) : "memory"); }
struct KTile { bf16x8 k[4]; };
struct VTile { v4u v[4]; };
__device__ __forceinline__ void load_k(KTile& T, const bf16* Kp, int row0, int r32, int hi) {
    const bf16* kr = Kp + (size_t)(row0 + r32) * HD + 8 * hi;
#pragma unroll
    for (int ks = 0; ks < 4; ++ks) T.k[ks] = *(const GAS bf16x8*)(kr + 16 * ks);
}
__device__ __forceinline__ void load_v(VTile& T, const bf16* Vp, int row0, int lane) {
#pragma unroll
    for (int i = 0; i < 4; ++i) { const int c = lane + 64 * i; T.v[i] = *(const GAS v4u*)(Vp + (size_t)(row0 + (c >> 3)) * HD + (c & 7) * 8); }
}
template <int TAU>
__device__ __forceinline__ void att_tile(const KTile& TK, const VTile& TV, const bf16x8 (&qf)[4], float& m, float& l, f32x16 (&o)[2], LAS char* vl, const LAS char* vrd, int lane, int r32, int hi) {
    f32x16 s = {};
#pragma unroll
    for (int ks = 0; ks < 4; ++ks) s = __builtin_amdgcn_mfma_f32_32x32x16_bf16(TK.k[ks], qf[ks], s, 0, 0, 0);
#pragma unroll
    for (int i = 0; i < 4; ++i) { const int c = lane + 64 * i, key = c >> 3, ch = c & 7; *(LAS v4u*)(vl + (ch >> 2) * 2048 + key * 64 + (ch & 3) * 16) = TV.v[i]; }
    if (TAU == 0) {
#pragma unroll
        for (int r = 0; r < 16; ++r) if (crow(r, hi) < r32) s[r] = -INFINITY;
    }
    if (TAU == 4) {
#pragma unroll
        for (int r = 0; r < 16; ++r) if (crow(r, hi) > r32) s[r] = -INFINITY;
    }
    float tm = fmaxf(fmaxf(s[0], s[1]), s[2]);
#pragma unroll
    for (int r = 3; r < 15; r += 2) tm = fmaxf(fmaxf(tm, s[r]), s[r + 1]);
    tm = fmaxf(tm, s[15]);
    tm = fmaxf(tm, __shfl_xor(tm, 32));
    if (__any(tm > m)) {
        const float mn = fmaxf(m, tm), al = __builtin_amdgcn_exp2f(m - mn);
        l *= al; o[0] = o[0] * al; o[1] = o[1] * al; m = mn;
    }
    float ps = 0.f;
#pragma unroll
    for (int r = 0; r < 16; ++r) { s[r] = __builtin_amdgcn_exp2f(s[r] - m); ps += s[r]; }
    l += ps;
    v4u pw0, pw1;
    pw0.x = cvt_pk_bf16(s[0], s[1]); pw0.y = cvt_pk_bf16(s[2], s[3]); pw0.z = cvt_pk_bf16(s[4], s[5]); pw0.w = cvt_pk_bf16(s[6], s[7]);
    pw1.x = cvt_pk_bf16(s[8], s[9]); pw1.y = cvt_pk_bf16(s[10], s[11]); pw1.z = cvt_pk_bf16(s[12], s[13]); pw1.w = cvt_pk_bf16(s[14], s[15]);
    const bf16x8 pf0 = __builtin_bit_cast(bf16x8, pw0), pf1 = __builtin_bit_cast(bf16x8, pw1);
    LDS_WAIT(); asm volatile("" ::: "memory");
#pragma unroll
    for (int d0 = 0; d0 < 2; ++d0) {
        const s16x4 a0 = vtr(vrd + d0 * 2048), a1 = vtr(vrd + d0 * 2048 + 512), a2 = vtr(vrd + d0 * 2048 + 1024), a3 = vtr(vrd + d0 * 2048 + 1536);
        const bf16x8 vf0 = (bf16x8){a0[0], a0[1], a0[2], a0[3], a1[0], a1[1], a1[2], a1[3]};
        const bf16x8 vf1 = (bf16x8){a2[0], a2[1], a2[2], a2[3], a3[0], a3[1], a3[2], a3[3]};
        o[d0] = __builtin_amdgcn_mfma_f32_32x32x16_bf16(vf0, pf0, o[d0], 0, 0, 0);
        o[d0] = __builtin_amdgcn_mfma_f32_32x32x16_bf16(vf1, pf1, o[d0], 0, 0, 0);
    }
    asm volatile("" ::: "memory");
}

__global__ void __launch_bounds__(NWAVES * 64, 2) mega_fwd(Args args) {
    extern __shared__ __attribute__((aligned(16))) unsigned char lds_raw[];
    LAS unsigned char* lds = (LAS unsigned char*)lds_raw;
    const int tid = threadIdx.x, lane = tid & 63, wave = __builtin_amdgcn_readfirstlane(tid >> 6);
    const int G = gridDim.x; const int bx = blockIdx.x; const int vcu = (G % 8 == 0) ? (bx % 8) * (G / 8) + bx / 8 : bx;
    unsigned char* ws = args.ws;
    const float* x = args.in[0]; const float* cvec = args.in[1]; const float* w_ada = args.in[2]; const float* b_ada = args.in[3]; const float* norm_w = args.in[4];
    const float* w_in = args.in[5]; const float* b_gate = args.in[6]; const float* q_norm_w = args.in[7]; const float* k_norm_w = args.in[8]; const float* w_attn_proj = args.in[9];
    const float* conv_w = args.in[10]; const float* conv_b = args.in[11]; const float* conv_ln_w = args.in[12]; const float* conv_ln_b = args.in[13];
    const float* w_conv_proj = args.in[14]; const float* w_out = args.in[15];
    float* out = args.out;
    float* ADA = (float*)(ws + WS_ADA);
    bf16* WIN = (bf16*)(ws + WS_WIN); bf16* W2 = (bf16*)(ws + WS_WA); bf16* WO = (bf16*)(ws + WS_WO);
    float* LSE = (float*)(ws + WS_LSE);
    bf16* HB = (bf16*)(ws + WS_H); bf16* A2 = (bf16*)(ws + WS_A2A);
    bf16* QB = (bf16*)(ws + WS_Q); bf16* KB = (bf16*)(ws + WS_K); bf16* VB = (bf16*)(ws + WS_V);
    bf16* MG = (bf16*)(ws + WS_MG);
    bf16* ZA = (bf16*)(ws + WS_ZA); bf16* GLU = (bf16*)(ws + WS_GLU); bf16* ZC = (bf16*)(ws + WS_ZC);
    bf16* SG = (bf16*)out;

    if (tid < 32) ((LAS unsigned*)(lds + MISC_OFF))[tid] = 0u;
    __syncthreads();
    XcdBarrier bar = xcd_barrier_post((unsigned*)(ws + WS_CTL) + 4096, (volatile LAS unsigned*)(lds + MISC_OFF) + 8);
#define GRID_BAR(k) xcd_barrier(bar)
    const int lo = args.ph_lo, hi_ph = args.ph_hi;
#define IN(k) (lo <= (k) && (k) < hi_ph)
#define BOTH(k) (IN(k) && IN((k) + 1))
    const int gw = vcu * NWAVES + wave, NGW = G * NWAVES;

    if (IN(0)) {
        {
            LAS float* sc = (LAS float*)lds; LAS float* part = (LAS float*)(lds + 32768);
            if (bx < ADA_N / 64) {
                for (int i = tid; i < BATCH * DM; i += NWAVES * 64) { const float v = cvec[i]; sc[i] = v * sigmoidf_(v); }
                __syncthreads();
                for (int item = bx; item < ADA_N / 64; item += G) {
                    const int j = item * 64 + lane; float a[BATCH];
#pragma unroll
                    for (int b = 0; b < BATCH; ++b) a[b] = 0.f;
#pragma unroll 4
                    for (int kk = 0; kk < 128; ++kk) { const int k = wave * 128 + kk; const float w = __builtin_nontemporal_load(w_ada + (size_t)k * ADA_N + j);
#pragma unroll
                        for (int b = 0; b < BATCH; ++b) a[b] += sc[b * DM + k] * w; }
#pragma unroll
                    for (int b = 0; b < BATCH; ++b) part[(wave * BATCH + b) * 64 + lane] = a[b];
                    __syncthreads();
                    { float s = b_ada[j];
#pragma unroll
                      for (int w = 0; w < NWAVES; ++w) s += part[(w * BATCH + wave) * 64 + lane];
                      ADA[(size_t)wave * ADA_N + j] = s; }
                    __syncthreads();
                }
            }
        }
        if (bx >= ADA_N / 64 || G <= ADA_N / 64) {
            LAS float* scr = (LAS float*)(lds + RING_OFF + wave * 16384);
            constexpr int I_IN = (DM / 64) * (NIN / 32), I_A = (CW / 64) * (DM / 32), I_O = (DM / 64) * (DM / 32);
            constexpr int NITEMS = I_IN + 2 * I_A + I_O;
            const int nsk = G > ADA_N / 64 ? ADA_N / 64 : 0;
            for (int it = (bx - nsk) * NWAVES + wave; it < NITEMS; it += (G - nsk) * NWAVES) {
                int r = it;
                if (r < I_IN) { p0_transpose_item<true>(w_in, DM, NIN, WIN, scr, r, lane); continue; } r -= I_IN;
                if (r < I_A) { p0_transpose_item<false>(w_attn_proj, CW, DM, W2, scr, r, lane, DM); continue; } r -= I_A;
                if (r < I_A) { p0_transpose_item<false>(w_conv_proj, CW, DM, W2 + CW, scr, r, lane, DM); continue; } r -= I_A;
                p0_transpose_item<false>(w_out, DM, DM, WO, scr, r, lane);
            }
        }
        if (BOTH(0)) GRID_BAR(0);
    }

    if (IN(1)) {
        for (int rb = gw; rb < M / 16; rb += NGW) {
            const int row0 = rb * 16, b = row0 >> 12;
            f32x4 gm[4], ga[4];
#pragma unroll
            for (int j = 0; j < 4; ++j) { const int c = 4 * lane + 256 * j;
                const f32x4 nw = *(const f32x4*)(norm_w + c), sc = *(const f32x4*)(ADA + (size_t)b * ADA_N + DM + c);
                gm[j] = nw * (sc + 1.0f); ga[j] = *(const f32x4*)(ADA + (size_t)b * ADA_N + c); }
            for (int r = 0; r < 16; ++r) {
                const GAS f32x4* xr = (const GAS f32x4*)(x + (size_t)(row0 + r) * DM) + lane;
                f32x4 v[4]; float s2 = 0.f;
#pragma unroll
                for (int j = 0; j < 4; ++j) { v[j] = __builtin_nontemporal_load(xr + 64 * j); s2 += (v[j].x * v[j].x + v[j].y * v[j].y) + (v[j].z * v[j].z + v[j].w * v[j].w); }
                const float rstd = __builtin_amdgcn_rsqf(wave_sum(s2) * (1.f / DM) + pg8::NORM_EPS);
                GAS v2u* o8 = (GAS v2u*)(HB + (size_t)(row0 + r) * DM) + lane;
#pragma unroll
                for (int j = 0; j < 4; ++j) { const f32x4 y = v[j] * rstd * gm[j] + ga[j]; v2u w; w.x = cvt_pk_bf16(y.x, y.y); w.y = cvt_pk_bf16(y.z, y.w); o8[64 * j] = w; }
            }
        }
        if (BOTH(1)) GRID_BAR(1);
    }

    if (IN(2)) {
        pg8::Gemm g{HB, WIN, M, NIN, DM}; pg8::StaticOrder S; S.init(M, NIN, G, bx);
        pg8::EpiIn E{QB, (WS_K - WS_Q) / 2, ZA, (WS_ZC - WS_ZA) / 2, GLU, (unsigned char*)SG, q_norm_w, k_norm_w, b_gate, lds + RING_OFF + RING_BYTES + wave * 2048};
        pg8::gemm_phase<pg8::EpiIn, pg8::StaticOrder, true, true>(lds + RING_OFF, g, S, E);
        if (BOTH(2)) GRID_BAR(2);
    }

    if (IN(3)) {
        {
            LAS unsigned* in32 = (LAS unsigned*)lds;
            LAS float* ot = (LAS float*)(lds + 65536);
            const int cp = tid & 255, th = tid >> 8;
            float w0[CK], w1[CK];
#pragma unroll
            for (int j = 0; j < CK; ++j) { const f32x2 w = *(const f32x2*)(conv_w + j * CW + 2 * cp); w0[j] = w.x; w1[j] = w.y; }
            const f32x2 cb = *(const f32x2*)(conv_b + 2 * cp);
            v4u pf[8];
#define CONV_FETCH(TILE) { const int b_ = (TILE) >> 7, t0_ = ((TILE) & 127) * 32; \
                _Pragma("unroll") for (int i = 0; i < 8; ++i) { int c = tid + 512 * i; c = c < 62 * 64 ? c : 62 * 64 - 1; const int r = c >> 6, ch = c & 63, t = t0_ - 30 + r; \
                    v4u val = *(const GAS v4u*)(GLU + ((size_t)b_ * SEQ + (t < 0 ? 0 : t)) * CW + ch * 8); if (t < 0) val = (v4u){0u, 0u, 0u, 0u}; pf[i] = val; } }
            if (bx < M / 32) CONV_FETCH(bx)
            for (int tile = bx; tile < M / 32; tile += G) {
                const int b = tile >> 7, t0 = (tile & 127) * 32; const size_t row0 = (size_t)b * SEQ + t0;
#pragma unroll
                for (int i = 0; i < 8; ++i) { const int c = tid + 512 * i; if (c < 62 * 64) *(LAS v4u*)(lds + (size_t)c * 16) = pf[i]; }
                v4u zc[4];
#pragma unroll
                for (int q = 0; q < 4; ++q) zc[q] = *(const GAS v4u*)(ZC + (row0 + wave + 8 * q) * CW + lane * 8);
                __syncthreads();
                { const int nt_ = tile + G < M / 32 ? tile + G : tile; CONV_FETCH(nt_) }
                unsigned xs[46];
#pragma unroll
                for (int i = 0; i < 46; ++i) xs[i] = in32[(th * 16 + i) * 256 + cp];
#pragma unroll
                for (int tl = 0; tl < 16; ++tl) { float a0 = cb.x, a1 = cb.y;
#pragma unroll
                    for (int j = 0; j < CK; ++j) { const unsigned xv = xs[tl + j]; a0 += w0[j] * bf_lo(xv); a1 += w1[j] * bf_hi(xv); }
                    *(LAS f32x2*)(ot + (th * 16 + tl) * CW + 2 * cp) = (f32x2){a0, a1}; }
                __syncthreads();
                {
                    const f32x4 lw0 = *(const f32x4*)(conv_ln_w + lane * 8), lw1 = *(const f32x4*)(conv_ln_w + lane * 8 + 4);
                    const f32x4 lb0 = *(const f32x4*)(conv_ln_b + lane * 8), lb1 = *(const f32x4*)(conv_ln_b + lane * 8 + 4);
#pragma unroll
                    for (int q = 0; q < 4; ++q) { const int tl = wave + 8 * q;
                        f32x4 v0 = *(const LAS f32x4*)(ot + tl * CW + lane * 8), v1 = *(const LAS f32x4*)(ot + tl * CW + lane * 8 + 4);
                        const float mean = wave_sum((v0.x + v0.y) + (v0.z + v0.w) + (v1.x + v1.y) + (v1.z + v1.w)) * (1.f / CW);
                        v0 = v0 - mean; v1 = v1 - mean;
                        const float var = wave_sum((v0.x * v0.x + v0.y * v0.y) + (v0.z * v0.z + v0.w * v0.w) + (v1.x * v1.x + v1.y * v1.y) + (v1.z * v1.z + v1.w * v1.w)) * (1.f / CW);
                        const float rstd = __builtin_amdgcn_rsqf(var + pg8::NORM_EPS);
                        v0 = v0 * rstd * lw0 + lb0; v1 = v1 * rstd * lw1 + lb1;
                        const v4u zq = zc[q];
                        const float z[8] = {bf_lo(zq.x), bf_hi(zq.x), bf_lo(zq.y), bf_hi(zq.y), bf_lo(zq.z), bf_hi(zq.z), bf_lo(zq.w), bf_hi(zq.w)};
#pragma unroll
                        for (int i = 0; i < 4; ++i) { v0[i] = v0[i] * sigmoidf_(v0[i]) * z[i]; v1[i] = v1[i] * sigmoidf_(v1[i]) * z[4 + i]; }
                        *(GAS v4u*)(A2 + (row0 + tl) * DM + CW + lane * 8) = pg8::pack8(v0, v1); }
                }
                __syncthreads();
            }
#undef CONV_FETCH
        }
        {
            const int r32 = lane & 31, hi = lane >> 5;
            const int vrd_off = (4 * hi + ((lane & 15) >> 2)) * 64 + ((lane >> 4) & 1) * 32 + (lane & 3) * 8;
            const int piece = wave & 3, tsel = wave >> 2;
            bf16* PB = (bf16*)(ws + WS_PB); float* PL = (float*)(ws + WS_LSE);
            const unsigned lds0 = (unsigned)(uintptr_t)lds_raw;
            const unsigned voffK = (unsigned)(((8 * piece + (lane >> 3)) * HD + (((lane & 7) ^ (((8 * piece + (lane >> 3)) >> 1) & 7)) << 3)) * 2);
            const unsigned voffV = (unsigned)(((16 * (piece & 1) + (lane >> 2)) * HD + (piece >> 1) * 32 + (lane & 3) * 8) * 2);
#define XT_CONST int xln_ = lane; asm volatile("" : "+v"(xln_)); const int xl_r = xln_ >> 3, xc0 = (xln_ & 7) ^ (xln_ >> 4);     \
            const unsigned xb_off = (unsigned)(xl_r * 128 + (xln_ & 7) * 16), xa_off = (unsigned)((xln_ & 31) * 128), xa_f = (unsigned)(((xln_ & 31) >> 1) & 7);
#define XT_B(T, I) (*(LAS v4u*)((T) + xb_off + (I) * 1024))
#define XT_A(T, CH) (*(LAS v4u*)((T) + xa_off + ((((unsigned)(CH)) ^ xa_f) << 4)))
#define ATT_BAR() do { asm volatile("s_waitcnt lgkmcnt(0)" ::: "memory"); __builtin_amdgcn_s_barrier(); asm volatile("" ::: "memory"); } while (0)
#define ATT_DMA(ISV, SRC, RROW, JSB, NT, LDSOFF, FORCE) do { \
                _Pragma("unroll") for (int m_ = 0; m_ < 6; ++m_) { const int kt_ = 2 * m_ + tsel; const int js_ = (JSB) + 32 * kt_; \
                    if (m_ < (NT) / 2 && ((FORCE) || js_ >= 0)) \
                        glds16s((SRC) + ((size_t)(RROW) + (js_ < 0 ? 0 : js_)) * HD, ISV ? voffV : voffK, (unsigned)__builtin_amdgcn_readfirstlane((int)(lds0 + (LDSOFF) + kt_ * 4096 + piece * 1024))); } } while (0)
#define ATT_ROUND_(FAST, G_, RROW, IU0, JB, KTB, KBUF, TSH, TOK0, PBO, PBL, MROW0, NKN, QNP, QNROW) do { \
                    const int iq = (IU0) + r32; const int tq = (iq << (TSH)) + (TOK0); \
                    f32x16 S[5]; \
                    _Pragma("unroll") for (int tau = 0; tau < 5; ++tau) { \
                        if ((FAST) || (JB) + 32 * tau >= 0) { \
                            const LAS char* kp = (const LAS char*)(lds + (KBUF) + ((KTB) + tau) * 4096 + r32 * 128); \
                            bf16x8 kf[4]; \
                            _Pragma("unroll") for (int ks = 0; ks < 4; ++ks) kf[ks] = *(const LAS bf16x8*)(kp + (((2 * ks + hi) ^ ((r32 >> 1) & 7)) << 4)); \
                            f32x16 sacc = {}; \
                            _Pragma("unroll") for (int ks = 0; ks < 4; ++ks) sacc = __builtin_amdgcn_mfma_f32_32x32x16_bf16(kf[ks], qf[ks], sacc, 0, 0, 0); \
                              \
                            if (tau == 0) { int rq = r32 - 4 * hi; asm volatile("" : "+v"(rq)); _Pragma("unroll") for (int r = 0; r < 16; ++r) if ((r & 3) + 8 * (r >> 2) < rq) sacc[r] = -INFINITY; } \
                            if (tau == 4) { int rq = r32 - 4 * hi; asm volatile("" : "+v"(rq)); _Pragma("unroll") for (int r = 0; r < 16; ++r) if ((r & 3) + 8 * (r >> 2) > rq) sacc[r] = -INFINITY; } \
                            S[tau] = sacc; \
                        } else { _Pragma("unroll") for (int r = 0; r < 16; ++r) S[tau][r] = -INFINITY; } } \
                    float mx = -INFINITY; \
                    _Pragma("unroll") for (int tau = 0; tau < 5; ++tau) _Pragma("unroll") for (int r = 0; r < 16; r += 2) mx = fmaxf(fmaxf(mx, S[tau][r]), S[tau][r + 1]); \
                    { const auto sw_ = __builtin_amdgcn_permlane32_swap(__float_as_uint(mx), __float_as_uint(mx), false, false); mx = fmaxf(__uint_as_float(sw_[0]), __uint_as_float(sw_[1])); } \
                    float l = 0.f; v4u P[5][2]; \
                    _Pragma("unroll") for (int tau = 0; tau < 5; ++tau) { f32x16 p = S[tau]; float ps = 0.f; \
                        _Pragma("unroll") for (int r = 0; r < 16; ++r) { p[r] = __builtin_amdgcn_exp2f(p[r] - mx); ps += p[r]; } \
                        l += ps; \
                        P[tau][0].x = cvt_pk_bf16(p[0], p[1]); P[tau][0].y = cvt_pk_bf16(p[2], p[3]); P[tau][0].z = cvt_pk_bf16(p[4], p[5]); P[tau][0].w = cvt_pk_bf16(p[6], p[7]); \
                        P[tau][1].x = cvt_pk_bf16(p[8], p[9]); P[tau][1].y = cvt_pk_bf16(p[10], p[11]); P[tau][1].z = cvt_pk_bf16(p[12], p[13]); P[tau][1].w = cvt_pk_bf16(p[14], p[15]); } \
                    { const auto sw_ = __builtin_amdgcn_permlane32_swap(__float_as_uint(l), __float_as_uint(l), false, false); l = __uint_as_float(sw_[0]) + __uint_as_float(sw_[1]); } \
                    asm volatile("s_waitcnt vmcnt(" #NKN ")" ::: "memory"); ATT_BAR();     \
                    XT_CONST LAS char* const xt = (LAS char*)(lds + (KBUF) + wave * 4096); \
                    ATT_LOAD_Q(qn, QNP, QNROW); \
                    if ((G_) < 2) ATT_LOAD_P(PBO, PBL, tq, IU0, TSH, TOK0); \
                    f32x16 o[2]; o[0] = f32x16{}; o[1] = f32x16{}; \
                    _Pragma("unroll") for (int tau = 0; tau < 5; ++tau) { \
                        if ((FAST) || (JB) + 32 * tau >= 0) { \
                            const LAS char* vp = (const LAS char*)(lds + ATT_V + ((KTB) + tau) * 4096 + vrd_off); \
                            const bf16x8 pf0 = __builtin_bit_cast(bf16x8, P[tau][0]), pf1 = __builtin_bit_cast(bf16x8, P[tau][1]); \
                            _Pragma("unroll") for (int d0 = 0; d0 < 2; ++d0) { \
                                const s16x4 a0 = vtr(vp + d0 * 2048), a1 = vtr(vp + d0 * 2048 + 512), a2 = vtr(vp + d0 * 2048 + 1024), a3 = vtr(vp + d0 * 2048 + 1536); \
                                const bf16x8 vf0 = (bf16x8){a0[0], a0[1], a0[2], a0[3], a1[0], a1[1], a1[2], a1[3]}; \
                                const bf16x8 vf1 = (bf16x8){a2[0], a2[1], a2[2], a2[3], a3[0], a3[1], a3[2], a3[3]}; \
                                o[d0] = __builtin_amdgcn_mfma_f32_32x32x16_bf16(vf0, pf0, o[d0], 0, 0, 0); \
                                o[d0] = __builtin_amdgcn_mfma_f32_32x32x16_bf16(vf1, pf1, o[d0], 0, 0, 0); } } } \
                    float lse = mx + __builtin_amdgcn_logf(l), sc_own = __builtin_amdgcn_rcpf(l), sc_p = 0.f; \
                    if ((G_) < 2) { const float mx2 = fmaxf(lse, plse), a = __builtin_amdgcn_exp2f(lse - mx2), bq = __builtin_amdgcn_exp2f(plse - mx2), inv = __builtin_amdgcn_rcpf(a + bq); \
                        sc_own = sc_own * a * inv; sc_p = bq * inv; lse = mx2 + __builtin_amdgcn_logf(a + bq); } \
                      \
                    if ((G_) < 2) { _Pragma("unroll") for (int i = 0; i < 4; ++i) XT_B(xt, i) = pq[i]; _Pragma("unroll") for (int c = 0; c < 4; ++c) pq[c] = XT_A(xt, 2 * c + hi); } \
                    if ((G_) < 2) { _Pragma("unroll") for (int c = 0; c < 4; ++c) { const auto rx = __builtin_amdgcn_permlane32_swap(pq[c].x, pq[c].z, false, false); const auto ry = __builtin_amdgcn_permlane32_swap(pq[c].y, pq[c].w, false, false); \
                        pp[2 * c] = (v2u){rx[0], ry[0]}; pp[2 * c + 1] = (v2u){rx[1], ry[1]}; } } \
                    if ((G_) > 0) { \
                        _Pragma("unroll") for (int d0 = 0; d0 < 2; ++d0) _Pragma("unroll") for (int j = 0; j < 2; ++j) { v2u w[2]; \
                            _Pragma("unroll") for (int q = 0; q < 2; ++q) { const int rg = 2 * j + q; \
                                float e0 = o[d0][4 * rg] * sc_own, e1 = o[d0][4 * rg + 1] * sc_own, e2 = o[d0][4 * rg + 2] * sc_own, e3 = o[d0][4 * rg + 3] * sc_own; \
                                if ((G_) < 2) { const v2u pw = pp[d0 * 4 + rg]; e0 += sc_p * bf_lo(pw.x); e1 += sc_p * bf_hi(pw.x); e2 += sc_p * bf_lo(pw.y); e3 += sc_p * bf_hi(pw.y); } \
                                w[q].x = cvt_pk_bf16(e0, e1); w[q].y = cvt_pk_bf16(e2, e3); } \
                            const auto rx = __builtin_amdgcn_permlane32_swap(w[0].x, w[1].x, false, false); const auto ry = __builtin_amdgcn_permlane32_swap(w[0].y, w[1].y, false, false); \
                            XT_A(xt, 2 * (d0 * 2 + j) + hi) = (v4u){rx[0], ry[0], rx[1], ry[1]}; } \
                        _Pragma("unroll") for (int i = 0; i < 4; ++i) *(GAS v4u*)((PBO) + (size_t)((((IU0) + xl_r + 8 * i) << (TSH)) + (TOK0)) * HD + 8 * (xc0 ^ (4 * (i & 1)))) = XT_B(xt, i); \
                        if (hi == 0) (PBL)[tq] = lse; \
                    } else { \
                        const size_t mrow = (size_t)(MROW0) + tq; \
                        v4u zq[4]; v2u zz[8]; \
                        _Pragma("unroll") for (int i = 0; i < 4; ++i) zq[i] = *(const GAS v4u*)(ZA + ((size_t)(MROW0) + ((((IU0) + xl_r + 8 * i) << (TSH)) + (TOK0))) * CW + h * 64 + 8 * (xc0 ^ (4 * (i & 1)))); \
                        _Pragma("unroll") for (int i = 0; i < 4; ++i) XT_B(xt, i) = zq[i]; _Pragma("unroll") for (int c = 0; c < 4; ++c) zq[c] = XT_A(xt, 2 * c + hi); \
                        _Pragma("unroll") for (int c = 0; c < 4; ++c) { const auto rx = __builtin_amdgcn_permlane32_swap(zq[c].x, zq[c].z, false, false); const auto ry = __builtin_amdgcn_permlane32_swap(zq[c].y, zq[c].w, false, false); \
                            zz[2 * c] = (v2u){rx[0], ry[0]}; zz[2 * c + 1] = (v2u){rx[1], ry[1]}; } \
                        _Pragma("unroll") for (int d0 = 0; d0 < 2; ++d0) _Pragma("unroll") for (int j = 0; j < 2; ++j) { v2u w[2]; \
                            _Pragma("unroll") for (int q = 0; q < 2; ++q) { const int rg = 2 * j + q; const v2u pw = pp[d0 * 4 + rg]; const v2u zw = zz[d0 * 4 + rg]; \
                                const float e0 = (o[d0][4 * rg] * sc_own + sc_p * bf_lo(pw.x)) * bf_lo(zw.x), e1 = (o[d0][4 * rg + 1] * sc_own + sc_p * bf_hi(pw.x)) * bf_hi(zw.x); \
                                const float e2 = (o[d0][4 * rg + 2] * sc_own + sc_p * bf_lo(pw.y)) * bf_lo(zw.y), e3 = (o[d0][4 * rg + 3] * sc_own + sc_p * bf_hi(pw.y)) * bf_hi(zw.y); \
                                w[q].x = cvt_pk_bf16(e0, e1); w[q].y = cvt_pk_bf16(e2, e3); } \
                            const auto rx = __builtin_amdgcn_permlane32_swap(w[0].x, w[1].x, false, false); const auto ry = __builtin_amdgcn_permlane32_swap(w[0].y, w[1].y, false, false); \
                            XT_A(xt, 2 * (d0 * 2 + j) + hi) = (v4u){rx[0], ry[0], rx[1], ry[1]}; } \
                        _Pragma("unroll") for (int i = 0; i < 4; ++i) *(GAS v4u*)(A2 + ((size_t)(MROW0) + ((((IU0) + xl_r + 8 * i) << (TSH)) + (TOK0))) * DM + h * 64 + 8 * (xc0 ^ (4 * (i & 1)))) = XT_B(xt, i); } \
                    ATT_XCH_Q(xt); \
                } while (0)
#define ATT_ROUND(...) ATT_ROUND_(0, __VA_ARGS__)
#define ATT_LOAD_Q(DST, QP, ROW0) do { _Pragma("unroll") for (int i = 0; i < 4; ++i) DST[i] = *(const GAS v4u*)((QP) + (size_t)((ROW0) + xl_r + 8 * i) * HD + 8 * (xc0 ^ (4 * (i & 1)))); } while (0)
#define ATT_XCH_Q(T) do { _Pragma("unroll") for (int i = 0; i < 4; ++i) XT_B(T, i) = qn[i]; _Pragma("unroll") for (int ks = 0; ks < 4; ++ks) qf[ks] = __builtin_bit_cast(bf16x8, XT_A(T, 2 * ks + hi)); } while (0)
#define ATT_LOAD_P(PBO, PBL, TQ, IU0, TSH, TOK0) do { _Pragma("unroll") for (int i = 0; i < 4; ++i) pq[i] = *(const GAS v4u*)((PBO) + (size_t)((((IU0) + xl_r + 8 * i) << (TSH)) + (TOK0)) * HD + 8 * (xc0 ^ (4 * (i & 1)))); \
                plse = (PBL)[TQ]; } while (0)
            bf16x8 qf[4]; v4u qn[4], pq[4]; v2u pp[8]; float plse;
            {
                const int NCH = BATCH * HPG * 16;
                if (vcu < NCH) { const int bh = vcu >> 4, res = vcu & 15; const size_t base = (size_t)(((bh >> 3) * 3 + 2) * 8 + (bh & 7)) * SEQ * HD;
                    { XT_CONST ATT_LOAD_Q(qn, QB + base, res * 256 + 32 * wave); ATT_XCH_Q((LAS char*)(lds + ATT_K1 + wave * 4096)); }
                    asm volatile("s_waitcnt vmcnt(0)" ::: "memory"); ATT_BAR();
                    ATT_DMA(false, KB + base, res * 256, 0, 8, ATT_K0, false); }
                int kpar = 0;
                for (int ch = vcu; ch < NCH; ch += G, kpar ^= 1) {
                    const int bh = ch >> 4, res = ch & 15, b = bh >> 3, h = bh & 7; const size_t base = (size_t)((b * 3 + 2) * 8 + h) * SEQ * HD;
                    const int chn = ch + G < NCH ? ch + G : ch, bhn = chn >> 4, resn = chn & 15; const size_t basen = (size_t)(((bhn >> 3) * 3 + 2) * 8 + (bhn & 7)) * SEQ * HD;
                    const int kbuf = kpar ? ATT_K1 : ATT_K0, knext = kpar ? ATT_K0 : ATT_K1;
                    if (ch == vcu) asm volatile("s_waitcnt vmcnt(0)" ::: "memory");
                    asm volatile("" : "+v"(qf[0]), "+v"(qf[1]), "+v"(qf[2]), "+v"(qf[3]));
                    ATT_BAR();
                    ATT_DMA(true, VB + base, res * 256, 0, 8, ATT_V, false);
                    if (ch + G < NCH) { ATT_DMA(false, KB + basen, resn * 256, 0, 8, knext, true);
                        ATT_ROUND(2, res * 256, 32 * wave, 32 * wave - 128, wave - 4, kbuf, 4, res, PB + (size_t)bh * SEQ * HD, PL + (size_t)bh * SEQ, 0, 4, QB + basen, resn * 256 + 32 * wave); }
                    else { ATT_ROUND(2, res * 256, 32 * wave, 32 * wave - 128, wave - 4, kbuf, 4, res, PB + (size_t)bh * SEQ * HD, PL + (size_t)bh * SEQ, 0, 0, QB + basen, resn * 256 + 32 * wave); }
                }
                asm volatile("s_waitcnt vmcnt(0)" ::: "memory"); ATT_BAR();
            }
            GRID_BAR(6);
            for (int item = vcu; item < BATCH * HPG * 4; item += G) {
                const int span = item & 3, h = (item >> 2) & 7, b = item >> 5, bh = b * 8 + h;
                bf16* pbo = PB + (size_t)bh * SEQ * HD; float* pbl = PL + (size_t)bh * SEQ;
                const size_t base1 = (size_t)((b * 3 + 1) * 8 + h) * SEQ * HD, base0 = (size_t)((b * 3 + 0) * 8 + h) * SEQ * HD;
#define ITEM_RND(RD, G_, BASE_, RROW_, QB0_, TSH_, TOK0_) const int G_ = (RD) < 4 ? 1 : 0; const size_t BASE_ = (RD) < 4 ? base1 : base0; \
                const int RROW_ = (RD) < 4 ? (RD) * 1024 : 0, QB0_ = (RD) < 4 ? (span << 8) : (span << 10) + (((RD) - 4) << 8), TSH_ = (RD) < 4 ? 2 : 0, TOK0_ = (RD) < 4 ? (RD) : 0;
                { ITEM_RND(0, g_, base_, rrow_, qb0_, tsh_, tok0_)
                  { XT_CONST ATT_LOAD_Q(qn, QB + base_, rrow_ + qb0_ + 32 * wave); ATT_XCH_Q((LAS char*)(lds + ATT_K1 + wave * 4096)); }
                  asm volatile("s_waitcnt vmcnt(0)" ::: "memory"); ATT_BAR();
                  ATT_DMA(false, KB + base_, rrow_, qb0_ - 128, 12, ATT_K0, false); }
                for (int rd = 0; rd < 8; ++rd) {
                    ITEM_RND(rd, g, base, rrow, qb0, tsh, tok0)
                    const int rdn = rd + 1 < 8 ? rd + 1 : rd; ITEM_RND(rdn, gn, basen, rrown, qb0n, tshn, tok0n)
                    const int kbuf = (rd & 1) ? ATT_K1 : ATT_K0, knext = (rd & 1) ? ATT_K0 : ATT_K1;
                    if (rd == 0 || rd == 4) asm volatile("s_waitcnt vmcnt(0)" ::: "memory");
                    asm volatile("" : "+v"(qf[0]), "+v"(qf[1]), "+v"(qf[2]), "+v"(qf[3]));
                    ATT_BAR();
                    ATT_DMA(true, VB + base, rrow, qb0 - 128, 12, ATT_V, false);
                    if (rd + 1 < 8) { ATT_DMA(false, KB + basen, rrown, qb0n - 128, 12, knext, true);
                        if (qb0 + 32 * wave - 128 >= 0) { ATT_ROUND_(1, g, rrow, qb0 + 32 * wave, qb0 + 32 * wave - 128, wave, kbuf, tsh, tok0, pbo, pbl, (size_t)b * SEQ, 6, QB + basen, rrown + qb0n + 32 * wave); }
                        else { ATT_ROUND(g, rrow, qb0 + 32 * wave, qb0 + 32 * wave - 128, wave, kbuf, tsh, tok0, pbo, pbl, (size_t)b * SEQ, 6, QB + basen, rrown + qb0n + 32 * wave); } }
                    else { ATT_ROUND(g, rrow, qb0 + 32 * wave, qb0 + 32 * wave - 128, wave, kbuf, tsh, tok0, pbo, pbl, (size_t)b * SEQ, 0, QB + basen, rrown + qb0n + 32 * wave); }
                }
#undef ITEM_RND
            }
            asm volatile("s_waitcnt vmcnt(0)" ::: "memory"); ATT_BAR();
#undef ATT_BAR
#undef ATT_DMA
#undef ATT_ROUND
#undef ATT_ROUND_
#undef ATT_LOAD_Q
#undef ATT_XCH_Q
#undef XT_CONST
#undef XT_A
#undef XT_B
#undef ATT_LOAD_P
        }
        if (BOTH(3)) GRID_BAR(3);
    }

    if (IN(4)) {
        { pg8::Gemm g{A2, W2, M, DM, DM}; pg8::StaticOrder S; S.init(M, DM, G, bx);
          pg8::EpiMerge2 E{(const unsigned char*)SG, MG, lds + RING_OFF + RING_BYTES + wave * 2048};
          pg8::gemm_phase<pg8::EpiMerge2, pg8::StaticOrder, true, true>(lds + RING_OFF, g, S, E); }
        if (BOTH(4)) GRID_BAR(4);
    }

    if (IN(5)) {
        pg8::Gemm g{MG, WO, M, DM, DM}; pg8::StaticOrder S; S.init(M, DM, G, bx);
        pg8::EpiOut E{x, out, ADA, lds + RING_OFF + RING_BYTES + wave * 2048};
        pg8::gemm_phase<pg8::EpiOut, pg8::StaticOrder, true, true>(lds + RING_OFF, g, S, E);
    }
#undef IN
#undef BOTH
}

extern "C" void kernel_launch(void* const* d_in, const int* in_sizes, int n_in, void* d_out, int out_size, void* d_ws, size_t ws_size, hipStream_t stream) {
    static int grid = 0;
    if (grid == 0) {
        if (n_in != 16 || in_sizes[0] != M * DM || out_size != M * DM || ws_size < WS_END) { fprintf(stderr, "kernel_launch: unexpected shapes (n_in %d, in0 %d, out %d, ws %zu)\n", n_in, n_in > 0 ? in_sizes[0] : -1, out_size, ws_size); grid = -1; return; }
        int dev = 0, cus = 0, per_cu = 0;
        if (hipGetDevice(&dev) != hipSuccess || hipDeviceGetAttribute(&cus, hipDeviceAttributeMultiprocessorCount, dev) != hipSuccess) { grid = -1; return; }
        if (hipFuncSetAttribute((const void*)mega_fwd, hipFuncAttributeMaxDynamicSharedMemorySize, LDS_BYTES) != hipSuccess) { fprintf(stderr, "kernel_launch: hipFuncSetAttribute failed\n"); grid = -1; return; }
        if (hipOccupancyMaxActiveBlocksPerMultiprocessor(&per_cu, (const void*)mega_fwd, NWAVES * 64, LDS_BYTES) != hipSuccess || per_cu < 1) { fprintf(stderr, "kernel_launch: occupancy query says %d\n", per_cu); (void)hipGetLastError(); per_cu = 1; }
        if (per_cu > 1) per_cu = 1;
        grid = cus * per_cu;
    }
    if (grid < 0) return;
    (void)hipMemsetAsync((char*)d_ws + WS_CTL, 0, CTL_ZERO_BYTES, stream);
    Args a{};
    for (int i = 0; i < 16; ++i) a.in[i] = (const float*)d_in[i];
    a.out = (float*)d_out; a.ws = (unsigned char*)d_ws;
    a.ph_lo = 0; a.ph_hi = N_PHASES;
    hipLaunchKernelGGL(mega_fwd, dim3(grid), dim3(NWAVES * 64), LDS_BYTES, stream, a);
}
```

```cpp
#include <hip/hip_runtime.h>
#include <cstdio>
#include <cstdint>

namespace pg8 {
#define PG8_LAS __attribute__((address_space(3)))
typedef unsigned short bf16_t;
typedef short bf16x8 __attribute__((ext_vector_type(8)));
typedef float f32x4 __attribute__((ext_vector_type(4)));
typedef unsigned u32x4 __attribute__((ext_vector_type(4)));
constexpr int BM = 256, BK = 64, HALF = 128, HTB = HALF * BK * 2, STAGE_BYTES = 8 * HTB, NXCD = 8, WGM = 8;

__host__ __device__ __forceinline__ int lds_byte(int r, int c) { const int st = (r >> 4) * 2 + (c >> 5), rr = r & 15, cc = c & 31, ob = rr * 64 + cc * 2; return st * 1024 + (ob ^ (((ob >> 9) & 1) << 5)); }
__host__ __device__ __forceinline__ void stage_rc(int b, int& R, int& C) { const int st = b / 1024, sb = b % 1024, swz = sb ^ (((sb >> 9) & 1) << 5); R = (st >> 1) * 16 + swz / 64; C = (st & 1) * 32 + (swz % 64) / 2; }
__host__ __device__ __forceinline__ int perm32(int rho) { const int n = rho >> 4, i = rho & 15; return 8 * (i >> 2) + 4 * n + (i & 3); }

struct Unit { int pm, pn; };
struct Gemm { const bf16_t* A; const bf16_t* Bt; int M, N, K; };

struct StaticOrder {
    int nM, nN, nwg, G, c;
    __host__ __device__ void init(int M, int N, int G_, int c_) { nM = M / BM; nN = N / BM; nwg = nM * nN; G = G_; c = c_; }
    __host__ __device__ bool next(int i, Unit& u) const {
        const long L = (long)i * G + c; if (L >= nwg) return false;
        int wgid = (int)L; { const int q = nwg / NXCD, r = nwg % NXCD, xcd = wgid % NXCD, off = wgid / NXCD; wgid = (xcd < r ? xcd * (q + 1) : r * (q + 1) + (xcd - r) * q) + off; }
        const int nig = WGM * nN, gid = wgid / nig, fm = gid * WGM, gsz = (nM - fm) < WGM ? (nM - fm) : WGM;
        u.pm = fm + ((wgid % nig) % gsz); u.pn = (wgid % nig) / gsz; return true;
    }
    __device__ __forceinline__ void a_ready(const Unit&) const {}
    __device__ __forceinline__ void done(const Unit&) const {}
};

typedef float f32x2_t __attribute__((ext_vector_type(2))); typedef __bf16 bf16x2_t __attribute__((ext_vector_type(2)));
__device__ __forceinline__ unsigned cvt_pk_bf16(float lo, float hi) { f32x2_t v = {lo, hi}; bf16x2_t b = __builtin_convertvector(v, bf16x2_t); return __builtin_bit_cast(unsigned, b); }
__device__ __forceinline__ float bf_lo(unsigned w) { return __uint_as_float(w << 16); }
__device__ __forceinline__ float bf_hi(unsigned w) { return __uint_as_float(w & 0xffff0000u); }
__device__ __forceinline__ float sigmoidf_(float x) { return __builtin_amdgcn_rcpf(1.0f + __builtin_amdgcn_exp2f(-1.4426950408889634f * x)); }
__device__ __forceinline__ u32x4 pack8(const f32x4& a, const f32x4& b) { u32x4 w; w.x = cvt_pk_bf16(a[0], a[1]); w.y = cvt_pk_bf16(a[2], a[3]); w.z = cvt_pk_bf16(b[0], b[1]); w.w = cvt_pk_bf16(b[2], b[3]); return w; }


constexpr float QSCALE = 0.125f * 1.4426950408889634f;
constexpr float NORM_EPS = 1e-6f;
#define PG8_XPOSE(P0, P1, T0, T1) do { *(PG8_LAS u32x4*)xw0 = (P0); *(PG8_LAS u32x4*)xw1 = (P1); T0 = *(const PG8_LAS u32x4*)xr0; T1 = *(const PG8_LAS u32x4*)(xr0 + 1024); } while (0)
#define PG8_XPOSE_ADDR PG8_LAS unsigned char* xw0 = scr + fr * 128 + 16 * (fq ^ (fr & 7)); PG8_LAS unsigned char* xw1 = scr + fr * 128 + 16 * ((4 + fq) ^ (fr & 7)); \
        const int r8 = 2 * fq + (fr >> 3), c8 = fr & 7; const PG8_LAS unsigned char* xr0 = scr + r8 * 128 + 16 * (c8 ^ (r8 & 7));
__device__ __forceinline__ size_t sg_frag(int pm, int t, int ai, int m, int wave, int lane) { return ((((((size_t)pm * 8 + t) * 2 + ai) * 4 + m) * 8 + wave) * 64 + lane) * 16; }
struct EpiIn {
    static constexpr bool PERM = true, AFTER_DRAIN = false; static constexpr int MIDK = 0;
    bf16_t *Q; size_t qkv_stride; bf16_t *ZA; size_t zc_off; bf16_t *GLU; unsigned char* SG; const float *qw, *kw, *bgate; PG8_LAS unsigned char* scr;
    __device__ __forceinline__ void operator()(const f32x4 (&acc)[2][2][4][2], const Unit& u, int wr, int wc, int fr, int fq) const {
        const int pn = u.pn;
        PG8_XPOSE_ADDR
        const int rown = u.pm * BM + wr * 64 + r8;
        if (pn < 18) {
            const int kind = pn / 6, rel = pn - kind * 6, g = rel >> 1, hb = ((rel & 1) << 2) + wc, sh = 2 * g;
            bf16_t* base = Q + (size_t)kind * qkv_stride;
            f32x4 wv[2][2];
            if (kind < 2) { const float* w = qw; if (kind == 1) w = kw; const float sc = kind == 0 ? QSCALE : 1.0f;
#pragma unroll
                for (int bj = 0; bj < 2; ++bj)
#pragma unroll
                    for (int n = 0; n < 2; ++n) wv[bj][n] = *(const f32x4*)(w + 32 * bj + 8 * fq + 4 * n) * sc; }
#pragma unroll
            for (int ai = 0; ai < 2; ++ai)
#pragma unroll
                for (int m = 0; m < 4; ++m) {
                    f32x4 v00 = acc[ai][0][m][0], v01 = acc[ai][0][m][1], v10 = acc[ai][1][m][0], v11 = acc[ai][1][m][1];
                    if (kind < 2) {
                        f32x4 q = v00 * v00 + v01 * v01 + v10 * v10 + v11 * v11; float ss = (q[0] + q[1]) + (q[2] + q[3]);
                        { const auto r16 = __builtin_amdgcn_permlane16_swap(__float_as_uint(ss), __float_as_uint(ss), false, false); ss = __uint_as_float(r16[0]) + __uint_as_float(r16[1]);
                          const auto r32_ = __builtin_amdgcn_permlane32_swap(__float_as_uint(ss), __float_as_uint(ss), false, false); ss = __uint_as_float(r32_[0]) + __uint_as_float(r32_[1]); }
                        const float rstd = __builtin_amdgcn_rsqf(ss * (1.0f / 64.0f) + NORM_EPS);
                        v00 = v00 * rstd * wv[0][0]; v01 = v01 * rstd * wv[0][1]; v10 = v10 * rstd * wv[1][0]; v11 = v11 * rstd * wv[1][1];
                    }
                    u32x4 t0, t1; PG8_XPOSE(pack8(v00, v01), pack8(v10, v11), t0, t1);
#pragma unroll
                    for (int h = 0; h < 2; ++h) { const int row = rown + ai * HALF + m * 16 + 8 * h, b = row >> 12, t = row & 4095;
                        const int tp = ((t & ((1 << sh) - 1)) << (12 - sh)) | (t >> sh);
                        __builtin_nontemporal_store(h ? t1 : t0, (u32x4*)(base + ((size_t)(((b * 3 + g) * 8 + hb) * 4096 + tp) * 64 + 8 * c8))); }
                }
        } else if (pn < 20 || (pn >= 24 && pn < 26)) {
            bf16_t* base = ZA + (pn < 20 ? (size_t)0 : zc_off); const int rel = pn < 20 ? pn - 18 : pn - 24; const int colN = rel * BM + wc * 32 + (c8 >> 2) * HALF + 8 * (c8 & 3);
#pragma unroll
            for (int ai = 0; ai < 2; ++ai)
#pragma unroll
                for (int m = 0; m < 4; ++m) { u32x4 p[2];
#pragma unroll
                    for (int bj = 0; bj < 2; ++bj) { f32x4 a = acc[ai][bj][m][0], b = acc[ai][bj][m][1];
#pragma unroll
                        for (int i = 0; i < 4; ++i) { a[i] = a[i] * sigmoidf_(a[i]); b[i] = b[i] * sigmoidf_(b[i]); }
                        p[bj] = pack8(a, b); }
                    u32x4 t0, t1; PG8_XPOSE(p[0], p[1], t0, t1);
                    bf16_t* dst = base + (size_t)(rown + ai * HALF + m * 16) * 512 + colN;
                    __builtin_nontemporal_store(t0, (u32x4*)dst); __builtin_nontemporal_store(t1, (u32x4*)(dst + 8 * 512)); }
        } else if (pn < 24) {
            const int colN = (pn - 20) * HALF + wc * 32 + 8 * (c8 & 3);
#pragma unroll
            for (int ai = 0; ai < 2; ++ai)
#pragma unroll
                for (int mp = 0; mp < 2; ++mp) { u32x4 p[2];
#pragma unroll
                    for (int q = 0; q < 2; ++q) { const int m = 2 * mp + q;
                        f32x4 a0 = acc[ai][0][m][0], a1 = acc[ai][0][m][1]; const f32x4 b0 = acc[ai][1][m][0], b1 = acc[ai][1][m][1];
#pragma unroll
                        for (int i = 0; i < 4; ++i) { a0[i] = a0[i] * sigmoidf_(b0[i]); a1[i] = a1[i] * sigmoidf_(b1[i]); }
                        p[q] = pack8(a0, a1); }
                    u32x4 t0, t1; PG8_XPOSE(p[0], p[1], t0, t1);
                    bf16_t* dst = GLU + (size_t)(rown + ai * HALF + (2 * mp + (c8 >> 2)) * 16) * 512 + colN;
                    __builtin_nontemporal_store(t0, (u32x4*)dst); __builtin_nontemporal_store(t1, (u32x4*)(dst + 8 * 512)); }
        } else {
            const int t = pn - 26; const int gc0 = t * BM + wc * 32 + 8 * fq;
            f32x4 bv[2][2];
#pragma unroll
            for (int bj = 0; bj < 2; ++bj)
#pragma unroll
                for (int n = 0; n < 2; ++n) bv[bj][n] = *(const f32x4*)(bgate + gc0 + HALF * bj + 4 * n);
#pragma unroll
            for (int ai = 0; ai < 2; ++ai)
#pragma unroll
                for (int m = 0; m < 4; ++m) {
                    u32x4 w;
#pragma unroll
                    for (int bj = 0; bj < 2; ++bj) { f32x4 a = acc[ai][bj][m][0] + bv[bj][0], b = acc[ai][bj][m][1] + bv[bj][1];
                        unsigned wa = 0u, wb = 0u;
#pragma unroll
                        for (int i = 0; i < 4; ++i) { wa = __builtin_amdgcn_cvt_pk_u8_f32(sigmoidf_(a[i]) * 255.0f, i, wa); wb = __builtin_amdgcn_cvt_pk_u8_f32(sigmoidf_(b[i]) * 255.0f, i, wb); }
                        if (bj == 0) { w.x = wa; w.y = wb; } else { w.z = wa; w.w = wb; } }
                    __builtin_nontemporal_store(w, (u32x4*)(SG + sg_frag(u.pm, t, ai, m, wr * 4 + wc, fq * 16 + fr))); }
        }
    }
};
struct EpiMerge2 {
    static constexpr bool PERM = true, AFTER_DRAIN = false; static constexpr int MIDK = 8;
    const unsigned char* SG; bf16_t* OUT; PG8_LAS unsigned char* scr;
    __device__ __forceinline__ void mid(f32x4 (&acc)[2][2][4][2], const Unit& u, int wr, int wc, int fr, int fq) const {
        asm volatile("" : "+v"(fr), "+v"(fq));
        const int wave = wr * 4 + wc, lane = fq * 16 + fr;
#pragma unroll
        for (int ai = 0; ai < 2; ++ai) {
            u32x4 ga[4], gc[4];
#pragma unroll
            for (int m = 0; m < 4; ++m) { ga[m] = *(const u32x4*)(SG + sg_frag(u.pm, u.pn, ai, m, wave, lane)); gc[m] = *(const u32x4*)(SG + sg_frag(u.pm, u.pn + 4, ai, m, wave, lane)); }
#pragma unroll
            for (int m = 0; m < 4; ++m)
#pragma unroll
                for (int bj = 0; bj < 2; ++bj) {
                    const unsigned gax = bj ? ga[m].z : ga[m].x, gay = bj ? ga[m].w : ga[m].y, gcx = bj ? gc[m].z : gc[m].x, gcy = bj ? gc[m].w : gc[m].y;
                    f32x4& a = acc[ai][bj][m][0]; f32x4& b = acc[ai][bj][m][1];
#pragma unroll
                    for (int i = 0; i < 4; ++i) {
                        a[i] *= (float)((gax >> (8 * i)) & 255u) * __builtin_amdgcn_rcpf(fmaxf((float)((gcx >> (8 * i)) & 255u), 0.5f));
                        b[i] *= (float)((gay >> (8 * i)) & 255u) * __builtin_amdgcn_rcpf(fmaxf((float)((gcy >> (8 * i)) & 255u), 0.5f)); } }
            asm volatile("" ::: "memory"); }
    }
    __device__ __forceinline__ void operator()(const f32x4 (&acc)[2][2][4][2], const Unit& u, int wr, int wc, int fr, int fq) const {
        asm volatile("" : "+v"(fr), "+v"(fq));
        const int wave = wr * 4 + wc, lane = fq * 16 + fr;
        PG8_XPOSE_ADDR
        const int rown = u.pm * BM + wr * 64 + r8, colN = u.pn * BM + wc * 32 + (c8 >> 2) * HALF + 8 * (c8 & 3);
#pragma unroll
        for (int ai = 0; ai < 2; ++ai) {
            u32x4 gw[4];
#pragma unroll
            for (int m = 0; m < 4; ++m) gw[m] = *(const u32x4*)(SG + sg_frag(u.pm, u.pn + 4, ai, m, wave, lane));
#pragma unroll
            for (int m = 0; m < 4; ++m) { u32x4 p[2];
#pragma unroll
                for (int bj = 0; bj < 2; ++bj) { const unsigned gx = bj ? gw[m].z : gw[m].x, gy = bj ? gw[m].w : gw[m].y;
                    f32x4 a = acc[ai][bj][m][0], b = acc[ai][bj][m][1];
#pragma unroll
                    for (int i = 0; i < 4; ++i) { a[i] *= fmaxf((float)((gx >> (8 * i)) & 255u), 0.5f) * (1.0f / 255.0f); b[i] *= fmaxf((float)((gy >> (8 * i)) & 255u), 0.5f) * (1.0f / 255.0f); }
                    p[bj] = pack8(a, b); }
                u32x4 t0, t1; PG8_XPOSE(p[0], p[1], t0, t1);
                bf16_t* dst = OUT + (size_t)(rown + ai * HALF + m * 16) * 1024 + colN;
                *(u32x4*)dst = t0; *(u32x4*)(dst + 8 * 1024) = t1; }
        }
    }
};
struct EpiOut {
    static constexpr bool PERM = true, AFTER_DRAIN = false; static constexpr int MIDK = 0;
    const float* X; float* OUT; const float* ADA; PG8_LAS unsigned char* scr;
    __device__ __forceinline__ void operator()(const f32x4 (&acc)[2][2][4][2], const Unit& u, int wr, int wc, int fr, int fq) const {
        asm volatile("" : "+v"(fr), "+v"(fq));
        const int r8 = 2 * fq + (fr >> 3), c8 = fr & 7;
        const int rowb = u.pm * BM + wr * 64 + r8, col0 = u.pn * BM + wc * 32 + 4 * c8; const int b = (u.pm * BM) >> 12;
        PG8_LAS unsigned char* w0 = scr + fr * 128 + 16 * ((2 * fq) ^ (fr & 7)); PG8_LAS unsigned char* w1 = scr + fr * 128 + 16 * ((2 * fq + 1) ^ (fr & 7));
        const PG8_LAS unsigned char* r0 = scr + r8 * 128 + 16 * (c8 ^ (r8 & 7)); const PG8_LAS unsigned char* r1 = r0 + 8 * 128;
        f32x4 gv[2];
#pragma unroll
        for (int bj = 0; bj < 2; ++bj) gv[bj] = *(const f32x4*)(ADA + (size_t)b * 3072 + 2048 + col0 + bj * HALF);
#pragma unroll
        for (int ai = 0; ai < 2; ++ai) {
            f32x4 xv[4][2][2];
#pragma unroll
            for (int m = 0; m < 4; ++m) { const size_t off = (size_t)(rowb + ai * HALF + m * 16) * 1024 + col0;
#pragma unroll
                for (int bj = 0; bj < 2; ++bj)
#pragma unroll
                    for (int h = 0; h < 2; ++h) xv[m][bj][h] = *(const f32x4*)(X + off + (size_t)h * 8 * 1024 + bj * HALF); }
#pragma unroll
            for (int m = 0; m < 4; ++m) { const size_t off = (size_t)(rowb + ai * HALF + m * 16) * 1024 + col0;
#pragma unroll
                for (int bj = 0; bj < 2; ++bj) {
                    *(PG8_LAS f32x4*)w0 = acc[ai][bj][m][0]; *(PG8_LAS f32x4*)w1 = acc[ai][bj][m][1];
                    const f32x4 t0 = *(const PG8_LAS f32x4*)r0, t1 = *(const PG8_LAS f32x4*)r1;
                    *(f32x4*)(OUT + off + bj * HALF) = xv[m][bj][0] + gv[bj] * t0;
                    *(f32x4*)(OUT + off + (size_t)8 * 1024 + bj * HALF) = xv[m][bj][1] + gv[bj] * t1; } }
        }
    }
};

template <class Epi, class Sched, bool ALIGN_EPI = false, bool SP2 = false>
__device__ __forceinline__ void gemm_phase(PG8_LAS unsigned char* lds, const Gemm g, const Sched& S, const Epi& E) {
    const int tid = threadIdx.x, wid = __builtin_amdgcn_readfirstlane(tid >> 6), lane = tid & 63, wr = wid >> 2, wc = wid & 3, fr = lane & 15, fq = lane >> 4;
    const int K = g.K, nt = K / BK;
    unsigned voffA[2], voffB[2];
#pragma unroll
    for (int i = 0; i < 2; ++i) { int R, C; stage_rc(tid * 16 + i * 8192, R, C); const int Rb = Epi::PERM ? ((R & ~31) + perm32(R & 31)) : R;
        voffA[i] = (unsigned)(R * K + C) * 2u; voffB[i] = (unsigned)(Rb * K + C) * 2u; }
    const size_t kstep = (size_t)(BK * 2);
    const size_t hstep = (size_t)HALF * K * 2;
    const size_t tstep = 2 * hstep;
    const unsigned ldsw = (unsigned)wid * 1024u;
    const int aoff = lds_byte(wr * 64 + fr, fq * 8), boff = lds_byte(wc * 32 + fr, fq * 8);
#define PG8_SA(b, h) (((b) * 2 + (h)) * HTB)
#define PG8_SB(b, h) ((4 + (b) * 2 + (h)) * HTB)
#define PG8_STAGE(bufoff, gbase, voff) do { _Pragma("unroll") for (int _i = 0; _i < 2; ++_i) \
        __builtin_amdgcn_global_load_lds((const unsigned*)((const char*)(gbase) + (voff)[_i]), (PG8_LAS unsigned*)(lds + (bufoff) + ldsw + _i * 8192), 16, 0, 0); } while (0)
#define PG8_LDA(dst, b, h) do { _Pragma("unroll") for (int m = 0; m < 4; ++m) _Pragma("unroll") for (int k = 0; k < 2; ++k) dst[m][k] = *(const PG8_LAS bf16x8*)(lds + PG8_SA(b, h) + aoff + m * 2048 + k * 1024); } while (0)
#define PG8_LDB(dst, b, h) do { _Pragma("unroll") for (int n = 0; n < 2; ++n) _Pragma("unroll") for (int k = 0; k < 2; ++k) dst[n][k] = *(const PG8_LAS bf16x8*)(lds + PG8_SB(b, h) + boff + n * 2048 + k * 1024); } while (0)
#define PG8_MMA(ai, bj, At, Bt) do { __builtin_amdgcn_s_setprio(1); _Pragma("unroll") for (int m = 0; m < 4; ++m) _Pragma("unroll") for (int n = 0; n < 2; ++n) _Pragma("unroll") for (int k = 0; k < 2; ++k) \
        acc[ai][bj][m][n] = __builtin_amdgcn_mfma_f32_16x16x32_bf16(Bt[n][k], At[m][k], acc[ai][bj][m][n], 0, 0, 0); __builtin_amdgcn_s_setprio(0); } while (0)
#define PG8_WAIT_V(n) asm volatile("s_waitcnt vmcnt(" #n ")" ::: "memory")
#define PG8_WAIT_L(n) asm volatile("s_waitcnt lgkmcnt(" #n ")" ::: "memory")
#define PG8_BAR __builtin_amdgcn_s_barrier()
#define PG8_SCHED __builtin_amdgcn_sched_barrier(0)
    Unit cur, nxt; int ui = 0;
    if (!S.next(0, cur)) return;
    f32x4 acc[2][2][4][2];
#pragma unroll
    for (int a = 0; a < 2; ++a)
#pragma unroll
        for (int b = 0; b < 2; ++b)
#pragma unroll
            for (int m = 0; m < 4; ++m)
#pragma unroll
                for (int n = 0; n < 2; ++n) acc[a][b][m][n] = (f32x4){0.f, 0.f, 0.f, 0.f};
    bf16x8 At[4][2], B0[2][2], B1[2][2];
    const char* cA = (const char*)g.A + (size_t)cur.pm * tstep; const char* cB = (const char*)g.Bt + (size_t)cur.pn * tstep;
    S.a_ready(cur);
    if constexpr (SP2) {
        PG8_STAGE(PG8_SB(0, 0), cB, voffB); PG8_STAGE(PG8_SB(0, 1), cB + hstep, voffB); PG8_STAGE(PG8_SA(0, 0), cA, voffA); PG8_STAGE(PG8_SA(0, 1), cA + hstep, voffA);
        if (wr == 1) PG8_BAR;
        PG8_WAIT_V(2); PG8_BAR;
        PG8_STAGE(PG8_SB(1, 0), cB + kstep, voffB); PG8_STAGE(PG8_SA(1, 0), cA + kstep, voffA); PG8_STAGE(PG8_SB(1, 1), cB + hstep + kstep, voffB);
        PG8_WAIT_V(6); PG8_BAR;
    } else {
        PG8_STAGE(PG8_SB(0, 0), cB, voffB); PG8_STAGE(PG8_SA(0, 0), cA, voffA); PG8_STAGE(PG8_SB(0, 1), cB + hstep, voffB); PG8_STAGE(PG8_SA(0, 1), cA + hstep, voffA);
        if (wr == 1) PG8_BAR;
        PG8_WAIT_V(4); PG8_BAR;
        PG8_STAGE(PG8_SB(1, 0), cB + kstep, voffB); PG8_STAGE(PG8_SA(1, 0), cA + kstep, voffA); PG8_STAGE(PG8_SB(1, 1), cB + hstep + kstep, voffB);
        PG8_WAIT_V(6); PG8_BAR;
    }
    for (;;) {
        const bool has_next = S.next(ui + 1, nxt);
        const char* nA = has_next ? (const char*)g.A + (size_t)nxt.pm * tstep : cA; const char* nB = has_next ? (const char*)g.Bt + (size_t)nxt.pn * tstep : cB;
        for (int t = 0; t < nt; t += 2) {
            const bool last = (t == nt - 2);
            const char* a1 = cA + (size_t)(t + 1) * kstep;
            const char* a2 = last ? nA : cA + (size_t)(t + 2) * kstep; const char* b2 = last ? nB : cB + (size_t)(t + 2) * kstep;
            const char* a3 = a2 + kstep; const char* b3 = b2 + kstep;
            if (last && has_next) S.a_ready(nxt);
            if constexpr (Epi::MIDK > 0) { if (t == Epi::MIDK) E.mid(acc, cur, wr, wc, fr, fq); }
            if constexpr (SP2) {
            PG8_LDB(B0, 0, 0); PG8_LDB(B1, 0, 1); PG8_SCHED; PG8_LDA(At, 0, 0); PG8_STAGE(PG8_SA(1, 1), a1 + hstep, voffA);
            PG8_WAIT_V(8); PG8_WAIT_L(0); PG8_BAR; PG8_MMA(0, 0, At, B0); PG8_MMA(0, 1, At, B1); PG8_BAR; PG8_SCHED;
            PG8_LDA(At, 0, 1); PG8_STAGE(PG8_SB(0, 0), b2, voffB); PG8_STAGE(PG8_SB(0, 1), b2 + hstep, voffB); PG8_STAGE(PG8_SA(0, 0), a2, voffA);
            PG8_WAIT_V(8); PG8_WAIT_L(0); PG8_BAR; PG8_MMA(1, 0, At, B0); PG8_MMA(1, 1, At, B1); PG8_BAR; PG8_SCHED;
            PG8_LDB(B0, 1, 0); PG8_LDB(B1, 1, 1); PG8_SCHED; PG8_LDA(At, 1, 0); PG8_STAGE(PG8_SA(0, 1), a2 + hstep, voffA);
            PG8_WAIT_V(8); PG8_WAIT_L(0); PG8_BAR; PG8_MMA(0, 0, At, B0); PG8_MMA(0, 1, At, B1); PG8_BAR; PG8_SCHED;
            PG8_LDA(At, 1, 1); PG8_STAGE(PG8_SB(1, 0), b3, voffB); PG8_STAGE(PG8_SB(1, 1), b3 + hstep, voffB); PG8_STAGE(PG8_SA(1, 0), a3, voffA);
            PG8_WAIT_V(8); PG8_WAIT_L(0); PG8_BAR; PG8_MMA(1, 0, At, B0); PG8_MMA(1, 1, At, B1); PG8_BAR; PG8_SCHED;
            } else {
            PG8_LDB(B0, 0, 0); PG8_SCHED; PG8_LDA(At, 0, 0); PG8_STAGE(PG8_SA(1, 1), a1 + hstep, voffA);
            PG8_WAIT_L(8); PG8_BAR; PG8_WAIT_L(0); PG8_MMA(0, 0, At, B0); PG8_BAR; PG8_SCHED;
            PG8_LDB(B1, 0, 1); PG8_STAGE(PG8_SB(0, 0), b2, voffB);
            PG8_BAR; PG8_WAIT_L(0); PG8_MMA(0, 1, At, B1); PG8_BAR;
            PG8_LDA(At, 0, 1); PG8_STAGE(PG8_SA(0, 0), a2, voffA);
            PG8_BAR; PG8_WAIT_L(0); PG8_MMA(1, 0, At, B0); PG8_BAR; PG8_SCHED;
            PG8_STAGE(PG8_SB(0, 1), b2 + hstep, voffB);
            PG8_WAIT_V(6); PG8_BAR; PG8_MMA(1, 1, At, B1); PG8_BAR;
            PG8_LDB(B0, 1, 0); PG8_SCHED; PG8_LDA(At, 1, 0); PG8_STAGE(PG8_SA(0, 1), a2 + hstep, voffA);
            PG8_WAIT_L(8); PG8_BAR; PG8_WAIT_L(0); PG8_MMA(0, 0, At, B0); PG8_BAR; PG8_SCHED;
            PG8_LDB(B1, 1, 1); PG8_STAGE(PG8_SB(1, 0), b3, voffB);
            PG8_BAR; PG8_WAIT_L(0); PG8_MMA(0, 1, At, B1); PG8_BAR;
            PG8_LDA(At, 1, 1); PG8_STAGE(PG8_SA(1, 0), a3, voffA);
            PG8_BAR; PG8_WAIT_L(0); PG8_MMA(1, 0, At, B0); PG8_BAR; PG8_SCHED;
            PG8_STAGE(PG8_SB(1, 1), b3 + hstep, voffB);
            PG8_WAIT_V(6); PG8_BAR; PG8_MMA(1, 1, At, B1); PG8_BAR;
            }
        }
        if constexpr (ALIGN_EPI) { if (wr == 0) PG8_BAR; }
        if constexpr (!Epi::AFTER_DRAIN) { E(acc, cur, wr, wc, fr, fq); S.done(cur); }
        if (!has_next) break;
#pragma unroll
        for (int a = 0; a < 2; ++a)
#pragma unroll
            for (int b = 0; b < 2; ++b)
#pragma unroll
                for (int m = 0; m < 4; ++m)
#pragma unroll
                    for (int n = 0; n < 2; ++n) acc[a][b][m][n] = (f32x4){0.f, 0.f, 0.f, 0.f};
        cur = nxt; cA = nA; cB = nB; ++ui;
        if constexpr (ALIGN_EPI) { if (wr == 1) PG8_BAR; }
    }
    PG8_WAIT_V(0);
    if constexpr (!ALIGN_EPI) { if (wr == 0) PG8_BAR; }
    PG8_BAR;
#undef PG8_SA
#undef PG8_SB
#undef PG8_STAGE
#undef PG8_LDA
#undef PG8_LDB
#undef PG8_MMA
#undef PG8_WAIT_V
#undef PG8_WAIT_L
#undef PG8_BAR
#undef PG8_SCHED
}
}

constexpr int NWAVES = 8;
constexpr int N_PHASES = 6;
constexpr int BATCH = 8, SEQ = 4096, DM = 1024, M = BATCH * SEQ;
constexpr int NIN = 8704, NHEAD = 24, NG = 3, HPG = 8, HD = 64, CW = 512, CK = 31;
constexpr int ADA_N = 3 * DM;

constexpr size_t MiB = 1u << 20;
constexpr size_t WS_CTL = 0, CTL_ZERO_BYTES = 64 * 1024;
constexpr size_t WS_ADA = 1 * MiB;
constexpr size_t WS_WIN = 422 * MiB;
constexpr size_t WS_WA = 440 * MiB, WS_WO = 442 * MiB;
constexpr size_t WS_LSE = 2 * MiB;
constexpr size_t WS_H = 448 * MiB;
constexpr size_t WS_A2A = 448 * MiB, WS_A2C = 480 * MiB;
constexpr size_t WS_Q = 38 * MiB, WS_K = 134 * MiB, WS_V = 230 * MiB;
constexpr size_t WS_T1 = 134 * MiB, WS_MG = 230 * MiB;
constexpr size_t WS_ZA = 326 * MiB, WS_GLU = 358 * MiB, WS_ZC = 390 * MiB;
constexpr size_t WS_PB = 6 * MiB;
constexpr size_t WS_END = 512 * MiB;

constexpr int RING_OFF = 0, RING_BYTES = 131072;
constexpr int ATT_K0 = 0, ATT_K1 = 49152, ATT_V = 98304, ATT_END = 147456;
constexpr int MISC_OFF = ATT_END;
constexpr int LDS_BYTES = 151552;

#define GAS __attribute__((address_space(1)))
#define LAS __attribute__((address_space(3)))
typedef unsigned short bf16;
typedef unsigned v4u __attribute__((ext_vector_type(4)));
typedef unsigned v2u __attribute__((ext_vector_type(2)));
typedef float f32x4 __attribute__((ext_vector_type(4)));
typedef float f32x2 __attribute__((ext_vector_type(2)));
typedef float f32x16 __attribute__((ext_vector_type(16)));
typedef short bf16x8 __attribute__((ext_vector_type(8)));
typedef short s16x4 __attribute__((ext_vector_type(4)));
#define RLX_AGENT __ATOMIC_RELAXED, __HIP_MEMORY_SCOPE_AGENT
#define LDS_WAIT() asm volatile("s_waitcnt lgkmcnt(0)" ::: "memory")
using pg8::cvt_pk_bf16; using pg8::bf_lo; using pg8::bf_hi; using pg8::sigmoidf_;

#define XB_TMO      128
#define XB_XCNT(j)  (256  + 64 * (j))
#define XB_XSUB(j)  (1280 + 64 * (j))
#define XB_XGEN(j)  (2304 + 64 * (j))
#define XB_TOP      3328
#define XB_TOPGEN   3392
#define XCD_BAR_WORDS 3456
#define XB_SPIN_CAP (1u << 18)
__device__ __forceinline__ unsigned xb_ld(unsigned* p)              { return __hip_atomic_load(p, __ATOMIC_RELAXED, __HIP_MEMORY_SCOPE_AGENT); }
__device__ __forceinline__ unsigned xb_add(unsigned* p, unsigned v) { return __hip_atomic_fetch_add(p, v, __ATOMIC_RELAXED, __HIP_MEMORY_SCOPE_AGENT); }
__device__ __forceinline__ unsigned xb_xcc_id() { return (unsigned)__builtin_amdgcn_s_getreg((3 << 11) | 20) & 0xFu; }
#define XB_SPIN(cond, bar) do { unsigned _sp = 0; while (cond) { __builtin_amdgcn_s_sleep(1); \
    if ((++_sp & 255u) == 0u) { if (xb_ld(&(bar)[XB_TMO])) break; if (_sp > XB_SPIN_CAP) { atomicAdd(&(bar)[XB_TMO], 1u); break; } } } } while (0)
struct XcdBarrier { unsigned* bar; unsigned x; volatile LAS unsigned* st; };
__device__ __forceinline__ XcdBarrier xcd_barrier_post(unsigned* bar, volatile LAS unsigned* st) {
    XcdBarrier b; b.bar = bar; b.x = xb_xcc_id(); b.st = st;
    if (threadIdx.x == 0) (void)xb_add(&bar[XB_XCNT(b.x)], 1u);
    return b;
}
__device__ __forceinline__ void xcd_barrier_complete(unsigned* bar, unsigned x, unsigned& nloc, unsigned& nx) {
    const unsigned G = gridDim.x * gridDim.y * gridDim.z;
    unsigned sum, cnt, mine, sp = 0u;
    for (;;) {
        sum = 0u; cnt = 0u; mine = 0u;
#pragma unroll
        for (unsigned j = 0; j < 16; ++j) { const unsigned c = xb_ld(&bar[XB_XCNT(j)]); sum += c; cnt += (c > 0u) ? 1u : 0u; mine = (j == x) ? c : mine; }
        if (sum == G) break;
        __builtin_amdgcn_s_sleep(1);
        if ((++sp & 255u) == 0u) { if (xb_ld(&bar[XB_TMO])) break; if (sp > XB_SPIN_CAP) { atomicAdd(&bar[XB_TMO], 1u); break; } }
    }
    nloc = mine > 0u ? mine : 1u; nx = cnt > 0u ? cnt : 1u;
}
__device__ __forceinline__ void xcd_barrier(const XcdBarrier& b) {
    asm volatile("s_waitcnt vmcnt(0)" ::: "memory");
    __syncthreads();
    if (threadIdx.x == 0) {
        unsigned* bar = b.bar;
        __builtin_amdgcn_s_waitcnt(0);
        unsigned nloc = b.st[0], nx = b.st[1];
        if (nloc == 0u) { xcd_barrier_complete(bar, b.x, nloc, nx); b.st[0] = nloc; b.st[1] = nx; }
        const unsigned old = xb_add(&bar[XB_XSUB(b.x)], 1u);
        const unsigned gen = old / nloc;
        if (old + 1u == (gen + 1u) * nloc) {
            __builtin_amdgcn_fence(__ATOMIC_RELEASE, "agent");
            asm volatile("s_waitcnt vmcnt(0)" ::: "memory");
            const unsigned og = xb_add(&bar[XB_TOP], 1u);
            const unsigned tg = og / nx;
            if (og + 1u == (tg + 1u) * nx) xb_add(&bar[XB_TOPGEN], 1u);
            else XB_SPIN(xb_ld(&bar[XB_TOPGEN]) == tg, bar);
            __builtin_amdgcn_fence(__ATOMIC_ACQUIRE, "agent");
            xb_add(&bar[XB_XGEN(b.x)], 1u);
            asm volatile("s_waitcnt vmcnt(0)" ::: "memory");
        } else {
            XB_SPIN(xb_ld(&bar[XB_XGEN(b.x)]) == gen, bar);
            __builtin_amdgcn_fence(__ATOMIC_ACQUIRE, "agent");
            asm volatile("s_waitcnt vmcnt(0)" ::: "memory");
        }
    }
    __syncthreads();
}

__device__ __forceinline__ float wave_sum(float v) {
    v += __uint_as_float(__builtin_amdgcn_update_dpp(0u, __float_as_uint(v), 0xB1, 0xF, 0xF, true));
    v += __uint_as_float(__builtin_amdgcn_update_dpp(0u, __float_as_uint(v), 0x4E, 0xF, 0xF, true));
    v += __uint_as_float(__builtin_amdgcn_update_dpp(0u, __float_as_uint(v), 0x124, 0xF, 0xF, true));
    v += __uint_as_float(__builtin_amdgcn_update_dpp(0u, __float_as_uint(v), 0x128, 0xF, 0xF, true));
    { const auto r = __builtin_amdgcn_permlane16_swap(__float_as_uint(v), __float_as_uint(v), false, false); v = __uint_as_float(r[0]) + __uint_as_float(r[1]); }
    { const auto r = __builtin_amdgcn_permlane32_swap(__float_as_uint(v), __float_as_uint(v), false, false); v = __uint_as_float(r[0]) + __uint_as_float(r[1]); }
    return v;
}
__device__ __forceinline__ unsigned f2bf(float f) { unsigned u = __builtin_bit_cast(unsigned, f); return (u + 0x7fffu + ((u >> 16) & 1u)) >> 16; }
__device__ __forceinline__ unsigned pk2(float lo, float hi) { return f2bf(lo) | (f2bf(hi) << 16); }

__device__ __forceinline__ int win_phys(int n0) {
    if (n0 < 4608) { const int reg = n0 / 1536, c = n0 - reg * 1536, head = c >> 6, dh = (c >> 5) & 1; return (reg * 6 + (head >> 2)) * 256 + 128 * dh + 32 * (head & 3); }
    if (n0 >= 5120 && n0 < 6144) { const int c = n0 - 5120, half = c >> 9, cc = c & 511; return (20 + (cc >> 7)) * 256 + 128 * half + (cc & 127); }
    return n0;
}
__device__ __forceinline__ int win_phys_g(int n) { return n; }
template <bool WIN>
__device__ __forceinline__ void p0_transpose_item(const float* W, int K, int N, bf16* WT, LAS float* scr, int item, int lane, int ldt = 0) {
    if (ldt == 0) ldt = K;
    const int nblk = N / 32, kb = item / nblk, nb = item % nblk, k0 = 64 * kb, n0 = 32 * nb;
    const int prow = WIN ? win_phys(n0) : n0;
#pragma unroll 8
    for (int i = 0; i < 32; ++i) { const int kk = 2 * i + (lane >> 5); scr[kk * 33 + (lane & 31)] = __builtin_nontemporal_load(W + (size_t)(k0 + kk) * N + n0 + (lane & 31)); }
    LDS_WAIT(); asm volatile("" ::: "memory");
    const int c = lane & 7;
#pragma unroll
    for (int j = 0; j < 4; ++j) { const int n = (lane >> 3) + 8 * j; const LAS float* s = scr + (8 * c) * 33 + n;
        v4u o; o.x = pk2(s[0 * 33], s[1 * 33]); o.y = pk2(s[2 * 33], s[3 * 33]); o.z = pk2(s[4 * 33], s[5 * 33]); o.w = pk2(s[6 * 33], s[7 * 33]);
        const int rown = (WIN && n0 >= 6656) ? win_phys_g(n0 + n) : prow + n;
        *(GAS v4u*)(WT + (size_t)rown * ldt + k0 + 8 * c) = o; }
    LDS_WAIT(); asm volatile("" ::: "memory");
}

struct Args { const float* in[16]; float* out; unsigned char* ws; int ph_lo, ph_hi; };
__device__ __forceinline__ int crow(int r, int hi) { return (r & 3) + 8 * (r >> 2) + 4 * hi; }
__device__ __forceinline__ s16x4 vtr(const LAS char* p) { typedef short v4i16_t __attribute__((ext_vector_type(4))); return __builtin_bit_cast(s16x4, __builtin_amdgcn_ds_read_tr16_b64_v4i16((LAS v4i16_t*)p)); }

__device__ __forceinline__ void glds16s(const void* sbase, unsigned voff, unsigned lds_dst) { unsigned keep;
    const unsigned long long sb = (unsigned long long)sbase;
    const unsigned lo = (unsigned)__builtin_amdgcn_readfirstlane((int)(unsigned)sb), hi = (unsigned)__builtin_amdgcn_readfirstlane((int)(unsigned)(sb >> 32));
    const unsigned long long sbu = ((unsigned long long)hi << 32) | lo;
    asm volatile("s_mov_b32 %0, m0\n\ts_mov_b32 m0, %3\n\ts_nop 4\n\tglobal_load_lds_dwordx4 %1, %2\n\ts_mov_b32 m0, %0" : "=&s"(keep) : "v"(voff), "s"(sbu), "s"(lds_dst) : "memory"); }
struct KTile { bf16x8 k[4]; };
struct VTile { v4u v[4]; };
__device__ __forceinline__ void load_k(KTile& T, const bf16* Kp, int row0, int r32, int hi) {
    const bf16* kr = Kp + (size_t)(row0 + r32) * HD + 8 * hi;
#pragma unroll
    for (int ks = 0; ks < 4; ++ks) T.k[ks] = *(const GAS bf16x8*)(kr + 16 * ks);
}
__device__ __forceinline__ void load_v(VTile& T, const bf16* Vp, int row0, int lane) {
#pragma unroll
    for (int i = 0; i < 4; ++i) { const int c = lane + 64 * i; T.v[i] = *(const GAS v4u*)(Vp + (size_t)(row0 + (c >> 3)) * HD + (c & 7) * 8); }
}
template <int TAU>
__device__ __forceinline__ void att_tile(const KTile& TK, const VTile& TV, const bf16x8 (&qf)[4], float& m, float& l, f32x16 (&o)[2], LAS char* vl, const LAS char* vrd, int lane, int r32, int hi) {
    f32x16 s = {};
#pragma unroll
    for (int ks = 0; ks < 4; ++ks) s = __builtin_amdgcn_mfma_f32_32x32x16_bf16(TK.k[ks], qf[ks], s, 0, 0, 0);
#pragma unroll
    for (int i = 0; i < 4; ++i) { const int c = lane + 64 * i, key = c >> 3, ch = c & 7; *(LAS v4u*)(vl + (ch >> 2) * 2048 + key * 64 + (ch & 3) * 16) = TV.v[i]; }
    if (TAU == 0) {
#pragma unroll
        for (int r = 0; r < 16; ++r) if (crow(r, hi) < r32) s[r] = -INFINITY;
    }
    if (TAU == 4) {
#pragma unroll
        for (int r = 0; r < 16; ++r) if (crow(r, hi) > r32) s[r] = -INFINITY;
    }
    float tm = fmaxf(fmaxf(s[0], s[1]), s[2]);
#pragma unroll
    for (int r = 3; r < 15; r += 2) tm = fmaxf(fmaxf(tm, s[r]), s[r + 1]);
    tm = fmaxf(tm, s[15]);
    tm = fmaxf(tm, __shfl_xor(tm, 32));
    if (__any(tm > m)) {
        const float mn = fmaxf(m, tm), al = __builtin_amdgcn_exp2f(m - mn);
        l *= al; o[0] = o[0] * al; o[1] = o[1] * al; m = mn;
    }
    float ps = 0.f;
#pragma unroll
    for (int r = 0; r < 16; ++r) { s[r] = __builtin_amdgcn_exp2f(s[r] - m); ps += s[r]; }
    l += ps;
    v4u pw0, pw1;
    pw0.x = cvt_pk_bf16(s[0], s[1]); pw0.y = cvt_pk_bf16(s[2], s[3]); pw0.z = cvt_pk_bf16(s[4], s[5]); pw0.w = cvt_pk_bf16(s[6], s[7]);
    pw1.x = cvt_pk_bf16(s[8], s[9]); pw1.y = cvt_pk_bf16(s[10], s[11]); pw1.z = cvt_pk_bf16(s[12], s[13]); pw1.w = cvt_pk_bf16(s[14], s[15]);
    const bf16x8 pf0 = __builtin_bit_cast(bf16x8, pw0), pf1 = __builtin_bit_cast(bf16x8, pw1);
    LDS_WAIT(); asm volatile("" ::: "memory");
#pragma unroll
    for (int d0 = 0; d0 < 2; ++d0) {
        const s16x4 a0 = vtr(vrd + d0 * 2048), a1 = vtr(vrd + d0 * 2048 + 512), a2 = vtr(vrd + d0 * 2048 + 1024), a3 = vtr(vrd + d0 * 2048 + 1536);
        const bf16x8 vf0 = (bf16x8){a0[0], a0[1], a0[2], a0[3], a1[0], a1[1], a1[2], a1[3]};
        const bf16x8 vf1 = (bf16x8){a2[0], a2[1], a2[2], a2[3], a3[0], a3[1], a3[2], a3[3]};
        o[d0] = __builtin_amdgcn_mfma_f32_32x32x16_bf16(vf0, pf0, o[d0], 0, 0, 0);
        o[d0] = __builtin_amdgcn_mfma_f32_32x32x16_bf16(vf1, pf1, o[d0], 0, 0, 0);
    }
    asm volatile("" ::: "memory");
}

__global__ void __launch_bounds__(NWAVES * 64, 2) mega_fwd(Args args) {
    extern __shared__ __attribute__((aligned(16))) unsigned char lds_raw[];
    LAS unsigned char* lds = (LAS unsigned char*)lds_raw;
    const int tid = threadIdx.x, lane = tid & 63, wave = __builtin_amdgcn_readfirstlane(tid >> 6);
    const int G = gridDim.x; const int bx = blockIdx.x; const int vcu = (G % 8 == 0) ? (bx % 8) * (G / 8) + bx / 8 : bx;
    unsigned char* ws = args.ws;
    const float* x = args.in[0]; const float* cvec = args.in[1]; const float* w_ada = args.in[2]; const float* b_ada = args.in[3]; const float* norm_w = args.in[4];
    const float* w_in = args.in[5]; const float* b_gate = args.in[6]; const float* q_norm_w = args.in[7]; const float* k_norm_w = args.in[8]; const float* w_attn_proj = args.in[9];
    const float* conv_w = args.in[10]; const float* conv_b = args.in[11]; const float* conv_ln_w = args.in[12]; const float* conv_ln_b = args.in[13];
    const float* w_conv_proj = args.in[14]; const float* w_out = args.in[15];
    float* out = args.out;
    float* ADA = (float*)(ws + WS_ADA);
    bf16* WIN = (bf16*)(ws + WS_WIN); bf16* W2 = (bf16*)(ws + WS_WA); bf16* WO = (bf16*)(ws + WS_WO);
    float* LSE = (float*)(ws + WS_LSE);
    bf16* HB = (bf16*)(ws + WS_H); bf16* A2 = (bf16*)(ws + WS_A2A);
    bf16* QB = (bf16*)(ws + WS_Q); bf16* KB = (bf16*)(ws + WS_K); bf16* VB = (bf16*)(ws + WS_V);
    bf16* MG = (bf16*)(ws + WS_MG);
    bf16* ZA = (bf16*)(ws + WS_ZA); bf16* GLU = (bf16*)(ws + WS_GLU); bf16* ZC = (bf16*)(ws + WS_ZC);
    bf16* SG = (bf16*)out;

    if (tid < 32) ((LAS unsigned*)(lds + MISC_OFF))[tid] = 0u;
    __syncthreads();
    XcdBarrier bar = xcd_barrier_post((unsigned*)(ws + WS_CTL) + 4096, (volatile LAS unsigned*)(lds + MISC_OFF) + 8);
#define GRID_BAR(k) xcd_barrier(bar)
    const int lo = args.ph_lo, hi_ph = args.ph_hi;
#define IN(k) (lo <= (k) && (k) < hi_ph)
#define BOTH(k) (IN(k) && IN((k) + 1))
    const int gw = vcu * NWAVES + wave, NGW = G * NWAVES;

    if (IN(0)) {
        {
            LAS float* sc = (LAS float*)lds; LAS float* part = (LAS float*)(lds + 32768);
            if (bx < ADA_N / 64) {
                for (int i = tid; i < BATCH * DM; i += NWAVES * 64) { const float v = cvec[i]; sc[i] = v * sigmoidf_(v); }
                __syncthreads();
                for (int item = bx; item < ADA_N / 64; item += G) {
                    const int j = item * 64 + lane; float a[BATCH];
#pragma unroll
                    for (int b = 0; b < BATCH; ++b) a[b] = 0.f;
#pragma unroll 4
                    for (int kk = 0; kk < 128; ++kk) { const int k = wave * 128 + kk; const float w = __builtin_nontemporal_load(w_ada + (size_t)k * ADA_N + j);
#pragma unroll
                        for (int b = 0; b < BATCH; ++b) a[b] += sc[b * DM + k] * w; }
#pragma unroll
                    for (int b = 0; b < BATCH; ++b) part[(wave * BATCH + b) * 64 + lane] = a[b];
                    __syncthreads();
                    { float s = b_ada[j];
#pragma unroll
                      for (int w = 0; w < NWAVES; ++w) s += part[(w * BATCH + wave) * 64 + lane];
                      ADA[(size_t)wave * ADA_N + j] = s; }
                    __syncthreads();
                }
            }
        }
        if (bx >= ADA_N / 64 || G <= ADA_N / 64) {
            LAS float* scr = (LAS float*)(lds + RING_OFF + wave * 16384);
            constexpr int I_IN = (DM / 64) * (NIN / 32), I_A = (CW / 64) * (DM / 32), I_O = (DM / 64) * (DM / 32);
            constexpr int NITEMS = I_IN + 2 * I_A + I_O;
            const int nsk = G > ADA_N / 64 ? ADA_N / 64 : 0;
            for (int it = (bx - nsk) * NWAVES + wave; it < NITEMS; it += (G - nsk) * NWAVES) {
                int r = it;
                if (r < I_IN) { p0_transpose_item<true>(w_in, DM, NIN, WIN, scr, r, lane); continue; } r -= I_IN;
                if (r < I_A) { p0_transpose_item<false>(w_attn_proj, CW, DM, W2, scr, r, lane, DM); continue; } r -= I_A;
                if (r < I_A) { p0_transpose_item<false>(w_conv_proj, CW, DM, W2 + CW, scr, r, lane, DM); continue; } r -= I_A;
                p0_transpose_item<false>(w_out, DM, DM, WO, scr, r, lane);
            }
        }
        if (BOTH(0)) GRID_BAR(0);
    }

    if (IN(1)) {
        for (int rb = gw; rb < M / 16; rb += NGW) {
            const int row0 = rb * 16, b = row0 >> 12;
            f32x4 gm[4], ga[4];
#pragma unroll
            for (int j = 0; j < 4; ++j) { const int c = 4 * lane + 256 * j;
                const f32x4 nw = *(const f32x4*)(norm_w + c), sc = *(const f32x4*)(ADA + (size_t)b * ADA_N + DM + c);
                gm[j] = nw * (sc + 1.0f); ga[j] = *(const f32x4*)(ADA + (size_t)b * ADA_N + c); }
            for (int r = 0; r < 16; ++r) {
                const GAS f32x4* xr = (const GAS f32x4*)(x + (size_t)(row0 + r) * DM) + lane;
                f32x4 v[4]; float s2 = 0.f;
#pragma unroll
                for (int j = 0; j < 4; ++j) { v[j] = __builtin_nontemporal_load(xr + 64 * j); s2 += (v[j].x * v[j].x + v[j].y * v[j].y) + (v[j].z * v[j].z + v[j].w * v[j].w); }
                const float rstd = __builtin_amdgcn_rsqf(wave_sum(s2) * (1.f / DM) + pg8::NORM_EPS);
                GAS v2u* o8 = (GAS v2u*)(HB + (size_t)(row0 + r) * DM) + lane;
#pragma unroll
                for (int j = 0; j < 4; ++j) { const f32x4 y = v[j] * rstd * gm[j] + ga[j]; v2u w; w.x = cvt_pk_bf16(y.x, y.y); w.y = cvt_pk_bf16(y.z, y.w); o8[64 * j] = w; }
            }
        }
        if (BOTH(1)) GRID_BAR(1);
    }

    if (IN(2)) {
        pg8::Gemm g{HB, WIN, M, NIN, DM}; pg8::StaticOrder S; S.init(M, NIN, G, bx);
        pg8::EpiIn E{QB, (WS_K - WS_Q) / 2, ZA, (WS_ZC - WS_ZA) / 2, GLU, (unsigned char*)SG, q_norm_w, k_norm_w, b_gate, lds + RING_OFF + RING_BYTES + wave * 2048};
        pg8::gemm_phase<pg8::EpiIn, pg8::StaticOrder, true, true>(lds + RING_OFF, g, S, E);
        if (BOTH(2)) GRID_BAR(2);
    }

    if (IN(3)) {
        {
            LAS unsigned* in32 = (LAS unsigned*)lds;
            LAS float* ot = (LAS float*)(lds + 65536);
            const int cp = tid & 255, th = tid >> 8;
            float w0[CK], w1[CK];
#pragma unroll
            for (int j = 0; j < CK; ++j) { const f32x2 w = *(const f32x2*)(conv_w + j * CW + 2 * cp); w0[j] = w.x; w1[j] = w.y; }
            const f32x2 cb = *(const f32x2*)(conv_b + 2 * cp);
            v4u pf[8];
#define CONV_FETCH(TILE) { const int b_ = (TILE) >> 7, t0_ = ((TILE) & 127) * 32; \
                _Pragma("unroll") for (int i = 0; i < 8; ++i) { int c = tid + 512 * i; c = c < 62 * 64 ? c : 62 * 64 - 1; const int r = c >> 6, ch = c & 63, t = t0_ - 30 + r; \
                    v4u val = *(const GAS v4u*)(GLU + ((size_t)b_ * SEQ + (t < 0 ? 0 : t)) * CW + ch * 8); if (t < 0) val = (v4u){0u, 0u, 0u, 0u}; pf[i] = val; } }
            if (bx < M / 32) CONV_FETCH(bx)
            for (int tile = bx; tile < M / 32; tile += G) {
                const int b = tile >> 7, t0 = (tile & 127) * 32; const size_t row0 = (size_t)b * SEQ + t0;
#pragma unroll
                for (int i = 0; i < 8; ++i) { const int c = tid + 512 * i; if (c < 62 * 64) *(LAS v4u*)(lds + (size_t)c * 16) = pf[i]; }
                v4u zc[4];
#pragma unroll
                for (int q = 0; q < 4; ++q) zc[q] = *(const GAS v4u*)(ZC + (row0 + wave + 8 * q) * CW + lane * 8);
                __syncthreads();
                { const int nt_ = tile + G < M / 32 ? tile + G : tile; CONV_FETCH(nt_) }
                unsigned xs[46];
#pragma unroll
                for (int i = 0; i < 46; ++i) xs[i] = in32[(th * 16 + i) * 256 + cp];
#pragma unroll
                for (int tl = 0; tl < 16; ++tl) { float a0 = cb.x, a1 = cb.y;
#pragma unroll
                    for (int j = 0; j < CK; ++j) { const unsigned xv = xs[tl + j]; a0 += w0[j] * bf_lo(xv); a1 += w1[j] * bf_hi(xv); }
                    *(LAS f32x2*)(ot + (th * 16 + tl) * CW + 2 * cp) = (f32x2){a0, a1}; }
                __syncthreads();
                {
                    const f32x4 lw0 = *(const f32x4*)(conv_ln_w + lane * 8), lw1 = *(const f32x4*)(conv_ln_w + lane * 8 + 4);
                    const f32x4 lb0 = *(const f32x4*)(conv_ln_b + lane * 8), lb1 = *(const f32x4*)(conv_ln_b + lane * 8 + 4);
#pragma unroll
                    for (int q = 0; q < 4; ++q) { const int tl = wave + 8 * q;
                        f32x4 v0 = *(const LAS f32x4*)(ot + tl * CW + lane * 8), v1 = *(const LAS f32x4*)(ot + tl * CW + lane * 8 + 4);
                        const float mean = wave_sum((v0.x + v0.y) + (v0.z + v0.w) + (v1.x + v1.y) + (v1.z + v1.w)) * (1.f / CW);
                        v0 = v0 - mean; v1 = v1 - mean;
                        const float var = wave_sum((v0.x * v0.x + v0.y * v0.y) + (v0.z * v0.z + v0.w * v0.w) + (v1.x * v1.x + v1.y * v1.y) + (v1.z * v1.z + v1.w * v1.w)) * (1.f / CW);
                        const float rstd = __builtin_amdgcn_rsqf(var + pg8::NORM_EPS);
                        v0 = v0 * rstd * lw0 + lb0; v1 = v1 * rstd * lw1 + lb1;
                        const v4u zq = zc[q];
                        const float z[8] = {bf_lo(zq.x), bf_hi(zq.x), bf_lo(zq.y), bf_hi(zq.y), bf_lo(zq.z), bf_hi(zq.z), bf_lo(zq.w), bf_hi(zq.w)};
#pragma unroll
                        for (int i = 0; i < 4; ++i) { v0[i] = v0[i] * sigmoidf_(v0[i]) * z[i]; v1[i] = v1[i] * sigmoidf_(v1[i]) * z[4 + i]; }
                        *(GAS v4u*)(A2 + (row0 + tl) * DM + CW + lane * 8) = pg8::pack8(v0, v1); }
                }
                __syncthreads();
            }
#undef CONV_FETCH
        }
        {
            const int r32 = lane & 31, hi = lane >> 5;
            const int vrd_off = (4 * hi + ((lane & 15) >> 2)) * 64 + ((lane >> 4) & 1) * 32 + (lane & 3) * 8;
            const int piece = wave & 3, tsel = wave >> 2;
            bf16* PB = (bf16*)(ws + WS_PB); float* PL = (float*)(ws + WS_LSE);
            const unsigned lds0 = (unsigned)(uintptr_t)lds_raw;
            const unsigned voffK = (unsigned)(((8 * piece + (lane >> 3)) * HD + (((lane & 7) ^ (((8 * piece + (lane >> 3)) >> 1) & 7)) << 3)) * 2);
            const unsigned voffV = (unsigned)(((16 * (piece & 1) + (lane >> 2)) * HD + (piece >> 1) * 32 + (lane & 3) * 8) * 2);
#define XT_CONST int xln_ = lane; asm volatile("" : "+v"(xln_)); const int xl_r = xln_ >> 3, xc0 = (xln_ & 7) ^ (xln_ >> 4);     \
            const unsigned xb_off = (unsigned)(xl_r * 128 + (xln_ & 7) * 16), xa_off = (unsigned)((xln_ & 31) * 128), xa_f = (unsigned)(((xln_ & 31) >> 1) & 7);
#define XT_B(T, I) (*(LAS v4u*)((T) + xb_off + (I) * 1024))
#define XT_A(T, CH) (*(LAS v4u*)((T) + xa_off + ((((unsigned)(CH)) ^ xa_f) << 4)))
#define ATT_BAR() do { asm volatile("s_waitcnt lgkmcnt(0)" ::: "memory"); __builtin_amdgcn_s_barrier(); asm volatile("" ::: "memory"); } while (0)
#define ATT_DMA(ISV, SRC, RROW, JSB, NT, LDSOFF, FORCE) do { \
                _Pragma("unroll") for (int m_ = 0; m_ < 6; ++m_) { const int kt_ = 2 * m_ + tsel; const int js_ = (JSB) + 32 * kt_; \
                    if (m_ < (NT) / 2 && ((FORCE) || js_ >= 0)) \
                        glds16s((SRC) + ((size_t)(RROW) + (js_ < 0 ? 0 : js_)) * HD, ISV ? voffV : voffK, (unsigned)__builtin_amdgcn_readfirstlane((int)(lds0 + (LDSOFF) + kt_ * 4096 + piece * 1024))); } } while (0)
#define ATT_ROUND_(FAST, G_, RROW, IU0, JB, KTB, KBUF, TSH, TOK0, PBO, PBL, MROW0, NKN, QNP, QNROW) do { \
                    const int iq = (IU0) + r32; const int tq = (iq << (TSH)) + (TOK0); \
                    f32x16 S[5]; \
                    _Pragma("unroll") for (int tau = 0; tau < 5; ++tau) { \
                        if ((FAST) || (JB) + 32 * tau >= 0) { \
                            const LAS char* kp = (const LAS char*)(lds + (KBUF) + ((KTB) + tau) * 4096 + r32 * 128); \
                            bf16x8 kf[4]; \
                            _Pragma("unroll") for (int ks = 0; ks < 4; ++ks) kf[ks] = *(const LAS bf16x8*)(kp + (((2 * ks + hi) ^ ((r32 >> 1) & 7)) << 4)); \
                            f32x16 sacc = {}; \
                            _Pragma("unroll") for (int ks = 0; ks < 4; ++ks) sacc = __builtin_amdgcn_mfma_f32_32x32x16_bf16(kf[ks], qf[ks], sacc, 0, 0, 0); \
                              \
                            if (tau == 0) { int rq = r32 - 4 * hi; asm volatile("" : "+v"(rq)); _Pragma("unroll") for (int r = 0; r < 16; ++r) if ((r & 3) + 8 * (r >> 2) < rq) sacc[r] = -INFINITY; } \
                            if (tau == 4) { int rq = r32 - 4 * hi; asm volatile("" : "+v"(rq)); _Pragma("unroll") for (int r = 0; r < 16; ++r) if ((r & 3) + 8 * (r >> 2) > rq) sacc[r] = -INFINITY; } \
                            S[tau] = sacc; \
                        } else { _Pragma("unroll") for (int r = 0; r < 16; ++r) S[tau][r] = -INFINITY; } } \
                    float mx = -INFINITY; \
                    _Pragma("unroll") for (int tau = 0; tau < 5; ++tau) _Pragma("unroll") for (int r = 0; r < 16; r += 2) mx = fmaxf(fmaxf(mx, S[tau][r]), S[tau][r + 1]); \
                    { const auto sw_ = __builtin_amdgcn_permlane32_swap(__float_as_uint(mx), __float_as_uint(mx), false, false); mx = fmaxf(__uint_as_float(sw_[0]), __uint_as_float(sw_[1])); } \
                    float l = 0.f; v4u P[5][2]; \
                    _Pragma("unroll") for (int tau = 0; tau < 5; ++tau) { f32x16 p = S[tau]; float ps = 0.f; \
                        _Pragma("unroll") for (int r = 0; r < 16; ++r) { p[r] = __builtin_amdgcn_exp2f(p[r] - mx); ps += p[r]; } \
                        l += ps; \
                        P[tau][0].x = cvt_pk_bf16(p[0], p[1]); P[tau][0].y = cvt_pk_bf16(p[2], p[3]); P[tau][0].z = cvt_pk_bf16(p[4], p[5]); P[tau][0].w = cvt_pk_bf16(p[6], p[7]); \
                        P[tau][1].x = cvt_pk_bf16(p[8], p[9]); P[tau][1].y = cvt_pk_bf16(p[10], p[11]); P[tau][1].z = cvt_pk_bf16(p[12], p[13]); P[tau][1].w = cvt_pk_bf16(p[14], p[15]); } \
                    { const auto sw_ = __builtin_amdgcn_permlane32_swap(__float_as_uint(l), __float_as_uint(l), false, false); l = __uint_as_float(sw_[0]) + __uint_as_float(sw_[1]); } \
                    asm volatile("s_waitcnt vmcnt(" #NKN ")" ::: "memory"); ATT_BAR();     \
                    XT_CONST LAS char* const xt = (LAS char*)(lds + (KBUF) + wave * 4096); \
                    ATT_LOAD_Q(qn, QNP, QNROW); \
                    if ((G_) < 2) ATT_LOAD_P(PBO, PBL, tq, IU0, TSH, TOK0); \
                    f32x16 o[2]; o[0] = f32x16{}; o[1] = f32x16{}; \
                    _Pragma("unroll") for (int tau = 0; tau < 5; ++tau) { \
                        if ((FAST) || (JB) + 32 * tau >= 0) { \
                            const LAS char* vp = (const LAS char*)(lds + ATT_V + ((KTB) + tau) * 4096 + vrd_off); \
                            const bf16x8 pf0 = __builtin_bit_cast(bf16x8, P[tau][0]), pf1 = __builtin_bit_cast(bf16x8, P[tau][1]); \
                            _Pragma("unroll") for (int d0 = 0; d0 < 2; ++d0) { \
                                const s16x4 a0 = vtr(vp + d0 * 2048), a1 = vtr(vp + d0 * 2048 + 512), a2 = vtr(vp + d0 * 2048 + 1024), a3 = vtr(vp + d0 * 2048 + 1536); \
                                const bf16x8 vf0 = (bf16x8){a0[0], a0[1], a0[2], a0[3], a1[0], a1[1], a1[2], a1[3]}; \
                                const bf16x8 vf1 = (bf16x8){a2[0], a2[1], a2[2], a2[3], a3[0], a3[1], a3[2], a3[3]}; \
                                o[d0] = __builtin_amdgcn_mfma_f32_32x32x16_bf16(vf0, pf0, o[d0], 0, 0, 0); \
                                o[d0] = __builtin_amdgcn_mfma_f32_32x32x16_bf16(vf1, pf1, o[d0], 0, 0, 0); } } } \
                    float lse = mx + __builtin_amdgcn_logf(l), sc_own = __builtin_amdgcn_rcpf(l), sc_p = 0.f; \
                    if ((G_) < 2) { const float mx2 = fmaxf(lse, plse), a = __builtin_amdgcn_exp2f(lse - mx2), bq = __builtin_amdgcn_exp2f(plse - mx2), inv = __builtin_amdgcn_rcpf(a + bq); \
                        sc_own = sc_own * a * inv; sc_p = bq * inv; lse = mx2 + __builtin_amdgcn_logf(a + bq); } \
                      \
                    if ((G_) < 2) { _Pragma("unroll") for (int i = 0; i < 4; ++i) XT_B(xt, i) = pq[i]; _Pragma("unroll") for (int c = 0; c < 4; ++c) pq[c] = XT_A(xt, 2 * c + hi); } \
                    if ((G_) < 2) { _Pragma("unroll") for (int c = 0; c < 4; ++c) { const auto rx = __builtin_amdgcn_permlane32_swap(pq[c].x, pq[c].z, false, false); const auto ry = __builtin_amdgcn_permlane32_swap(pq[c].y, pq[c].w, false, false); \
                        pp[2 * c] = (v2u){rx[0], ry[0]}; pp[2 * c + 1] = (v2u){rx[1], ry[1]}; } } \
                    if ((G_) > 0) { \
                        _Pragma("unroll") for (int d0 = 0; d0 < 2; ++d0) _Pragma("unroll") for (int j = 0; j < 2; ++j) { v2u w[2]; \
                            _Pragma("unroll") for (int q = 0; q < 2; ++q) { const int rg = 2 * j + q; \
                                float e0 = o[d0][4 * rg] * sc_own, e1 = o[d0][4 * rg + 1] * sc_own, e2 = o[d0][4 * rg + 2] * sc_own, e3 = o[d0][4 * rg + 3] * sc_own; \
                                if ((G_) < 2) { const v2u pw = pp[d0 * 4 + rg]; e0 += sc_p * bf_lo(pw.x); e1 += sc_p * bf_hi(pw.x); e2 += sc_p * bf_lo(pw.y); e3 += sc_p * bf_hi(pw.y); } \
                                w[q].x = cvt_pk_bf16(e0, e1); w[q].y = cvt_pk_bf16(e2, e3); } \
                            const auto rx = __builtin_amdgcn_permlane32_swap(w[0].x, w[1].x, false, false); const auto ry = __builtin_amdgcn_permlane32_swap(w[0].y, w[1].y, false, false); \
                            XT_A(xt, 2 * (d0 * 2 + j) + hi) = (v4u){rx[0], ry[0], rx[1], ry[1]}; } \
                        _Pragma("unroll") for (int i = 0; i < 4; ++i) *(GAS v4u*)((PBO) + (size_t)((((IU0) + xl_r + 8 * i) << (TSH)) + (TOK0)) * HD + 8 * (xc0 ^ (4 * (i & 1)))) = XT_B(xt, i); \
                        if (hi == 0) (PBL)[tq] = lse; \
                    } else { \
                        const size_t mrow = (size_t)(MROW0) + tq; \
                        v4u zq[4]; v2u zz[8]; \
                        _Pragma("unroll") for (int i = 0; i < 4; ++i) zq[i] = *(const GAS v4u*)(ZA + ((size_t)(MROW0) + ((((IU0) + xl_r + 8 * i) << (TSH)) + (TOK0))) * CW + h * 64 + 8 * (xc0 ^ (4 * (i & 1)))); \
                        _Pragma("unroll") for (int i = 0; i < 4; ++i) XT_B(xt, i) = zq[i]; _Pragma("unroll") for (int c = 0; c < 4; ++c) zq[c] = XT_A(xt, 2 * c + hi); \
                        _Pragma("unroll") for (int c = 0; c < 4; ++c) { const auto rx = __builtin_amdgcn_permlane32_swap(zq[c].x, zq[c].z, false, false); const auto ry = __builtin_amdgcn_permlane32_swap(zq[c].y, zq[c].w, false, false); \
                            zz[2 * c] = (v2u){rx[0], ry[0]}; zz[2 * c + 1] = (v2u){rx[1], ry[1]}; } \
                        _Pragma("unroll") for (int d0 = 0; d0 < 2; ++d0) _Pragma("unroll") for (int j = 0; j < 2; ++j) { v2u w[2]; \
                            _Pragma("unroll") for (int q = 0; q < 2; ++q) { const int rg = 2 * j + q; const v2u pw = pp[d0 * 4 + rg]; const v2u zw = zz[d0 * 4 + rg]; \
                                const float e0 = (o[d0][4 * rg] * sc_own + sc_p * bf_lo(pw.x)) * bf_lo(zw.x), e1 = (o[d0][4 * rg + 1] * sc_own + sc_p * bf_hi(pw.x)) * bf_hi(zw.x); \
                                const float e2 = (o[d0][4 * rg + 2] * sc_own + sc_p * bf_lo(pw.y)) * bf_lo(zw.y), e3 = (o[d0][4 * rg + 3] * sc_own + sc_p * bf_hi(pw.y)) * bf_hi(zw.y); \
                                w[q].x = cvt_pk_bf16(e0, e1); w[q].y = cvt_pk_bf16(e2, e3); } \
                            const auto rx = __builtin_amdgcn_permlane32_swap(w[0].x, w[1].x, false, false); const auto ry = __builtin_amdgcn_permlane32_swap(w[0].y, w[1].y, false, false); \
                            XT_A(xt, 2 * (d0 * 2 + j) + hi) = (v4u){rx[0], ry[0], rx[1], ry[1]}; } \
                        _Pragma("unroll") for (int i = 0; i < 4; ++i) *(GAS v4u*)(A2 + ((size_t)(MROW0) + ((((IU0) + xl_r + 8 * i) << (TSH)) + (TOK0))) * DM + h * 64 + 8 * (xc0 ^ (4 * (i & 1)))) = XT_B(xt, i); } \
                    ATT_XCH_Q(xt); \
                } while (0)
#define ATT_ROUND(...) ATT_ROUND_(0, __VA_ARGS__)
#define ATT_LOAD_Q(DST, QP, ROW0) do { _Pragma("unroll") for (int i = 0; i < 4; ++i) DST[i] = *(const GAS v4u*)((QP) + (size_t)((ROW0) + xl_r + 8 * i) * HD + 8 * (xc0 ^ (4 * (i & 1)))); } while (0)
#define ATT_XCH_Q(T) do { _Pragma("unroll") for (int i = 0; i < 4; ++i) XT_B(T, i) = qn[i]; _Pragma("unroll") for (int ks = 0; ks < 4; ++ks) qf[ks] = __builtin_bit_cast(bf16x8, XT_A(T, 2 * ks + hi)); } while (0)
#define ATT_LOAD_P(PBO, PBL, TQ, IU0, TSH, TOK0) do { _Pragma("unroll") for (int i = 0; i < 4; ++i) pq[i] = *(const GAS v4u*)((PBO) + (size_t)((((IU0) + xl_r + 8 * i) << (TSH)) + (TOK0)) * HD + 8 * (xc0 ^ (4 * (i & 1)))); \
                plse = (PBL)[TQ]; } while (0)
            bf16x8 qf[4]; v4u qn[4], pq[4]; v2u pp[8]; float plse;
            {
                const int NCH = BATCH * HPG * 16;
                if (vcu < NCH) { const int bh = vcu >> 4, res = vcu & 15; const size_t base = (size_t)(((bh >> 3) * 3 + 2) * 8 + (bh & 7)) * SEQ * HD;
                    { XT_CONST ATT_LOAD_Q(qn, QB + base, res * 256 + 32 * wave); ATT_XCH_Q((LAS char*)(lds + ATT_K1 + wave * 4096)); }
                    asm volatile("s_waitcnt vmcnt(0)" ::: "memory"); ATT_BAR();
                    ATT_DMA(false, KB + base, res * 256, 0, 8, ATT_K0, false); }
                int kpar = 0;
                for (int ch = vcu; ch < NCH; ch += G, kpar ^= 1) {
                    const int bh = ch >> 4, res = ch & 15, b = bh >> 3, h = bh & 7; const size_t base = (size_t)((b * 3 + 2) * 8 + h) * SEQ * HD;
                    const int chn = ch + G < NCH ? ch + G : ch, bhn = chn >> 4, resn = chn & 15; const size_t basen = (size_t)(((bhn >> 3) * 3 + 2) * 8 + (bhn & 7)) * SEQ * HD;
                    const int kbuf = kpar ? ATT_K1 : ATT_K0, knext = kpar ? ATT_K0 : ATT_K1;
                    if (ch == vcu) asm volatile("s_waitcnt vmcnt(0)" ::: "memory");
                    asm volatile("" : "+v"(qf[0]), "+v"(qf[1]), "+v"(qf[2]), "+v"(qf[3]));
                    ATT_BAR();
                    ATT_DMA(true, VB + base, res * 256, 0, 8, ATT_V, false);
                    if (ch + G < NCH) { ATT_DMA(false, KB + basen, resn * 256, 0, 8, knext, true);
                        ATT_ROUND(2, res * 256, 32 * wave, 32 * wave - 128, wave - 4, kbuf, 4, res, PB + (size_t)bh * SEQ * HD, PL + (size_t)bh * SEQ, 0, 4, QB + basen, resn * 256 + 32 * wave); }
                    else { ATT_ROUND(2, res * 256, 32 * wave, 32 * wave - 128, wave - 4, kbuf, 4, res, PB + (size_t)bh * SEQ * HD, PL + (size_t)bh * SEQ, 0, 0, QB + basen, resn * 256 + 32 * wave); }
                }
                asm volatile("s_waitcnt vmcnt(0)" ::: "memory"); ATT_BAR();
            }
            GRID_BAR(6);
            for (int item = vcu; item < BATCH * HPG * 4; item += G) {
                const int span = item & 3, h = (item >> 2) & 7, b = item >> 5, bh = b * 8 + h;
                bf16* pbo = PB + (size_t)bh * SEQ * HD; float* pbl = PL + (size_t)bh * SEQ;
                const size_t base1 = (size_t)((b * 3 + 1) * 8 + h) * SEQ * HD, base0 = (size_t)((b * 3 + 0) * 8 + h) * SEQ * HD;
#define ITEM_RND(RD, G_, BASE_, RROW_, QB0_, TSH_, TOK0_) const int G_ = (RD) < 4 ? 1 : 0; const size_t BASE_ = (RD) < 4 ? base1 : base0; \
                const int RROW_ = (RD) < 4 ? (RD) * 1024 : 0, QB0_ = (RD) < 4 ? (span << 8) : (span << 10) + (((RD) - 4) << 8), TSH_ = (RD) < 4 ? 2 : 0, TOK0_ = (RD) < 4 ? (RD) : 0;
                { ITEM_RND(0, g_, base_, rrow_, qb0_, tsh_, tok0_)
                  { XT_CONST ATT_LOAD_Q(qn, QB + base_, rrow_ + qb0_ + 32 * wave); ATT_XCH_Q((LAS char*)(lds + ATT_K1 + wave * 4096)); }
                  asm volatile("s_waitcnt vmcnt(0)" ::: "memory"); ATT_BAR();
                  ATT_DMA(false, KB + base_, rrow_, qb0_ - 128, 12, ATT_K0, false); }
                for (int rd = 0; rd < 8; ++rd) {
                    ITEM_RND(rd, g, base, rrow, qb0, tsh, tok0)
                    const int rdn = rd + 1 < 8 ? rd + 1 : rd; ITEM_RND(rdn, gn, basen, rrown, qb0n, tshn, tok0n)
                    const int kbuf = (rd & 1) ? ATT_K1 : ATT_K0, knext = (rd & 1) ? ATT_K0 : ATT_K1;
                    if (rd == 0 || rd == 4) asm volatile("s_waitcnt vmcnt(0)" ::: "memory");
                    asm volatile("" : "+v"(qf[0]), "+v"(qf[1]), "+v"(qf[2]), "+v"(qf[3]));
                    ATT_BAR();
                    ATT_DMA(true, VB + base, rrow, qb0 - 128, 12, ATT_V, false);
                    if (rd + 1 < 8) { ATT_DMA(false, KB + basen, rrown, qb0n - 128, 12, knext, true);
                        if (qb0 + 32 * wave - 128 >= 0) { ATT_ROUND_(1, g, rrow, qb0 + 32 * wave, qb0 + 32 * wave - 128, wave, kbuf, tsh, tok0, pbo, pbl, (size_t)b * SEQ, 6, QB + basen, rrown + qb0n + 32 * wave); }
                        else { ATT_ROUND(g, rrow, qb0 + 32 * wave, qb0 + 32 * wave - 128, wave, kbuf, tsh, tok0, pbo, pbl, (size_t)b * SEQ, 6, QB + basen, rrown + qb0n + 32 * wave); } }
                    else { ATT_ROUND(g, rrow, qb0 + 32 * wave, qb0 + 32 * wave - 128, wave, kbuf, tsh, tok0, pbo, pbl, (size_t)b * SEQ, 0, QB + basen, rrown + qb0n + 32 * wave); }
                }
#undef ITEM_RND
            }
            asm volatile("s_waitcnt vmcnt(0)" ::: "memory"); ATT_BAR();
#undef ATT_BAR
#undef ATT_DMA
#undef ATT_ROUND
#undef ATT_ROUND_
#undef ATT_LOAD_Q
#undef ATT_XCH_Q
#undef XT_CONST
#undef XT_A
#undef XT_B
#undef ATT_LOAD_P
        }
        if (BOTH(3)) GRID_BAR(3);
    }

    if (IN(4)) {
        { pg8::Gemm g{A2, W2, M, DM, DM}; pg8::StaticOrder S; S.init(M, DM, G, bx);
          pg8::EpiMerge2 E{(const unsigned char*)SG, MG, lds + RING_OFF + RING_BYTES + wave * 2048};
          pg8::gemm_phase<pg8::EpiMerge2, pg8::StaticOrder, true, true>(lds + RING_OFF, g, S, E); }
        if (BOTH(4)) GRID_BAR(4);
    }

    if (IN(5)) {
        pg8::Gemm g{MG, WO, M, DM, DM}; pg8::StaticOrder S; S.init(M, DM, G, bx);
        pg8::EpiOut E{x, out, ADA, lds + RING_OFF + RING_BYTES + wave * 2048};
        pg8::gemm_phase<pg8::EpiOut, pg8::StaticOrder, true, true>(lds + RING_OFF, g, S, E);
    }
#undef IN
#undef BOTH
}

extern "C" void kernel_launch(void* const* d_in, const int* in_sizes, int n_in, void* d_out, int out_size, void* d_ws, size_t ws_size, hipStream_t stream) {
    static int grid = 0;
    if (grid == 0) {
        if (n_in != 16 || in_sizes[0] != M * DM || out_size != M * DM || ws_size < WS_END) { fprintf(stderr, "kernel_launch: unexpected shapes (n_in %d, in0 %d, out %d, ws %zu)\n", n_in, n_in > 0 ? in_sizes[0] : -1, out_size, ws_size); grid = -1; return; }
        int dev = 0, cus = 0, per_cu = 0;
        if (hipGetDevice(&dev) != hipSuccess || hipDeviceGetAttribute(&cus, hipDeviceAttributeMultiprocessorCount, dev) != hipSuccess) { grid = -1; return; }
        if (hipFuncSetAttribute((const void*)mega_fwd, hipFuncAttributeMaxDynamicSharedMemorySize, LDS_BYTES) != hipSuccess) { fprintf(stderr, "kernel_launch: hipFuncSetAttribute failed\n"); grid = -1; return; }
        if (hipOccupancyMaxActiveBlocksPerMultiprocessor(&per_cu, (const void*)mega_fwd, NWAVES * 64, LDS_BYTES) != hipSuccess || per_cu < 1) { fprintf(stderr, "kernel_launch: occupancy query says %d\n", per_cu); (void)hipGetLastError(); per_cu = 1; }
        if (per_cu > 1) per_cu = 1;
        grid = cus * per_cu;
    }
    if (grid < 0) return;
    (void)hipMemsetAsync((char*)d_ws + WS_CTL, 0, CTL_ZERO_BYTES, stream);
    Args a{};
    for (int i = 0; i < 16; ++i) a.in[i] = (const float*)d_in[i];
    a.out = (float*)d_out; a.ws = (unsigned char*)d_ws;
    a.ph_lo = 0; a.ph_hi = N_PHASES;
    hipLaunchKernelGGL(mega_fwd, dim3(grid), dim3(NWAVES * 64), LDS_BYTES, stream, a);
}
```

```cpp
#include <hip/hip_runtime.h>
#include <cstdio>
#include <cstdint>

namespace pg8 {
#define PG8_LAS __attribute__((address_space(3)))
typedef unsigned short bf16_t;
typedef short bf16x8 __attribute__((ext_vector_type(8)));
typedef float f32x4 __attribute__((ext_vector_type(4)));
typedef unsigned u32x4 __attribute__((ext_vector_type(4)));
constexpr int BM = 256, BK = 64, HALF = 128, HTB = HALF * BK * 2, STAGE_BYTES = 8 * HTB, NXCD = 8, WGM = 8;

__host__ __device__ __forceinline__ int lds_byte(int r, int c) { const int st = (r >> 4) * 2 + (c >> 5), rr = r & 15, cc = c & 31, ob = rr * 64 + cc * 2; return st * 1024 + (ob ^ (((ob >> 9) & 1) << 5)); }
__host__ __device__ __forceinline__ void stage_rc(int b, int& R, int& C) { const int st = b / 1024, sb = b % 1024, swz = sb ^ (((sb >> 9) & 1) << 5); R = (st >> 1) * 16 + swz / 64; C = (st & 1) * 32 + (swz % 64) / 2; }
__host__ __device__ __forceinline__ int perm32(int rho) { const int n = rho >> 4, i = rho & 15; return 8 * (i >> 2) + 4 * n + (i & 3); }

struct Unit { int pm, pn; };
struct Gemm { const bf16_t* A; const bf16_t* Bt; int M, N, K; };

struct StaticOrder {
    int nM, nN, nwg, G, c;
    __host__ __device__ void init(int M, int N, int G_, int c_) { nM = M / BM; nN = N / BM; nwg = nM * nN; G = G_; c = c_; }
    __host__ __device__ bool next(int i, Unit& u) const {
        const long L = (long)i * G + c; if (L >= nwg) return false;
        int wgid = (int)L; { const int q = nwg / NXCD, r = nwg % NXCD, xcd = wgid % NXCD, off = wgid / NXCD; wgid = (xcd < r ? xcd * (q + 1) : r * (q + 1) + (xcd - r) * q) + off; }
        const int nig = WGM * nN, gid = wgid / nig, fm = gid * WGM, gsz = (nM - fm) < WGM ? (nM - fm) : WGM;
        u.pm = fm + ((wgid % nig) % gsz); u.pn = (wgid % nig) / gsz; return true;
    }
    __device__ __forceinline__ void a_ready(const Unit&) const {}
    __device__ __forceinline__ void done(const Unit&) const {}
};

typedef float f32x2_t __attribute__((ext_vector_type(2))); typedef __bf16 bf16x2_t __attribute__((ext_vector_type(2)));
__device__ __forceinline__ unsigned cvt_pk_bf16(float lo, float hi) { f32x2_t v = {lo, hi}; bf16x2_t b = __builtin_convertvector(v, bf16x2_t); return __builtin_bit_cast(unsigned, b); }
__device__ __forceinline__ float bf_lo(unsigned w) { return __uint_as_float(w << 16); }
__device__ __forceinline__ float bf_hi(unsigned w) { return __uint_as_float(w & 0xffff0000u); }
__device__ __forceinline__ float sigmoidf_(float x) { return __builtin_amdgcn_rcpf(1.0f + __builtin_amdgcn_exp2f(-1.4426950408889634f * x)); }
__device__ __forceinline__ u32x4 pack8(const f32x4& a, const f32x4& b) { u32x4 w; w.x = cvt_pk_bf16(a[0], a[1]); w.y = cvt_pk_bf16(a[2], a[3]); w.z = cvt_pk_bf16(b[0], b[1]); w.w = cvt_pk_bf16(b[2], b[3]); return w; }


constexpr float QSCALE = 0.125f * 1.4426950408889634f;
constexpr float NORM_EPS = 1e-6f;
#define PG8_XPOSE(P0, P1, T0, T1) do { *(PG8_LAS u32x4*)xw0 = (P0); *(PG8_LAS u32x4*)xw1 = (P1); T0 = *(const PG8_LAS u32x4*)xr0; T1 = *(const PG8_LAS u32x4*)(xr0 + 1024); } while (0)
#define PG8_XPOSE_ADDR PG8_LAS unsigned char* xw0 = scr + fr * 128 + 16 * (fq ^ (fr & 7)); PG8_LAS unsigned char* xw1 = scr + fr * 128 + 16 * ((4 + fq) ^ (fr & 7)); \
        const int r8 = 2 * fq + (fr >> 3), c8 = fr & 7; const PG8_LAS unsigned char* xr0 = scr + r8 * 128 + 16 * (c8 ^ (r8 & 7));
__device__ __forceinline__ size_t sg_frag(int pm, int t, int ai, int m, int wave, int lane) { return ((((((size_t)pm * 8 + t) * 2 + ai) * 4 + m) * 8 + wave) * 64 + lane) * 16; }
struct EpiIn {
    static constexpr bool PERM = true, AFTER_DRAIN = false; static constexpr int MIDK = 0;
    bf16_t *Q; size_t qkv_stride; bf16_t *ZA; size_t zc_off; bf16_t *GLU; unsigned char* SG; const float *qw, *kw, *bgate; PG8_LAS unsigned char* scr;
    __device__ __forceinline__ void operator()(const f32x4 (&acc)[2][2][4][2], const Unit& u, int wr, int wc, int fr, int fq) const {
        const int pn = u.pn;
        PG8_XPOSE_ADDR
        const int rown = u.pm * BM + wr * 64 + r8;
        if (pn < 18) {
            const int kind = pn / 6, rel = pn - kind * 6, g = rel >> 1, hb = ((rel & 1) << 2) + wc, sh = 2 * g;
            bf16_t* base = Q + (size_t)kind * qkv_stride;
            f32x4 wv[2][2];
            if (kind < 2) { const float* w = qw; if (kind == 1) w = kw; const float sc = kind == 0 ? QSCALE : 1.0f;
#pragma unroll
                for (int bj = 0; bj < 2; ++bj)
#pragma unroll
                    for (int n = 0; n < 2; ++n) wv[bj][n] = *(const f32x4*)(w + 32 * bj + 8 * fq + 4 * n) * sc; }
#pragma unroll
            for (int ai = 0; ai < 2; ++ai)
#pragma unroll
                for (int m = 0; m < 4; ++m) {
                    f32x4 v00 = acc[ai][0][m][0], v01 = acc[ai][0][m][1], v10 = acc[ai][1][m][0], v11 = acc[ai][1][m][1];
                    if (kind < 2) {
                        f32x4 q = v00 * v00 + v01 * v01 + v10 * v10 + v11 * v11; float ss = (q[0] + q[1]) + (q[2] + q[3]);
                        { const auto r16 = __builtin_amdgcn_permlane16_swap(__float_as_uint(ss), __float_as_uint(ss), false, false); ss = __uint_as_float(r16[0]) + __uint_as_float(r16[1]);
                          const auto r32_ = __builtin_amdgcn_permlane32_swap(__float_as_uint(ss), __float_as_uint(ss), false, false); ss = __uint_as_float(r32_[0]) + __uint_as_float(r32_[1]); }
                        const float rstd = __builtin_amdgcn_rsqf(ss * (1.0f / 64.0f) + NORM_EPS);
                        v00 = v00 * rstd * wv[0][0]; v01 = v01 * rstd * wv[0][1]; v10 = v10 * rstd * wv[1][0]; v11 = v11 * rstd * wv[1][1];
                    }
                    u32x4 t0, t1; PG8_XPOSE(pack8(v00, v01), pack8(v10, v11), t0, t1);
#pragma unroll
                    for (int h = 0; h < 2; ++h) { const int row = rown + ai * HALF + m * 16 + 8 * h, b = row >> 12, t = row & 4095;
                        const int tp = ((t & ((1 << sh) - 1)) << (12 - sh)) | (t >> sh);
                        __builtin_nontemporal_store(h ? t1 : t0, (u32x4*)(base + ((size_t)(((b * 3 + g) * 8 + hb) * 4096 + tp) * 64 + 8 * c8))); }
                }
        } else if (pn < 20 || (pn >= 24 && pn < 26)) {
            bf16_t* base = ZA + (pn < 20 ? (size_t)0 : zc_off); const int rel = pn < 20 ? pn - 18 : pn - 24; const int colN = rel * BM + wc * 32 + (c8 >> 2) * HALF + 8 * (c8 & 3);
#pragma unroll
            for (int ai = 0; ai < 2; ++ai)
#pragma unroll
                for (int m = 0; m < 4; ++m) { u32x4 p[2];
#pragma unroll
                    for (int bj = 0; bj < 2; ++bj) { f32x4 a = acc[ai][bj][m][0], b = acc[ai][bj][m][1];
#pragma unroll
                        for (int i = 0; i < 4; ++i) { a[i] = a[i] * sigmoidf_(a[i]); b[i] = b[i] * sigmoidf_(b[i]); }
                        p[bj] = pack8(a, b); }
                    u32x4 t0, t1; PG8_XPOSE(p[0], p[1], t0, t1);
                    bf16_t* dst = base + (size_t)(rown + ai * HALF + m * 16) * 512 + colN;
                    __builtin_nontemporal_store(t0, (u32x4*)dst); __builtin_nontemporal_store(t1, (u32x4*)(dst + 8 * 512)); }
        } else if (pn < 24) {
            const int colN = (pn - 20) * HALF + wc * 32 + 8 * (c8 & 3);
#pragma unroll
            for (int ai = 0; ai < 2; ++ai)
#pragma unroll
                for (int mp = 0; mp < 2; ++mp) { u32x4 p[2];
#pragma unroll
                    for (int q = 0; q < 2; ++q) { const int m = 2 * mp + q;
                        f32x4 a0 = acc[ai][0][m][0], a1 = acc[ai][0][m][1]; const f32x4 b0 = acc[ai][1][m][0], b1 = acc[ai][1][m][1];
#pragma unroll
                        for (int i = 0; i < 4; ++i) { a0[i] = a0[i] * sigmoidf_(b0[i]); a1[i] = a1[i] * sigmoidf_(b1[i]); }
                        p[q] = pack8(a0, a1); }
                    u32x4 t0, t1; PG8_XPOSE(p[0], p[1], t0, t1);
                    bf16_t* dst = GLU + (size_t)(rown + ai * HALF + (2 * mp + (c8 >> 2)) * 16) * 512 + colN;
                    __builtin_nontemporal_store(t0, (u32x4*)dst); __builtin_nontemporal_store(t1, (u32x4*)(dst + 8 * 512)); }
        } else {
            const int t = pn - 26; const int gc0 = t * BM + wc * 32 + 8 * fq;
            f32x4 bv[2][2];
#pragma unroll
            for (int bj = 0; bj < 2; ++bj)
#pragma unroll
                for (int n = 0; n < 2; ++n) bv[bj][n] = *(const f32x4*)(bgate + gc0 + HALF * bj + 4 * n);
#pragma unroll
            for (int ai = 0; ai < 2; ++ai)
#pragma unroll
                for (int m = 0; m < 4; ++m) {
                    u32x4 w;
#pragma unroll
                    for (int bj = 0; bj < 2; ++bj) { f32x4 a = acc[ai][bj][m][0] + bv[bj][0], b = acc[ai][bj][m][1] + bv[bj][1];
                        unsigned wa = 0u, wb = 0u;
#pragma unroll
                        for (int i = 0; i < 4; ++i) { wa = __builtin_amdgcn_cvt_pk_u8_f32(sigmoidf_(a[i]) * 255.0f, i, wa); wb = __builtin_amdgcn_cvt_pk_u8_f32(sigmoidf_(b[i]) * 255.0f, i, wb); }
                        if (bj == 0) { w.x = wa; w.y = wb; } else { w.z = wa; w.w = wb; } }
                    __builtin_nontemporal_store(w, (u32x4*)(SG + sg_frag(u.pm, t, ai, m, wr * 4 + wc, fq * 16 + fr))); }
        }
    }
};
struct EpiMerge2 {
    static constexpr bool PERM = true, AFTER_DRAIN = false; static constexpr int MIDK = 8;
    const unsigned char* SG; bf16_t* OUT; PG8_LAS unsigned char* scr;
    __device__ __forceinline__ void mid(f32x4 (&acc)[2][2][4][2], const Unit& u, int wr, int wc, int fr, int fq) const {
        asm volatile("" : "+v"(fr), "+v"(fq));
        const int wave = wr * 4 + wc, lane = fq * 16 + fr;
#pragma unroll
        for (int ai = 0; ai < 2; ++ai) {
            u32x4 ga[4], gc[4];
#pragma unroll
            for (int m = 0; m < 4; ++m) { ga[m] = *(const u32x4*)(SG + sg_frag(u.pm, u.pn, ai, m, wave, lane)); gc[m] = *(const u32x4*)(SG + sg_frag(u.pm, u.pn + 4, ai, m, wave, lane)); }
#pragma unroll
            for (int m = 0; m < 4; ++m)
#pragma unroll
                for (int bj = 0; bj < 2; ++bj) {
                    const unsigned gax = bj ? ga[m].z : ga[m].x, gay = bj ? ga[m].w : ga[m].y, gcx = bj ? gc[m].z : gc[m].x, gcy = bj ? gc[m].w : gc[m].y;
                    f32x4& a = acc[ai][bj][m][0]; f32x4& b = acc[ai][bj][m][1];
#pragma unroll
                    for (int i = 0; i < 4; ++i) {
                        a[i] *= (float)((gax >> (8 * i)) & 255u) * __builtin_amdgcn_rcpf(fmaxf((float)((gcx >> (8 * i)) & 255u), 0.5f));
                        b[i] *= (float)((gay >> (8 * i)) & 255u) * __builtin_amdgcn_rcpf(fmaxf((float)((gcy >> (8 * i)) & 255u), 0.5f)); } }
            asm volatile("" ::: "memory"); }
    }
    __device__ __forceinline__ void operator()(const f32x4 (&acc)[2][2][4][2], const Unit& u, int wr, int wc, int fr, int fq) const {
        asm volatile("" : "+v"(fr), "+v"(fq));
        const int wave = wr * 4 + wc, lane = fq * 16 + fr;
        PG8_XPOSE_ADDR
        const int rown = u.pm * BM + wr * 64 + r8, colN = u.pn * BM + wc * 32 + (c8 >> 2) * HALF + 8 * (c8 & 3);
#pragma unroll
        for (int ai = 0; ai < 2; ++ai) {
            u32x4 gw[4];
#pragma unroll
            for (int m = 0; m < 4; ++m) gw[m] = *(const u32x4*)(SG + sg_frag(u.pm, u.pn + 4, ai, m, wave, lane));
#pragma unroll
            for (int m = 0; m < 4; ++m) { u32x4 p[2];
#pragma unroll
                for (int bj = 0; bj < 2; ++bj) { const unsigned gx = bj ? gw[m].z : gw[m].x, gy = bj ? gw[m].w : gw[m].y;
                    f32x4 a = acc[ai][bj][m][0], b = acc[ai][bj][m][1];
#pragma unroll
                    for (int i = 0; i < 4; ++i) { a[i] *= fmaxf((float)((gx >> (8 * i)) & 255u), 0.5f) * (1.0f / 255.0f); b[i] *= fmaxf((float)((gy >> (8 * i)) & 255u), 0.5f) * (1.0f / 255.0f); }
                    p[bj] = pack8(a, b); }
                u32x4 t0, t1; PG8_XPOSE(p[0], p[1], t0, t1);
                bf16_t* dst = OUT + (size_t)(rown + ai * HALF + m * 16) * 1024 + colN;
                *(u32x4*)dst = t0; *(u32x4*)(dst + 8 * 1024) = t1; }
        }
    }
};
struct EpiOut {
    static constexpr bool PERM = true, AFTER_DRAIN = false; static constexpr int MIDK = 0;
    const float* X; float* OUT; const float* ADA; PG8_LAS unsigned char* scr;
    __device__ __forceinline__ void operator()(const f32x4 (&acc)[2][2][4][2], const Unit& u, int wr, int wc, int fr, int fq) const {
        asm volatile("" : "+v"(fr), "+v"(fq));
        const int r8 = 2 * fq + (fr >> 3), c8 = fr & 7;
        const int rowb = u.pm * BM + wr * 64 + r8, col0 = u.pn * BM + wc * 32 + 4 * c8; const int b = (u.pm * BM) >> 12;
        PG8_LAS unsigned char* w0 = scr + fr * 128 + 16 * ((2 * fq) ^ (fr & 7)); PG8_LAS unsigned char* w1 = scr + fr * 128 + 16 * ((2 * fq + 1) ^ (fr & 7));
        const PG8_LAS unsigned char* r0 = scr + r8 * 128 + 16 * (c8 ^ (r8 & 7)); const PG8_LAS unsigned char* r1 = r0 + 8 * 128;
        f32x4 gv[2];
#pragma unroll
        for (int bj = 0; bj < 2; ++bj) gv[bj] = *(const f32x4*)(ADA + (size_t)b * 3072 + 2048 + col0 + bj * HALF);
#pragma unroll
        for (int ai = 0; ai < 2; ++ai) {
            f32x4 xv[4][2][2];
#pragma unroll
            for (int m = 0; m < 4; ++m) { const size_t off = (size_t)(rowb + ai * HALF + m * 16) * 1024 + col0;
#pragma unroll
                for (int bj = 0; bj < 2; ++bj)
#pragma unroll
                    for (int h = 0; h < 2; ++h) xv[m][bj][h] = *(const f32x4*)(X + off + (size_t)h * 8 * 1024 + bj * HALF); }
#pragma unroll
            for (int m = 0; m < 4; ++m) { const size_t off = (size_t)(rowb + ai * HALF + m * 16) * 1024 + col0;
#pragma unroll
                for (int bj = 0; bj < 2; ++bj) {
                    *(PG8_LAS f32x4*)w0 = acc[ai][bj][m][0]; *(PG8_LAS f32x4*)w1 = acc[ai][bj][m][1];
                    const f32x4 t0 = *(const PG8_LAS f32x4*)r0, t1 = *(const PG8_LAS f32x4*)r1;
                    *(f32x4*)(OUT + off + bj * HALF) = xv[m][bj][0] + gv[bj] * t0;
                    *(f32x4*)(OUT + off + (size_t)8 * 1024 + bj * HALF) = xv[m][bj][1] + gv[bj] * t1; } }
        }
    }
};

template <class Epi, class Sched, bool ALIGN_EPI = false, bool SP2 = false>
__device__ __forceinline__ void gemm_phase(PG8_LAS unsigned char* lds, const Gemm g, const Sched& S, const Epi& E) {
    const int tid = threadIdx.x, wid = __builtin_amdgcn_readfirstlane(tid >> 6), lane = tid & 63, wr = wid >> 2, wc = wid & 3, fr = lane & 15, fq = lane >> 4;
    const int K = g.K, nt = K / BK;
    unsigned voffA[2], voffB[2];
#pragma unroll
    for (int i = 0; i < 2; ++i) { int R, C; stage_rc(tid * 16 + i * 8192, R, C); const int Rb = Epi::PERM ? ((R & ~31) + perm32(R & 31)) : R;
        voffA[i] = (unsigned)(R * K + C) * 2u; voffB[i] = (unsigned)(Rb * K + C) * 2u; }
    const size_t kstep = (size_t)(BK * 2);
    const size_t hstep = (size_t)HALF * K * 2;
    const size_t tstep = 2 * hstep;
    const unsigned ldsw = (unsigned)wid * 1024u;
    const int aoff = lds_byte(wr * 64 + fr, fq * 8), boff = lds_byte(wc * 32 + fr, fq * 8);
#define PG8_SA(b, h) (((b) * 2 + (h)) * HTB)
#define PG8_SB(b, h) ((4 + (b) * 2 + (h)) * HTB)
#define PG8_STAGE(bufoff, gbase, voff) do { _Pragma("unroll") for (int _i = 0; _i < 2; ++_i) \
        __builtin_amdgcn_global_load_lds((const unsigned*)((const char*)(gbase) + (voff)[_i]), (PG8_LAS unsigned*)(lds + (bufoff) + ldsw + _i * 8192), 16, 0, 0); } while (0)
#define PG8_LDA(dst, b, h) do { _Pragma("unroll") for (int m = 0; m < 4; ++m) _Pragma("unroll") for (int k = 0; k < 2; ++k) dst[m][k] = *(const PG8_LAS bf16x8*)(lds + PG8_SA(b, h) + aoff + m * 2048 + k * 1024); } while (0)
#define PG8_LDB(dst, b, h) do { _Pragma("unroll") for (int n = 0; n < 2; ++n) _Pragma("unroll") for (int k = 0; k < 2; ++k) dst[n][k] = *(const PG8_LAS bf16x8*)(lds + PG8_SB(b, h) + boff + n * 2048 + k * 1024); } while (0)
#define PG8_MMA(ai, bj, At, Bt) do { __builtin_amdgcn_s_setprio(1); _Pragma("unroll") for (int m = 0; m < 4; ++m) _Pragma("unroll") for (int n = 0; n < 2; ++n) _Pragma("unroll") for (int k = 0; k < 2; ++k) \
        acc[ai][bj][m][n] = __builtin_amdgcn_mfma_f32_16x16x32_bf16(Bt[n][k], At[m][k], acc[ai][bj][m][n], 0, 0, 0); __builtin_amdgcn_s_setprio(0); } while (0)
#define PG8_WAIT_V(n) asm volatile("s_waitcnt vmcnt(" #n ")" ::: "memory")
#define PG8_WAIT_L(n) asm volatile("s_waitcnt lgkmcnt(" #n ")" ::: "memory")
#define PG8_BAR __builtin_amdgcn_s_barrier()
#define PG8_SCHED __builtin_amdgcn_sched_barrier(0)
    Unit cur, nxt; int ui = 0;
    if (!S.next(0, cur)) return;
    f32x4 acc[2][2][4][2];
#pragma unroll
    for (int a = 0; a < 2; ++a)
#pragma unroll
        for (int b = 0; b < 2; ++b)
#pragma unroll
            for (int m = 0; m < 4; ++m)
#pragma unroll
                for (int n = 0; n < 2; ++n) acc[a][b][m][n] = (f32x4){0.f, 0.f, 0.f, 0.f};
    bf16x8 At[4][2], B0[2][2], B1[2][2];
    const char* cA = (const char*)g.A + (size_t)cur.pm * tstep; const char* cB = (const char*)g.Bt + (size_t)cur.pn * tstep;
    S.a_ready(cur);
    if constexpr (SP2) {
        PG8_STAGE(PG8_SB(0, 0), cB, voffB); PG8_STAGE(PG8_SB(0, 1), cB + hstep, voffB); PG8_STAGE(PG8_SA(0, 0), cA, voffA); PG8_STAGE(PG8_SA(0, 1), cA + hstep, voffA);
        if (wr == 1) PG8_BAR;
        PG8_WAIT_V(2); PG8_BAR;
        PG8_STAGE(PG8_SB(1, 0), cB + kstep, voffB); PG8_STAGE(PG8_SA(1, 0), cA + kstep, voffA); PG8_STAGE(PG8_SB(1, 1), cB + hstep + kstep, voffB);
        PG8_WAIT_V(6); PG8_BAR;
    } else {
        PG8_STAGE(PG8_SB(0, 0), cB, voffB); PG8_STAGE(PG8_SA(0, 0), cA, voffA); PG8_STAGE(PG8_SB(0, 1), cB + hstep, voffB); PG8_STAGE(PG8_SA(0, 1), cA + hstep, voffA);
        if (wr == 1) PG8_BAR;
        PG8_WAIT_V(4); PG8_BAR;
        PG8_STAGE(PG8_SB(1, 0), cB + kstep, voffB); PG8_STAGE(PG8_SA(1, 0), cA + kstep, voffA); PG8_STAGE(PG8_SB(1, 1), cB + hstep + kstep, voffB);
        PG8_WAIT_V(6); PG8_BAR;
    }
    for (;;) {
        const bool has_next = S.next(ui + 1, nxt);
        const char* nA = has_next ? (const char*)g.A + (size_t)nxt.pm * tstep : cA; const char* nB = has_next ? (const char*)g.Bt + (size_t)nxt.pn * tstep : cB;
        for (int t = 0; t < nt; t += 2) {
            const bool last = (t == nt - 2);
            const char* a1 = cA + (size_t)(t + 1) * kstep;
            const char* a2 = last ? nA : cA + (size_t)(t + 2) * kstep; const char* b2 = last ? nB : cB + (size_t)(t + 2) * kstep;
            const char* a3 = a2 + kstep; const char* b3 = b2 + kstep;
            if (last && has_next) S.a_ready(nxt);
            if constexpr (Epi::MIDK > 0) { if (t == Epi::MIDK) E.mid(acc, cur, wr, wc, fr, fq); }
            if constexpr (SP2) {
            PG8_LDB(B0, 0, 0); PG8_LDB(B1, 0, 1); PG8_SCHED; PG8_LDA(At, 0, 0); PG8_STAGE(PG8_SA(1, 1), a1 + hstep, voffA);
            PG8_WAIT_V(8); PG8_WAIT_L(0); PG8_BAR; PG8_MMA(0, 0, At, B0); PG8_MMA(0, 1, At, B1); PG8_BAR; PG8_SCHED;
            PG8_LDA(At, 0, 1); PG8_STAGE(PG8_SB(0, 0), b2, voffB); PG8_STAGE(PG8_SB(0, 1), b2 + hstep, voffB); PG8_STAGE(PG8_SA(0, 0), a2, voffA);
            PG8_WAIT_V(8); PG8_WAIT_L(0); PG8_BAR; PG8_MMA(1, 0, At, B0); PG8_MMA(1, 1, At, B1); PG8_BAR; PG8_SCHED;
            PG8_LDB(B0, 1, 0); PG8_LDB(B1, 1, 1); PG8_SCHED; PG8_LDA(At, 1, 0); PG8_STAGE(PG8_SA(0, 1), a2 + hstep, voffA);
            PG8_WAIT_V(8); PG8_WAIT_L(0); PG8_BAR; PG8_MMA(0, 0, At, B0); PG8_MMA(0, 1, At, B1); PG8_BAR; PG8_SCHED;
            PG8_LDA(At, 1, 1); PG8_STAGE(PG8_SB(1, 0), b3, voffB); PG8_STAGE(PG8_SB(1, 1), b3 + hstep, voffB); PG8_STAGE(PG8_SA(1, 0), a3, voffA);
            PG8_WAIT_V(8); PG8_WAIT_L(0); PG8_BAR; PG8_MMA(1, 0, At, B0); PG8_MMA(1, 1, At, B1); PG8_BAR; PG8_SCHED;
            } else {
            PG8_LDB(B0, 0, 0); PG8_SCHED; PG8_LDA(At, 0, 0); PG8_STAGE(PG8_SA(1, 1), a1 + hstep, voffA);
            PG8_WAIT_L(8); PG8_BAR; PG8_WAIT_L(0); PG8_MMA(0, 0, At, B0); PG8_BAR; PG8_SCHED;
            PG8_LDB(B1, 0, 1); PG8_STAGE(PG8_SB(0, 0), b2, voffB);
            PG8_BAR; PG8_WAIT_L(0); PG8_MMA(0, 1, At, B1); PG8_BAR;
            PG8_LDA(At, 0, 1); PG8_STAGE(PG8_SA(0, 0), a2, voffA);
            PG8_BAR; PG8_WAIT_L(0); PG8_MMA(1, 0, At, B0); PG8_BAR; PG8_SCHED;
            PG8_STAGE(PG8_SB(0, 1), b2 + hstep, voffB);
            PG8_WAIT_V(6); PG8_BAR; PG8_MMA(1, 1, At, B1); PG8_BAR;
            PG8_LDB(B0, 1, 0); PG8_SCHED; PG8_LDA(At, 1, 0); PG8_STAGE(PG8_SA(0, 1), a2 + hstep, voffA);
            PG8_WAIT_L(8); PG8_BAR; PG8_WAIT_L(0); PG8_MMA(0, 0, At, B0); PG8_BAR; PG8_SCHED;
            PG8_LDB(B1, 1, 1); PG8_STAGE(PG8_SB(1, 0), b3, voffB);
            PG8_BAR; PG8_WAIT_L(0); PG8_MMA(0, 1, At, B1); PG8_BAR;
            PG8_LDA(At, 1, 1); PG8_STAGE(PG8_SA(1, 0), a3, voffA);
            PG8_BAR; PG8_WAIT_L(0); PG8_MMA(1, 0, At, B0); PG8_BAR; PG8_SCHED;
            PG8_STAGE(PG8_SB(1, 1), b3 + hstep, voffB);
            PG8_WAIT_V(6); PG8_BAR; PG8_MMA(1, 1, At, B1); PG8_BAR;
            }
        }
        if constexpr (ALIGN_EPI) { if (wr == 0) PG8_BAR; }
        if constexpr (!Epi::AFTER_DRAIN) { E(acc, cur, wr, wc, fr, fq); S.done(cur); }
        if (!has_next) break;
#pragma unroll
        for (int a = 0; a < 2; ++a)
#pragma unroll
            for (int b = 0; b < 2; ++b)
#pragma unroll
                for (int m = 0; m < 4; ++m)
#pragma unroll
                    for (int n = 0; n < 2; ++n) acc[a][b][m][n] = (f32x4){0.f, 0.f, 0.f, 0.f};
        cur = nxt; cA = nA; cB = nB; ++ui;
        if constexpr (ALIGN_EPI) { if (wr == 1) PG8_BAR; }
    }
    PG8_WAIT_V(0);
    if constexpr (!ALIGN_EPI) { if (wr == 0) PG8_BAR; }
    PG8_BAR;
#undef PG8_SA
#undef PG8_SB
#undef PG8_STAGE
#undef PG8_LDA
#undef PG8_LDB
#undef PG8_MMA
#undef PG8_WAIT_V
#undef PG8_WAIT_L
#undef PG8_BAR
#undef PG8_SCHED
}
}

constexpr int NWAVES = 8;
constexpr int N_PHASES = 6;
constexpr int BATCH = 8, SEQ = 4096, DM = 1024, M = BATCH * SEQ;
constexpr int NIN = 8704, NHEAD = 24, NG = 3, HPG = 8, HD = 64, CW = 512, CK = 31;
constexpr int ADA_N = 3 * DM;

constexpr size_t MiB = 1u << 20;
constexpr size_t WS_CTL = 0, CTL_ZERO_BYTES = 64 * 1024;
constexpr size_t WS_ADA = 1 * MiB;
constexpr size_t WS_WIN = 422 * MiB;
constexpr size_t WS_WA = 440 * MiB, WS_WO = 442 * MiB;
constexpr size_t WS_LSE = 2 * MiB;
constexpr size_t WS_H = 448 * MiB;
constexpr size_t WS_A2A = 448 * MiB, WS_A2C = 480 * MiB;
constexpr size_t WS_Q = 38 * MiB, WS_K = 134 * MiB, WS_V = 230 * MiB;
constexpr size_t WS_T1 = 134 * MiB, WS_MG = 230 * MiB;
constexpr size_t WS_ZA = 326 * MiB, WS_GLU = 358 * MiB, WS_ZC = 390 * MiB;
constexpr size_t WS_PB = 6 * MiB;
constexpr size_t WS_END = 512 * MiB;

constexpr int RING_OFF = 0, RING_BYTES = 131072;
constexpr int ATT_K0 = 0, ATT_K1 = 49152, ATT_V = 98304, ATT_END = 147456;
constexpr int MISC_OFF = ATT_END;
constexpr int LDS_BYTES = 151552;

#define GAS __attribute__((address_space(1)))
#define LAS __attribute__((address_space(3)))
typedef unsigned short bf16;
typedef unsigned v4u __attribute__((ext_vector_type(4)));
typedef unsigned v2u __attribute__((ext_vector_type(2)));
typedef float f32x4 __attribute__((ext_vector_type(4)));
typedef float f32x2 __attribute__((ext_vector_type(2)));
typedef float f32x16 __attribute__((ext_vector_type(16)));
typedef short bf16x8 __attribute__((ext_vector_type(8)));
typedef short s16x4 __attribute__((ext_vector_type(4)));
#define RLX_AGENT __ATOMIC_RELAXED, __HIP_MEMORY_SCOPE_AGENT
#define LDS_WAIT() asm volatile("s_waitcnt lgkmcnt(0)" ::: "memory")
using pg8::cvt_pk_bf16; using pg8::bf_lo; using pg8::bf_hi; using pg8::sigmoidf_;

#define XB_TMO      128
#define XB_XCNT(j)  (256  + 64 * (j))
#define XB_XSUB(j)  (1280 + 64 * (j))
#define XB_XGEN(j)  (2304 + 64 * (j))
#define XB_TOP      3328
#define XB_TOPGEN   3392
#define XCD_BAR_WORDS 3456
#define XB_SPIN_CAP (1u << 18)
__device__ __forceinline__ unsigned xb_ld(unsigned* p)              { return __hip_atomic_load(p, __ATOMIC_RELAXED, __HIP_MEMORY_SCOPE_AGENT); }
__device__ __forceinline__ unsigned xb_add(unsigned* p, unsigned v) { return __hip_atomic_fetch_add(p, v, __ATOMIC_RELAXED, __HIP_MEMORY_SCOPE_AGENT); }
__device__ __forceinline__ unsigned xb_xcc_id() { return (unsigned)__builtin_amdgcn_s_getreg((3 << 11) | 20) & 0xFu; }
#define XB_SPIN(cond, bar) do { unsigned _sp = 0; while (cond) { __builtin_amdgcn_s_sleep(1); \
    if ((++_sp & 255u) == 0u) { if (xb_ld(&(bar)[XB_TMO])) break; if (_sp > XB_SPIN_CAP) { atomicAdd(&(bar)[XB_TMO], 1u); break; } } } } while (0)
struct XcdBarrier { unsigned* bar; unsigned x; volatile LAS unsigned* st; };
__device__ __forceinline__ XcdBarrier xcd_barrier_post(unsigned* bar, volatile LAS unsigned* st) {
    XcdBarrier b; b.bar = bar; b.x = xb_xcc_id(); b.st = st;
    if (threadIdx.x == 0) (void)xb_add(&bar[XB_XCNT(b.x)], 1u);
    return b;
}
__device__ __forceinline__ void xcd_barrier_complete(unsigned* bar, unsigned x, unsigned& nloc, unsigned& nx) {
    const unsigned G = gridDim.x * gridDim.y * gridDim.z;
    unsigned sum, cnt, mine, sp = 0u;
    for (;;) {
        sum = 0u; cnt = 0u; mine = 0u;
#pragma unroll
        for (unsigned j = 0; j < 16; ++j) { const unsigned c = xb_ld(&bar[XB_XCNT(j)]); sum += c; cnt += (c > 0u) ? 1u : 0u; mine = (j == x) ? c : mine; }
        if (sum == G) break;
        __builtin_amdgcn_s_sleep(1);
        if ((++sp & 255u) == 0u) { if (xb_ld(&bar[XB_TMO])) break; if (sp > XB_SPIN_CAP) { atomicAdd(&bar[XB_TMO], 1u); break; } }
    }
    nloc = mine > 0u ? mine : 1u; nx = cnt > 0u ? cnt : 1u;
}
__device__ __forceinline__ void xcd_barrier(const XcdBarrier& b) {
    asm volatile("s_waitcnt vmcnt(0)" ::: "memory");
    __syncthreads();
    if (threadIdx.x == 0) {
        unsigned* bar = b.bar;
        __builtin_amdgcn_s_waitcnt(0);
        unsigned nloc = b.st[0], nx = b.st[1];
        if (nloc == 0u) { xcd_barrier_complete(bar, b.x, nloc, nx); b.st[0] = nloc; b.st[1] = nx; }
        const unsigned old = xb_add(&bar[XB_XSUB(b.x)], 1u);
        const unsigned gen = old / nloc;
        if (old + 1u == (gen + 1u) * nloc) {
            __builtin_amdgcn_fence(__ATOMIC_RELEASE, "agent");
            asm volatile("s_waitcnt vmcnt(0)" ::: "memory");
            const unsigned og = xb_add(&bar[XB_TOP], 1u);
            const unsigned tg = og / nx;
            if (og + 1u == (tg + 1u) * nx) xb_add(&bar[XB_TOPGEN], 1u);
            else XB_SPIN(xb_ld(&bar[XB_TOPGEN]) == tg, bar);
            __builtin_amdgcn_fence(__ATOMIC_ACQUIRE, "agent");
            xb_add(&bar[XB_XGEN(b.x)], 1u);
            asm volatile("s_waitcnt vmcnt(0)" ::: "memory");
        } else {
            XB_SPIN(xb_ld(&bar[XB_XGEN(b.x)]) == gen, bar);
            __builtin_amdgcn_fence(__ATOMIC_ACQUIRE, "agent");
            asm volatile("s_waitcnt vmcnt(0)" ::: "memory");
        }
    }
    __syncthreads();
}

__device__ __forceinline__ float wave_sum(float v) {
    v += __uint_as_float(__builtin_amdgcn_update_dpp(0u, __float_as_uint(v), 0xB1, 0xF, 0xF, true));
    v += __uint_as_float(__builtin_amdgcn_update_dpp(0u, __float_as_uint(v), 0x4E, 0xF, 0xF, true));
    v += __uint_as_float(__builtin_amdgcn_update_dpp(0u, __float_as_uint(v), 0x124, 0xF, 0xF, true));
    v += __uint_as_float(__builtin_amdgcn_update_dpp(0u, __float_as_uint(v), 0x128, 0xF, 0xF, true));
    { const auto r = __builtin_amdgcn_permlane16_swap(__float_as_uint(v), __float_as_uint(v), false, false); v = __uint_as_float(r[0]) + __uint_as_float(r[1]); }
    { const auto r = __builtin_amdgcn_permlane32_swap(__float_as_uint(v), __float_as_uint(v), false, false); v = __uint_as_float(r[0]) + __uint_as_float(r[1]); }
    return v;
}
__device__ __forceinline__ unsigned f2bf(float f) { unsigned u = __builtin_bit_cast(unsigned, f); return (u + 0x7fffu + ((u >> 16) & 1u)) >> 16; }
__device__ __forceinline__ unsigned pk2(float lo, float hi) { return f2bf(lo) | (f2bf(hi) << 16); }

__device__ __forceinline__ int win_phys(int n0) {
    if (n0 < 4608) { const int reg = n0 / 1536, c = n0 - reg * 1536, head = c >> 6, dh = (c >> 5) & 1; return (reg * 6 + (head >> 2)) * 256 + 128 * dh + 32 * (head & 3); }
    if (n0 >= 5120 && n0 < 6144) { const int c = n0 - 5120, half = c >> 9, cc = c & 511; return (20 + (cc >> 7)) * 256 + 128 * half + (cc & 127); }
    return n0;
}
__device__ __forceinline__ int win_phys_g(int n) { return n; }
template <bool WIN>
__device__ __forceinline__ void p0_transpose_item(const float* W, int K, int N, bf16* WT, LAS float* scr, int item, int lane, int ldt = 0) {
    if (ldt == 0) ldt = K;
    const int nblk = N / 32, kb = item / nblk, nb = item % nblk, k0 = 64 * kb, n0 = 32 * nb;
    const int prow = WIN ? win_phys(n0) : n0;
#pragma unroll 8
    for (int i = 0; i < 32; ++i) { const int kk = 2 * i + (lane >> 5); scr[kk * 33 + (lane & 31)] = __builtin_nontemporal_load(W + (size_t)(k0 + kk) * N + n0 + (lane & 31)); }
    LDS_WAIT(); asm volatile("" ::: "memory");
    const int c = lane & 7;
#pragma unroll
    for (int j = 0; j < 4; ++j) { const int n = (lane >> 3) + 8 * j; const LAS float* s = scr + (8 * c) * 33 + n;
        v4u o; o.x = pk2(s[0 * 33], s[1 * 33]); o.y = pk2(s[2 * 33], s[3 * 33]); o.z = pk2(s[4 * 33], s[5 * 33]); o.w = pk2(s[6 * 33], s[7 * 33]);
        const int rown = (WIN && n0 >= 6656) ? win_phys_g(n0 + n) : prow + n;
        *(GAS v4u*)(WT + (size_t)rown * ldt + k0 + 8 * c) = o; }
    LDS_WAIT(); asm volatile("" ::: "memory");
}

struct Args { const float* in[16]; float* out; unsigned char* ws; int ph_lo, ph_hi; };
__device__ __forceinline__ int crow(int r, int hi) { return (r & 3) + 8 * (r >> 2) + 4 * hi; }
__device__ __forceinline__ s16x4 vtr(const LAS char* p) { typedef short v4i16_t __attribute__((ext_vector_type(4))); return __builtin_bit_cast(s16x4, __builtin_amdgcn_ds_read_tr16_b64_v4i16((LAS v4i16_t*)p)); }

__device__ __forceinline__ void glds16s(const void* sbase, unsigned voff, unsigned lds_dst) { unsigned keep;
    const unsigned long long sb = (unsigned long long)sbase;
    const unsigned lo = (unsigned)__builtin_amdgcn_readfirstlane((int)(unsigned)sb), hi = (unsigned)__builtin_amdgcn_readfirstlane((int)(unsigned)(sb >> 32));
    const unsigned long long sbu = ((unsigned long long)hi << 32) | lo;
    asm volatile("s_mov_b32 %0, m0\n\ts_mov_b32 m0, %3\n\ts_nop 4\n\tglobal_load_lds_dwordx4 %1, %2\n\ts_mov_b32 m0, %0" : "=&s"(keep) : "v"(voff), "s"(sbu), "s"(lds_dst) : "memory"); }
struct KTile { bf16x8 k[4]; };
struct VTile { v4u v[4]; };
__device__ __forceinline__ void load_k(KTile& T, const bf16* Kp, int row0, int r32, int hi) {
    const bf16* kr = Kp + (size_t)(row0 + r32) * HD + 8 * hi;
#pragma unroll
    for (int ks = 0; ks < 4; ++ks) T.k[ks] = *(const GAS bf16x8*)(kr + 16 * ks);
}
__device__ __forceinline__ void load_v(VTile& T, const bf16* Vp, int row0, int lane) {
#pragma unroll
    for (int i = 0; i < 4; ++i) { const int c = lane + 64 * i; T.v[i] = *(const GAS v4u*)(Vp + (size_t)(row0 + (c >> 3)) * HD + (c & 7) * 8); }
}
template <int TAU>
__device__ __forceinline__ void att_tile(const KTile& TK, const VTile& TV, const bf16x8 (&qf)[4], float& m, float& l, f32x16 (&o)[2], LAS char* vl, const LAS char* vrd, int lane, int r32, int hi) {
    f32x16 s = {};
#pragma unroll
    for (int ks = 0; ks < 4; ++ks) s = __builtin_amdgcn_mfma_f32_32x32x16_bf16(TK.k[ks], qf[ks], s, 0, 0, 0);
#pragma unroll
    for (int i = 0; i < 4; ++i) { const int c = lane + 64 * i, key = c >> 3, ch = c & 7; *(LAS v4u*)(vl + (ch >> 2) * 2048 + key * 64 + (ch & 3) * 16) = TV.v[i]; }
    if (TAU == 0) {
#pragma unroll
        for (int r = 0; r < 16; ++r) if (crow(r, hi) < r32) s[r] = -INFINITY;
    }
    if (TAU == 4) {
#pragma unroll
        for (int r = 0; r < 16; ++r) if (crow(r, hi) > r32) s[r] = -INFINITY;
    }
    float tm = fmaxf(fmaxf(s[0], s[1]), s[2]);
#pragma unroll
    for (int r = 3; r < 15; r += 2) tm = fmaxf(fmaxf(tm, s[r]), s[r + 1]);
    tm = fmaxf(tm, s[15]);
    tm = fmaxf(tm, __shfl_xor(tm, 32));
    if (__any(tm > m)) {
        const float mn = fmaxf(m, tm), al = __builtin_amdgcn_exp2f(m - mn);
        l *= al; o[0] = o[0] * al; o[1] = o[1] * al; m = mn;
    }
    float ps = 0.f;
#pragma unroll
    for (int r = 0; r < 16; ++r) { s[r] = __builtin_amdgcn_exp2f(s[r] - m); ps += s[r]; }
    l += ps;
    v4u pw0, pw1;
    pw0.x = cvt_pk_bf16(s[0], s[1]); pw0.y = cvt_pk_bf16(s[2], s[3]); pw0.z = cvt_pk_bf16(s[4], s[5]); pw0.w = cvt_pk_bf16(s[6], s[7]);
    pw1.x = cvt_pk_bf16(s[8], s[9]); pw1.y = cvt_pk_bf16(s[10], s[11]); pw1.z = cvt_pk_bf16(s[12], s[13]); pw1.w = cvt_pk_bf16(s[14], s[15]);
    const bf16x8 pf0 = __builtin_bit_cast(bf16x8, pw0), pf1 = __builtin_bit_cast(bf16x8, pw1);
    LDS_WAIT(); asm volatile("" ::: "memory");
#pragma unroll
    for (int d0 = 0; d0 < 2; ++d0) {
        const s16x4 a0 = vtr(vrd + d0 * 2048), a1 = vtr(vrd + d0 * 2048 + 512), a2 = vtr(vrd + d0 * 2048 + 1024), a3 = vtr(vrd + d0 * 2048 + 1536);
        const bf16x8 vf0 = (bf16x8){a0[0], a0[1], a0[2], a0[3], a1[0], a1[1], a1[2], a1[3]};
        const bf16x8 vf1 = (bf16x8){a2[0], a2[1], a2[2], a2[3], a3[0], a3[1], a3[2], a3[3]};
        o[d0] = __builtin_amdgcn_mfma_f32_32x32x16_bf16(vf0, pf0, o[d0], 0, 0, 0);
        o[d0] = __builtin_amdgcn_mfma_f32_32x32x16_bf16(vf1, pf1, o[d0], 0, 0, 0);
    }
    asm volatile("" ::: "memory");
}

__global__ void __launch_bounds__(NWAVES * 64, 2) mega_fwd(Args args) {
    extern __shared__ __attribute__((aligned(16))) unsigned char lds_raw[];
    LAS unsigned char* lds = (LAS unsigned char*)lds_raw;
    const int tid = threadIdx.x, lane = tid & 63, wave = __builtin_amdgcn_readfirstlane(tid >> 6);
    const int G = gridDim.x; const int bx = blockIdx.x; const int vcu = (G % 8 == 0) ? (bx % 8) * (G / 8) + bx / 8 : bx;
    unsigned char* ws = args.ws;
    const float* x = args.in[0]; const float* cvec = args.in[1]; const float* w_ada = args.in[2]; const float* b_ada = args.in[3]; const float* norm_w = args.in[4];
    const float* w_in = args.in[5]; const float* b_gate = args.in[6]; const float* q_norm_w = args.in[7]; const float* k_norm_w = args.in[8]; const float* w_attn_proj = args.in[9];
    const float* conv_w = args.in[10]; const float* conv_b = args.in[11]; const float* conv_ln_w = args.in[12]; const float* conv_ln_b = args.in[13];
    const float* w_conv_proj = args.in[14]; const float* w_out = args.in[15];
    float* out = args.out;
    float* ADA = (float*)(ws + WS_ADA);
    bf16* WIN = (bf16*)(ws + WS_WIN); bf16* W2 = (bf16*)(ws + WS_WA); bf16* WO = (bf16*)(ws + WS_WO);
    float* LSE = (float*)(ws + WS_LSE);
    bf16* HB = (bf16*)(ws + WS_H); bf16* A2 = (bf16*)(ws + WS_A2A);
    bf16* QB = (bf16*)(ws + WS_Q); bf16* KB = (bf16*)(ws + WS_K); bf16* VB = (bf16*)(ws + WS_V);
    bf16* MG = (bf16*)(ws + WS_MG);
    bf16* ZA = (bf16*)(ws + WS_ZA); bf16* GLU = (bf16*)(ws + WS_GLU); bf16* ZC = (bf16*)(ws + WS_ZC);
    bf16* SG = (bf16*)out;

    if (tid < 32) ((LAS unsigned*)(lds + MISC_OFF))[tid] = 0u;
    __syncthreads();
    XcdBarrier bar = xcd_barrier_post((unsigned*)(ws + WS_CTL) + 4096, (volatile LAS unsigned*)(lds + MISC_OFF) + 8);
#define GRID_BAR(k) xcd_barrier(bar)
    const int lo = args.ph_lo, hi_ph = args.ph_hi;
#define IN(k) (lo <= (k) && (k) < hi_ph)
#define BOTH(k) (IN(k) && IN((k) + 1))
    const int gw = vcu * NWAVES + wave, NGW = G * NWAVES;

    if (IN(0)) {
        {
            LAS float* sc = (LAS float*)lds; LAS float* part = (LAS float*)(lds + 32768);
            if (bx < ADA_N / 64) {
                for (int i = tid; i < BATCH * DM; i += NWAVES * 64) { const float v = cvec[i]; sc[i] = v * sigmoidf_(v); }
                __syncthreads();
                for (int item = bx; item < ADA_N / 64; item += G) {
                    const int j = item * 64 + lane; float a[BATCH];
#pragma unroll
                    for (int b = 0; b < BATCH; ++b) a[b] = 0.f;
#pragma unroll 16
                    for (int kk = 0; kk < 128; ++kk) { const int k = wave * 128 + kk; const float w = __builtin_nontemporal_load(w_ada + (size_t)k * ADA_N + j);
#pragma unroll
                        for (int b = 0; b < BATCH; ++b) a[b] += sc[b * DM + k] * w; }
#pragma unroll
                    for (int b = 0; b < BATCH; ++b) part[(wave * BATCH + b) * 64 + lane] = a[b];
                    __syncthreads();
                    { float s = b_ada[j];
#pragma unroll
                      for (int w = 0; w < NWAVES; ++w) s += part[(w * BATCH + wave) * 64 + lane];
                      ADA[(size_t)wave * ADA_N + j] = s; }
                    __syncthreads();
                }
            }
        }
        if (bx >= ADA_N / 64 || G <= ADA_N / 64) {
            LAS float* scr = (LAS float*)(lds + RING_OFF + wave * 16384);
            constexpr int I_IN = (DM / 64) * (NIN / 32), I_A = (CW / 64) * (DM / 32), I_O = (DM / 64) * (DM / 32);
            constexpr int NITEMS = I_IN + 2 * I_A + I_O;
            const int nsk = G > ADA_N / 64 ? ADA_N / 64 : 0;
            for (int it = (bx - nsk) * NWAVES + wave; it < NITEMS; it += (G - nsk) * NWAVES) {
                int r = it;
                if (r < I_IN) { p0_transpose_item<true>(w_in, DM, NIN, WIN, scr, r, lane); continue; } r -= I_IN;
                if (r < I_A) { p0_transpose_item<false>(w_attn_proj, CW, DM, W2, scr, r, lane, DM); continue; } r -= I_A;
                if (r < I_A) { p0_transpose_item<false>(w_conv_proj, CW, DM, W2 + CW, scr, r, lane, DM); continue; } r -= I_A;
                p0_transpose_item<false>(w_out, DM, DM, WO, scr, r, lane);
            }
        }
        if (BOTH(0)) GRID_BAR(0);
    }

    if (IN(1)) {
        for (int rb = gw; rb < M / 16; rb += NGW) {
            const int row0 = rb * 16, b = row0 >> 12;
            f32x4 gm[4], ga[4];
#pragma unroll
            for (int j = 0; j < 4; ++j) { const int c = 4 * lane + 256 * j;
                const f32x4 nw = *(const f32x4*)(norm_w + c), sc = *(const f32x4*)(ADA + (size_t)b * ADA_N + DM + c);
                gm[j] = nw * (sc + 1.0f); ga[j] = *(const f32x4*)(ADA + (size_t)b * ADA_N + c); }
            for (int r = 0; r < 16; ++r) {
                const GAS f32x4* xr = (const GAS f32x4*)(x + (size_t)(row0 + r) * DM) + lane;
                f32x4 v[4]; float s2 = 0.f;
#pragma unroll
                for (int j = 0; j < 4; ++j) { v[j] = __builtin_nontemporal_load(xr + 64 * j); s2 += (v[j].x * v[j].x + v[j].y * v[j].y) + (v[j].z * v[j].z + v[j].w * v[j].w); }
                const float rstd = __builtin_amdgcn_rsqf(wave_sum(s2) * (1.f / DM) + pg8::NORM_EPS);
                GAS v2u* o8 = (GAS v2u*)(HB + (size_t)(row0 + r) * DM) + lane;
#pragma unroll
                for (int j = 0; j < 4; ++j) { const f32x4 y = v[j] * rstd * gm[j] + ga[j]; v2u w; w.x = cvt_pk_bf16(y.x, y.y); w.y = cvt_pk_bf16(y.z, y.w); o8[64 * j] = w; }
            }
        }
        if (BOTH(1)) GRID_BAR(1);
    }

    if (IN(2)) {
        pg8::Gemm g{HB, WIN, M, NIN, DM}; pg8::StaticOrder S; S.init(M, NIN, G, bx);
        pg8::EpiIn E{QB, (WS_K - WS_Q) / 2, ZA, (WS_ZC - WS_ZA) / 2, GLU, (unsigned char*)SG, q_norm_w, k_norm_w, b_gate, lds + RING_OFF + RING_BYTES + wave * 2048};
        pg8::gemm_phase<pg8::EpiIn, pg8::StaticOrder, true, true>(lds + RING_OFF, g, S, E);
        if (BOTH(2)) GRID_BAR(2);
    }

    if (IN(3)) {
        {
            LAS unsigned* in32 = (LAS unsigned*)lds;
            LAS float* ot = (LAS float*)(lds + 65536);
            const int cp = tid & 255, th = tid >> 8;
            float w0[CK], w1[CK];
#pragma unroll
            for (int j = 0; j < CK; ++j) { const f32x2 w = *(const f32x2*)(conv_w + j * CW + 2 * cp); w0[j] = w.x; w1[j] = w.y; }
            const f32x2 cb = *(const f32x2*)(conv_b + 2 * cp);
            v4u pf[8];
#define CONV_FETCH(TILE) { const int b_ = (TILE) >> 7, t0_ = ((TILE) & 127) * 32; \
                _Pragma("unroll") for (int i = 0; i < 8; ++i) { int c = tid + 512 * i; c = c < 62 * 64 ? c : 62 * 64 - 1; const int r = c >> 6, ch = c & 63, t = t0_ - 30 + r; \
                    v4u val = *(const GAS v4u*)(GLU + ((size_t)b_ * SEQ + (t < 0 ? 0 : t)) * CW + ch * 8); if (t < 0) val = (v4u){0u, 0u, 0u, 0u}; pf[i] = val; } }
            if (bx < M / 32) CONV_FETCH(bx)
            for (int tile = bx; tile < M / 32; tile += G) {
                const int b = tile >> 7, t0 = (tile & 127) * 32; const size_t row0 = (size_t)b * SEQ + t0;
#pragma unroll
                for (int i = 0; i < 8; ++i) { const int c = tid + 512 * i; if (c < 62 * 64) *(LAS v4u*)(lds + (size_t)c * 16) = pf[i]; }
                v4u zc[4];
#pragma unroll
                for (int q = 0; q < 4; ++q) zc[q] = *(const GAS v4u*)(ZC + (row0 + wave + 8 * q) * CW + lane * 8);
                __syncthreads();
                { const int nt_ = tile + G < M / 32 ? tile + G : tile; CONV_FETCH(nt_) }
                unsigned xs[46];
#pragma unroll
                for (int i = 0; i < 46; ++i) xs[i] = in32[(th * 16 + i) * 256 + cp];
#pragma unroll
                for (int tl = 0; tl < 16; ++tl) { float a0 = cb.x, a1 = cb.y;
#pragma unroll
                    for (int j = 0; j < CK; ++j) { const unsigned xv = xs[tl + j]; a0 += w0[j] * bf_lo(xv); a1 += w1[j] * bf_hi(xv); }
                    *(LAS f32x2*)(ot + (th * 16 + tl) * CW + 2 * cp) = (f32x2){a0, a1}; }
                __syncthreads();
                {
                    const f32x4 lw0 = *(const f32x4*)(conv_ln_w + lane * 8), lw1 = *(const f32x4*)(conv_ln_w + lane * 8 + 4);
                    const f32x4 lb0 = *(const f32x4*)(conv_ln_b + lane * 8), lb1 = *(const f32x4*)(conv_ln_b + lane * 8 + 4);
#pragma unroll
                    for (int q = 0; q < 4; ++q) { const int tl = wave + 8 * q;
                        f32x4 v0 = *(const LAS f32x4*)(ot + tl * CW + lane * 8), v1 = *(const LAS f32x4*)(ot + tl * CW + lane * 8 + 4);
                        const float mean = wave_sum((v0.x + v0.y) + (v0.z + v0.w) + (v1.x + v1.y) + (v1.z + v1.w)) * (1.f / CW);
                        v0 = v0 - mean; v1 = v1 - mean;
                        const float var = wave_sum((v0.x * v0.x + v0.y * v0.y) + (v0.z * v0.z + v0.w * v0.w) + (v1.x * v1.x + v1.y * v1.y) + (v1.z * v1.z + v1.w * v1.w)) * (1.f / CW);
                        const float rstd = __builtin_amdgcn_rsqf(var + pg8::NORM_EPS);
                        v0 = v0 * rstd * lw0 + lb0; v1 = v1 * rstd * lw1 + lb1;
                        const v4u zq = zc[q];
                        const float z[8] = {bf_lo(zq.x), bf_hi(zq.x), bf_lo(zq.y), bf_hi(zq.y), bf_lo(zq.z), bf_hi(zq.z), bf_lo(zq.w), bf_hi(zq.w)};
#pragma unroll
                        for (int i = 0; i < 4; ++i) { v0[i] = v0[i] * sigmoidf_(v0[i]) * z[i]; v1[i] = v1[i] * sigmoidf_(v1[i]) * z[4 + i]; }
                        *(GAS v4u*)(A2 + (row0 + tl) * DM + CW + lane * 8) = pg8::pack8(v0, v1); }
                }
                __syncthreads();
            }
#undef CONV_FETCH
        }
        {
            const int r32 = lane & 31, hi = lane >> 5;
            const int vrd_off = (4 * hi + ((lane & 15) >> 2)) * 64 + ((lane >> 4) & 1) * 32 + (lane & 3) * 8;
            const int piece = wave & 3, tsel = wave >> 2;
            bf16* PB = (bf16*)(ws + WS_PB); float* PL = (float*)(ws + WS_LSE);
            const unsigned lds0 = (unsigned)(uintptr_t)lds_raw;
            const unsigned voffK = (unsigned)(((8 * piece + (lane >> 3)) * HD + (((lane & 7) ^ (((8 * piece + (lane >> 3)) >> 1) & 7)) << 3)) * 2);
            const unsigned voffV = (unsigned)(((16 * (piece & 1) + (lane >> 2)) * HD + (piece >> 1) * 32 + (lane & 3) * 8) * 2);
#define XT_CONST int xln_ = lane; asm volatile("" : "+v"(xln_)); const int xl_r = xln_ >> 3, xc0 = (xln_ & 7) ^ (xln_ >> 4);     \
            const unsigned xb_off = (unsigned)(xl_r * 128 + (xln_ & 7) * 16), xa_off = (unsigned)((xln_ & 31) * 128), xa_f = (unsigned)(((xln_ & 31) >> 1) & 7);
#define XT_B(T, I) (*(LAS v4u*)((T) + xb_off + (I) * 1024))
#define XT_A(T, CH) (*(LAS v4u*)((T) + xa_off + ((((unsigned)(CH)) ^ xa_f) << 4)))
#define ATT_BAR() do { asm volatile("s_waitcnt lgkmcnt(0)" ::: "memory"); __builtin_amdgcn_s_barrier(); asm volatile("" ::: "memory"); } while (0)
#define ATT_DMA(ISV, SRC, RROW, JSB, NT, LDSOFF, FORCE) do { \
                _Pragma("unroll") for (int m_ = 0; m_ < 6; ++m_) { const int kt_ = 2 * m_ + tsel; const int js_ = (JSB) + 32 * kt_; \
                    if (m_ < (NT) / 2 && ((FORCE) || js_ >= 0)) \
                        glds16s((SRC) + ((size_t)(RROW) + (js_ < 0 ? 0 : js_)) * HD, ISV ? voffV : voffK, (unsigned)__builtin_amdgcn_readfirstlane((int)(lds0 + (LDSOFF) + kt_ * 4096 + piece * 1024))); } } while (0)
#define ATT_ROUND_(FAST, G_, RROW, IU0, JB, KTB, KBUF, TSH, TOK0, PBO, PBL, MROW0, NKN, QNP, QNROW) do { \
                    const int iq = (IU0) + r32; const int tq = (iq << (TSH)) + (TOK0); \
                    f32x16 S[5]; \
                    _Pragma("unroll") for (int tau = 0; tau < 5; ++tau) { \
                        if ((FAST) || (JB) + 32 * tau >= 0) { \
                            const LAS char* kp = (const LAS char*)(lds + (KBUF) + ((KTB) + tau) * 4096 + r32 * 128); \
                            bf16x8 kf[4]; \
                            _Pragma("unroll") for (int ks = 0; ks < 4; ++ks) kf[ks] = *(const LAS bf16x8*)(kp + (((2 * ks + hi) ^ ((r32 >> 1) & 7)) << 4)); \
                            f32x16 sacc = {}; \
                            _Pragma("unroll") for (int ks = 0; ks < 4; ++ks) sacc = __builtin_amdgcn_mfma_f32_32x32x16_bf16(kf[ks], qf[ks], sacc, 0, 0, 0); \
                              \
                            if (tau == 0) { int rq = r32 - 4 * hi; asm volatile("" : "+v"(rq)); _Pragma("unroll") for (int r = 0; r < 16; ++r) if ((r & 3) + 8 * (r >> 2) < rq) sacc[r] = -INFINITY; } \
                            if (tau == 4) { int rq = r32 - 4 * hi; asm volatile("" : "+v"(rq)); _Pragma("unroll") for (int r = 0; r < 16; ++r) if ((r & 3) + 8 * (r >> 2) > rq) sacc[r] = -INFINITY; } \
                            S[tau] = sacc; \
                        } else { _Pragma("unroll") for (int r = 0; r < 16; ++r) S[tau][r] = -INFINITY; } } \
                    float mx = -INFINITY; \
                    _Pragma("unroll") for (int tau = 0; tau < 5; ++tau) _Pragma("unroll") for (int r = 0; r < 16; r += 2) mx = fmaxf(fmaxf(mx, S[tau][r]), S[tau][r + 1]); \
                    { const auto sw_ = __builtin_amdgcn_permlane32_swap(__float_as_uint(mx), __float_as_uint(mx), false, false); mx = fmaxf(__uint_as_float(sw_[0]), __uint_as_float(sw_[1])); } \
                    float l = 0.f; v4u P[5][2]; \
                    _Pragma("unroll") for (int tau = 0; tau < 5; ++tau) { f32x16 p = S[tau]; float ps = 0.f; \
                        _Pragma("unroll") for (int r = 0; r < 16; ++r) { p[r] = __builtin_amdgcn_exp2f(p[r] - mx); ps += p[r]; } \
                        l += ps; \
                        P[tau][0].x = cvt_pk_bf16(p[0], p[1]); P[tau][0].y = cvt_pk_bf16(p[2], p[3]); P[tau][0].z = cvt_pk_bf16(p[4], p[5]); P[tau][0].w = cvt_pk_bf16(p[6], p[7]); \
                        P[tau][1].x = cvt_pk_bf16(p[8], p[9]); P[tau][1].y = cvt_pk_bf16(p[10], p[11]); P[tau][1].z = cvt_pk_bf16(p[12], p[13]); P[tau][1].w = cvt_pk_bf16(p[14], p[15]); } \
                    { const auto sw_ = __builtin_amdgcn_permlane32_swap(__float_as_uint(l), __float_as_uint(l), false, false); l = __uint_as_float(sw_[0]) + __uint_as_float(sw_[1]); } \
                    asm volatile("s_waitcnt vmcnt(" #NKN ")" ::: "memory"); ATT_BAR();     \
                    XT_CONST LAS char* const xt = (LAS char*)(lds + (KBUF) + wave * 4096); \
                    ATT_LOAD_Q(qn, QNP, QNROW); \
                    if ((G_) < 2) ATT_LOAD_P(PBO, PBL, tq, IU0, TSH, TOK0); \
                    f32x16 o[2]; o[0] = f32x16{}; o[1] = f32x16{}; \
                    _Pragma("unroll") for (int tau = 0; tau < 5; ++tau) { \
                        if ((FAST) || (JB) + 32 * tau >= 0) { \
                            const LAS char* vp = (const LAS char*)(lds + ATT_V + ((KTB) + tau) * 4096 + vrd_off); \
                            const bf16x8 pf0 = __builtin_bit_cast(bf16x8, P[tau][0]), pf1 = __builtin_bit_cast(bf16x8, P[tau][1]); \
                            _Pragma("unroll") for (int d0 = 0; d0 < 2; ++d0) { \
                                const s16x4 a0 = vtr(vp + d0 * 2048), a1 = vtr(vp + d0 * 2048 + 512), a2 = vtr(vp + d0 * 2048 + 1024), a3 = vtr(vp + d0 * 2048 + 1536); \
                                const bf16x8 vf0 = (bf16x8){a0[0], a0[1], a0[2], a0[3], a1[0], a1[1], a1[2], a1[3]}; \
                                const bf16x8 vf1 = (bf16x8){a2[0], a2[1], a2[2], a2[3], a3[0], a3[1], a3[2], a3[3]}; \
                                o[d0] = __builtin_amdgcn_mfma_f32_32x32x16_bf16(vf0, pf0, o[d0], 0, 0, 0); \
                                o[d0] = __builtin_amdgcn_mfma_f32_32x32x16_bf16(vf1, pf1, o[d0], 0, 0, 0); } } } \
                    float lse = mx + __builtin_amdgcn_logf(l), sc_own = __builtin_amdgcn_rcpf(l), sc_p = 0.f; \
                    if ((G_) < 2) { const float mx2 = fmaxf(lse, plse), a = __builtin_amdgcn_exp2f(lse - mx2), bq = __builtin_amdgcn_exp2f(plse - mx2), inv = __builtin_amdgcn_rcpf(a + bq); \
                        sc_own = sc_own * a * inv; sc_p = bq * inv; lse = mx2 + __builtin_amdgcn_logf(a + bq); } \
                      \
                    if ((G_) < 2) { _Pragma("unroll") for (int i = 0; i < 4; ++i) XT_B(xt, i) = pq[i]; _Pragma("unroll") for (int c = 0; c < 4; ++c) pq[c] = XT_A(xt, 2 * c + hi); } \
                    if ((G_) < 2) { _Pragma("unroll") for (int c = 0; c < 4; ++c) { const auto rx = __builtin_amdgcn_permlane32_swap(pq[c].x, pq[c].z, false, false); const auto ry = __builtin_amdgcn_permlane32_swap(pq[c].y, pq[c].w, false, false); \
                        pp[2 * c] = (v2u){rx[0], ry[0]}; pp[2 * c + 1] = (v2u){rx[1], ry[1]}; } } \
                    if ((G_) > 0) { \
                        _Pragma("unroll") for (int d0 = 0; d0 < 2; ++d0) _Pragma("unroll") for (int j = 0; j < 2; ++j) { v2u w[2]; \
                            _Pragma("unroll") for (int q = 0; q < 2; ++q) { const int rg = 2 * j + q; \
                                float e0 = o[d0][4 * rg] * sc_own, e1 = o[d0][4 * rg + 1] * sc_own, e2 = o[d0][4 * rg + 2] * sc_own, e3 = o[d0][4 * rg + 3] * sc_own; \
                                if ((G_) < 2) { const v2u pw = pp[d0 * 4 + rg]; e0 += sc_p * bf_lo(pw.x); e1 += sc_p * bf_hi(pw.x); e2 += sc_p * bf_lo(pw.y); e3 += sc_p * bf_hi(pw.y); } \
                                w[q].x = cvt_pk_bf16(e0, e1); w[q].y = cvt_pk_bf16(e2, e3); } \
                            const auto rx = __builtin_amdgcn_permlane32_swap(w[0].x, w[1].x, false, false); const auto ry = __builtin_amdgcn_permlane32_swap(w[0].y, w[1].y, false, false); \
                            XT_A(xt, 2 * (d0 * 2 + j) + hi) = (v4u){rx[0], ry[0], rx[1], ry[1]}; } \
                        _Pragma("unroll") for (int i = 0; i < 4; ++i) *(GAS v4u*)((PBO) + (size_t)((((IU0) + xl_r + 8 * i) << (TSH)) + (TOK0)) * HD + 8 * (xc0 ^ (4 * (i & 1)))) = XT_B(xt, i); \
                        if (hi == 0) (PBL)[tq] = lse; \
                    } else { \
                        const size_t mrow = (size_t)(MROW0) + tq; \
                        v4u zq[4]; v2u zz[8]; \
                        _Pragma("unroll") for (int i = 0; i < 4; ++i) zq[i] = *(const GAS v4u*)(ZA + ((size_t)(MROW0) + ((((IU0) + xl_r + 8 * i) << (TSH)) + (TOK0))) * CW + h * 64 + 8 * (xc0 ^ (4 * (i & 1)))); \
                        _Pragma("unroll") for (int i = 0; i < 4; ++i) XT_B(xt, i) = zq[i]; _Pragma("unroll") for (int c = 0; c < 4; ++c) zq[c] = XT_A(xt, 2 * c + hi); \
                        _Pragma("unroll") for (int c = 0; c < 4; ++c) { const auto rx = __builtin_amdgcn_permlane32_swap(zq[c].x, zq[c].z, false, false); const auto ry = __builtin_amdgcn_permlane32_swap(zq[c].y, zq[c].w, false, false); \
                            zz[2 * c] = (v2u){rx[0], ry[0]}; zz[2 * c + 1] = (v2u){rx[1], ry[1]}; } \
                        _Pragma("unroll") for (int d0 = 0; d0 < 2; ++d0) _Pragma("unroll") for (int j = 0; j < 2; ++j) { v2u w[2]; \
                            _Pragma("unroll") for (int q = 0; q < 2; ++q) { const int rg = 2 * j + q; const v2u pw = pp[d0 * 4 + rg]; const v2u zw = zz[d0 * 4 + rg]; \
                                const float e0 = (o[d0][4 * rg] * sc_own + sc_p * bf_lo(pw.x)) * bf_lo(zw.x), e1 = (o[d0][4 * rg + 1] * sc_own + sc_p * bf_hi(pw.x)) * bf_hi(zw.x); \
                                const float e2 = (o[d0][4 * rg + 2] * sc_own + sc_p * bf_lo(pw.y)) * bf_lo(zw.y), e3 = (o[d0][4 * rg + 3] * sc_own + sc_p * bf_hi(pw.y)) * bf_hi(zw.y); \
                                w[q].x = cvt_pk_bf16(e0, e1); w[q].y = cvt_pk_bf16(e2, e3); } \
                            const auto rx = __builtin_amdgcn_permlane32_swap(w[0].x, w[1].x, false, false); const auto ry = __builtin_amdgcn_permlane32_swap(w[0].y, w[1].y, false, false); \
                            XT_A(xt, 2 * (d0 * 2 + j) + hi) = (v4u){rx[0], ry[0], rx[1], ry[1]}; } \
                        _Pragma("unroll") for (int i = 0; i < 4; ++i) *(GAS v4u*)(A2 + ((size_t)(MROW0) + ((((IU0) + xl_r + 8 * i) << (TSH)) + (TOK0))) * DM + h * 64 + 8 * (xc0 ^ (4 * (i & 1)))) = XT_B(xt, i); } \
                    ATT_XCH_Q(xt); \
                } while (0)
#define ATT_ROUND(...) ATT_ROUND_(0, __VA_ARGS__)
#define ATT_LOAD_Q(DST, QP, ROW0) do { _Pragma("unroll") for (int i = 0; i < 4; ++i) DST[i] = *(const GAS v4u*)((QP) + (size_t)((ROW0) + xl_r + 8 * i) * HD + 8 * (xc0 ^ (4 * (i & 1)))); } while (0)
#define ATT_XCH_Q(T) do { _Pragma("unroll") for (int i = 0; i < 4; ++i) XT_B(T, i) = qn[i]; _Pragma("unroll") for (int ks = 0; ks < 4; ++ks) qf[ks] = __builtin_bit_cast(bf16x8, XT_A(T, 2 * ks + hi)); } while (0)
#define ATT_LOAD_P(PBO, PBL, TQ, IU0, TSH, TOK0) do { _Pragma("unroll") for (int i = 0; i < 4; ++i) pq[i] = *(const GAS v4u*)((PBO) + (size_t)((((IU0) + xl_r + 8 * i) << (TSH)) + (TOK0)) * HD + 8 * (xc0 ^ (4 * (i & 1)))); \
                plse = (PBL)[TQ]; } while (0)
            bf16x8 qf[4]; v4u qn[4], pq[4]; v2u pp[8]; float plse;
            {
                const int NCH = BATCH * HPG * 16;
                if (vcu < NCH) { const int bh = vcu >> 4, res = vcu & 15; const size_t base = (size_t)(((bh >> 3) * 3 + 2) * 8 + (bh & 7)) * SEQ * HD;
                    { XT_CONST ATT_LOAD_Q(qn, QB + base, res * 256 + 32 * wave); ATT_XCH_Q((LAS char*)(lds + ATT_K1 + wave * 4096)); }
                    asm volatile("s_waitcnt vmcnt(0)" ::: "memory"); ATT_BAR();
                    ATT_DMA(false, KB + base, res * 256, 0, 8, ATT_K0, false); }
                int kpar = 0;
                for (int ch = vcu; ch < NCH; ch += G, kpar ^= 1) {
                    const int bh = ch >> 4, res = ch & 15, b = bh >> 3, h = bh & 7; const size_t base = (size_t)((b * 3 + 2) * 8 + h) * SEQ * HD;
                    const int chn = ch + G < NCH ? ch + G : ch, bhn = chn >> 4, resn = chn & 15; const size_t basen = (size_t)(((bhn >> 3) * 3 + 2) * 8 + (bhn & 7)) * SEQ * HD;
                    const int kbuf = kpar ? ATT_K1 : ATT_K0, knext = kpar ? ATT_K0 : ATT_K1;
                    if (ch == vcu) asm volatile("s_waitcnt vmcnt(0)" ::: "memory");
                    asm volatile("" : "+v"(qf[0]), "+v"(qf[1]), "+v"(qf[2]), "+v"(qf[3]));
                    ATT_BAR();
                    ATT_DMA(true, VB + base, res * 256, 0, 8, ATT_V, false);
                    if (ch + G < NCH) { ATT_DMA(false, KB + basen, resn * 256, 0, 8, knext, true);
                        if (wave >= 4) { ATT_ROUND_(1, 2, res * 256, 32 * wave, 32 * wave - 128, wave - 4, kbuf, 4, res, PB + (size_t)bh * SEQ * HD, PL + (size_t)bh * SEQ, 0, 4, QB + basen, resn * 256 + 32 * wave); }
                        else { ATT_ROUND(2, res * 256, 32 * wave, 32 * wave - 128, wave - 4, kbuf, 4, res, PB + (size_t)bh * SEQ * HD, PL + (size_t)bh * SEQ, 0, 4, QB + basen, resn * 256 + 32 * wave); } }
                    else { ATT_ROUND(2, res * 256, 32 * wave, 32 * wave - 128, wave - 4, kbuf, 4, res, PB + (size_t)bh * SEQ * HD, PL + (size_t)bh * SEQ, 0, 0, QB + basen, resn * 256 + 32 * wave); }
                }
                asm volatile("s_waitcnt vmcnt(0)" ::: "memory"); ATT_BAR();
            }
            GRID_BAR(6);
            for (int item = vcu; item < BATCH * HPG * 4; item += G) {
                const int span = item & 3, h = (item >> 2) & 7, b = item >> 5, bh = b * 8 + h;
                bf16* pbo = PB + (size_t)bh * SEQ * HD; float* pbl = PL + (size_t)bh * SEQ;
                const size_t base1 = (size_t)((b * 3 + 1) * 8 + h) * SEQ * HD, base0 = (size_t)((b * 3 + 0) * 8 + h) * SEQ * HD;
#define ITEM_RND(RD, G_, BASE_, RROW_, QB0_, TSH_, TOK0_) const int G_ = (RD) < 4 ? 1 : 0; const size_t BASE_ = (RD) < 4 ? base1 : base0; \
                const int RROW_ = (RD) < 4 ? (RD) * 1024 : 0, QB0_ = (RD) < 4 ? (span << 8) : (span << 10) + (((RD) - 4) << 8), TSH_ = (RD) < 4 ? 2 : 0, TOK0_ = (RD) < 4 ? (RD) : 0;
                { ITEM_RND(0, g_, base_, rrow_, qb0_, tsh_, tok0_)
                  { XT_CONST ATT_LOAD_Q(qn, QB + base_, rrow_ + qb0_ + 32 * wave); ATT_XCH_Q((LAS char*)(lds + ATT_K1 + wave * 4096)); }
                  asm volatile("s_waitcnt vmcnt(0)" ::: "memory"); ATT_BAR();
                  ATT_DMA(false, KB + base_, rrow_, qb0_ - 128, 12, ATT_K0, false); }
                for (int rd = 0; rd < 8; ++rd) {
                    ITEM_RND(rd, g, base, rrow, qb0, tsh, tok0)
                    const int rdn = rd + 1 < 8 ? rd + 1 : rd; ITEM_RND(rdn, gn, basen, rrown, qb0n, tshn, tok0n)
                    const int kbuf = (rd & 1) ? ATT_K1 : ATT_K0, knext = (rd & 1) ? ATT_K0 : ATT_K1;
                    if (rd == 0 || rd == 4) asm volatile("s_waitcnt vmcnt(0)" ::: "memory");
                    asm volatile("" : "+v"(qf[0]), "+v"(qf[1]), "+v"(qf[2]), "+v"(qf[3]));
                    ATT_BAR();
                    ATT_DMA(true, VB + base, rrow, qb0 - 128, 12, ATT_V, false);
                    if (rd + 1 < 8) { ATT_DMA(false, KB + basen, rrown, qb0n - 128, 12, knext, true);
                        if (qb0 + 32 * wave - 128 >= 0) { ATT_ROUND_(1, g, rrow, qb0 + 32 * wave, qb0 + 32 * wave - 128, wave, kbuf, tsh, tok0, pbo, pbl, (size_t)b * SEQ, 6, QB + basen, rrown + qb0n + 32 * wave); }
                        else { ATT_ROUND(g, rrow, qb0 + 32 * wave, qb0 + 32 * wave - 128, wave, kbuf, tsh, tok0, pbo, pbl, (size_t)b * SEQ, 6, QB + basen, rrown + qb0n + 32 * wave); } }
                    else { ATT_ROUND(g, rrow, qb0 + 32 * wave, qb0 + 32 * wave - 128, wave, kbuf, tsh, tok0, pbo, pbl, (size_t)b * SEQ, 0, QB + basen, rrown + qb0n + 32 * wave); }
                }
#undef ITEM_RND
            }
            asm volatile("s_waitcnt vmcnt(0)" ::: "memory"); ATT_BAR();
#undef ATT_BAR
#undef ATT_DMA
#undef ATT_ROUND
#undef ATT_ROUND_
#undef ATT_LOAD_Q
#undef ATT_XCH_Q
#undef XT_CONST
#undef XT_A
#undef XT_B
#undef ATT_LOAD_P
        }
        if (BOTH(3)) GRID_BAR(3);
    }

    if (IN(4)) {
        { pg8::Gemm g{A2, W2, M, DM, DM}; pg8::StaticOrder S; S.init(M, DM, G, bx);
          pg8::EpiMerge2 E{(const unsigned char*)SG, MG, lds + RING_OFF + RING_BYTES + wave * 2048};
          pg8::gemm_phase<pg8::EpiMerge2, pg8::StaticOrder, true, true>(lds + RING_OFF, g, S, E); }
        if (BOTH(4)) GRID_BAR(4);
    }

    if (IN(5)) {
        pg8::Gemm g{MG, WO, M, DM, DM}; pg8::StaticOrder S; S.init(M, DM, G, bx);
        pg8::EpiOut E{x, out, ADA, lds + RING_OFF + RING_BYTES + wave * 2048};
        pg8::gemm_phase<pg8::EpiOut, pg8::StaticOrder, true, true>(lds + RING_OFF, g, S, E);
    }
#undef IN
#undef BOTH
}

extern "C" void kernel_launch(void* const* d_in, const int* in_sizes, int n_in, void* d_out, int out_size, void* d_ws, size_t ws_size, hipStream_t stream) {
    static int grid = 0;
    if (grid == 0) {
        if (n_in != 16 || in_sizes[0] != M * DM || out_size != M * DM || ws_size < WS_END) { fprintf(stderr, "kernel_launch: unexpected shapes (n_in %d, in0 %d, out %d, ws %zu)\n", n_in, n_in > 0 ? in_sizes[0] : -1, out_size, ws_size); grid = -1; return; }
        int dev = 0, cus = 0, per_cu = 0;
        if (hipGetDevice(&dev) != hipSuccess || hipDeviceGetAttribute(&cus, hipDeviceAttributeMultiprocessorCount, dev) != hipSuccess) { grid = -1; return; }
        if (hipFuncSetAttribute((const void*)mega_fwd, hipFuncAttributeMaxDynamicSharedMemorySize, LDS_BYTES) != hipSuccess) { fprintf(stderr, "kernel_launch: hipFuncSetAttribute failed\n"); grid = -1; return; }
        if (hipOccupancyMaxActiveBlocksPerMultiprocessor(&per_cu, (const void*)mega_fwd, NWAVES * 64, LDS_BYTES) != hipSuccess || per_cu < 1) { fprintf(stderr, "kernel_launch: occupancy query says %d\n", per_cu); (void)hipGetLastError(); per_cu = 1; }
        if (per_cu > 1) per_cu = 1;
        grid = cus * per_cu;
    }
    if (grid < 0) return;
    (void)hipMemsetAsync((char*)d_ws + WS_CTL, 0, CTL_ZERO_BYTES, stream);
    Args a{};
    for (int i = 0; i < 16; ++i) a.in[i] = (const float*)d_in[i];
    a.out = (float*)d_out; a.ws = (unsigned char*)d_ws;
    a.ph_lo = 0; a.ph_hi = N_PHASES;
    hipLaunchKernelGGL(mega_fwd, dim3(grid), dim3(NWAVES * 64), LDS_BYTES, stream, a);
}
```

```cpp
#include <hip/hip_runtime.h>
#include <cstdio>
#include <cstdint>

namespace pg8 {
#define PG8_LAS __attribute__((address_space(3)))
typedef unsigned short bf16_t;
typedef short bf16x8 __attribute__((ext_vector_type(8)));
typedef float f32x4 __attribute__((ext_vector_type(4)));
typedef unsigned u32x4 __attribute__((ext_vector_type(4)));
constexpr int BM = 256, BK = 64, HALF = 128, HTB = HALF * BK * 2, STAGE_BYTES = 8 * HTB, NXCD = 8, WGM = 8;

__host__ __device__ __forceinline__ int lds_byte(int r, int c) { const int st = (r >> 4) * 2 + (c >> 5), rr = r & 15, cc = c & 31, ob = rr * 64 + cc * 2; return st * 1024 + (ob ^ (((ob >> 9) & 1) << 5)); }
__host__ __device__ __forceinline__ void stage_rc(int b, int& R, int& C) { const int st = b / 1024, sb = b % 1024, swz = sb ^ (((sb >> 9) & 1) << 5); R = (st >> 1) * 16 + swz / 64; C = (st & 1) * 32 + (swz % 64) / 2; }
__host__ __device__ __forceinline__ int perm32(int rho) { const int n = rho >> 4, i = rho & 15; return 8 * (i >> 2) + 4 * n + (i & 3); }

struct Unit { int pm, pn; };
struct Gemm { const bf16_t* A; const bf16_t* Bt; int M, N, K; };

struct StaticOrder {
    int nM, nN, nwg, G, c;
    __host__ __device__ void init(int M, int N, int G_, int c_) { nM = M / BM; nN = N / BM; nwg = nM * nN; G = G_; c = c_; }
    __host__ __device__ bool next(int i, Unit& u) const {
        const long L = (long)i * G + c; if (L >= nwg) return false;
        int wgid = (int)L; { const int q = nwg / NXCD, r = nwg % NXCD, xcd = wgid % NXCD, off = wgid / NXCD; wgid = (xcd < r ? xcd * (q + 1) : r * (q + 1) + (xcd - r) * q) + off; }
        const int nig = WGM * nN, gid = wgid / nig, fm = gid * WGM, gsz = (nM - fm) < WGM ? (nM - fm) : WGM;
        u.pm = fm + ((wgid % nig) % gsz); u.pn = (wgid % nig) / gsz; return true;
    }
    __device__ __forceinline__ void a_ready(const Unit&) const {}
    __device__ __forceinline__ void done(const Unit&) const {}
};

typedef float f32x2_t __attribute__((ext_vector_type(2))); typedef __bf16 bf16x2_t __attribute__((ext_vector_type(2)));
__device__ __forceinline__ unsigned cvt_pk_bf16(float lo, float hi) { f32x2_t v = {lo, hi}; bf16x2_t b = __builtin_convertvector(v, bf16x2_t); return __builtin_bit_cast(unsigned, b); }
__device__ __forceinline__ float bf_lo(unsigned w) { return __uint_as_float(w << 16); }
__device__ __forceinline__ float bf_hi(unsigned w) { return __uint_as_float(w & 0xffff0000u); }
__device__ __forceinline__ float sigmoidf_(float x) { return __builtin_amdgcn_rcpf(1.0f + __builtin_amdgcn_exp2f(-1.4426950408889634f * x)); }
__device__ __forceinline__ u32x4 pack8(const f32x4& a, const f32x4& b) { u32x4 w; w.x = cvt_pk_bf16(a[0], a[1]); w.y = cvt_pk_bf16(a[2], a[3]); w.z = cvt_pk_bf16(b[0], b[1]); w.w = cvt_pk_bf16(b[2], b[3]); return w; }


constexpr float QSCALE = 0.125f * 1.4426950408889634f;
constexpr float NORM_EPS = 1e-6f;
#define PG8_XPOSE(P0, P1, T0, T1) do { *(PG8_LAS u32x4*)xw0 = (P0); *(PG8_LAS u32x4*)xw1 = (P1); T0 = *(const PG8_LAS u32x4*)xr0; T1 = *(const PG8_LAS u32x4*)(xr0 + 1024); } while (0)
#define PG8_XPOSE_ADDR PG8_LAS unsigned char* xw0 = scr + fr * 128 + 16 * (fq ^ (fr & 7)); PG8_LAS unsigned char* xw1 = scr + fr * 128 + 16 * ((4 + fq) ^ (fr & 7)); \
        const int r8 = 2 * fq + (fr >> 3), c8 = fr & 7; const PG8_LAS unsigned char* xr0 = scr + r8 * 128 + 16 * (c8 ^ (r8 & 7));
__device__ __forceinline__ size_t sg_frag(int pm, int t, int ai, int m, int wave, int lane) { return ((((((size_t)pm * 8 + t) * 2 + ai) * 4 + m) * 8 + wave) * 64 + lane) * 16; }
struct EpiIn {
    static constexpr bool PERM = true, AFTER_DRAIN = false; static constexpr int MIDK = 0;
    bf16_t *Q; size_t qkv_stride; bf16_t *ZA; size_t zc_off; bf16_t *GLU; unsigned char* SG; const float *qw, *kw, *bgate; PG8_LAS unsigned char* scr;
    __device__ __forceinline__ void operator()(const f32x4 (&acc)[2][2][4][2], const Unit& u, int wr, int wc, int fr, int fq) const {
        const int pn = u.pn;
        PG8_XPOSE_ADDR
        const int rown = u.pm * BM + wr * 64 + r8;
        if (pn < 18) {
            const int kind = pn / 6, rel = pn - kind * 6, g = rel >> 1, hb = ((rel & 1) << 2) + wc, sh = 2 * g;
            bf16_t* base = Q + (size_t)kind * qkv_stride;
            f32x4 wv[2][2];
            if (kind < 2) { const float* w = qw; if (kind == 1) w = kw; const float sc = kind == 0 ? QSCALE : 1.0f;
#pragma unroll
                for (int bj = 0; bj < 2; ++bj)
#pragma unroll
                    for (int n = 0; n < 2; ++n) wv[bj][n] = *(const f32x4*)(w + 32 * bj + 8 * fq + 4 * n) * sc; }
#pragma unroll
            for (int ai = 0; ai < 2; ++ai)
#pragma unroll
                for (int m = 0; m < 4; ++m) {
                    f32x4 v00 = acc[ai][0][m][0], v01 = acc[ai][0][m][1], v10 = acc[ai][1][m][0], v11 = acc[ai][1][m][1];
                    if (kind < 2) {
                        f32x4 q = v00 * v00 + v01 * v01 + v10 * v10 + v11 * v11; float ss = (q[0] + q[1]) + (q[2] + q[3]);
                        { const auto r16 = __builtin_amdgcn_permlane16_swap(__float_as_uint(ss), __float_as_uint(ss), false, false); ss = __uint_as_float(r16[0]) + __uint_as_float(r16[1]);
                          const auto r32_ = __builtin_amdgcn_permlane32_swap(__float_as_uint(ss), __float_as_uint(ss), false, false); ss = __uint_as_float(r32_[0]) + __uint_as_float(r32_[1]); }
                        const float rstd = __builtin_amdgcn_rsqf(ss * (1.0f / 64.0f) + NORM_EPS);
                        v00 = v00 * rstd * wv[0][0]; v01 = v01 * rstd * wv[0][1]; v10 = v10 * rstd * wv[1][0]; v11 = v11 * rstd * wv[1][1];
                    }
                    u32x4 t0, t1; PG8_XPOSE(pack8(v00, v01), pack8(v10, v11), t0, t1);
#pragma unroll
                    for (int h = 0; h < 2; ++h) { const int row = rown + ai * HALF + m * 16 + 8 * h, b = row >> 12, t = row & 4095;
                        const int tp = ((t & ((1 << sh) - 1)) << (12 - sh)) | (t >> sh);
                        __builtin_nontemporal_store(h ? t1 : t0, (u32x4*)(base + ((size_t)(((b * 3 + g) * 8 + hb) * 4096 + tp) * 64 + 8 * c8))); }
                }
        } else if (pn < 20 || (pn >= 24 && pn < 26)) {
            bf16_t* base = ZA + (pn < 20 ? (size_t)0 : zc_off); const int rel = pn < 20 ? pn - 18 : pn - 24; const int colN = rel * BM + wc * 32 + (c8 >> 2) * HALF + 8 * (c8 & 3);
#pragma unroll
            for (int ai = 0; ai < 2; ++ai)
#pragma unroll
                for (int m = 0; m < 4; ++m) { u32x4 p[2];
#pragma unroll
                    for (int bj = 0; bj < 2; ++bj) { f32x4 a = acc[ai][bj][m][0], b = acc[ai][bj][m][1];
#pragma unroll
                        for (int i = 0; i < 4; ++i) { a[i] = a[i] * sigmoidf_(a[i]); b[i] = b[i] * sigmoidf_(b[i]); }
                        p[bj] = pack8(a, b); }
                    u32x4 t0, t1; PG8_XPOSE(p[0], p[1], t0, t1);
                    bf16_t* dst = base + (size_t)(rown + ai * HALF + m * 16) * 512 + colN;
                    __builtin_nontemporal_store(t0, (u32x4*)dst); __builtin_nontemporal_store(t1, (u32x4*)(dst + 8 * 512)); }
        } else if (pn < 24) {
            const int colN = (pn - 20) * HALF + wc * 32 + 8 * (c8 & 3);
#pragma unroll
            for (int ai = 0; ai < 2; ++ai)
#pragma unroll
                for (int mp = 0; mp < 2; ++mp) { u32x4 p[2];
#pragma unroll
                    for (int q = 0; q < 2; ++q) { const int m = 2 * mp + q;
                        f32x4 a0 = acc[ai][0][m][0], a1 = acc[ai][0][m][1]; const f32x4 b0 = acc[ai][1][m][0], b1 = acc[ai][1][m][1];
#pragma unroll
                        for (int i = 0; i < 4; ++i) { a0[i] = a0[i] * sigmoidf_(b0[i]); a1[i] = a1[i] * sigmoidf_(b1[i]); }
                        p[q] = pack8(a0, a1); }
                    u32x4 t0, t1; PG8_XPOSE(p[0], p[1], t0, t1);
                    bf16_t* dst = GLU + (size_t)(rown + ai * HALF + (2 * mp + (c8 >> 2)) * 16) * 512 + colN;
                    __builtin_nontemporal_store(t0, (u32x4*)dst); __builtin_nontemporal_store(t1, (u32x4*)(dst + 8 * 512)); }
        } else {
            const int t = pn - 26; const int gc0 = t * BM + wc * 32 + 8 * fq;
            f32x4 bv[2][2];
#pragma unroll
            for (int bj = 0; bj < 2; ++bj)
#pragma unroll
                for (int n = 0; n < 2; ++n) bv[bj][n] = *(const f32x4*)(bgate + gc0 + HALF * bj + 4 * n);
#pragma unroll
            for (int ai = 0; ai < 2; ++ai)
#pragma unroll
                for (int m = 0; m < 4; ++m) {
                    u32x4 w;
#pragma unroll
                    for (int bj = 0; bj < 2; ++bj) { f32x4 a = acc[ai][bj][m][0] + bv[bj][0], b = acc[ai][bj][m][1] + bv[bj][1];
                        unsigned wa = 0u, wb = 0u;
#pragma unroll
                        for (int i = 0; i < 4; ++i) { wa = __builtin_amdgcn_cvt_pk_u8_f32(sigmoidf_(a[i]) * 255.0f, i, wa); wb = __builtin_amdgcn_cvt_pk_u8_f32(sigmoidf_(b[i]) * 255.0f, i, wb); }
                        if (bj == 0) { w.x = wa; w.y = wb; } else { w.z = wa; w.w = wb; } }
                    __builtin_nontemporal_store(w, (u32x4*)(SG + sg_frag(u.pm, t, ai, m, wr * 4 + wc, fq * 16 + fr))); }
        }
    }
};
struct EpiMerge2 {
    static constexpr bool PERM = true, AFTER_DRAIN = false; static constexpr int MIDK = 8;
    const unsigned char* SG; bf16_t* OUT; PG8_LAS unsigned char* scr;
    __device__ __forceinline__ void mid(f32x4 (&acc)[2][2][4][2], const Unit& u, int wr, int wc, int fr, int fq) const {
        asm volatile("" : "+v"(fr), "+v"(fq));
        const int wave = wr * 4 + wc, lane = fq * 16 + fr;
#pragma unroll
        for (int ai = 0; ai < 2; ++ai) {
            u32x4 ga[4], gc[4];
#pragma unroll
            for (int m = 0; m < 4; ++m) { ga[m] = *(const u32x4*)(SG + sg_frag(u.pm, u.pn, ai, m, wave, lane)); gc[m] = *(const u32x4*)(SG + sg_frag(u.pm, u.pn + 4, ai, m, wave, lane)); }
#pragma unroll
            for (int m = 0; m < 4; ++m)
#pragma unroll
                for (int bj = 0; bj < 2; ++bj) {
                    const unsigned gax = bj ? ga[m].z : ga[m].x, gay = bj ? ga[m].w : ga[m].y, gcx = bj ? gc[m].z : gc[m].x, gcy = bj ? gc[m].w : gc[m].y;
                    f32x4& a = acc[ai][bj][m][0]; f32x4& b = acc[ai][bj][m][1];
#pragma unroll
                    for (int i = 0; i < 4; ++i) {
                        a[i] *= (float)((gax >> (8 * i)) & 255u) * __builtin_amdgcn_rcpf(fmaxf((float)((gcx >> (8 * i)) & 255u), 0.5f));
                        b[i] *= (float)((gay >> (8 * i)) & 255u) * __builtin_amdgcn_rcpf(fmaxf((float)((gcy >> (8 * i)) & 255u), 0.5f)); } }
            asm volatile("" ::: "memory"); }
    }
    __device__ __forceinline__ void operator()(const f32x4 (&acc)[2][2][4][2], const Unit& u, int wr, int wc, int fr, int fq) const {
        asm volatile("" : "+v"(fr), "+v"(fq));
        const int wave = wr * 4 + wc, lane = fq * 16 + fr;
        PG8_XPOSE_ADDR
        const int rown = u.pm * BM + wr * 64 + r8, colN = u.pn * BM + wc * 32 + (c8 >> 2) * HALF + 8 * (c8 & 3);
#pragma unroll
        for (int ai = 0; ai < 2; ++ai) {
            u32x4 gw[4];
#pragma unroll
            for (int m = 0; m < 4; ++m) gw[m] = *(const u32x4*)(SG + sg_frag(u.pm, u.pn + 4, ai, m, wave, lane));
#pragma unroll
            for (int m = 0; m < 4; ++m) { u32x4 p[2];
#pragma unroll
                for (int bj = 0; bj < 2; ++bj) { const unsigned gx = bj ? gw[m].z : gw[m].x, gy = bj ? gw[m].w : gw[m].y;
                    f32x4 a = acc[ai][bj][m][0], b = acc[ai][bj][m][1];
#pragma unroll
                    for (int i = 0; i < 4; ++i) { a[i] *= fmaxf((float)((gx >> (8 * i)) & 255u), 0.5f) * (1.0f / 255.0f); b[i] *= fmaxf((float)((gy >> (8 * i)) & 255u), 0.5f) * (1.0f / 255.0f); }
                    p[bj] = pack8(a, b); }
                u32x4 t0, t1; PG8_XPOSE(p[0], p[1], t0, t1);
                bf16_t* dst = OUT + (size_t)(rown + ai * HALF + m * 16) * 1024 + colN;
                *(u32x4*)dst = t0; *(u32x4*)(dst + 8 * 1024) = t1; }
        }
    }
};
struct EpiOut {
    static constexpr bool PERM = true, AFTER_DRAIN = false; static constexpr int MIDK = 0;
    const float* X; float* OUT; const float* ADA; PG8_LAS unsigned char* scr;
    __device__ __forceinline__ void operator()(const f32x4 (&acc)[2][2][4][2], const Unit& u, int wr, int wc, int fr, int fq) const {
        asm volatile("" : "+v"(fr), "+v"(fq));
        const int r8 = 2 * fq + (fr >> 3), c8 = fr & 7;
        const int rowb = u.pm * BM + wr * 64 + r8, col0 = u.pn * BM + wc * 32 + 4 * c8; const int b = (u.pm * BM) >> 12;
        PG8_LAS unsigned char* w0 = scr + fr * 128 + 16 * ((2 * fq) ^ (fr & 7)); PG8_LAS unsigned char* w1 = scr + fr * 128 + 16 * ((2 * fq + 1) ^ (fr & 7));
        const PG8_LAS unsigned char* r0 = scr + r8 * 128 + 16 * (c8 ^ (r8 & 7)); const PG8_LAS unsigned char* r1 = r0 + 8 * 128;
        f32x4 gv[2];
#pragma unroll
        for (int bj = 0; bj < 2; ++bj) gv[bj] = *(const f32x4*)(ADA + (size_t)b * 3072 + 2048 + col0 + bj * HALF);
#pragma unroll
        for (int ai = 0; ai < 2; ++ai) {
            f32x4 xv[4][2][2];
#pragma unroll
            for (int m = 0; m < 4; ++m) { const size_t off = (size_t)(rowb + ai * HALF + m * 16) * 1024 + col0;
#pragma unroll
                for (int bj = 0; bj < 2; ++bj)
#pragma unroll
                    for (int h = 0; h < 2; ++h) xv[m][bj][h] = *(const f32x4*)(X + off + (size_t)h * 8 * 1024 + bj * HALF); }
#pragma unroll
            for (int m = 0; m < 4; ++m) { const size_t off = (size_t)(rowb + ai * HALF + m * 16) * 1024 + col0;
#pragma unroll
                for (int bj = 0; bj < 2; ++bj) {
                    *(PG8_LAS f32x4*)w0 = acc[ai][bj][m][0]; *(PG8_LAS f32x4*)w1 = acc[ai][bj][m][1];
                    const f32x4 t0 = *(const PG8_LAS f32x4*)r0, t1 = *(const PG8_LAS f32x4*)r1;
                    *(f32x4*)(OUT + off + bj * HALF) = xv[m][bj][0] + gv[bj] * t0;
                    *(f32x4*)(OUT + off + (size_t)8 * 1024 + bj * HALF) = xv[m][bj][1] + gv[bj] * t1; } }
        }
    }
};

template <class Epi, class Sched, bool ALIGN_EPI = false, bool SP2 = false>
__device__ __forceinline__ void gemm_phase(PG8_LAS unsigned char* lds, const Gemm g, const Sched& S, const Epi& E) {
    const int tid = threadIdx.x, wid = __builtin_amdgcn_readfirstlane(tid >> 6), lane = tid & 63, wr = wid >> 2, wc = wid & 3, fr = lane & 15, fq = lane >> 4;
    const int K = g.K, nt = K / BK;
    unsigned voffA[2], voffB[2];
#pragma unroll
    for (int i = 0; i < 2; ++i) { int R, C; stage_rc(tid * 16 + i * 8192, R, C); const int Rb = Epi::PERM ? ((R & ~31) + perm32(R & 31)) : R;
        voffA[i] = (unsigned)(R * K + C) * 2u; voffB[i] = (unsigned)(Rb * K + C) * 2u; }
    const size_t kstep = (size_t)(BK * 2);
    const size_t hstep = (size_t)HALF * K * 2;
    const size_t tstep = 2 * hstep;
    const unsigned ldsw = (unsigned)wid * 1024u;
    const int aoff = lds_byte(wr * 64 + fr, fq * 8), boff = lds_byte(wc * 32 + fr, fq * 8);
#define PG8_SA(b, h) (((b) * 2 + (h)) * HTB)
#define PG8_SB(b, h) ((4 + (b) * 2 + (h)) * HTB)
#define PG8_STAGE(bufoff, gbase, voff) do { _Pragma("unroll") for (int _i = 0; _i < 2; ++_i) \
        __builtin_amdgcn_global_load_lds((const unsigned*)((const char*)(gbase) + (voff)[_i]), (PG8_LAS unsigned*)(lds + (bufoff) + ldsw + _i * 8192), 16, 0, 0); } while (0)
#define PG8_LDA(dst, b, h) do { _Pragma("unroll") for (int m = 0; m < 4; ++m) _Pragma("unroll") for (int k = 0; k < 2; ++k) dst[m][k] = *(const PG8_LAS bf16x8*)(lds + PG8_SA(b, h) + aoff + m * 2048 + k * 1024); } while (0)
#define PG8_LDB(dst, b, h) do { _Pragma("unroll") for (int n = 0; n < 2; ++n) _Pragma("unroll") for (int k = 0; k < 2; ++k) dst[n][k] = *(const PG8_LAS bf16x8*)(lds + PG8_SB(b, h) + boff + n * 2048 + k * 1024); } while (0)
#define PG8_MMA(ai, bj, At, Bt) do { __builtin_amdgcn_s_setprio(1); _Pragma("unroll") for (int m = 0; m < 4; ++m) _Pragma("unroll") for (int n = 0; n < 2; ++n) _Pragma("unroll") for (int k = 0; k < 2; ++k) \
        acc[ai][bj][m][n] = __builtin_amdgcn_mfma_f32_16x16x32_bf16(Bt[n][k], At[m][k], acc[ai][bj][m][n], 0, 0, 0); __builtin_amdgcn_s_setprio(0); } while (0)
#define PG8_WAIT_V(n) asm volatile("s_waitcnt vmcnt(" #n ")" ::: "memory")
#define PG8_WAIT_L(n) asm volatile("s_waitcnt lgkmcnt(" #n ")" ::: "memory")
#define PG8_BAR __builtin_amdgcn_s_barrier()
#define PG8_SCHED __builtin_amdgcn_sched_barrier(0)
    Unit cur, nxt; int ui = 0;
    if (!S.next(0, cur)) return;
    f32x4 acc[2][2][4][2];
#pragma unroll
    for (int a = 0; a < 2; ++a)
#pragma unroll
        for (int b = 0; b < 2; ++b)
#pragma unroll
            for (int m = 0; m < 4; ++m)
#pragma unroll
                for (int n = 0; n < 2; ++n) acc[a][b][m][n] = (f32x4){0.f, 0.f, 0.f, 0.f};
    bf16x8 At[4][2], B0[2][2], B1[2][2];
    const char* cA = (const char*)g.A + (size_t)cur.pm * tstep; const char* cB = (const char*)g.Bt + (size_t)cur.pn * tstep;
    S.a_ready(cur);
    if constexpr (SP2) {
        PG8_STAGE(PG8_SB(0, 0), cB, voffB); PG8_STAGE(PG8_SB(0, 1), cB + hstep, voffB); PG8_STAGE(PG8_SA(0, 0), cA, voffA); PG8_STAGE(PG8_SA(0, 1), cA + hstep, voffA);
        if (wr == 1) PG8_BAR;
        PG8_WAIT_V(2); PG8_BAR;
        PG8_STAGE(PG8_SB(1, 0), cB + kstep, voffB); PG8_STAGE(PG8_SA(1, 0), cA + kstep, voffA); PG8_STAGE(PG8_SB(1, 1), cB + hstep + kstep, voffB);
        PG8_WAIT_V(6); PG8_BAR;
    } else {
        PG8_STAGE(PG8_SB(0, 0), cB, voffB); PG8_STAGE(PG8_SA(0, 0), cA, voffA); PG8_STAGE(PG8_SB(0, 1), cB + hstep, voffB); PG8_STAGE(PG8_SA(0, 1), cA + hstep, voffA);
        if (wr == 1) PG8_BAR;
        PG8_WAIT_V(4); PG8_BAR;
        PG8_STAGE(PG8_SB(1, 0), cB + kstep, voffB); PG8_STAGE(PG8_SA(1, 0), cA + kstep, voffA); PG8_STAGE(PG8_SB(1, 1), cB + hstep + kstep, voffB);
        PG8_WAIT_V(6); PG8_BAR;
    }
    for (;;) {
        const bool has_next = S.next(ui + 1, nxt);
        const char* nA = has_next ? (const char*)g.A + (size_t)nxt.pm * tstep : cA; const char* nB = has_next ? (const char*)g.Bt + (size_t)nxt.pn * tstep : cB;
        for (int t = 0; t < nt; t += 2) {
            const bool last = (t == nt - 2);
            const char* a1 = cA + (size_t)(t + 1) * kstep;
            const char* a2 = last ? nA : cA + (size_t)(t + 2) * kstep; const char* b2 = last ? nB : cB + (size_t)(t + 2) * kstep;
            const char* a3 = a2 + kstep; const char* b3 = b2 + kstep;
            if (last && has_next) S.a_ready(nxt);
            if constexpr (Epi::MIDK > 0) { if (t == Epi::MIDK) E.mid(acc, cur, wr, wc, fr, fq); }
            if constexpr (SP2) {
            PG8_LDB(B0, 0, 0); PG8_LDB(B1, 0, 1); PG8_SCHED; PG8_LDA(At, 0, 0); PG8_STAGE(PG8_SA(1, 1), a1 + hstep, voffA);
            PG8_WAIT_V(8); PG8_WAIT_L(0); PG8_BAR; PG8_MMA(0, 0, At, B0); PG8_MMA(0, 1, At, B1); PG8_BAR; PG8_SCHED;
            PG8_LDA(At, 0, 1); PG8_STAGE(PG8_SB(0, 0), b2, voffB); PG8_STAGE(PG8_SB(0, 1), b2 + hstep, voffB); PG8_STAGE(PG8_SA(0, 0), a2, voffA);
            PG8_WAIT_V(8); PG8_WAIT_L(0); PG8_BAR; PG8_MMA(1, 0, At, B0); PG8_MMA(1, 1, At, B1); PG8_BAR; PG8_SCHED;
            PG8_LDB(B0, 1, 0); PG8_LDB(B1, 1, 1); PG8_SCHED; PG8_LDA(At, 1, 0); PG8_STAGE(PG8_SA(0, 1), a2 + hstep, voffA);
            PG8_WAIT_V(8); PG8_WAIT_L(0); PG8_BAR; PG8_MMA(0, 0, At, B0); PG8_MMA(0, 1, At, B1); PG8_BAR; PG8_SCHED;
            PG8_LDA(At, 1, 1); PG8_STAGE(PG8_SB(1, 0), b3, voffB); PG8_STAGE(PG8_SB(1, 1), b3 + hstep, voffB); PG8_STAGE(PG8_SA(1, 0), a3, voffA);
            PG8_WAIT_V(8); PG8_WAIT_L(0); PG8_BAR; PG8_MMA(1, 0, At, B0); PG8_MMA(1, 1, At, B1); PG8_BAR; PG8_SCHED;
            } else {
            PG8_LDB(B0, 0, 0); PG8_SCHED; PG8_LDA(At, 0, 0); PG8_STAGE(PG8_SA(1, 1), a1 + hstep, voffA);
            PG8_WAIT_L(8); PG8_BAR; PG8_WAIT_L(0); PG8_MMA(0, 0, At, B0); PG8_BAR; PG8_SCHED;
            PG8_LDB(B1, 0, 1); PG8_STAGE(PG8_SB(0, 0), b2, voffB);
            PG8_BAR; PG8_WAIT_L(0); PG8_MMA(0, 1, At, B1); PG8_BAR;
            PG8_LDA(At, 0, 1); PG8_STAGE(PG8_SA(0, 0), a2, voffA);
            PG8_BAR; PG8_WAIT_L(0); PG8_MMA(1, 0, At, B0); PG8_BAR; PG8_SCHED;
            PG8_STAGE(PG8_SB(0, 1), b2 + hstep, voffB);
            PG8_WAIT_V(6); PG8_BAR; PG8_MMA(1, 1, At, B1); PG8_BAR;
            PG8_LDB(B0, 1, 0); PG8_SCHED; PG8_LDA(At, 1, 0); PG8_STAGE(PG8_SA(0, 1), a2 + hstep, voffA);
            PG8_WAIT_L(8); PG8_BAR; PG8_WAIT_L(0); PG8_MMA(0, 0, At, B0); PG8_BAR; PG8_SCHED;
            PG8_LDB(B1, 1, 1); PG8_STAGE(PG8_SB(1, 0), b3, voffB);
            PG8_BAR; PG8_WAIT_L(0); PG8_MMA(0, 1, At, B1); PG8_BAR;
            PG8_LDA(At, 1, 1); PG8_STAGE(PG8_SA(1, 0), a3, voffA);
            PG8_BAR; PG8_WAIT_L(0); PG8_MMA(1, 0, At, B0); PG8_BAR; PG8_SCHED;
            PG8_STAGE(PG8_SB(1, 1), b3 + hstep, voffB);
            PG8_WAIT_V(6); PG8_BAR; PG8_MMA(1, 1, At, B1); PG8_BAR;
            }
        }
        if constexpr (ALIGN_EPI) { if (wr == 0) PG8_BAR; }
        if constexpr (!Epi::AFTER_DRAIN) { E(acc, cur, wr, wc, fr, fq); S.done(cur); }
        if (!has_next) break;
#pragma unroll
        for (int a = 0; a < 2; ++a)
#pragma unroll
            for (int b = 0; b < 2; ++b)
#pragma unroll
                for (int m = 0; m < 4; ++m)
#pragma unroll
                    for (int n = 0; n < 2; ++n) acc[a][b][m][n] = (f32x4){0.f, 0.f, 0.f, 0.f};
        cur = nxt; cA = nA; cB = nB; ++ui;
        if constexpr (ALIGN_EPI) { if (wr == 1) PG8_BAR; }
    }
    PG8_WAIT_V(0);
    if constexpr (!ALIGN_EPI) { if (wr == 0) PG8_BAR; }
    PG8_BAR;
#undef PG8_SA
#undef PG8_SB
#undef PG8_STAGE
#undef PG8_LDA
#undef PG8_LDB
#undef PG8_MMA
#undef PG8_WAIT_V
#undef PG8_WAIT_L
#undef PG8_BAR
#undef PG8_SCHED
}
}

constexpr int NWAVES = 8;
constexpr int N_PHASES = 6;
constexpr int BATCH = 8, SEQ = 4096, DM = 1024, M = BATCH * SEQ;
constexpr int NIN = 8704, NHEAD = 24, NG = 3, HPG = 8, HD = 64, CW = 512, CK = 31;
constexpr int ADA_N = 3 * DM;

constexpr size_t MiB = 1u << 20;
constexpr size_t WS_CTL = 0, CTL_ZERO_BYTES = 64 * 1024;
constexpr size_t WS_ADA = 1 * MiB;
constexpr size_t WS_WIN = 422 * MiB;
constexpr size_t WS_WA = 440 * MiB, WS_WO = 442 * MiB;
constexpr size_t WS_LSE = 2 * MiB;
constexpr size_t WS_H = 448 * MiB;
constexpr size_t WS_A2A = 448 * MiB, WS_A2C = 480 * MiB;
constexpr size_t WS_Q = 38 * MiB, WS_K = 134 * MiB, WS_V = 230 * MiB;
constexpr size_t WS_T1 = 134 * MiB, WS_MG = 230 * MiB;
constexpr size_t WS_ZA = 326 * MiB, WS_GLU = 358 * MiB, WS_ZC = 390 * MiB;
constexpr size_t WS_PB = 6 * MiB;
constexpr size_t WS_END = 512 * MiB;

constexpr int RING_OFF = 0, RING_BYTES = 131072;
constexpr int ATT_K0 = 0, ATT_K1 = 49152, ATT_V = 98304, ATT_END = 147456;
constexpr int MISC_OFF = ATT_END;
constexpr int LDS_BYTES = 151552;

#define GAS __attribute__((address_space(1)))
#define LAS __attribute__((address_space(3)))
typedef unsigned short bf16;
typedef unsigned v4u __attribute__((ext_vector_type(4)));
typedef unsigned v2u __attribute__((ext_vector_type(2)));
typedef float f32x4 __attribute__((ext_vector_type(4)));
typedef float f32x2 __attribute__((ext_vector_type(2)));
typedef float f32x16 __attribute__((ext_vector_type(16)));
typedef short bf16x8 __attribute__((ext_vector_type(8)));
typedef short s16x4 __attribute__((ext_vector_type(4)));
#define RLX_AGENT __ATOMIC_RELAXED, __HIP_MEMORY_SCOPE_AGENT
#define LDS_WAIT() asm volatile("s_waitcnt lgkmcnt(0)" ::: "memory")
using pg8::cvt_pk_bf16; using pg8::bf_lo; using pg8::bf_hi; using pg8::sigmoidf_;

#define XB_TMO      128
#define XB_XCNT(j)  (256  + 64 * (j))
#define XB_XSUB(j)  (1280 + 64 * (j))
#define XB_XGEN(j)  (2304 + 64 * (j))
#define XB_TOP      3328
#define XB_TOPGEN   3392
#define XCD_BAR_WORDS 3456
#define XB_SPIN_CAP (1u << 18)
__device__ __forceinline__ unsigned xb_ld(unsigned* p)              { return __hip_atomic_load(p, __ATOMIC_RELAXED, __HIP_MEMORY_SCOPE_AGENT); }
__device__ __forceinline__ unsigned xb_add(unsigned* p, unsigned v) { return __hip_atomic_fetch_add(p, v, __ATOMIC_RELAXED, __HIP_MEMORY_SCOPE_AGENT); }
__device__ __forceinline__ unsigned xb_xcc_id() { return (unsigned)__builtin_amdgcn_s_getreg((3 << 11) | 20) & 0xFu; }
#define XB_SPIN(cond, bar) do { unsigned _sp = 0; while (cond) { __builtin_amdgcn_s_sleep(1); \
    if ((++_sp & 255u) == 0u) { if (xb_ld(&(bar)[XB_TMO])) break; if (_sp > XB_SPIN_CAP) { atomicAdd(&(bar)[XB_TMO], 1u); break; } } } } while (0)
struct XcdBarrier { unsigned* bar; unsigned x; volatile LAS unsigned* st; };
__device__ __forceinline__ XcdBarrier xcd_barrier_post(unsigned* bar, volatile LAS unsigned* st) {
    XcdBarrier b; b.bar = bar; b.x = xb_xcc_id(); b.st = st;
    if (threadIdx.x == 0) (void)xb_add(&bar[XB_XCNT(b.x)], 1u);
    return b;
}
__device__ __forceinline__ void xcd_barrier_complete(unsigned* bar, unsigned x, unsigned& nloc, unsigned& nx) {
    const unsigned G = gridDim.x * gridDim.y * gridDim.z;
    unsigned sum, cnt, mine, sp = 0u;
    for (;;) {
        sum = 0u; cnt = 0u; mine = 0u;
#pragma unroll
        for (unsigned j = 0; j < 16; ++j) { const unsigned c = xb_ld(&bar[XB_XCNT(j)]); sum += c; cnt += (c > 0u) ? 1u : 0u; mine = (j == x) ? c : mine; }
        if (sum == G) break;
        __builtin_amdgcn_s_sleep(1);
        if ((++sp & 255u) == 0u) { if (xb_ld(&bar[XB_TMO])) break; if (sp > XB_SPIN_CAP) { atomicAdd(&bar[XB_TMO], 1u); break; } }
    }
    nloc = mine > 0u ? mine : 1u; nx = cnt > 0u ? cnt : 1u;
}
__device__ __forceinline__ void xcd_barrier(const XcdBarrier& b) {
    asm volatile("s_waitcnt vmcnt(0)" ::: "memory");
    __syncthreads();
    if (threadIdx.x == 0) {
        unsigned* bar = b.bar;
        __builtin_amdgcn_s_waitcnt(0);
        unsigned nloc = b.st[0], nx = b.st[1];
        if (nloc == 0u) { xcd_barrier_complete(bar, b.x, nloc, nx); b.st[0] = nloc; b.st[1] = nx; }
        const unsigned old = xb_add(&bar[XB_XSUB(b.x)], 1u);
        const unsigned gen = old / nloc;
        if (old + 1u == (gen + 1u) * nloc) {
            __builtin_amdgcn_fence(__ATOMIC_RELEASE, "agent");
            asm volatile("s_waitcnt vmcnt(0)" ::: "memory");
            const unsigned og = xb_add(&bar[XB_TOP], 1u);
            const unsigned tg = og / nx;
            if (og + 1u == (tg + 1u) * nx) xb_add(&bar[XB_TOPGEN], 1u);
            else XB_SPIN(xb_ld(&bar[XB_TOPGEN]) == tg, bar);
            __builtin_amdgcn_fence(__ATOMIC_ACQUIRE, "agent");
            xb_add(&bar[XB_XGEN(b.x)], 1u);
            asm volatile("s_waitcnt vmcnt(0)" ::: "memory");
        } else {
            XB_SPIN(xb_ld(&bar[XB_XGEN(b.x)]) == gen, bar);
            __builtin_amdgcn_fence(__ATOMIC_ACQUIRE, "agent");
            asm volatile("s_waitcnt vmcnt(0)" ::: "memory");
        }
    }
    __syncthreads();
}

__device__ __forceinline__ float wave_sum(float v) {
    v += __uint_as_float(__builtin_amdgcn_update_dpp(0u, __float_as_uint(v), 0xB1, 0xF, 0xF, true));
    v += __uint_as_float(__builtin_amdgcn_update_dpp(0u, __float_as_uint(v), 0x4E, 0xF, 0xF, true));
    v += __uint_as_float(__builtin_amdgcn_update_dpp(0u, __float_as_uint(v), 0x124, 0xF, 0xF, true));
    v += __uint_as_float(__builtin_amdgcn_update_dpp(0u, __float_as_uint(v), 0x128, 0xF, 0xF, true));
    { const auto r = __builtin_amdgcn_permlane16_swap(__float_as_uint(v), __float_as_uint(v), false, false); v = __uint_as_float(r[0]) + __uint_as_float(r[1]); }
    { const auto r = __builtin_amdgcn_permlane32_swap(__float_as_uint(v), __float_as_uint(v), false, false); v = __uint_as_float(r[0]) + __uint_as_float(r[1]); }
    return v;
}
__device__ __forceinline__ unsigned f2bf(float f) { unsigned u = __builtin_bit_cast(unsigned, f); return (u + 0x7fffu + ((u >> 16) & 1u)) >> 16; }
__device__ __forceinline__ unsigned pk2(float lo, float hi) { return f2bf(lo) | (f2bf(hi) << 16); }

__device__ __forceinline__ int win_phys(int n0) {
    if (n0 < 4608) { const int reg = n0 / 1536, c = n0 - reg * 1536, head = c >> 6, dh = (c >> 5) & 1; return (reg * 6 + (head >> 2)) * 256 + 128 * dh + 32 * (head & 3); }
    if (n0 >= 5120 && n0 < 6144) { const int c = n0 - 5120, half = c >> 9, cc = c & 511; return (20 + (cc >> 7)) * 256 + 128 * half + (cc & 127); }
    return n0;
}
__device__ __forceinline__ int win_phys_g(int n) { return n; }
template <bool WIN>
__device__ __forceinline__ void p0_transpose_item(const float* W, int K, int N, bf16* WT, LAS float* scr, int item, int lane, int ldt = 0) {
    if (ldt == 0) ldt = K;
    const int nblk = N / 32, kb = item / nblk, nb = item % nblk, k0 = 64 * kb, n0 = 32 * nb;
    const int prow = WIN ? win_phys(n0) : n0;
#pragma unroll 8
    for (int i = 0; i < 32; ++i) { const int kk = 2 * i + (lane >> 5); scr[kk * 33 + (lane & 31)] = __builtin_nontemporal_load(W + (size_t)(k0 + kk) * N + n0 + (lane & 31)); }
    LDS_WAIT(); asm volatile("" ::: "memory");
    const int c = lane & 7;
#pragma unroll
    for (int j = 0; j < 4; ++j) { const int n = (lane >> 3) + 8 * j; const LAS float* s = scr + (8 * c) * 33 + n;
        v4u o; o.x = pk2(s[0 * 33], s[1 * 33]); o.y = pk2(s[2 * 33], s[3 * 33]); o.z = pk2(s[4 * 33], s[5 * 33]); o.w = pk2(s[6 * 33], s[7 * 33]);
        const int rown = (WIN && n0 >= 6656) ? win_phys_g(n0 + n) : prow + n;
        *(GAS v4u*)(WT + (size_t)rown * ldt + k0 + 8 * c) = o; }
    LDS_WAIT(); asm volatile("" ::: "memory");
}

struct Args { const float* in[16]; float* out; unsigned char* ws; int ph_lo, ph_hi; };
__device__ __forceinline__ int crow(int r, int hi) { return (r & 3) + 8 * (r >> 2) + 4 * hi; }
__device__ __forceinline__ s16x4 vtr(const LAS char* p) { typedef short v4i16_t __attribute__((ext_vector_type(4))); return __builtin_bit_cast(s16x4, __builtin_amdgcn_ds_read_tr16_b64_v4i16((LAS v4i16_t*)p)); }

__device__ __forceinline__ void glds16s(const void* sbase, unsigned voff, unsigned lds_dst) { unsigned keep;
    const unsigned long long sb = (unsigned long long)sbase;
    const unsigned lo = (unsigned)__builtin_amdgcn_readfirstlane((int)(unsigned)sb), hi = (unsigned)__builtin_amdgcn_readfirstlane((int)(unsigned)(sb >> 32));
    const unsigned long long sbu = ((unsigned long long)hi << 32) | lo;
    asm volatile("s_mov_b32 %0, m0\n\ts_mov_b32 m0, %3\n\ts_nop 4\n\tglobal_load_lds_dwordx4 %1, %2\n\ts_mov_b32 m0, %0" : "=&s"(keep) : "v"(voff), "s"(sbu), "s"(lds_dst) : "memory"); }
struct KTile { bf16x8 k[4]; };
struct VTile { v4u v[4]; };
__device__ __forceinline__ void load_k(KTile& T, const bf16* Kp, int row0, int r32, int hi) {
    const bf16* kr = Kp + (size_t)(row0 + r32) * HD + 8 * hi;
#pragma unroll
    for (int ks = 0; ks < 4; ++ks) T.k[ks] = *(const GAS bf16x8*)(kr + 16 * ks);
}
__device__ __forceinline__ void load_v(VTile& T, const bf16* Vp, int row0, int lane) {
#pragma unroll
    for (int i = 0; i < 4; ++i) { const int c = lane + 64 * i; T.v[i] = *(const GAS v4u*)(Vp + (size_t)(row0 + (c >> 3)) * HD + (c & 7) * 8); }
}
template <int TAU>
__device__ __forceinline__ void att_tile(const KTile& TK, const VTile& TV, const bf16x8 (&qf)[4], float& m, float& l, f32x16 (&o)[2], LAS char* vl, const LAS char* vrd, int lane, int r32, int hi) {
    f32x16 s = {};
#pragma unroll
    for (int ks = 0; ks < 4; ++ks) s = __builtin_amdgcn_mfma_f32_32x32x16_bf16(TK.k[ks], qf[ks], s, 0, 0, 0);
#pragma unroll
    for (int i = 0; i < 4; ++i) { const int c = lane + 64 * i, key = c >> 3, ch = c & 7; *(LAS v4u*)(vl + (ch >> 2) * 2048 + key * 64 + (ch & 3) * 16) = TV.v[i]; }
    if (TAU == 0) {
#pragma unroll
        for (int r = 0; r < 16; ++r) if (crow(r, hi) < r32) s[r] = -INFINITY;
    }
    if (TAU == 4) {
#pragma unroll
        for (int r = 0; r < 16; ++r) if (crow(r, hi) > r32) s[r] = -INFINITY;
    }
    float tm = fmaxf(fmaxf(s[0], s[1]), s[2]);
#pragma unroll
    for (int r = 3; r < 15; r += 2) tm = fmaxf(fmaxf(tm, s[r]), s[r + 1]);
    tm = fmaxf(tm, s[15]);
    tm = fmaxf(tm, __shfl_xor(tm, 32));
    if (__any(tm > m)) {
        const float mn = fmaxf(m, tm), al = __builtin_amdgcn_exp2f(m - mn);
        l *= al; o[0] = o[0] * al; o[1] = o[1] * al; m = mn;
    }
    float ps = 0.f;
#pragma unroll
    for (int r = 0; r < 16; ++r) { s[r] = __builtin_amdgcn_exp2f(s[r] - m); ps += s[r]; }
    l += ps;
    v4u pw0, pw1;
    pw0.x = cvt_pk_bf16(s[0], s[1]); pw0.y = cvt_pk_bf16(s[2], s[3]); pw0.z = cvt_pk_bf16(s[4], s[5]); pw0.w = cvt_pk_bf16(s[6], s[7]);
    pw1.x = cvt_pk_bf16(s[8], s[9]); pw1.y = cvt_pk_bf16(s[10], s[11]); pw1.z = cvt_pk_bf16(s[12], s[13]); pw1.w = cvt_pk_bf16(s[14], s[15]);
    const bf16x8 pf0 = __builtin_bit_cast(bf16x8, pw0), pf1 = __builtin_bit_cast(bf16x8, pw1);
    LDS_WAIT(); asm volatile("" ::: "memory");
#pragma unroll
    for (int d0 = 0; d0 < 2; ++d0) {
        const s16x4 a0 = vtr(vrd + d0 * 2048), a1 = vtr(vrd + d0 * 2048 + 512), a2 = vtr(vrd + d0 * 2048 + 1024), a3 = vtr(vrd + d0 * 2048 + 1536);
        const bf16x8 vf0 = (bf16x8){a0[0], a0[1], a0[2], a0[3], a1[0], a1[1], a1[2], a1[3]};
        const bf16x8 vf1 = (bf16x8){a2[0], a2[1], a2[2], a2[3], a3[0], a3[1], a3[2], a3[3]};
        o[d0] = __builtin_amdgcn_mfma_f32_32x32x16_bf16(vf0, pf0, o[d0], 0, 0, 0);
        o[d0] = __builtin_amdgcn_mfma_f32_32x32x16_bf16(vf1, pf1, o[d0], 0, 0, 0);
    }
    asm volatile("" ::: "memory");
}

__global__ void __launch_bounds__(NWAVES * 64, 2) mega_fwd(Args args) {
    extern __shared__ __attribute__((aligned(16))) unsigned char lds_raw[];
    LAS unsigned char* lds = (LAS unsigned char*)lds_raw;
    const int tid = threadIdx.x, lane = tid & 63, wave = __builtin_amdgcn_readfirstlane(tid >> 6);
    const int G = gridDim.x; const int bx = blockIdx.x; const int vcu = (G % 8 == 0) ? (bx % 8) * (G / 8) + bx / 8 : bx;
    unsigned char* ws = args.ws;
    const float* x = args.in[0]; const float* cvec = args.in[1]; const float* w_ada = args.in[2]; const float* b_ada = args.in[3]; const float* norm_w = args.in[4];
    const float* w_in = args.in[5]; const float* b_gate = args.in[6]; const float* q_norm_w = args.in[7]; const float* k_norm_w = args.in[8]; const float* w_attn_proj = args.in[9];
    const float* conv_w = args.in[10]; const float* conv_b = args.in[11]; const float* conv_ln_w = args.in[12]; const float* conv_ln_b = args.in[13];
    const float* w_conv_proj = args.in[14]; const float* w_out = args.in[15];
    float* out = args.out;
    float* ADA = (float*)(ws + WS_ADA);
    bf16* WIN = (bf16*)(ws + WS_WIN); bf16* W2 = (bf16*)(ws + WS_WA); bf16* WO = (bf16*)(ws + WS_WO);
    float* LSE = (float*)(ws + WS_LSE);
    bf16* HB = (bf16*)(ws + WS_H); bf16* A2 = (bf16*)(ws + WS_A2A);
    bf16* QB = (bf16*)(ws + WS_Q); bf16* KB = (bf16*)(ws + WS_K); bf16* VB = (bf16*)(ws + WS_V);
    bf16* MG = (bf16*)(ws + WS_MG);
    bf16* ZA = (bf16*)(ws + WS_ZA); bf16* GLU = (bf16*)(ws + WS_GLU); bf16* ZC = (bf16*)(ws + WS_ZC);
    bf16* SG = (bf16*)out;

    if (tid < 32) ((LAS unsigned*)(lds + MISC_OFF))[tid] = 0u;
    __syncthreads();
    XcdBarrier bar = xcd_barrier_post((unsigned*)(ws + WS_CTL) + 4096, (volatile LAS unsigned*)(lds + MISC_OFF) + 8);
#define GRID_BAR(k) xcd_barrier(bar)
    const int lo = args.ph_lo, hi_ph = args.ph_hi;
#define IN(k) (lo <= (k) && (k) < hi_ph)
#define BOTH(k) (IN(k) && IN((k) + 1))
    const int gw = vcu * NWAVES + wave, NGW = G * NWAVES;

    if (IN(0)) {
        {
            LAS float* sc = (LAS float*)lds; LAS float* part = (LAS float*)(lds + 32768);
            if (bx < ADA_N / 64) {
                for (int i = tid; i < BATCH * DM; i += NWAVES * 64) { const float v = cvec[i]; sc[i] = v * sigmoidf_(v); }
                __syncthreads();
                for (int item = bx; item < ADA_N / 64; item += G) {
                    const int j = item * 64 + lane; float a[BATCH];
#pragma unroll
                    for (int b = 0; b < BATCH; ++b) a[b] = 0.f;
#pragma unroll 16
                    for (int kk = 0; kk < 128; ++kk) { const int k = wave * 128 + kk; const float w = __builtin_nontemporal_load(w_ada + (size_t)k * ADA_N + j);
#pragma unroll
                        for (int b = 0; b < BATCH; ++b) a[b] += sc[b * DM + k] * w; }
#pragma unroll
                    for (int b = 0; b < BATCH; ++b) part[(wave * BATCH + b) * 64 + lane] = a[b];
                    __syncthreads();
                    { float s = b_ada[j];
#pragma unroll
                      for (int w = 0; w < NWAVES; ++w) s += part[(w * BATCH + wave) * 64 + lane];
                      ADA[(size_t)wave * ADA_N + j] = s; }
                    __syncthreads();
                }
            }
        }
        if (bx >= ADA_N / 64 || G <= ADA_N / 64) {
            LAS float* scr = (LAS float*)(lds + RING_OFF + wave * 16384);
            constexpr int I_IN = (DM / 64) * (NIN / 32), I_A = (CW / 64) * (DM / 32), I_O = (DM / 64) * (DM / 32);
            constexpr int NITEMS = I_IN + 2 * I_A + I_O;
            const int nsk = G > ADA_N / 64 ? ADA_N / 64 : 0;
            for (int it = (bx - nsk) * NWAVES + wave; it < NITEMS; it += (G - nsk) * NWAVES) {
                int r = it;
                if (r < I_IN) { p0_transpose_item<true>(w_in, DM, NIN, WIN, scr, r, lane); continue; } r -= I_IN;
                if (r < I_A) { p0_transpose_item<false>(w_attn_proj, CW, DM, W2, scr, r, lane, DM); continue; } r -= I_A;
                if (r < I_A) { p0_transpose_item<false>(w_conv_proj, CW, DM, W2 + CW, scr, r, lane, DM); continue; } r -= I_A;
                p0_transpose_item<false>(w_out, DM, DM, WO, scr, r, lane);
            }
        }
        if (BOTH(0)) GRID_BAR(0);
    }

    if (IN(1)) {
        for (int rb = gw; rb < M / 16; rb += NGW) {
            const int row0 = rb * 16, b = row0 >> 12;
            f32x4 gm[4], ga[4];
#pragma unroll
            for (int j = 0; j < 4; ++j) { const int c = 4 * lane + 256 * j;
                const f32x4 nw = *(const f32x4*)(norm_w + c), sc = *(const f32x4*)(ADA + (size_t)b * ADA_N + DM + c);
                gm[j] = nw * (sc + 1.0f); ga[j] = *(const f32x4*)(ADA + (size_t)b * ADA_N + c); }
            for (int r = 0; r < 16; ++r) {
                const GAS f32x4* xr = (const GAS f32x4*)(x + (size_t)(row0 + r) * DM) + lane;
                f32x4 v[4]; float s2 = 0.f;
#pragma unroll
                for (int j = 0; j < 4; ++j) { v[j] = __builtin_nontemporal_load(xr + 64 * j); s2 += (v[j].x * v[j].x + v[j].y * v[j].y) + (v[j].z * v[j].z + v[j].w * v[j].w); }
                const float rstd = __builtin_amdgcn_rsqf(wave_sum(s2) * (1.f / DM) + pg8::NORM_EPS);
                GAS v2u* o8 = (GAS v2u*)(HB + (size_t)(row0 + r) * DM) + lane;
#pragma unroll
                for (int j = 0; j < 4; ++j) { const f32x4 y = v[j] * rstd * gm[j] + ga[j]; v2u w; w.x = cvt_pk_bf16(y.x, y.y); w.y = cvt_pk_bf16(y.z, y.w); o8[64 * j] = w; }
            }
        }
        if (BOTH(1)) GRID_BAR(1);
    }

    if (IN(2)) {
        pg8::Gemm g{HB, WIN, M, NIN, DM}; pg8::StaticOrder S; S.init(M, NIN, G, bx);
        pg8::EpiIn E{QB, (WS_K - WS_Q) / 2, ZA, (WS_ZC - WS_ZA) / 2, GLU, (unsigned char*)SG, q_norm_w, k_norm_w, b_gate, lds + RING_OFF + RING_BYTES + wave * 2048};
        pg8::gemm_phase<pg8::EpiIn, pg8::StaticOrder, true, true>(lds + RING_OFF, g, S, E);
        if (BOTH(2)) GRID_BAR(2);
    }

    if (IN(3)) {
        {
            LAS unsigned* in32 = (LAS unsigned*)lds;
            LAS float* ot = (LAS float*)(lds + 65536);
            const int cp = tid & 255, th = tid >> 8;
            float w0[CK], w1[CK];
#pragma unroll
            for (int j = 0; j < CK; ++j) { const f32x2 w = *(const f32x2*)(conv_w + j * CW + 2 * cp); w0[j] = w.x; w1[j] = w.y; }
            const f32x2 cb = *(const f32x2*)(conv_b + 2 * cp);
            v4u pf[8];
#define CONV_FETCH(TILE) { const int b_ = (TILE) >> 7, t0_ = ((TILE) & 127) * 32; \
                _Pragma("unroll") for (int i = 0; i < 8; ++i) { int c = tid + 512 * i; c = c < 62 * 64 ? c : 62 * 64 - 1; const int r = c >> 6, ch = c & 63, t = t0_ - 30 + r; \
                    v4u val = *(const GAS v4u*)(GLU + ((size_t)b_ * SEQ + (t < 0 ? 0 : t)) * CW + ch * 8); if (t < 0) val = (v4u){0u, 0u, 0u, 0u}; pf[i] = val; } }
            if (bx < M / 32) CONV_FETCH(bx)
            for (int tile = bx; tile < M / 32; tile += G) {
                const int b = tile >> 7, t0 = (tile & 127) * 32; const size_t row0 = (size_t)b * SEQ + t0;
#pragma unroll
                for (int i = 0; i < 8; ++i) { const int c = tid + 512 * i; if (c < 62 * 64) *(LAS v4u*)(lds + (size_t)c * 16) = pf[i]; }
                v4u zc[4];
#pragma unroll
                for (int q = 0; q < 4; ++q) zc[q] = *(const GAS v4u*)(ZC + (row0 + wave + 8 * q) * CW + lane * 8);
                __syncthreads();
                { const int nt_ = tile + G < M / 32 ? tile + G : tile; CONV_FETCH(nt_) }
                unsigned xs[46];
#pragma unroll
                for (int i = 0; i < 46; ++i) xs[i] = in32[(th * 16 + i) * 256 + cp];
#pragma unroll
                for (int tl = 0; tl < 16; ++tl) { float a0 = cb.x, a1 = cb.y;
#pragma unroll
                    for (int j = 0; j < CK; ++j) { const unsigned xv = xs[tl + j]; a0 += w0[j] * bf_lo(xv); a1 += w1[j] * bf_hi(xv); }
                    *(LAS f32x2*)(ot + (th * 16 + tl) * CW + 2 * cp) = (f32x2){a0, a1}; }
                __syncthreads();
                {
                    const f32x4 lw0 = *(const f32x4*)(conv_ln_w + lane * 8), lw1 = *(const f32x4*)(conv_ln_w + lane * 8 + 4);
                    const f32x4 lb0 = *(const f32x4*)(conv_ln_b + lane * 8), lb1 = *(const f32x4*)(conv_ln_b + lane * 8 + 4);
#pragma unroll
                    for (int q = 0; q < 4; ++q) { const int tl = wave + 8 * q;
                        f32x4 v0 = *(const LAS f32x4*)(ot + tl * CW + lane * 8), v1 = *(const LAS f32x4*)(ot + tl * CW + lane * 8 + 4);
                        const float mean = wave_sum((v0.x + v0.y) + (v0.z + v0.w) + (v1.x + v1.y) + (v1.z + v1.w)) * (1.f / CW);
                        v0 = v0 - mean; v1 = v1 - mean;
                        const float var = wave_sum((v0.x * v0.x + v0.y * v0.y) + (v0.z * v0.z + v0.w * v0.w) + (v1.x * v1.x + v1.y * v1.y) + (v1.z * v1.z + v1.w * v1.w)) * (1.f / CW);
                        const float rstd = __builtin_amdgcn_rsqf(var + pg8::NORM_EPS);
                        v0 = v0 * rstd * lw0 + lb0; v1 = v1 * rstd * lw1 + lb1;
                        const v4u zq = zc[q];
                        const float z[8] = {bf_lo(zq.x), bf_hi(zq.x), bf_lo(zq.y), bf_hi(zq.y), bf_lo(zq.z), bf_hi(zq.z), bf_lo(zq.w), bf_hi(zq.w)};
#pragma unroll
                        for (int i = 0; i < 4; ++i) { v0[i] = v0[i] * sigmoidf_(v0[i]) * z[i]; v1[i] = v1[i] * sigmoidf_(v1[i]) * z[4 + i]; }
                        *(GAS v4u*)(A2 + (row0 + tl) * DM + CW + lane * 8) = pg8::pack8(v0, v1); }
                }
                __syncthreads();
            }
#undef CONV_FETCH
        }
        {
            const int r32 = lane & 31, hi = lane >> 5;
            const int vrd_off = (4 * hi + ((lane & 15) >> 2)) * 64 + ((lane >> 4) & 1) * 32 + (lane & 3) * 8;
            const int piece = wave & 3, tsel = wave >> 2;
            bf16* PB = (bf16*)(ws + WS_PB); float* PL = (float*)(ws + WS_LSE);
            const unsigned lds0 = (unsigned)(uintptr_t)lds_raw;
            const unsigned voffK = (unsigned)(((8 * piece + (lane >> 3)) * HD + (((lane & 7) ^ (((8 * piece + (lane >> 3)) >> 1) & 7)) << 3)) * 2);
            const unsigned voffV = (unsigned)(((16 * (piece & 1) + (lane >> 2)) * HD + (piece >> 1) * 32 + (lane & 3) * 8) * 2);
#define XT_CONST int xln_ = lane; asm volatile("" : "+v"(xln_)); const int xl_r = xln_ >> 3, xc0 = (xln_ & 7) ^ (xln_ >> 4);     \
            const unsigned xb_off = (unsigned)(xl_r * 128 + (xln_ & 7) * 16), xa_off = (unsigned)((xln_ & 31) * 128), xa_f = (unsigned)(((xln_ & 31) >> 1) & 7);
#define XT_B(T, I) (*(LAS v4u*)((T) + xb_off + (I) * 1024))
#define XT_A(T, CH) (*(LAS v4u*)((T) + xa_off + ((((unsigned)(CH)) ^ xa_f) << 4)))
#define ATT_BAR() do { asm volatile("s_waitcnt lgkmcnt(0)" ::: "memory"); __builtin_amdgcn_s_barrier(); asm volatile("" ::: "memory"); } while (0)
#define ATT_DMA(ISV, SRC, RROW, JSB, NT, LDSOFF, FORCE) do { \
                _Pragma("unroll") for (int m_ = 0; m_ < 6; ++m_) { const int kt_ = 2 * m_ + tsel; const int js_ = (JSB) + 32 * kt_; \
                    if (m_ < (NT) / 2 && ((FORCE) || js_ >= 0)) \
                        glds16s((SRC) + ((size_t)(RROW) + (js_ < 0 ? 0 : js_)) * HD, ISV ? voffV : voffK, (unsigned)__builtin_amdgcn_readfirstlane((int)(lds0 + (LDSOFF) + kt_ * 4096 + piece * 1024))); } } while (0)
#define ATT_MID_HOOK
#define ATT_ROUND_(FAST, G_, RROW, IU0, JB, KTB, KBUF, TSH, TOK0, PBO, PBL, MROW0, NKN, QNP, QNROW) do { \
                    const int iq = (IU0) + r32; const int tq = (iq << (TSH)) + (TOK0); \
                    f32x16 S[5]; \
                    _Pragma("unroll") for (int tau = 0; tau < 5; ++tau) { \
                        if ((FAST) || (JB) + 32 * tau >= 0) { \
                            const LAS char* kp = (const LAS char*)(lds + (KBUF) + ((KTB) + tau) * 4096 + r32 * 128); \
                            bf16x8 kf[4]; \
                            _Pragma("unroll") for (int ks = 0; ks < 4; ++ks) kf[ks] = *(const LAS bf16x8*)(kp + (((2 * ks + hi) ^ ((r32 >> 1) & 7)) << 4)); \
                            f32x16 sacc = {}; \
                            _Pragma("unroll") for (int ks = 0; ks < 4; ++ks) sacc = __builtin_amdgcn_mfma_f32_32x32x16_bf16(kf[ks], qf[ks], sacc, 0, 0, 0); \
                              \
                            if (tau == 0) { int rq = r32 - 4 * hi; asm volatile("" : "+v"(rq)); _Pragma("unroll") for (int r = 0; r < 16; ++r) if ((r & 3) + 8 * (r >> 2) < rq) sacc[r] = -INFINITY; } \
                            if (tau == 4) { int rq = r32 - 4 * hi; asm volatile("" : "+v"(rq)); _Pragma("unroll") for (int r = 0; r < 16; ++r) if ((r & 3) + 8 * (r >> 2) > rq) sacc[r] = -INFINITY; } \
                            S[tau] = sacc; \
                        } else { _Pragma("unroll") for (int r = 0; r < 16; ++r) S[tau][r] = -INFINITY; } } \
                    float mx = -INFINITY; \
                    _Pragma("unroll") for (int tau = 0; tau < 5; ++tau) _Pragma("unroll") for (int r = 0; r < 16; r += 2) mx = fmaxf(fmaxf(mx, S[tau][r]), S[tau][r + 1]); \
                    { const auto sw_ = __builtin_amdgcn_permlane32_swap(__float_as_uint(mx), __float_as_uint(mx), false, false); mx = fmaxf(__uint_as_float(sw_[0]), __uint_as_float(sw_[1])); } \
                    float l = 0.f; v4u P[5][2]; \
                    _Pragma("unroll") for (int tau = 0; tau < 5; ++tau) { f32x16 p = S[tau]; float ps = 0.f; \
                        _Pragma("unroll") for (int r = 0; r < 16; ++r) { p[r] = __builtin_amdgcn_exp2f(p[r] - mx); ps += p[r]; } \
                        l += ps; \
                        P[tau][0].x = cvt_pk_bf16(p[0], p[1]); P[tau][0].y = cvt_pk_bf16(p[2], p[3]); P[tau][0].z = cvt_pk_bf16(p[4], p[5]); P[tau][0].w = cvt_pk_bf16(p[6], p[7]); \
                        P[tau][1].x = cvt_pk_bf16(p[8], p[9]); P[tau][1].y = cvt_pk_bf16(p[10], p[11]); P[tau][1].z = cvt_pk_bf16(p[12], p[13]); P[tau][1].w = cvt_pk_bf16(p[14], p[15]); } \
                    { const auto sw_ = __builtin_amdgcn_permlane32_swap(__float_as_uint(l), __float_as_uint(l), false, false); l = __uint_as_float(sw_[0]) + __uint_as_float(sw_[1]); } \
                    asm volatile("s_waitcnt vmcnt(" #NKN ")" ::: "memory"); ATT_BAR();     \
                    ATT_MID_HOOK \
                    XT_CONST LAS char* const xt = (LAS char*)(lds + (KBUF) + wave * 4096); \
                    ATT_LOAD_Q(qn, QNP, QNROW); \
                    if ((G_) < 2) ATT_LOAD_P(PBO, PBL, tq, IU0, TSH, TOK0); \
                    f32x16 o[2]; o[0] = f32x16{}; o[1] = f32x16{}; \
                    _Pragma("unroll") for (int tau = 0; tau < 5; ++tau) { \
                        if ((FAST) || (JB) + 32 * tau >= 0) { \
                            const LAS char* vp = (const LAS char*)(lds + ATT_V + ((KTB) + tau) * 4096 + vrd_off); \
                            const bf16x8 pf0 = __builtin_bit_cast(bf16x8, P[tau][0]), pf1 = __builtin_bit_cast(bf16x8, P[tau][1]); \
                            _Pragma("unroll") for (int d0 = 0; d0 < 2; ++d0) { \
                                const s16x4 a0 = vtr(vp + d0 * 2048), a1 = vtr(vp + d0 * 2048 + 512), a2 = vtr(vp + d0 * 2048 + 1024), a3 = vtr(vp + d0 * 2048 + 1536); \
                                const bf16x8 vf0 = (bf16x8){a0[0], a0[1], a0[2], a0[3], a1[0], a1[1], a1[2], a1[3]}; \
                                const bf16x8 vf1 = (bf16x8){a2[0], a2[1], a2[2], a2[3], a3[0], a3[1], a3[2], a3[3]}; \
                                o[d0] = __builtin_amdgcn_mfma_f32_32x32x16_bf16(vf0, pf0, o[d0], 0, 0, 0); \
                                o[d0] = __builtin_amdgcn_mfma_f32_32x32x16_bf16(vf1, pf1, o[d0], 0, 0, 0); } } } \
                    float lse = mx + __builtin_amdgcn_logf(l), sc_own = __builtin_amdgcn_rcpf(l), sc_p = 0.f; \
                    if ((G_) < 2) { const float mx2 = fmaxf(lse, plse), a = __builtin_amdgcn_exp2f(lse - mx2), bq = __builtin_amdgcn_exp2f(plse - mx2), inv = __builtin_amdgcn_rcpf(a + bq); \
                        sc_own = sc_own * a * inv; sc_p = bq * inv; lse = mx2 + __builtin_amdgcn_logf(a + bq); } \
                      \
                    if ((G_) < 2) { _Pragma("unroll") for (int i = 0; i < 4; ++i) XT_B(xt, i) = pq[i]; _Pragma("unroll") for (int c = 0; c < 4; ++c) pq[c] = XT_A(xt, 2 * c + hi); } \
                    if ((G_) < 2) { _Pragma("unroll") for (int c = 0; c < 4; ++c) { const auto rx = __builtin_amdgcn_permlane32_swap(pq[c].x, pq[c].z, false, false); const auto ry = __builtin_amdgcn_permlane32_swap(pq[c].y, pq[c].w, false, false); \
                        pp[2 * c] = (v2u){rx[0], ry[0]}; pp[2 * c + 1] = (v2u){rx[1], ry[1]}; } } \
                    if ((G_) > 0) { \
                        _Pragma("unroll") for (int d0 = 0; d0 < 2; ++d0) _Pragma("unroll") for (int j = 0; j < 2; ++j) { v2u w[2]; \
                            _Pragma("unroll") for (int q = 0; q < 2; ++q) { const int rg = 2 * j + q; \
                                float e0 = o[d0][4 * rg] * sc_own, e1 = o[d0][4 * rg + 1] * sc_own, e2 = o[d0][4 * rg + 2] * sc_own, e3 = o[d0][4 * rg + 3] * sc_own; \
                                if ((G_) < 2) { const v2u pw = pp[d0 * 4 + rg]; e0 += sc_p * bf_lo(pw.x); e1 += sc_p * bf_hi(pw.x); e2 += sc_p * bf_lo(pw.y); e3 += sc_p * bf_hi(pw.y); } \
                                w[q].x = cvt_pk_bf16(e0, e1); w[q].y = cvt_pk_bf16(e2, e3); } \
                            const auto rx = __builtin_amdgcn_permlane32_swap(w[0].x, w[1].x, false, false); const auto ry = __builtin_amdgcn_permlane32_swap(w[0].y, w[1].y, false, false); \
                            XT_A(xt, 2 * (d0 * 2 + j) + hi) = (v4u){rx[0], ry[0], rx[1], ry[1]}; } \
                        _Pragma("unroll") for (int i = 0; i < 4; ++i) *(GAS v4u*)((PBO) + (size_t)((((IU0) + xl_r + 8 * i) << (TSH)) + (TOK0)) * HD + 8 * (xc0 ^ (4 * (i & 1)))) = XT_B(xt, i); \
                        if (hi == 0) (PBL)[tq] = lse; \
                    } else { \
                        const size_t mrow = (size_t)(MROW0) + tq; \
                        v4u zq[4]; v2u zz[8]; \
                        _Pragma("unroll") for (int i = 0; i < 4; ++i) zq[i] = *(const GAS v4u*)(ZA + ((size_t)(MROW0) + ((((IU0) + xl_r + 8 * i) << (TSH)) + (TOK0))) * CW + h * 64 + 8 * (xc0 ^ (4 * (i & 1)))); \
                        _Pragma("unroll") for (int i = 0; i < 4; ++i) XT_B(xt, i) = zq[i]; _Pragma("unroll") for (int c = 0; c < 4; ++c) zq[c] = XT_A(xt, 2 * c + hi); \
                        _Pragma("unroll") for (int c = 0; c < 4; ++c) { const auto rx = __builtin_amdgcn_permlane32_swap(zq[c].x, zq[c].z, false, false); const auto ry = __builtin_amdgcn_permlane32_swap(zq[c].y, zq[c].w, false, false); \
                            zz[2 * c] = (v2u){rx[0], ry[0]}; zz[2 * c + 1] = (v2u){rx[1], ry[1]}; } \
                        _Pragma("unroll") for (int d0 = 0; d0 < 2; ++d0) _Pragma("unroll") for (int j = 0; j < 2; ++j) { v2u w[2]; \
                            _Pragma("unroll") for (int q = 0; q < 2; ++q) { const int rg = 2 * j + q; const v2u pw = pp[d0 * 4 + rg]; const v2u zw = zz[d0 * 4 + rg]; \
                                const float e0 = (o[d0][4 * rg] * sc_own + sc_p * bf_lo(pw.x)) * bf_lo(zw.x), e1 = (o[d0][4 * rg + 1] * sc_own + sc_p * bf_hi(pw.x)) * bf_hi(zw.x); \
                                const float e2 = (o[d0][4 * rg + 2] * sc_own + sc_p * bf_lo(pw.y)) * bf_lo(zw.y), e3 = (o[d0][4 * rg + 3] * sc_own + sc_p * bf_hi(pw.y)) * bf_hi(zw.y); \
                                w[q].x = cvt_pk_bf16(e0, e1); w[q].y = cvt_pk_bf16(e2, e3); } \
                            const auto rx = __builtin_amdgcn_permlane32_swap(w[0].x, w[1].x, false, false); const auto ry = __builtin_amdgcn_permlane32_swap(w[0].y, w[1].y, false, false); \
                            XT_A(xt, 2 * (d0 * 2 + j) + hi) = (v4u){rx[0], ry[0], rx[1], ry[1]}; } \
                        _Pragma("unroll") for (int i = 0; i < 4; ++i) *(GAS v4u*)(A2 + ((size_t)(MROW0) + ((((IU0) + xl_r + 8 * i) << (TSH)) + (TOK0))) * DM + h * 64 + 8 * (xc0 ^ (4 * (i & 1)))) = XT_B(xt, i); } \
                    ATT_XCH_Q(xt); \
                } while (0)
#define ATT_ROUND(...) ATT_ROUND_(0, __VA_ARGS__)
#define ATT_LOAD_Q(DST, QP, ROW0) do { _Pragma("unroll") for (int i = 0; i < 4; ++i) DST[i] = *(const GAS v4u*)((QP) + (size_t)((ROW0) + xl_r + 8 * i) * HD + 8 * (xc0 ^ (4 * (i & 1)))); } while (0)
#define ATT_XCH_Q(T) do { _Pragma("unroll") for (int i = 0; i < 4; ++i) XT_B(T, i) = qn[i]; _Pragma("unroll") for (int ks = 0; ks < 4; ++ks) qf[ks] = __builtin_bit_cast(bf16x8, XT_A(T, 2 * ks + hi)); } while (0)
#define ATT_LOAD_P(PBO, PBL, TQ, IU0, TSH, TOK0) do { _Pragma("unroll") for (int i = 0; i < 4; ++i) pq[i] = *(const GAS v4u*)((PBO) + (size_t)((((IU0) + xl_r + 8 * i) << (TSH)) + (TOK0)) * HD + 8 * (xc0 ^ (4 * (i & 1)))); \
                plse = (PBL)[TQ]; } while (0)
            bf16x8 qf[4]; v4u qn[4], pq[4]; v2u pp[8]; float plse;
            {
                const int NCH = BATCH * HPG * 16;
                if (vcu < NCH) { const int bh = vcu >> 4, res = vcu & 15; const size_t base = (size_t)(((bh >> 3) * 3 + 2) * 8 + (bh & 7)) * SEQ * HD;
                    { XT_CONST ATT_LOAD_Q(qn, QB + base, res * 256 + 32 * wave); ATT_XCH_Q((LAS char*)(lds + ATT_K1 + wave * 4096)); }
                    asm volatile("s_waitcnt vmcnt(0)" ::: "memory"); ATT_BAR();
                    ATT_DMA(false, KB + base, res * 256, 0, 8, ATT_K0, false); }
                int kpar = 0;
                for (int ch = vcu; ch < NCH; ch += G, kpar ^= 1) {
                    const int bh = ch >> 4, res = ch & 15, b = bh >> 3, h = bh & 7; const size_t base = (size_t)((b * 3 + 2) * 8 + h) * SEQ * HD;
                    const int chn = ch + G < NCH ? ch + G : ch, bhn = chn >> 4, resn = chn & 15; const size_t basen = (size_t)(((bhn >> 3) * 3 + 2) * 8 + (bhn & 7)) * SEQ * HD;
                    const int kbuf = kpar ? ATT_K1 : ATT_K0, knext = kpar ? ATT_K0 : ATT_K1;
                    if (ch == vcu) asm volatile("s_waitcnt vmcnt(0)" ::: "memory");
                    asm volatile("" : "+v"(qf[0]), "+v"(qf[1]), "+v"(qf[2]), "+v"(qf[3]));
                    ATT_BAR();
                    ATT_DMA(true, VB + base, res * 256, 0, 8, ATT_V, false);
                    if (ch + G < NCH) { ATT_DMA(false, KB + basen, resn * 256, 0, 8, knext, true);
                        if (wave >= 4) { ATT_ROUND_(1, 2, res * 256, 32 * wave, 32 * wave - 128, wave - 4, kbuf, 4, res, PB + (size_t)bh * SEQ * HD, PL + (size_t)bh * SEQ, 0, 4, QB + basen, resn * 256 + 32 * wave); }
                        else { ATT_ROUND(2, res * 256, 32 * wave, 32 * wave - 128, wave - 4, kbuf, 4, res, PB + (size_t)bh * SEQ * HD, PL + (size_t)bh * SEQ, 0, 4, QB + basen, resn * 256 + 32 * wave); } }
                    else { ATT_ROUND(2, res * 256, 32 * wave, 32 * wave - 128, wave - 4, kbuf, 4, res, PB + (size_t)bh * SEQ * HD, PL + (size_t)bh * SEQ, 0, 0, QB + basen, resn * 256 + 32 * wave); }
                }
                asm volatile("s_waitcnt vmcnt(0)" ::: "memory"); ATT_BAR();
            }
            GRID_BAR(6);
            for (int item = vcu; item < BATCH * HPG * 4; item += G) {
                const int span = item & 3, h = (item >> 2) & 7, b = item >> 5, bh = b * 8 + h;
                bf16* pbo = PB + (size_t)bh * SEQ * HD; float* pbl = PL + (size_t)bh * SEQ;
                const size_t base1 = (size_t)((b * 3 + 1) * 8 + h) * SEQ * HD, base0 = (size_t)((b * 3 + 0) * 8 + h) * SEQ * HD;
#define ITEM_RND(RD, G_, BASE_, RROW_, QB0_, TSH_, TOK0_) const int G_ = (RD) < 4 ? 1 : 0; const size_t BASE_ = (RD) < 4 ? base1 : base0; \
                const int RROW_ = (RD) < 4 ? (RD) * 1024 : 0, QB0_ = (RD) < 4 ? (span << 8) : (span << 10) + (((RD) - 4) << 8), TSH_ = (RD) < 4 ? 2 : 0, TOK0_ = (RD) < 4 ? (RD) : 0;
                { ITEM_RND(0, g_, base_, rrow_, qb0_, tsh_, tok0_)
                  { XT_CONST ATT_LOAD_Q(qn, QB + base_, rrow_ + qb0_ + 32 * wave); ATT_XCH_Q((LAS char*)(lds + ATT_K1 + wave * 4096)); }
                  asm volatile("s_waitcnt vmcnt(0)" ::: "memory"); ATT_BAR();
                  ATT_DMA(false, KB + base_, rrow_, qb0_ - 128, 12, ATT_K0, false); }
                for (int rd = 0; rd < 8; ++rd) {
                    ITEM_RND(rd, g, base, rrow, qb0, tsh, tok0)
                    const int rdn = rd + 1 < 8 ? rd + 1 : rd; ITEM_RND(rdn, gn, basen, rrown, qb0n, tshn, tok0n)
                    const int kbuf = (rd & 1) ? ATT_K1 : ATT_K0, knext = (rd & 1) ? ATT_K0 : ATT_K1;
                    if (rd == 0 || rd == 4) asm volatile("s_waitcnt vmcnt(0)" ::: "memory");
                    asm volatile("" : "+v"(qf[0]), "+v"(qf[1]), "+v"(qf[2]), "+v"(qf[3]));
                    ATT_BAR();
                    ATT_DMA(true, VB + base, rrow, qb0 - 128, 12, ATT_V, false);
                    if (rd + 1 < 8) {
#undef ATT_MID_HOOK
#define ATT_MID_HOOK ATT_DMA(false, KB + basen, rrown, qb0n - 128, 12, knext, true);
                        if (qb0 + 32 * wave - 128 >= 0) { ATT_ROUND_(1, g, rrow, qb0 + 32 * wave, qb0 + 32 * wave - 128, wave, kbuf, tsh, tok0, pbo, pbl, (size_t)b * SEQ, 0, QB + basen, rrown + qb0n + 32 * wave); }
                        else { ATT_ROUND(g, rrow, qb0 + 32 * wave, qb0 + 32 * wave - 128, wave, kbuf, tsh, tok0, pbo, pbl, (size_t)b * SEQ, 0, QB + basen, rrown + qb0n + 32 * wave); }
#undef ATT_MID_HOOK
#define ATT_MID_HOOK
                    }
                    else { ATT_ROUND(g, rrow, qb0 + 32 * wave, qb0 + 32 * wave - 128, wave, kbuf, tsh, tok0, pbo, pbl, (size_t)b * SEQ, 0, QB + basen, rrown + qb0n + 32 * wave); }
                }
#undef ITEM_RND
            }
            asm volatile("s_waitcnt vmcnt(0)" ::: "memory"); ATT_BAR();
#undef ATT_BAR
#undef ATT_DMA
#undef ATT_ROUND
#undef ATT_ROUND_
#undef ATT_LOAD_Q
#undef ATT_XCH_Q
#undef XT_CONST
#undef XT_A
#undef XT_B
#undef ATT_LOAD_P
        }
        if (BOTH(3)) GRID_BAR(3);
    }

    if (IN(4)) {
        { pg8::Gemm g{A2, W2, M, DM, DM}; pg8::StaticOrder S; S.init(M, DM, G, bx);
          pg8::EpiMerge2 E{(const unsigned char*)SG, MG, lds + RING_OFF + RING_BYTES + wave * 2048};
          pg8::gemm_phase<pg8::EpiMerge2, pg8::StaticOrder, true, true>(lds + RING_OFF, g, S, E); }
        if (BOTH(4)) GRID_BAR(4);
    }

    if (IN(5)) {
        pg8::Gemm g{MG, WO, M, DM, DM}; pg8::StaticOrder S; S.init(M, DM, G, bx);
        pg8::EpiOut E{x, out, ADA, lds + RING_OFF + RING_BYTES + wave * 2048};
        pg8::gemm_phase<pg8::EpiOut, pg8::StaticOrder, true, true>(lds + RING_OFF, g, S, E);
    }
#undef IN
#undef BOTH
}

extern "C" void kernel_launch(void* const* d_in, const int* in_sizes, int n_in, void* d_out, int out_size, void* d_ws, size_t ws_size, hipStream_t stream) {
    static int grid = 0;
    if (grid == 0) {
        if (n_in != 16 || in_sizes[0] != M * DM || out_size != M * DM || ws_size < WS_END) { fprintf(stderr, "kernel_launch: unexpected shapes (n_in %d, in0 %d, out %d, ws %zu)\n", n_in, n_in > 0 ? in_sizes[0] : -1, out_size, ws_size); grid = -1; return; }
        int dev = 0, cus = 0, per_cu = 0;
        if (hipGetDevice(&dev) != hipSuccess || hipDeviceGetAttribute(&cus, hipDeviceAttributeMultiprocessorCount, dev) != hipSuccess) { grid = -1; return; }
        if (hipFuncSetAttribute((const void*)mega_fwd, hipFuncAttributeMaxDynamicSharedMemorySize, LDS_BYTES) != hipSuccess) { fprintf(stderr, "kernel_launch: hipFuncSetAttribute failed\n"); grid = -1; return; }
        if (hipOccupancyMaxActiveBlocksPerMultiprocessor(&per_cu, (const void*)mega_fwd, NWAVES * 64, LDS_BYTES) != hipSuccess || per_cu < 1) { fprintf(stderr, "kernel_launch: occupancy query says %d\n", per_cu); (void)hipGetLastError(); per_cu = 1; }
        if (per_cu > 1) per_cu = 1;
        grid = cus * per_cu;
    }
    if (grid < 0) return;
    (void)hipMemsetAsync((char*)d_ws + WS_CTL, 0, CTL_ZERO_BYTES, stream);
    Args a{};
    for (int i = 0; i < 16; ++i) a.in[i] = (const float*)d_in[i];
    a.out = (float*)d_out; a.ws = (unsigned char*)d_ws;
    a.ph_lo = 0; a.ph_hi = N_PHASES;
    hipLaunchKernelGGL(mega_fwd, dim3(grid), dim3(NWAVES * 64), LDS_BYTES, stream, a);
}
```

```cpp
#include <hip/hip_runtime.h>
#include <cstdio>
#include <cstdint>

namespace pg8 {
#define PG8_LAS __attribute__((address_space(3)))
typedef unsigned short bf16_t;
typedef short bf16x8 __attribute__((ext_vector_type(8)));
typedef float f32x4 __attribute__((ext_vector_type(4)));
typedef unsigned u32x4 __attribute__((ext_vector_type(4)));
constexpr int BM = 256, BK = 64, HALF = 128, HTB = HALF * BK * 2, STAGE_BYTES = 8 * HTB, NXCD = 8, WGM = 8;

__host__ __device__ __forceinline__ int lds_byte(int r, int c) { const int st = (r >> 4) * 2 + (c >> 5), rr = r & 15, cc = c & 31, ob = rr * 64 + cc * 2; return st * 1024 + (ob ^ (((ob >> 9) & 1) << 5)); }
__host__ __device__ __forceinline__ void stage_rc(int b, int& R, int& C) { const int st = b / 1024, sb = b % 1024, swz = sb ^ (((sb >> 9) & 1) << 5); R = (st >> 1) * 16 + swz / 64; C = (st & 1) * 32 + (swz % 64) / 2; }
__host__ __device__ __forceinline__ int perm32(int rho) { const int n = rho >> 4, i = rho & 15; return 8 * (i >> 2) + 4 * n + (i & 3); }

struct Unit { int pm, pn; };
struct Gemm { const bf16_t* A; const bf16_t* Bt; int M, N, K; };

struct StaticOrder {
    int nM, nN, nwg, G, c;
    __host__ __device__ void init(int M, int N, int G_, int c_) { nM = M / BM; nN = N / BM; nwg = nM * nN; G = G_; c = c_; }
    __host__ __device__ bool next(int i, Unit& u) const {
        const long L = (long)i * G + c; if (L >= nwg) return false;
        int wgid = (int)L; { const int q = nwg / NXCD, r = nwg % NXCD, xcd = wgid % NXCD, off = wgid / NXCD; wgid = (xcd < r ? xcd * (q + 1) : r * (q + 1) + (xcd - r) * q) + off; }
        const int nig = WGM * nN, gid = wgid / nig, fm = gid * WGM, gsz = (nM - fm) < WGM ? (nM - fm) : WGM;
        u.pm = fm + ((wgid % nig) % gsz); u.pn = (wgid % nig) / gsz; return true;
    }
    __device__ __forceinline__ void a_ready(const Unit&) const {}
    __device__ __forceinline__ void done(const Unit&) const {}
};

typedef float f32x2_t __attribute__((ext_vector_type(2))); typedef __bf16 bf16x2_t __attribute__((ext_vector_type(2)));
__device__ __forceinline__ unsigned cvt_pk_bf16(float lo, float hi) { f32x2_t v = {lo, hi}; bf16x2_t b = __builtin_convertvector(v, bf16x2_t); return __builtin_bit_cast(unsigned, b); }
__device__ __forceinline__ float bf_lo(unsigned w) { return __uint_as_float(w << 16); }
__device__ __forceinline__ float bf_hi(unsigned w) { return __uint_as_float(w & 0xffff0000u); }
__device__ __forceinline__ float sigmoidf_(float x) { return __builtin_amdgcn_rcpf(1.0f + __builtin_amdgcn_exp2f(-1.4426950408889634f * x)); }
constexpr float NLOG2E = -1.4426950408889634f;
__device__ __forceinline__ f32x4 vexp2(const f32x4& v) { f32x4 r; r[0] = __builtin_amdgcn_exp2f(v[0]); r[1] = __builtin_amdgcn_exp2f(v[1]); r[2] = __builtin_amdgcn_exp2f(v[2]); r[3] = __builtin_amdgcn_exp2f(v[3]); return r; }
__device__ __forceinline__ f32x4 vrcp(const f32x4& v) { f32x4 r; r[0] = __builtin_amdgcn_rcpf(v[0]); r[1] = __builtin_amdgcn_rcpf(v[1]); r[2] = __builtin_amdgcn_rcpf(v[2]); r[3] = __builtin_amdgcn_rcpf(v[3]); return r; }
__device__ __forceinline__ f32x4 gated4(const f32x4& a, const f32x4& b) { return a * vrcp(vexp2(b * NLOG2E) + 1.0f); }
__device__ __forceinline__ f32x4 sig255_4(const f32x4& g, const f32x4& bs) {
    const f32x4 c = {1.0f / 255.0f, 1.0f / 255.0f, 1.0f / 255.0f, 1.0f / 255.0f}, k = {NLOG2E, NLOG2E, NLOG2E, NLOG2E};
    return vrcp(__builtin_elementwise_fma(vexp2(__builtin_elementwise_fma(g, k, bs)), c, c)); }
__device__ __forceinline__ u32x4 pack8(const f32x4& a, const f32x4& b) { u32x4 w; w.x = cvt_pk_bf16(a[0], a[1]); w.y = cvt_pk_bf16(a[2], a[3]); w.z = cvt_pk_bf16(b[0], b[1]); w.w = cvt_pk_bf16(b[2], b[3]); return w; }


constexpr float QSCALE = 0.125f * 1.4426950408889634f;
constexpr float NORM_EPS = 1e-6f;
#define PG8_XPOSE(P0, P1, T0, T1) do { *(PG8_LAS u32x4*)xw0 = (P0); *(PG8_LAS u32x4*)xw1 = (P1); T0 = *(const PG8_LAS u32x4*)xr0; T1 = *(const PG8_LAS u32x4*)(xr0 + 1024); } while (0)
#define PG8_XPOSE_ADDR PG8_LAS unsigned char* xw0 = scr + fr * 128 + 16 * (fq ^ (fr & 7)); PG8_LAS unsigned char* xw1 = scr + fr * 128 + 16 * ((4 + fq) ^ (fr & 7)); \
        const int r8 = 2 * fq + (fr >> 3), c8 = fr & 7; const PG8_LAS unsigned char* xr0 = scr + r8 * 128 + 16 * (c8 ^ (r8 & 7));
__device__ __forceinline__ size_t sg_frag(int pm, int t, int ai, int m, int wave, int lane) { return ((((((size_t)pm * 8 + t) * 2 + ai) * 4 + m) * 8 + wave) * 64 + lane) * 16; }
struct EpiIn {
    static constexpr bool PERM = true, AFTER_DRAIN = false; static constexpr int MIDK = 0;
    bf16_t *Q; size_t qkv_stride; bf16_t *ZA; size_t zc_off; bf16_t *GLU; unsigned char* SG; const float *qw, *kw, *bgate; PG8_LAS unsigned char* scr;
    __device__ __forceinline__ void operator()(const f32x4 (&acc)[2][2][4][2], const Unit& u, int wr, int wc, int fr, int fq) const {
        const int pn = u.pn;
        PG8_XPOSE_ADDR
        const int rown = u.pm * BM + wr * 64 + r8;
        if (pn < 18) {
            const int kind = pn / 6, rel = pn - kind * 6, g = rel >> 1, hb = ((rel & 1) << 2) + wc, sh = 2 * g;
            bf16_t* base = Q + (size_t)kind * qkv_stride;
            f32x4 wv[2][2];
            if (kind < 2) { const float* w = qw; if (kind == 1) w = kw; const float sc = kind == 0 ? QSCALE : 1.0f;
#pragma unroll
                for (int bj = 0; bj < 2; ++bj)
#pragma unroll
                    for (int n = 0; n < 2; ++n) wv[bj][n] = *(const f32x4*)(w + 32 * bj + 8 * fq + 4 * n) * sc; }
#pragma unroll
            for (int ai = 0; ai < 2; ++ai)
#pragma unroll
                for (int m = 0; m < 4; ++m) {
                    f32x4 v00 = acc[ai][0][m][0], v01 = acc[ai][0][m][1], v10 = acc[ai][1][m][0], v11 = acc[ai][1][m][1];
                    if (kind < 2) {
                        f32x4 q = v00 * v00 + v01 * v01 + v10 * v10 + v11 * v11; float ss = (q[0] + q[1]) + (q[2] + q[3]);
                        { const auto r16 = __builtin_amdgcn_permlane16_swap(__float_as_uint(ss), __float_as_uint(ss), false, false); ss = __uint_as_float(r16[0]) + __uint_as_float(r16[1]);
                          const auto r32_ = __builtin_amdgcn_permlane32_swap(__float_as_uint(ss), __float_as_uint(ss), false, false); ss = __uint_as_float(r32_[0]) + __uint_as_float(r32_[1]); }
                        const float rstd = __builtin_amdgcn_rsqf(ss * (1.0f / 64.0f) + NORM_EPS);
                        v00 = v00 * rstd * wv[0][0]; v01 = v01 * rstd * wv[0][1]; v10 = v10 * rstd * wv[1][0]; v11 = v11 * rstd * wv[1][1];
                    }
                    u32x4 t0, t1; PG8_XPOSE(pack8(v00, v01), pack8(v10, v11), t0, t1);
#pragma unroll
                    for (int h = 0; h < 2; ++h) { const int row = rown + ai * HALF + m * 16 + 8 * h, b = row >> 12, t = row & 4095;
                        const int tp = ((t & ((1 << sh) - 1)) << (12 - sh)) | (t >> sh);
                        __builtin_nontemporal_store(h ? t1 : t0, (u32x4*)(base + ((size_t)(((b * 3 + g) * 8 + hb) * 4096 + tp) * 64 + 8 * c8))); }
                }
        } else if (pn < 20 || (pn >= 24 && pn < 26)) {
            bf16_t* base = ZA + (pn < 20 ? (size_t)0 : zc_off); const int rel = pn < 20 ? pn - 18 : pn - 24; const int colN = rel * BM + wc * 32 + (c8 >> 2) * HALF + 8 * (c8 & 3);
#pragma unroll
            for (int ai = 0; ai < 2; ++ai)
#pragma unroll
                for (int m = 0; m < 4; ++m) { u32x4 p[2];
#pragma unroll
                    for (int bj = 0; bj < 2; ++bj) { f32x4 a = acc[ai][bj][m][0], b = acc[ai][bj][m][1];
#pragma unroll
                        for (int i = 0; i < 1; ++i) { a = gated4(a, a); b = gated4(b, b); }
                        p[bj] = pack8(a, b); }
                    u32x4 t0, t1; PG8_XPOSE(p[0], p[1], t0, t1);
                    bf16_t* dst = base + (size_t)(rown + ai * HALF + m * 16) * 512 + colN;
                    __builtin_nontemporal_store(t0, (u32x4*)dst); __builtin_nontemporal_store(t1, (u32x4*)(dst + 8 * 512)); }
        } else if (pn < 24) {
            const int colN = (pn - 20) * HALF + wc * 32 + 8 * (c8 & 3);
#pragma unroll
            for (int ai = 0; ai < 2; ++ai)
#pragma unroll
                for (int mp = 0; mp < 2; ++mp) { u32x4 p[2];
#pragma unroll
                    for (int q = 0; q < 2; ++q) { const int m = 2 * mp + q;
                        f32x4 a0 = acc[ai][0][m][0], a1 = acc[ai][0][m][1]; const f32x4 b0 = acc[ai][1][m][0], b1 = acc[ai][1][m][1];
#pragma unroll
                        for (int i = 0; i < 1; ++i) { a0 = gated4(a0, b0); a1 = gated4(a1, b1); }
                        p[q] = pack8(a0, a1); }
                    u32x4 t0, t1; PG8_XPOSE(p[0], p[1], t0, t1);
                    bf16_t* dst = GLU + (size_t)(rown + ai * HALF + (2 * mp + (c8 >> 2)) * 16) * 512 + colN;
                    __builtin_nontemporal_store(t0, (u32x4*)dst); __builtin_nontemporal_store(t1, (u32x4*)(dst + 8 * 512)); }
        } else {
            const int t = pn - 26; const int gc0 = t * BM + wc * 32 + 8 * fq;
            f32x4 bv[2][2];
#pragma unroll
            for (int bj = 0; bj < 2; ++bj)
#pragma unroll
                for (int n = 0; n < 2; ++n) bv[bj][n] = *(const f32x4*)(bgate + gc0 + HALF * bj + 4 * n) * NLOG2E;
#pragma unroll
            for (int ai = 0; ai < 2; ++ai)
#pragma unroll
                for (int m = 0; m < 4; ++m) {
                    u32x4 w;
#pragma unroll
                    for (int bj = 0; bj < 2; ++bj) { const f32x4 a = sig255_4(acc[ai][bj][m][0], bv[bj][0]), b = sig255_4(acc[ai][bj][m][1], bv[bj][1]);
                        unsigned wa = 0u, wb = 0u;
#pragma unroll
                        for (int i = 0; i < 4; ++i) { wa = __builtin_amdgcn_cvt_pk_u8_f32(a[i], i, wa); wb = __builtin_amdgcn_cvt_pk_u8_f32(b[i], i, wb); }
                        if (bj == 0) { w.x = wa; w.y = wb; } else { w.z = wa; w.w = wb; } }
                    __builtin_nontemporal_store(w, (u32x4*)(SG + sg_frag(u.pm, t, ai, m, wr * 4 + wc, fq * 16 + fr))); }
        }
    }
};
struct EpiMerge2 {
    static constexpr bool PERM = true, AFTER_DRAIN = false; static constexpr int MIDK = 8;
    const unsigned char* SG; bf16_t* OUT; PG8_LAS unsigned char* scr;
    __device__ __forceinline__ void mid(f32x4 (&acc)[2][2][4][2], const Unit& u, int wr, int wc, int fr, int fq) const {
        asm volatile("" : "+v"(fr), "+v"(fq));
        const int wave = wr * 4 + wc, lane = fq * 16 + fr;
#pragma unroll
        for (int ai = 0; ai < 2; ++ai) {
            u32x4 ga[4], gc[4];
#pragma unroll
            for (int m = 0; m < 4; ++m) { ga[m] = *(const u32x4*)(SG + sg_frag(u.pm, u.pn, ai, m, wave, lane)); gc[m] = *(const u32x4*)(SG + sg_frag(u.pm, u.pn + 4, ai, m, wave, lane)); }
#pragma unroll
            for (int m = 0; m < 4; ++m)
#pragma unroll
                for (int bj = 0; bj < 2; ++bj) {
                    const unsigned gax = bj ? ga[m].z : ga[m].x, gay = bj ? ga[m].w : ga[m].y, gcx = bj ? gc[m].z : gc[m].x, gcy = bj ? gc[m].w : gc[m].y;
                    f32x4& a = acc[ai][bj][m][0]; f32x4& b = acc[ai][bj][m][1];
#pragma unroll
                    for (int i = 0; i < 4; ++i) {
                        a[i] *= (float)((gax >> (8 * i)) & 255u) * __builtin_amdgcn_rcpf(fmaxf((float)((gcx >> (8 * i)) & 255u), 0.5f));
                        b[i] *= (float)((gay >> (8 * i)) & 255u) * __builtin_amdgcn_rcpf(fmaxf((float)((gcy >> (8 * i)) & 255u), 0.5f)); } }
            asm volatile("" ::: "memory"); }
    }
    __device__ __forceinline__ void operator()(const f32x4 (&acc)[2][2][4][2], const Unit& u, int wr, int wc, int fr, int fq) const {
        asm volatile("" : "+v"(fr), "+v"(fq));
        const int wave = wr * 4 + wc, lane = fq * 16 + fr;
        PG8_XPOSE_ADDR
        const int rown = u.pm * BM + wr * 64 + r8, colN = u.pn * BM + wc * 32 + (c8 >> 2) * HALF + 8 * (c8 & 3);
#pragma unroll
        for (int ai = 0; ai < 2; ++ai) {
            u32x4 gw[4];
#pragma unroll
            for (int m = 0; m < 4; ++m) gw[m] = *(const u32x4*)(SG + sg_frag(u.pm, u.pn + 4, ai, m, wave, lane));
#pragma unroll
            for (int m = 0; m < 4; ++m) { u32x4 p[2];
#pragma unroll
                for (int bj = 0; bj < 2; ++bj) { const unsigned gx = bj ? gw[m].z : gw[m].x, gy = bj ? gw[m].w : gw[m].y;
                    f32x4 a = acc[ai][bj][m][0], b = acc[ai][bj][m][1];
#pragma unroll
                    for (int i = 0; i < 4; ++i) { a[i] *= fmaxf((float)((gx >> (8 * i)) & 255u), 0.5f) * (1.0f / 255.0f); b[i] *= fmaxf((float)((gy >> (8 * i)) & 255u), 0.5f) * (1.0f / 255.0f); }
                    p[bj] = pack8(a, b); }
                u32x4 t0, t1; PG8_XPOSE(p[0], p[1], t0, t1);
                bf16_t* dst = OUT + (size_t)(rown + ai * HALF + m * 16) * 1024 + colN;
                *(u32x4*)dst = t0; *(u32x4*)(dst + 8 * 1024) = t1; }
        }
    }
};
struct EpiOut {
    static constexpr bool PERM = true, AFTER_DRAIN = false; static constexpr int MIDK = 0;
    const float* X; float* OUT; const float* ADA; PG8_LAS unsigned char* scr;
    __device__ __forceinline__ void operator()(const f32x4 (&acc)[2][2][4][2], const Unit& u, int wr, int wc, int fr, int fq) const {
        asm volatile("" : "+v"(fr), "+v"(fq));
        const int r8 = 2 * fq + (fr >> 3), c8 = fr & 7;
        const int rowb = u.pm * BM + wr * 64 + r8, col0 = u.pn * BM + wc * 32 + 4 * c8; const int b = (u.pm * BM) >> 12;
        PG8_LAS unsigned char* w0 = scr + fr * 128 + 16 * ((2 * fq) ^ (fr & 7)); PG8_LAS unsigned char* w1 = scr + fr * 128 + 16 * ((2 * fq + 1) ^ (fr & 7));
        const PG8_LAS unsigned char* r0 = scr + r8 * 128 + 16 * (c8 ^ (r8 & 7)); const PG8_LAS unsigned char* r1 = r0 + 8 * 128;
        f32x4 gv[2];
#pragma unroll
        for (int bj = 0; bj < 2; ++bj) gv[bj] = *(const f32x4*)(ADA + (size_t)b * 3072 + 2048 + col0 + bj * HALF);
#pragma unroll
        for (int ai = 0; ai < 2; ++ai) {
            f32x4 xv[4][2][2];
#pragma unroll
            for (int m = 0; m < 4; ++m) { const size_t off = (size_t)(rowb + ai * HALF + m * 16) * 1024 + col0;
#pragma unroll
                for (int bj = 0; bj < 2; ++bj)
#pragma unroll
                    for (int h = 0; h < 2; ++h) xv[m][bj][h] = *(const f32x4*)(X + off + (size_t)h * 8 * 1024 + bj * HALF); }
#pragma unroll
            for (int m = 0; m < 4; ++m) { const size_t off = (size_t)(rowb + ai * HALF + m * 16) * 1024 + col0;
#pragma unroll
                for (int bj = 0; bj < 2; ++bj) {
                    *(PG8_LAS f32x4*)w0 = acc[ai][bj][m][0]; *(PG8_LAS f32x4*)w1 = acc[ai][bj][m][1];
                    const f32x4 t0 = *(const PG8_LAS f32x4*)r0, t1 = *(const PG8_LAS f32x4*)r1;
                    *(f32x4*)(OUT + off + bj * HALF) = xv[m][bj][0] + gv[bj] * t0;
                    *(f32x4*)(OUT + off + (size_t)8 * 1024 + bj * HALF) = xv[m][bj][1] + gv[bj] * t1; } }
        }
    }
};

template <class Epi, class Sched, bool ALIGN_EPI = false, bool SP2 = false>
__device__ __forceinline__ void gemm_phase(PG8_LAS unsigned char* lds, const Gemm g, const Sched& S, const Epi& E) {
    const int tid = threadIdx.x, wid = __builtin_amdgcn_readfirstlane(tid >> 6), lane = tid & 63, wr = wid >> 2, wc = wid & 3, fr = lane & 15, fq = lane >> 4;
    const int K = g.K, nt = K / BK;
    unsigned voffA[2], voffB[2];
#pragma unroll
    for (int i = 0; i < 2; ++i) { int R, C; stage_rc(tid * 16 + i * 8192, R, C); const int Rb = Epi::PERM ? ((R & ~31) + perm32(R & 31)) : R;
        voffA[i] = (unsigned)(R * K + C) * 2u; voffB[i] = (unsigned)(Rb * K + C) * 2u; }
    const size_t kstep = (size_t)(BK * 2);
    const size_t hstep = (size_t)HALF * K * 2;
    const size_t tstep = 2 * hstep;
    const unsigned ldsw = (unsigned)wid * 1024u;
    const int aoff = lds_byte(wr * 64 + fr, fq * 8), boff = lds_byte(wc * 32 + fr, fq * 8);
#define PG8_SA(b, h) (((b) * 2 + (h)) * HTB)
#define PG8_SB(b, h) ((4 + (b) * 2 + (h)) * HTB)
#define PG8_STAGE(bufoff, gbase, voff) do { _Pragma("unroll") for (int _i = 0; _i < 2; ++_i) \
        __builtin_amdgcn_global_load_lds((const unsigned*)((const char*)(gbase) + (voff)[_i]), (PG8_LAS unsigned*)(lds + (bufoff) + ldsw + _i * 8192), 16, 0, 0); } while (0)
#define PG8_LDA(dst, b, h) do { _Pragma("unroll") for (int m = 0; m < 4; ++m) _Pragma("unroll") for (int k = 0; k < 2; ++k) dst[m][k] = *(const PG8_LAS bf16x8*)(lds + PG8_SA(b, h) + aoff + m * 2048 + k * 1024); } while (0)
#define PG8_LDB(dst, b, h) do { _Pragma("unroll") for (int n = 0; n < 2; ++n) _Pragma("unroll") for (int k = 0; k < 2; ++k) dst[n][k] = *(const PG8_LAS bf16x8*)(lds + PG8_SB(b, h) + boff + n * 2048 + k * 1024); } while (0)
#define PG8_MMA(ai, bj, At, Bt) do { __builtin_amdgcn_s_setprio(1); _Pragma("unroll") for (int m = 0; m < 4; ++m) _Pragma("unroll") for (int n = 0; n < 2; ++n) _Pragma("unroll") for (int k = 0; k < 2; ++k) \
        acc[ai][bj][m][n] = __builtin_amdgcn_mfma_f32_16x16x32_bf16(Bt[n][k], At[m][k], acc[ai][bj][m][n], 0, 0, 0); __builtin_amdgcn_s_setprio(0); } while (0)
#define PG8_WAIT_V(n) asm volatile("s_waitcnt vmcnt(" #n ")" ::: "memory")
#define PG8_WAIT_L(n) asm volatile("s_waitcnt lgkmcnt(" #n ")" ::: "memory")
#define PG8_BAR __builtin_amdgcn_s_barrier()
#define PG8_SCHED __builtin_amdgcn_sched_barrier(0)
    Unit cur, nxt; int ui = 0;
    if (!S.next(0, cur)) return;
    f32x4 acc[2][2][4][2];
#pragma unroll
    for (int a = 0; a < 2; ++a)
#pragma unroll
        for (int b = 0; b < 2; ++b)
#pragma unroll
            for (int m = 0; m < 4; ++m)
#pragma unroll
                for (int n = 0; n < 2; ++n) acc[a][b][m][n] = (f32x4){0.f, 0.f, 0.f, 0.f};
    bf16x8 At[4][2], B0[2][2], B1[2][2];
    const char* cA = (const char*)g.A + (size_t)cur.pm * tstep; const char* cB = (const char*)g.Bt + (size_t)cur.pn * tstep;
    S.a_ready(cur);
    if constexpr (SP2) {
        PG8_STAGE(PG8_SB(0, 0), cB, voffB); PG8_STAGE(PG8_SB(0, 1), cB + hstep, voffB); PG8_STAGE(PG8_SA(0, 0), cA, voffA); PG8_STAGE(PG8_SA(0, 1), cA + hstep, voffA);
        if (wr == 1) PG8_BAR;
        PG8_WAIT_V(2); PG8_BAR;
        PG8_STAGE(PG8_SB(1, 0), cB + kstep, voffB); PG8_STAGE(PG8_SA(1, 0), cA + kstep, voffA); PG8_STAGE(PG8_SB(1, 1), cB + hstep + kstep, voffB);
        PG8_WAIT_V(6); PG8_BAR;
    } else {
        PG8_STAGE(PG8_SB(0, 0), cB, voffB); PG8_STAGE(PG8_SA(0, 0), cA, voffA); PG8_STAGE(PG8_SB(0, 1), cB + hstep, voffB); PG8_STAGE(PG8_SA(0, 1), cA + hstep, voffA);
        if (wr == 1) PG8_BAR;
        PG8_WAIT_V(4); PG8_BAR;
        PG8_STAGE(PG8_SB(1, 0), cB + kstep, voffB); PG8_STAGE(PG8_SA(1, 0), cA + kstep, voffA); PG8_STAGE(PG8_SB(1, 1), cB + hstep + kstep, voffB);
        PG8_WAIT_V(6); PG8_BAR;
    }
    for (;;) {
        const bool has_next = S.next(ui + 1, nxt);
        const char* nA = has_next ? (const char*)g.A + (size_t)nxt.pm * tstep : cA; const char* nB = has_next ? (const char*)g.Bt + (size_t)nxt.pn * tstep : cB;
        for (int t = 0; t < nt; t += 2) {
            const bool last = (t == nt - 2);
            const char* a1 = cA + (size_t)(t + 1) * kstep;
            const char* a2 = last ? nA : cA + (size_t)(t + 2) * kstep; const char* b2 = last ? nB : cB + (size_t)(t + 2) * kstep;
            const char* a3 = a2 + kstep; const char* b3 = b2 + kstep;
            if (last && has_next) S.a_ready(nxt);
            if constexpr (Epi::MIDK > 0) { if (t == Epi::MIDK) E.mid(acc, cur, wr, wc, fr, fq); }
            if constexpr (SP2) {
            PG8_LDB(B0, 0, 0); PG8_LDB(B1, 0, 1); PG8_SCHED; PG8_LDA(At, 0, 0); PG8_STAGE(PG8_SA(1, 1), a1 + hstep, voffA);
            PG8_WAIT_V(8); PG8_WAIT_L(0); PG8_BAR; PG8_MMA(0, 0, At, B0); PG8_MMA(0, 1, At, B1); PG8_BAR; PG8_SCHED;
            PG8_LDA(At, 0, 1); PG8_STAGE(PG8_SB(0, 0), b2, voffB); PG8_STAGE(PG8_SB(0, 1), b2 + hstep, voffB); PG8_STAGE(PG8_SA(0, 0), a2, voffA);
            PG8_WAIT_V(8); PG8_WAIT_L(0); PG8_BAR; PG8_MMA(1, 0, At, B0); PG8_MMA(1, 1, At, B1); PG8_BAR; PG8_SCHED;
            PG8_LDB(B0, 1, 0); PG8_LDB(B1, 1, 1); PG8_SCHED; PG8_LDA(At, 1, 0); PG8_STAGE(PG8_SA(0, 1), a2 + hstep, voffA);
            PG8_WAIT_V(8); PG8_WAIT_L(0); PG8_BAR; PG8_MMA(0, 0, At, B0); PG8_MMA(0, 1, At, B1); PG8_BAR; PG8_SCHED;
            PG8_LDA(At, 1, 1); PG8_STAGE(PG8_SB(1, 0), b3, voffB); PG8_STAGE(PG8_SB(1, 1), b3 + hstep, voffB); PG8_STAGE(PG8_SA(1, 0), a3, voffA);
            PG8_WAIT_V(8); PG8_WAIT_L(0); PG8_BAR; PG8_MMA(1, 0, At, B0); PG8_MMA(1, 1, At, B1); PG8_BAR; PG8_SCHED;
            } else {
            PG8_LDB(B0, 0, 0); PG8_SCHED; PG8_LDA(At, 0, 0); PG8_STAGE(PG8_SA(1, 1), a1 + hstep, voffA);
            PG8_WAIT_L(8); PG8_BAR; PG8_WAIT_L(0); PG8_MMA(0, 0, At, B0); PG8_BAR; PG8_SCHED;
            PG8_LDB(B1, 0, 1); PG8_STAGE(PG8_SB(0, 0), b2, voffB);
            PG8_BAR; PG8_WAIT_L(0); PG8_MMA(0, 1, At, B1); PG8_BAR;
            PG8_LDA(At, 0, 1); PG8_STAGE(PG8_SA(0, 0), a2, voffA);
            PG8_BAR; PG8_WAIT_L(0); PG8_MMA(1, 0, At, B0); PG8_BAR; PG8_SCHED;
            PG8_STAGE(PG8_SB(0, 1), b2 + hstep, voffB);
            PG8_WAIT_V(6); PG8_BAR; PG8_MMA(1, 1, At, B1); PG8_BAR;
            PG8_LDB(B0, 1, 0); PG8_SCHED; PG8_LDA(At, 1, 0); PG8_STAGE(PG8_SA(0, 1), a2 + hstep, voffA);
            PG8_WAIT_L(8); PG8_BAR; PG8_WAIT_L(0); PG8_MMA(0, 0, At, B0); PG8_BAR; PG8_SCHED;
            PG8_LDB(B1, 1, 1); PG8_STAGE(PG8_SB(1, 0), b3, voffB);
            PG8_BAR; PG8_WAIT_L(0); PG8_MMA(0, 1, At, B1); PG8_BAR;
            PG8_LDA(At, 1, 1); PG8_STAGE(PG8_SA(1, 0), a3, voffA);
            PG8_BAR; PG8_WAIT_L(0); PG8_MMA(1, 0, At, B0); PG8_BAR; PG8_SCHED;
            PG8_STAGE(PG8_SB(1, 1), b3 + hstep, voffB);
            PG8_WAIT_V(6); PG8_BAR; PG8_MMA(1, 1, At, B1); PG8_BAR;
            }
        }
        if constexpr (ALIGN_EPI) { if (wr == 0) PG8_BAR; }
        if constexpr (!Epi::AFTER_DRAIN) { E(acc, cur, wr, wc, fr, fq); S.done(cur); }
        if (!has_next) break;
#pragma unroll
        for (int a = 0; a < 2; ++a)
#pragma unroll
            for (int b = 0; b < 2; ++b)
#pragma unroll
                for (int m = 0; m < 4; ++m)
#pragma unroll
                    for (int n = 0; n < 2; ++n) acc[a][b][m][n] = (f32x4){0.f, 0.f, 0.f, 0.f};
        cur = nxt; cA = nA; cB = nB; ++ui;
        if constexpr (ALIGN_EPI) { if (wr == 1) PG8_BAR; }
    }
    PG8_WAIT_V(0);
    if constexpr (!ALIGN_EPI) { if (wr == 0) PG8_BAR; }
    PG8_BAR;
#undef PG8_SA
#undef PG8_SB
#undef PG8_STAGE
#undef PG8_LDA
#undef PG8_LDB
#undef PG8_MMA
#undef PG8_WAIT_V
#undef PG8_WAIT_L
#undef PG8_BAR
#undef PG8_SCHED
}
}

constexpr int NWAVES = 8;
constexpr int N_PHASES = 6;
constexpr int BATCH = 8, SEQ = 4096, DM = 1024, M = BATCH * SEQ;
constexpr int NIN = 8704, NHEAD = 24, NG = 3, HPG = 8, HD = 64, CW = 512, CK = 31;
constexpr int ADA_N = 3 * DM;

constexpr size_t MiB = 1u << 20;
constexpr size_t WS_CTL = 0, CTL_ZERO_BYTES = 64 * 1024;
constexpr size_t WS_ADA = 1 * MiB;
constexpr size_t WS_WIN = 422 * MiB;
constexpr size_t WS_WA = 440 * MiB, WS_WO = 442 * MiB;
constexpr size_t WS_LSE = 2 * MiB;
constexpr size_t WS_H = 448 * MiB;
constexpr size_t WS_A2A = 448 * MiB, WS_A2C = 480 * MiB;
constexpr size_t WS_Q = 38 * MiB, WS_K = 134 * MiB, WS_V = 230 * MiB;
constexpr size_t WS_T1 = 134 * MiB, WS_MG = 230 * MiB;
constexpr size_t WS_ZA = 326 * MiB, WS_GLU = 358 * MiB, WS_ZC = 390 * MiB;
constexpr size_t WS_PB = 6 * MiB;
constexpr size_t WS_END = 512 * MiB;

constexpr int RING_OFF = 0, RING_BYTES = 131072;
constexpr int ATT_K0 = 0, ATT_K1 = 49152, ATT_V = 98304, ATT_END = 147456;
constexpr int MISC_OFF = ATT_END;
constexpr int LDS_BYTES = 151552;

#define GAS __attribute__((address_space(1)))
#define LAS __attribute__((address_space(3)))
typedef unsigned short bf16;
typedef unsigned v4u __attribute__((ext_vector_type(4)));
typedef unsigned v2u __attribute__((ext_vector_type(2)));
typedef float f32x4 __attribute__((ext_vector_type(4)));
typedef float f32x2 __attribute__((ext_vector_type(2)));
typedef float f32x16 __attribute__((ext_vector_type(16)));
typedef short bf16x8 __attribute__((ext_vector_type(8)));
typedef short s16x4 __attribute__((ext_vector_type(4)));
#define RLX_AGENT __ATOMIC_RELAXED, __HIP_MEMORY_SCOPE_AGENT
#define LDS_WAIT() asm volatile("s_waitcnt lgkmcnt(0)" ::: "memory")
using pg8::cvt_pk_bf16; using pg8::bf_lo; using pg8::bf_hi; using pg8::sigmoidf_;

#define XB_TMO      128
#define XB_XCNT(j)  (256  + 64 * (j))
#define XB_XSUB(j)  (1280 + 64 * (j))
#define XB_XGEN(j)  (2304 + 64 * (j))
#define XB_TOP      3328
#define XB_TOPGEN   3392
#define XCD_BAR_WORDS 3456
#define XB_SPIN_CAP (1u << 18)
__device__ __forceinline__ unsigned xb_ld(unsigned* p)              { return __hip_atomic_load(p, __ATOMIC_RELAXED, __HIP_MEMORY_SCOPE_AGENT); }
__device__ __forceinline__ unsigned xb_add(unsigned* p, unsigned v) { return __hip_atomic_fetch_add(p, v, __ATOMIC_RELAXED, __HIP_MEMORY_SCOPE_AGENT); }
__device__ __forceinline__ unsigned xb_xcc_id() { return (unsigned)__builtin_amdgcn_s_getreg((3 << 11) | 20) & 0xFu; }
#define XB_SPIN(cond, bar) do { unsigned _sp = 0; while (cond) { __builtin_amdgcn_s_sleep(1); \
    if ((++_sp & 255u) == 0u) { if (xb_ld(&(bar)[XB_TMO])) break; if (_sp > XB_SPIN_CAP) { atomicAdd(&(bar)[XB_TMO], 1u); break; } } } } while (0)
struct XcdBarrier { unsigned* bar; unsigned x; volatile LAS unsigned* st; };
__device__ __forceinline__ XcdBarrier xcd_barrier_post(unsigned* bar, volatile LAS unsigned* st) {
    XcdBarrier b; b.bar = bar; b.x = xb_xcc_id(); b.st = st;
    if (threadIdx.x == 0) (void)xb_add(&bar[XB_XCNT(b.x)], 1u);
    return b;
}
__device__ __forceinline__ void xcd_barrier_complete(unsigned* bar, unsigned x, unsigned& nloc, unsigned& nx) {
    const unsigned G = gridDim.x * gridDim.y * gridDim.z;
    unsigned sum, cnt, mine, sp = 0u;
    for (;;) {
        sum = 0u; cnt = 0u; mine = 0u;
#pragma unroll
        for (unsigned j = 0; j < 16; ++j) { const unsigned c = xb_ld(&bar[XB_XCNT(j)]); sum += c; cnt += (c > 0u) ? 1u : 0u; mine = (j == x) ? c : mine; }
        if (sum == G) break;
        __builtin_amdgcn_s_sleep(1);
        if ((++sp & 255u) == 0u) { if (xb_ld(&bar[XB_TMO])) break; if (sp > XB_SPIN_CAP) { atomicAdd(&bar[XB_TMO], 1u); break; } }
    }
    nloc = mine > 0u ? mine : 1u; nx = cnt > 0u ? cnt : 1u;
}
__device__ __forceinline__ void xcd_barrier(const XcdBarrier& b) {
    asm volatile("s_waitcnt vmcnt(0)" ::: "memory");
    __syncthreads();
    if (threadIdx.x == 0) {
        unsigned* bar = b.bar;
        __builtin_amdgcn_s_waitcnt(0);
        unsigned nloc = b.st[0], nx = b.st[1];
        if (nloc == 0u) { xcd_barrier_complete(bar, b.x, nloc, nx); b.st[0] = nloc; b.st[1] = nx; }
        const unsigned old = xb_add(&bar[XB_XSUB(b.x)], 1u);
        const unsigned gen = old / nloc;
        if (old + 1u == (gen + 1u) * nloc) {
            __builtin_amdgcn_fence(__ATOMIC_RELEASE, "agent");
            asm volatile("s_waitcnt vmcnt(0)" ::: "memory");
            const unsigned og = xb_add(&bar[XB_TOP], 1u);
            const unsigned tg = og / nx;
            if (og + 1u == (tg + 1u) * nx) xb_add(&bar[XB_TOPGEN], 1u);
            else XB_SPIN(xb_ld(&bar[XB_TOPGEN]) == tg, bar);
            __builtin_amdgcn_fence(__ATOMIC_ACQUIRE, "agent");
            xb_add(&bar[XB_XGEN(b.x)], 1u);
            asm volatile("s_waitcnt vmcnt(0)" ::: "memory");
        } else {
            XB_SPIN(xb_ld(&bar[XB_XGEN(b.x)]) == gen, bar);
            __builtin_amdgcn_fence(__ATOMIC_ACQUIRE, "agent");
            asm volatile("s_waitcnt vmcnt(0)" ::: "memory");
        }
    }
    __syncthreads();
}

__device__ __forceinline__ float wave_sum(float v) {
    v += __uint_as_float(__builtin_amdgcn_update_dpp(0u, __float_as_uint(v), 0xB1, 0xF, 0xF, true));
    v += __uint_as_float(__builtin_amdgcn_update_dpp(0u, __float_as_uint(v), 0x4E, 0xF, 0xF, true));
    v += __uint_as_float(__builtin_amdgcn_update_dpp(0u, __float_as_uint(v), 0x124, 0xF, 0xF, true));
    v += __uint_as_float(__builtin_amdgcn_update_dpp(0u, __float_as_uint(v), 0x128, 0xF, 0xF, true));
    { const auto r = __builtin_amdgcn_permlane16_swap(__float_as_uint(v), __float_as_uint(v), false, false); v = __uint_as_float(r[0]) + __uint_as_float(r[1]); }
    { const auto r = __builtin_amdgcn_permlane32_swap(__float_as_uint(v), __float_as_uint(v), false, false); v = __uint_as_float(r[0]) + __uint_as_float(r[1]); }
    return v;
}
__device__ __forceinline__ unsigned f2bf(float f) { unsigned u = __builtin_bit_cast(unsigned, f); return (u + 0x7fffu + ((u >> 16) & 1u)) >> 16; }
__device__ __forceinline__ unsigned pk2(float lo, float hi) { return f2bf(lo) | (f2bf(hi) << 16); }

__device__ __forceinline__ int win_phys(int n0) {
    if (n0 < 4608) { const int reg = n0 / 1536, c = n0 - reg * 1536, head = c >> 6, dh = (c >> 5) & 1; return (reg * 6 + (head >> 2)) * 256 + 128 * dh + 32 * (head & 3); }
    if (n0 >= 5120 && n0 < 6144) { const int c = n0 - 5120, half = c >> 9, cc = c & 511; return (20 + (cc >> 7)) * 256 + 128 * half + (cc & 127); }
    return n0;
}
__device__ __forceinline__ int win_phys_g(int n) { return n; }
template <bool WIN>
__device__ __forceinline__ void p0_transpose_item(const float* W, int K, int N, bf16* WT, LAS float* scr, int item, int lane, int ldt = 0) {
    if (ldt == 0) ldt = K;
    const int nblk = N / 32, kb = item / nblk, nb = item % nblk, k0 = 64 * kb, n0 = 32 * nb;
    const int prow = WIN ? win_phys(n0) : n0;
#pragma unroll 8
    for (int i = 0; i < 32; ++i) { const int kk = 2 * i + (lane >> 5); scr[kk * 33 + (lane & 31)] = __builtin_nontemporal_load(W + (size_t)(k0 + kk) * N + n0 + (lane & 31)); }
    LDS_WAIT(); asm volatile("" ::: "memory");
    const int c = lane & 7;
#pragma unroll
    for (int j = 0; j < 4; ++j) { const int n = (lane >> 3) + 8 * j; const LAS float* s = scr + (8 * c) * 33 + n;
        v4u o; o.x = pk2(s[0 * 33], s[1 * 33]); o.y = pk2(s[2 * 33], s[3 * 33]); o.z = pk2(s[4 * 33], s[5 * 33]); o.w = pk2(s[6 * 33], s[7 * 33]);
        const int rown = (WIN && n0 >= 6656) ? win_phys_g(n0 + n) : prow + n;
        *(GAS v4u*)(WT + (size_t)rown * ldt + k0 + 8 * c) = o; }
    LDS_WAIT(); asm volatile("" ::: "memory");
}

struct Args { const float* in[16]; float* out; unsigned char* ws; int ph_lo, ph_hi; };
__device__ __forceinline__ int crow(int r, int hi) { return (r & 3) + 8 * (r >> 2) + 4 * hi; }
__device__ __forceinline__ s16x4 vtr(const LAS char* p) { typedef short v4i16_t __attribute__((ext_vector_type(4))); return __builtin_bit_cast(s16x4, __builtin_amdgcn_ds_read_tr16_b64_v4i16((LAS v4i16_t*)p)); }

__device__ __forceinline__ void glds16s(const void* sbase, unsigned voff, unsigned lds_dst) { unsigned keep;
    const unsigned long long sb = (unsigned long long)sbase;
    const unsigned lo = (unsigned)__builtin_amdgcn_readfirstlane((int)(unsigned)sb), hi = (unsigned)__builtin_amdgcn_readfirstlane((int)(unsigned)(sb >> 32));
    const unsigned long long sbu = ((unsigned long long)hi << 32) | lo;
    asm volatile("s_mov_b32 %0, m0\n\ts_mov_b32 m0, %3\n\ts_nop 4\n\tglobal_load_lds_dwordx4 %1, %2\n\ts_mov_b32 m0, %0" : "=&s"(keep) : "v"(voff), "s"(sbu), "s"(lds_dst) : "memory"); }
struct KTile { bf16x8 k[4]; };
struct VTile { v4u v[4]; };
__device__ __forceinline__ void load_k(KTile& T, const bf16* Kp, int row0, int r32, int hi) {
    const bf16* kr = Kp + (size_t)(row0 + r32) * HD + 8 * hi;
#pragma unroll
    for (int ks = 0; ks < 4; ++ks) T.k[ks] = *(const GAS bf16x8*)(kr + 16 * ks);
}
__device__ __forceinline__ void load_v(VTile& T, const bf16* Vp, int row0, int lane) {
#pragma unroll
    for (int i = 0; i < 4; ++i) { const int c = lane + 64 * i; T.v[i] = *(const GAS v4u*)(Vp + (size_t)(row0 + (c >> 3)) * HD + (c & 7) * 8); }
}
template <int TAU>
__device__ __forceinline__ void att_tile(const KTile& TK, const VTile& TV, const bf16x8 (&qf)[4], float& m, float& l, f32x16 (&o)[2], LAS char* vl, const LAS char* vrd, int lane, int r32, int hi) {
    f32x16 s = {};
#pragma unroll
    for (int ks = 0; ks < 4; ++ks) s = __builtin_amdgcn_mfma_f32_32x32x16_bf16(TK.k[ks], qf[ks], s, 0, 0, 0);
#pragma unroll
    for (int i = 0; i < 4; ++i) { const int c = lane + 64 * i, key = c >> 3, ch = c & 7; *(LAS v4u*)(vl + (ch >> 2) * 2048 + key * 64 + (ch & 3) * 16) = TV.v[i]; }
    if (TAU == 0) {
#pragma unroll
        for (int r = 0; r < 16; ++r) if (crow(r, hi) < r32) s[r] = -INFINITY;
    }
    if (TAU == 4) {
#pragma unroll
        for (int r = 0; r < 16; ++r) if (crow(r, hi) > r32) s[r] = -INFINITY;
    }
    float tm = fmaxf(fmaxf(s[0], s[1]), s[2]);
#pragma unroll
    for (int r = 3; r < 15; r += 2) tm = fmaxf(fmaxf(tm, s[r]), s[r + 1]);
    tm = fmaxf(tm, s[15]);
    tm = fmaxf(tm, __shfl_xor(tm, 32));
    if (__any(tm > m)) {
        const float mn = fmaxf(m, tm), al = __builtin_amdgcn_exp2f(m - mn);
        l *= al; o[0] = o[0] * al; o[1] = o[1] * al; m = mn;
    }
    float ps = 0.f;
#pragma unroll
    for (int r = 0; r < 16; ++r) { s[r] = __builtin_amdgcn_exp2f(s[r] - m); ps += s[r]; }
    l += ps;
    v4u pw0, pw1;
    pw0.x = cvt_pk_bf16(s[0], s[1]); pw0.y = cvt_pk_bf16(s[2], s[3]); pw0.z = cvt_pk_bf16(s[4], s[5]); pw0.w = cvt_pk_bf16(s[6], s[7]);
    pw1.x = cvt_pk_bf16(s[8], s[9]); pw1.y = cvt_pk_bf16(s[10], s[11]); pw1.z = cvt_pk_bf16(s[12], s[13]); pw1.w = cvt_pk_bf16(s[14], s[15]);
    const bf16x8 pf0 = __builtin_bit_cast(bf16x8, pw0), pf1 = __builtin_bit_cast(bf16x8, pw1);
    LDS_WAIT(); asm volatile("" ::: "memory");
#pragma unroll
    for (int d0 = 0; d0 < 2; ++d0) {
        const s16x4 a0 = vtr(vrd + d0 * 2048), a1 = vtr(vrd + d0 * 2048 + 512), a2 = vtr(vrd + d0 * 2048 + 1024), a3 = vtr(vrd + d0 * 2048 + 1536);
        const bf16x8 vf0 = (bf16x8){a0[0], a0[1], a0[2], a0[3], a1[0], a1[1], a1[2], a1[3]};
        const bf16x8 vf1 = (bf16x8){a2[0], a2[1], a2[2], a2[3], a3[0], a3[1], a3[2], a3[3]};
        o[d0] = __builtin_amdgcn_mfma_f32_32x32x16_bf16(vf0, pf0, o[d0], 0, 0, 0);
        o[d0] = __builtin_amdgcn_mfma_f32_32x32x16_bf16(vf1, pf1, o[d0], 0, 0, 0);
    }
    asm volatile("" ::: "memory");
}

__global__ void __launch_bounds__(NWAVES * 64, 2) mega_fwd(Args args) {
    extern __shared__ __attribute__((aligned(16))) unsigned char lds_raw[];
    LAS unsigned char* lds = (LAS unsigned char*)lds_raw;
    const int tid = threadIdx.x, lane = tid & 63, wave = __builtin_amdgcn_readfirstlane(tid >> 6);
    const int G = gridDim.x; const int bx = blockIdx.x; const int vcu = (G % 8 == 0) ? (bx % 8) * (G / 8) + bx / 8 : bx;
    unsigned char* ws = args.ws;
    const float* x = args.in[0]; const float* cvec = args.in[1]; const float* w_ada = args.in[2]; const float* b_ada = args.in[3]; const float* norm_w = args.in[4];
    const float* w_in = args.in[5]; const float* b_gate = args.in[6]; const float* q_norm_w = args.in[7]; const float* k_norm_w = args.in[8]; const float* w_attn_proj = args.in[9];
    const float* conv_w = args.in[10]; const float* conv_b = args.in[11]; const float* conv_ln_w = args.in[12]; const float* conv_ln_b = args.in[13];
    const float* w_conv_proj = args.in[14]; const float* w_out = args.in[15];
    float* out = args.out;
    float* ADA = (float*)(ws + WS_ADA);
    bf16* WIN = (bf16*)(ws + WS_WIN); bf16* W2 = (bf16*)(ws + WS_WA); bf16* WO = (bf16*)(ws + WS_WO);
    float* LSE = (float*)(ws + WS_LSE);
    bf16* HB = (bf16*)(ws + WS_H); bf16* A2 = (bf16*)(ws + WS_A2A);
    bf16* QB = (bf16*)(ws + WS_Q); bf16* KB = (bf16*)(ws + WS_K); bf16* VB = (bf16*)(ws + WS_V);
    bf16* MG = (bf16*)(ws + WS_MG);
    bf16* ZA = (bf16*)(ws + WS_ZA); bf16* GLU = (bf16*)(ws + WS_GLU); bf16* ZC = (bf16*)(ws + WS_ZC);
    bf16* SG = (bf16*)out;

    if (tid < 32) ((LAS unsigned*)(lds + MISC_OFF))[tid] = 0u;
    __syncthreads();
    XcdBarrier bar = xcd_barrier_post((unsigned*)(ws + WS_CTL) + 4096, (volatile LAS unsigned*)(lds + MISC_OFF) + 8);
#define GRID_BAR(k) xcd_barrier(bar)
    const int lo = args.ph_lo, hi_ph = args.ph_hi;
#define IN(k) (lo <= (k) && (k) < hi_ph)
#define BOTH(k) (IN(k) && IN((k) + 1))
    const int gw = vcu * NWAVES + wave, NGW = G * NWAVES;

    if (IN(0)) {
        {
            LAS float* sc = (LAS float*)lds; LAS float* part = (LAS float*)(lds + 32768);
            if (bx < ADA_N / 64) {
                for (int i = tid; i < BATCH * DM; i += NWAVES * 64) { const float v = cvec[i]; sc[i] = v * sigmoidf_(v); }
                __syncthreads();
                for (int item = bx; item < ADA_N / 64; item += G) {
                    const int j = item * 64 + lane; float a[BATCH];
#pragma unroll
                    for (int b = 0; b < BATCH; ++b) a[b] = 0.f;
#pragma unroll 16
                    for (int kk = 0; kk < 128; ++kk) { const int k = wave * 128 + kk; const float w = __builtin_nontemporal_load(w_ada + (size_t)k * ADA_N + j);
#pragma unroll
                        for (int b = 0; b < BATCH; ++b) a[b] += sc[b * DM + k] * w; }
#pragma unroll
                    for (int b = 0; b < BATCH; ++b) part[(wave * BATCH + b) * 64 + lane] = a[b];
                    __syncthreads();
                    { float s = b_ada[j];
#pragma unroll
                      for (int w = 0; w < NWAVES; ++w) s += part[(w * BATCH + wave) * 64 + lane];
                      ADA[(size_t)wave * ADA_N + j] = s; }
                    __syncthreads();
                }
            }
        }
        if (bx >= ADA_N / 64 || G <= ADA_N / 64) {
            LAS float* scr = (LAS float*)(lds + RING_OFF + wave * 16384);
            constexpr int I_IN = (DM / 64) * (NIN / 32), I_A = (CW / 64) * (DM / 32), I_O = (DM / 64) * (DM / 32);
            constexpr int NITEMS = I_IN + 2 * I_A + I_O;
            const int nsk = G > ADA_N / 64 ? ADA_N / 64 : 0;
            for (int it = (bx - nsk) * NWAVES + wave; it < NITEMS; it += (G - nsk) * NWAVES) {
                int r = it;
                if (r < I_IN) { p0_transpose_item<true>(w_in, DM, NIN, WIN, scr, r, lane); continue; } r -= I_IN;
                if (r < I_A) { p0_transpose_item<false>(w_attn_proj, CW, DM, W2, scr, r, lane, DM); continue; } r -= I_A;
                if (r < I_A) { p0_transpose_item<false>(w_conv_proj, CW, DM, W2 + CW, scr, r, lane, DM); continue; } r -= I_A;
                p0_transpose_item<false>(w_out, DM, DM, WO, scr, r, lane);
            }
        }
        if (BOTH(0)) GRID_BAR(0);
    }

    if (IN(1)) {
        for (int rb = gw; rb < M / 16; rb += NGW) {
            const int row0 = rb * 16, b = row0 >> 12;
            f32x4 gm[4], ga[4];
#pragma unroll
            for (int j = 0; j < 4; ++j) { const int c = 4 * lane + 256 * j;
                const f32x4 nw = *(const f32x4*)(norm_w + c), sc = *(const f32x4*)(ADA + (size_t)b * ADA_N + DM + c);
                gm[j] = nw * (sc + 1.0f); ga[j] = *(const f32x4*)(ADA + (size_t)b * ADA_N + c); }
            for (int r = 0; r < 16; ++r) {
                const GAS f32x4* xr = (const GAS f32x4*)(x + (size_t)(row0 + r) * DM) + lane;
                f32x4 v[4]; float s2 = 0.f;
#pragma unroll
                for (int j = 0; j < 4; ++j) { v[j] = __builtin_nontemporal_load(xr + 64 * j); s2 += (v[j].x * v[j].x + v[j].y * v[j].y) + (v[j].z * v[j].z + v[j].w * v[j].w); }
                const float rstd = __builtin_amdgcn_rsqf(wave_sum(s2) * (1.f / DM) + pg8::NORM_EPS);
                GAS v2u* o8 = (GAS v2u*)(HB + (size_t)(row0 + r) * DM) + lane;
#pragma unroll
                for (int j = 0; j < 4; ++j) { const f32x4 y = v[j] * rstd * gm[j] + ga[j]; v2u w; w.x = cvt_pk_bf16(y.x, y.y); w.y = cvt_pk_bf16(y.z, y.w); o8[64 * j] = w; }
            }
        }
        if (BOTH(1)) GRID_BAR(1);
    }

    if (IN(2)) {
        pg8::Gemm g{HB, WIN, M, NIN, DM}; pg8::StaticOrder S; S.init(M, NIN, G, bx);
        pg8::EpiIn E{QB, (WS_K - WS_Q) / 2, ZA, (WS_ZC - WS_ZA) / 2, GLU, (unsigned char*)SG, q_norm_w, k_norm_w, b_gate, lds + RING_OFF + RING_BYTES + wave * 2048};
        pg8::gemm_phase<pg8::EpiIn, pg8::StaticOrder, true, true>(lds + RING_OFF, g, S, E);
        if (BOTH(2)) GRID_BAR(2);
    }

    if (IN(3)) {
        {
            LAS unsigned* in32 = (LAS unsigned*)lds;
            LAS float* ot = (LAS float*)(lds + 65536);
            const int cp = tid & 255, th = tid >> 8;
            float w0[CK], w1[CK];
#pragma unroll
            for (int j = 0; j < CK; ++j) { const f32x2 w = *(const f32x2*)(conv_w + j * CW + 2 * cp); w0[j] = w.x; w1[j] = w.y; }
            const f32x2 cb = *(const f32x2*)(conv_b + 2 * cp);
            v4u pf[8];
#define CONV_FETCH(TILE) { const int b_ = (TILE) >> 7, t0_ = ((TILE) & 127) * 32; \
                _Pragma("unroll") for (int i = 0; i < 8; ++i) { int c = tid + 512 * i; c = c < 62 * 64 ? c : 62 * 64 - 1; const int r = c >> 6, ch = c & 63, t = t0_ - 30 + r; \
                    v4u val = *(const GAS v4u*)(GLU + ((size_t)b_ * SEQ + (t < 0 ? 0 : t)) * CW + ch * 8); if (t < 0) val = (v4u){0u, 0u, 0u, 0u}; pf[i] = val; } }
            if (bx < M / 32) CONV_FETCH(bx)
            for (int tile = bx; tile < M / 32; tile += G) {
                const int b = tile >> 7, t0 = (tile & 127) * 32; const size_t row0 = (size_t)b * SEQ + t0;
#pragma unroll
                for (int i = 0; i < 8; ++i) { const int c = tid + 512 * i; if (c < 62 * 64) *(LAS v4u*)(lds + (size_t)c * 16) = pf[i]; }
                v4u zc[4];
#pragma unroll
                for (int q = 0; q < 4; ++q) zc[q] = *(const GAS v4u*)(ZC + (row0 + wave + 8 * q) * CW + lane * 8);
                __syncthreads();
                { const int nt_ = tile + G < M / 32 ? tile + G : tile; CONV_FETCH(nt_) }
                unsigned xs[46];
#pragma unroll
                for (int i = 0; i < 46; ++i) xs[i] = in32[(th * 16 + i) * 256 + cp];
#pragma unroll
                for (int tl = 0; tl < 16; ++tl) { float a0 = cb.x, a1 = cb.y;
#pragma unroll
                    for (int j = 0; j < CK; ++j) { const unsigned xv = xs[tl + j]; a0 += w0[j] * bf_lo(xv); a1 += w1[j] * bf_hi(xv); }
                    *(LAS f32x2*)(ot + (th * 16 + tl) * CW + 2 * cp) = (f32x2){a0, a1}; }
                __syncthreads();
                {
                    const f32x4 lw0 = *(const f32x4*)(conv_ln_w + lane * 8), lw1 = *(const f32x4*)(conv_ln_w + lane * 8 + 4);
                    const f32x4 lb0 = *(const f32x4*)(conv_ln_b + lane * 8), lb1 = *(const f32x4*)(conv_ln_b + lane * 8 + 4);
#pragma unroll
                    for (int q = 0; q < 4; ++q) { const int tl = wave + 8 * q;
                        f32x4 v0 = *(const LAS f32x4*)(ot + tl * CW + lane * 8), v1 = *(const LAS f32x4*)(ot + tl * CW + lane * 8 + 4);
                        const float mean = wave_sum((v0.x + v0.y) + (v0.z + v0.w) + (v1.x + v1.y) + (v1.z + v1.w)) * (1.f / CW);
                        v0 = v0 - mean; v1 = v1 - mean;
                        const float var = wave_sum((v0.x * v0.x + v0.y * v0.y) + (v0.z * v0.z + v0.w * v0.w) + (v1.x * v1.x + v1.y * v1.y) + (v1.z * v1.z + v1.w * v1.w)) * (1.f / CW);
                        const float rstd = __builtin_amdgcn_rsqf(var + pg8::NORM_EPS);
                        v0 = v0 * rstd * lw0 + lb0; v1 = v1 * rstd * lw1 + lb1;
                        const v4u zq = zc[q];
                        const float z[8] = {bf_lo(zq.x), bf_hi(zq.x), bf_lo(zq.y), bf_hi(zq.y), bf_lo(zq.z), bf_hi(zq.z), bf_lo(zq.w), bf_hi(zq.w)};
#pragma unroll
                        for (int i = 0; i < 1; ++i) { v0 = pg8::gated4(v0, v0) * (f32x4){z[0], z[1], z[2], z[3]}; v1 = pg8::gated4(v1, v1) * (f32x4){z[4], z[5], z[6], z[7]}; }
                        *(GAS v4u*)(A2 + (row0 + tl) * DM + CW + lane * 8) = pg8::pack8(v0, v1); }
                }
                __syncthreads();
            }
#undef CONV_FETCH
        }
        {
            const int r32 = lane & 31, hi = lane >> 5;
            const int vrd_off = (4 * hi + ((lane & 15) >> 2)) * 64 + ((lane >> 4) & 1) * 32 + (lane & 3) * 8;
            const int piece = wave & 3, tsel = wave >> 2;
            bf16* PB = (bf16*)(ws + WS_PB); float* PL = (float*)(ws + WS_LSE);
            const unsigned lds0 = (unsigned)(uintptr_t)lds_raw;
            const unsigned voffK = (unsigned)(((8 * piece + (lane >> 3)) * HD + (((lane & 7) ^ (((8 * piece + (lane >> 3)) >> 1) & 7)) << 3)) * 2);
            const unsigned voffV = (unsigned)(((16 * (piece & 1) + (lane >> 2)) * HD + (piece >> 1) * 32 + (lane & 3) * 8) * 2);
#define XT_CONST int xln_ = lane; asm volatile("" : "+v"(xln_)); const int xl_r = xln_ >> 3, xc0 = (xln_ & 7) ^ (xln_ >> 4);     \
            const unsigned xb_off = (unsigned)(xl_r * 128 + (xln_ & 7) * 16), xa_off = (unsigned)((xln_ & 31) * 128), xa_f = (unsigned)(((xln_ & 31) >> 1) & 7);
#define XT_B(T, I) (*(LAS v4u*)((T) + xb_off + (I) * 1024))
#define XT_A(T, CH) (*(LAS v4u*)((T) + xa_off + ((((unsigned)(CH)) ^ xa_f) << 4)))
#define ATT_BAR() do { asm volatile("s_waitcnt lgkmcnt(0)" ::: "memory"); __builtin_amdgcn_s_barrier(); asm volatile("" ::: "memory"); } while (0)
#define ATT_DMA(ISV, SRC, RROW, JSB, NT, LDSOFF, FORCE) do { \
                _Pragma("unroll") for (int m_ = 0; m_ < 6; ++m_) { const int kt_ = 2 * m_ + tsel; const int js_ = (JSB) + 32 * kt_; \
                    if (m_ < (NT) / 2 && ((FORCE) || js_ >= 0)) \
                        glds16s((SRC) + ((size_t)(RROW) + (js_ < 0 ? 0 : js_)) * HD, ISV ? voffV : voffK, (unsigned)__builtin_amdgcn_readfirstlane((int)(lds0 + (LDSOFF) + kt_ * 4096 + piece * 1024))); } } while (0)
#define ATT_MID_HOOK
#define ATT_ROUND_(FAST, G_, RROW, IU0, JB, KTB, KBUF, TSH, TOK0, PBO, PBL, MROW0, NKN, QNP, QNROW) do { \
                    const int iq = (IU0) + r32; const int tq = (iq << (TSH)) + (TOK0); \
                    f32x16 S[5]; \
                    _Pragma("unroll") for (int tau = 0; tau < 5; ++tau) { \
                        if ((FAST) || (JB) + 32 * tau >= 0) { \
                            const LAS char* kp = (const LAS char*)(lds + (KBUF) + ((KTB) + tau) * 4096 + r32 * 128); \
                            bf16x8 kf[4]; \
                            _Pragma("unroll") for (int ks = 0; ks < 4; ++ks) kf[ks] = *(const LAS bf16x8*)(kp + (((2 * ks + hi) ^ ((r32 >> 1) & 7)) << 4)); \
                            f32x16 sacc = {}; \
                            _Pragma("unroll") for (int ks = 0; ks < 4; ++ks) sacc = __builtin_amdgcn_mfma_f32_32x32x16_bf16(kf[ks], qf[ks], sacc, 0, 0, 0); \
                              \
                            if (tau == 0) { int rq = r32 - 4 * hi; asm volatile("" : "+v"(rq)); _Pragma("unroll") for (int r = 0; r < 16; ++r) if ((r & 3) + 8 * (r >> 2) < rq) sacc[r] = -INFINITY; } \
                            if (tau == 4) { int rq = r32 - 4 * hi; asm volatile("" : "+v"(rq)); _Pragma("unroll") for (int r = 0; r < 16; ++r) if ((r & 3) + 8 * (r >> 2) > rq) sacc[r] = -INFINITY; } \
                            S[tau] = sacc; \
                        } else { _Pragma("unroll") for (int r = 0; r < 16; ++r) S[tau][r] = -INFINITY; } } \
                    float mx = -INFINITY; \
                    _Pragma("unroll") for (int tau = 0; tau < 5; ++tau) _Pragma("unroll") for (int r = 0; r < 16; r += 2) mx = fmaxf(fmaxf(mx, S[tau][r]), S[tau][r + 1]); \
                    { const auto sw_ = __builtin_amdgcn_permlane32_swap(__float_as_uint(mx), __float_as_uint(mx), false, false); mx = fmaxf(__uint_as_float(sw_[0]), __uint_as_float(sw_[1])); } \
                    float l = 0.f; v4u P[5][2]; \
                    _Pragma("unroll") for (int tau = 0; tau < 5; ++tau) { f32x16 p = S[tau]; float ps = 0.f; \
                        _Pragma("unroll") for (int r = 0; r < 16; ++r) { p[r] = __builtin_amdgcn_exp2f(p[r] - mx); ps += p[r]; } \
                        l += ps; \
                        P[tau][0].x = cvt_pk_bf16(p[0], p[1]); P[tau][0].y = cvt_pk_bf16(p[2], p[3]); P[tau][0].z = cvt_pk_bf16(p[4], p[5]); P[tau][0].w = cvt_pk_bf16(p[6], p[7]); \
                        P[tau][1].x = cvt_pk_bf16(p[8], p[9]); P[tau][1].y = cvt_pk_bf16(p[10], p[11]); P[tau][1].z = cvt_pk_bf16(p[12], p[13]); P[tau][1].w = cvt_pk_bf16(p[14], p[15]); } \
                    { const auto sw_ = __builtin_amdgcn_permlane32_swap(__float_as_uint(l), __float_as_uint(l), false, false); l = __uint_as_float(sw_[0]) + __uint_as_float(sw_[1]); } \
                    asm volatile("s_waitcnt vmcnt(" #NKN ")" ::: "memory"); ATT_BAR();     \
                    ATT_MID_HOOK \
                    XT_CONST LAS char* const xt = (LAS char*)(lds + (KBUF) + wave * 4096); \
                    ATT_LOAD_Q(qn, QNP, QNROW); \
                    if ((G_) < 2) ATT_LOAD_P(PBO, PBL, tq, IU0, TSH, TOK0); \
                    f32x16 o[2]; o[0] = f32x16{}; o[1] = f32x16{}; \
                    _Pragma("unroll") for (int tau = 0; tau < 5; ++tau) { \
                        if ((FAST) || (JB) + 32 * tau >= 0) { \
                            const LAS char* vp = (const LAS char*)(lds + ATT_V + ((KTB) + tau) * 4096 + vrd_off); \
                            const bf16x8 pf0 = __builtin_bit_cast(bf16x8, P[tau][0]), pf1 = __builtin_bit_cast(bf16x8, P[tau][1]); \
                            _Pragma("unroll") for (int d0 = 0; d0 < 2; ++d0) { \
                                const s16x4 a0 = vtr(vp + d0 * 2048), a1 = vtr(vp + d0 * 2048 + 512), a2 = vtr(vp + d0 * 2048 + 1024), a3 = vtr(vp + d0 * 2048 + 1536); \
                                const bf16x8 vf0 = (bf16x8){a0[0], a0[1], a0[2], a0[3], a1[0], a1[1], a1[2], a1[3]}; \
                                const bf16x8 vf1 = (bf16x8){a2[0], a2[1], a2[2], a2[3], a3[0], a3[1], a3[2], a3[3]}; \
                                o[d0] = __builtin_amdgcn_mfma_f32_32x32x16_bf16(vf0, pf0, o[d0], 0, 0, 0); \
                                o[d0] = __builtin_amdgcn_mfma_f32_32x32x16_bf16(vf1, pf1, o[d0], 0, 0, 0); } } } \
                    float lse = mx + __builtin_amdgcn_logf(l), sc_own = __builtin_amdgcn_rcpf(l), sc_p = 0.f; \
                    if ((G_) < 2) { const float mx2 = fmaxf(lse, plse), a = __builtin_amdgcn_exp2f(lse - mx2), bq = __builtin_amdgcn_exp2f(plse - mx2), inv = __builtin_amdgcn_rcpf(a + bq); \
                        sc_own = sc_own * a * inv; sc_p = bq * inv; lse = mx2 + __builtin_amdgcn_logf(a + bq); } \
                      \
                    if ((G_) < 2) { _Pragma("unroll") for (int i = 0; i < 4; ++i) XT_B(xt, i) = pq[i]; _Pragma("unroll") for (int c = 0; c < 4; ++c) pq[c] = XT_A(xt, 2 * c + hi); } \
                    if ((G_) < 2) { _Pragma("unroll") for (int c = 0; c < 4; ++c) { const auto rx = __builtin_amdgcn_permlane32_swap(pq[c].x, pq[c].z, false, false); const auto ry = __builtin_amdgcn_permlane32_swap(pq[c].y, pq[c].w, false, false); \
                        pp[2 * c] = (v2u){rx[0], ry[0]}; pp[2 * c + 1] = (v2u){rx[1], ry[1]}; } } \
                    if ((G_) > 0) { \
                        _Pragma("unroll") for (int d0 = 0; d0 < 2; ++d0) _Pragma("unroll") for (int j = 0; j < 2; ++j) { v2u w[2]; \
                            _Pragma("unroll") for (int q = 0; q < 2; ++q) { const int rg = 2 * j + q; \
                                float e0 = o[d0][4 * rg] * sc_own, e1 = o[d0][4 * rg + 1] * sc_own, e2 = o[d0][4 * rg + 2] * sc_own, e3 = o[d0][4 * rg + 3] * sc_own; \
                                if ((G_) < 2) { const v2u pw = pp[d0 * 4 + rg]; e0 += sc_p * bf_lo(pw.x); e1 += sc_p * bf_hi(pw.x); e2 += sc_p * bf_lo(pw.y); e3 += sc_p * bf_hi(pw.y); } \
                                w[q].x = cvt_pk_bf16(e0, e1); w[q].y = cvt_pk_bf16(e2, e3); } \
                            const auto rx = __builtin_amdgcn_permlane32_swap(w[0].x, w[1].x, false, false); const auto ry = __builtin_amdgcn_permlane32_swap(w[0].y, w[1].y, false, false); \
                            XT_A(xt, 2 * (d0 * 2 + j) + hi) = (v4u){rx[0], ry[0], rx[1], ry[1]}; } \
                        _Pragma("unroll") for (int i = 0; i < 4; ++i) *(GAS v4u*)((PBO) + (size_t)((((IU0) + xl_r + 8 * i) << (TSH)) + (TOK0)) * HD + 8 * (xc0 ^ (4 * (i & 1)))) = XT_B(xt, i); \
                        if (hi == 0) (PBL)[tq] = lse; \
                    } else { \
                        const size_t mrow = (size_t)(MROW0) + tq; \
                        v4u zq[4]; v2u zz[8]; \
                        _Pragma("unroll") for (int i = 0; i < 4; ++i) zq[i] = *(const GAS v4u*)(ZA + ((size_t)(MROW0) + ((((IU0) + xl_r + 8 * i) << (TSH)) + (TOK0))) * CW + h * 64 + 8 * (xc0 ^ (4 * (i & 1)))); \
                        _Pragma("unroll") for (int i = 0; i < 4; ++i) XT_B(xt, i) = zq[i]; _Pragma("unroll") for (int c = 0; c < 4; ++c) zq[c] = XT_A(xt, 2 * c + hi); \
                        _Pragma("unroll") for (int c = 0; c < 4; ++c) { const auto rx = __builtin_amdgcn_permlane32_swap(zq[c].x, zq[c].z, false, false); const auto ry = __builtin_amdgcn_permlane32_swap(zq[c].y, zq[c].w, false, false); \
                            zz[2 * c] = (v2u){rx[0], ry[0]}; zz[2 * c + 1] = (v2u){rx[1], ry[1]}; } \
                        _Pragma("unroll") for (int d0 = 0; d0 < 2; ++d0) _Pragma("unroll") for (int j = 0; j < 2; ++j) { v2u w[2]; \
                            _Pragma("unroll") for (int q = 0; q < 2; ++q) { const int rg = 2 * j + q; const v2u pw = pp[d0 * 4 + rg]; const v2u zw = zz[d0 * 4 + rg]; \
                                const float e0 = (o[d0][4 * rg] * sc_own + sc_p * bf_lo(pw.x)) * bf_lo(zw.x), e1 = (o[d0][4 * rg + 1] * sc_own + sc_p * bf_hi(pw.x)) * bf_hi(zw.x); \
                                const float e2 = (o[d0][4 * rg + 2] * sc_own + sc_p * bf_lo(pw.y)) * bf_lo(zw.y), e3 = (o[d0][4 * rg + 3] * sc_own + sc_p * bf_hi(pw.y)) * bf_hi(zw.y); \
                                w[q].x = cvt_pk_bf16(e0, e1); w[q].y = cvt_pk_bf16(e2, e3); } \
                            const auto rx = __builtin_amdgcn_permlane32_swap(w[0].x, w[1].x, false, false); const auto ry = __builtin_amdgcn_permlane32_swap(w[0].y, w[1].y, false, false); \
                            XT_A(xt, 2 * (d0 * 2 + j) + hi) = (v4u){rx[0], ry[0], rx[1], ry[1]}; } \
                        _Pragma("unroll") for (int i = 0; i < 4; ++i) *(GAS v4u*)(A2 + ((size_t)(MROW0) + ((((IU0) + xl_r + 8 * i) << (TSH)) + (TOK0))) * DM + h * 64 + 8 * (xc0 ^ (4 * (i & 1)))) = XT_B(xt, i); } \
                    ATT_XCH_Q(xt); \
                } while (0)
#define ATT_ROUND(...) ATT_ROUND_(0, __VA_ARGS__)
#define ATT_LOAD_Q(DST, QP, ROW0) do { _Pragma("unroll") for (int i = 0; i < 4; ++i) DST[i] = *(const GAS v4u*)((QP) + (size_t)((ROW0) + xl_r + 8 * i) * HD + 8 * (xc0 ^ (4 * (i & 1)))); } while (0)
#define ATT_XCH_Q(T) do { _Pragma("unroll") for (int i = 0; i < 4; ++i) XT_B(T, i) = qn[i]; _Pragma("unroll") for (int ks = 0; ks < 4; ++ks) qf[ks] = __builtin_bit_cast(bf16x8, XT_A(T, 2 * ks + hi)); } while (0)
#define ATT_LOAD_P(PBO, PBL, TQ, IU0, TSH, TOK0) do { _Pragma("unroll") for (int i = 0; i < 4; ++i) pq[i] = *(const GAS v4u*)((PBO) + (size_t)((((IU0) + xl_r + 8 * i) << (TSH)) + (TOK0)) * HD + 8 * (xc0 ^ (4 * (i & 1)))); \
                plse = (PBL)[TQ]; } while (0)
            bf16x8 qf[4]; v4u qn[4], pq[4]; v2u pp[8]; float plse;
            {
                const int NCH = BATCH * HPG * 16;
                if (vcu < NCH) { const int bh = vcu >> 4, res = vcu & 15; const size_t base = (size_t)(((bh >> 3) * 3 + 2) * 8 + (bh & 7)) * SEQ * HD;
                    { XT_CONST ATT_LOAD_Q(qn, QB + base, res * 256 + 32 * wave); ATT_XCH_Q((LAS char*)(lds + ATT_K1 + wave * 4096)); }
                    asm volatile("s_waitcnt vmcnt(0)" ::: "memory"); ATT_BAR();
                    ATT_DMA(false, KB + base, res * 256, 0, 8, ATT_K0, false); }
                int kpar = 0;
                for (int ch = vcu; ch < NCH; ch += G, kpar ^= 1) {
                    const int bh = ch >> 4, res = ch & 15, b = bh >> 3, h = bh & 7; const size_t base = (size_t)((b * 3 + 2) * 8 + h) * SEQ * HD;
                    const int chn = ch + G < NCH ? ch + G : ch, bhn = chn >> 4, resn = chn & 15; const size_t basen = (size_t)(((bhn >> 3) * 3 + 2) * 8 + (bhn & 7)) * SEQ * HD;
                    const int kbuf = kpar ? ATT_K1 : ATT_K0, knext = kpar ? ATT_K0 : ATT_K1;
                    if (ch == vcu) asm volatile("s_waitcnt vmcnt(0)" ::: "memory");
                    asm volatile("" : "+v"(qf[0]), "+v"(qf[1]), "+v"(qf[2]), "+v"(qf[3]));
                    ATT_BAR();
                    ATT_DMA(true, VB + base, res * 256, 0, 8, ATT_V, false);
                    if (ch + G < NCH) { ATT_DMA(false, KB + basen, resn * 256, 0, 8, knext, true);
                        if (wave >= 4) { ATT_ROUND_(1, 2, res * 256, 32 * wave, 32 * wave - 128, wave - 4, kbuf, 4, res, PB + (size_t)bh * SEQ * HD, PL + (size_t)bh * SEQ, 0, 4, QB + basen, resn * 256 + 32 * wave); }
                        else { ATT_ROUND(2, res * 256, 32 * wave, 32 * wave - 128, wave - 4, kbuf, 4, res, PB + (size_t)bh * SEQ * HD, PL + (size_t)bh * SEQ, 0, 4, QB + basen, resn * 256 + 32 * wave); } }
                    else { ATT_ROUND(2, res * 256, 32 * wave, 32 * wave - 128, wave - 4, kbuf, 4, res, PB + (size_t)bh * SEQ * HD, PL + (size_t)bh * SEQ, 0, 0, QB + basen, resn * 256 + 32 * wave); }
                }
                asm volatile("s_waitcnt vmcnt(0)" ::: "memory"); ATT_BAR();
            }
            GRID_BAR(6);
            for (int item = vcu; item < BATCH * HPG * 4; item += G) {
                const int span = item & 3, h = (item >> 2) & 7, b = item >> 5, bh = b * 8 + h;
                bf16* pbo = PB + (size_t)bh * SEQ * HD; float* pbl = PL + (size_t)bh * SEQ;
                const size_t base1 = (size_t)((b * 3 + 1) * 8 + h) * SEQ * HD, base0 = (size_t)((b * 3 + 0) * 8 + h) * SEQ * HD;
#define ITEM_RND(RD, G_, BASE_, RROW_, QB0_, TSH_, TOK0_) const int G_ = (RD) < 4 ? 1 : 0; const size_t BASE_ = (RD) < 4 ? base1 : base0; \
                const int RROW_ = (RD) < 4 ? (RD) * 1024 : 0, QB0_ = (RD) < 4 ? (span << 8) : (span << 10) + (((RD) - 4) << 8), TSH_ = (RD) < 4 ? 2 : 0, TOK0_ = (RD) < 4 ? (RD) : 0;
                { ITEM_RND(0, g_, base_, rrow_, qb0_, tsh_, tok0_)
                  { XT_CONST ATT_LOAD_Q(qn, QB + base_, rrow_ + qb0_ + 32 * wave); ATT_XCH_Q((LAS char*)(lds + ATT_K1 + wave * 4096)); }
                  asm volatile("s_waitcnt vmcnt(0)" ::: "memory"); ATT_BAR();
                  ATT_DMA(false, KB + base_, rrow_, qb0_ - 128, 12, ATT_K0, false); }
                for (int rd = 0; rd < 8; ++rd) {
                    ITEM_RND(rd, g, base, rrow, qb0, tsh, tok0)
                    const int rdn = rd + 1 < 8 ? rd + 1 : rd; ITEM_RND(rdn, gn, basen, rrown, qb0n, tshn, tok0n)
                    const int kbuf = (rd & 1) ? ATT_K1 : ATT_K0, knext = (rd & 1) ? ATT_K0 : ATT_K1;
                    if (rd == 0 || rd == 4) asm volatile("s_waitcnt vmcnt(0)" ::: "memory");
                    asm volatile("" : "+v"(qf[0]), "+v"(qf[1]), "+v"(qf[2]), "+v"(qf[3]));
                    ATT_BAR();
                    ATT_DMA(true, VB + base, rrow, qb0 - 128, 12, ATT_V, false);
                    if (rd + 1 < 8) {
#undef ATT_MID_HOOK
#define ATT_MID_HOOK ATT_DMA(false, KB + basen, rrown, qb0n - 128, 12, knext, true);
                        if (qb0 + 32 * wave - 128 >= 0) { ATT_ROUND_(1, g, rrow, qb0 + 32 * wave, qb0 + 32 * wave - 128, wave, kbuf, tsh, tok0, pbo, pbl, (size_t)b * SEQ, 0, QB + basen, rrown + qb0n + 32 * wave); }
                        else { ATT_ROUND(g, rrow, qb0 + 32 * wave, qb0 + 32 * wave - 128, wave, kbuf, tsh, tok0, pbo, pbl, (size_t)b * SEQ, 0, QB + basen, rrown + qb0n + 32 * wave); }
#undef ATT_MID_HOOK
#define ATT_MID_HOOK
                    }
                    else { ATT_ROUND(g, rrow, qb0 + 32 * wave, qb0 + 32 * wave - 128, wave, kbuf, tsh, tok0, pbo, pbl, (size_t)b * SEQ, 0, QB + basen, rrown + qb0n + 32 * wave); }
                }
#undef ITEM_RND
            }
            asm volatile("s_waitcnt vmcnt(0)" ::: "memory"); ATT_BAR();
#undef ATT_BAR
#undef ATT_DMA
#undef ATT_ROUND
#undef ATT_ROUND_
#undef ATT_LOAD_Q
#undef ATT_XCH_Q
#undef XT_CONST
#undef XT_A
#undef XT_B
#undef ATT_LOAD_P
        }
        if (BOTH(3)) GRID_BAR(3);
    }

    if (IN(4)) {
        { pg8::Gemm g{A2, W2, M, DM, DM}; pg8::StaticOrder S; S.init(M, DM, G, bx);
          pg8::EpiMerge2 E{(const unsigned char*)SG, MG, lds + RING_OFF + RING_BYTES + wave * 2048};
          pg8::gemm_phase<pg8::EpiMerge2, pg8::StaticOrder, true, true>(lds + RING_OFF, g, S, E); }
        if (BOTH(4)) GRID_BAR(4);
    }

    if (IN(5)) {
        pg8::Gemm g{MG, WO, M, DM, DM}; pg8::StaticOrder S; S.init(M, DM, G, bx);
        pg8::EpiOut E{x, out, ADA, lds + RING_OFF + RING_BYTES + wave * 2048};
        pg8::gemm_phase<pg8::EpiOut, pg8::StaticOrder, true, true>(lds + RING_OFF, g, S, E);
    }
#undef IN
#undef BOTH
}

extern "C" void kernel_launch(void* const* d_in, const int* in_sizes, int n_in, void* d_out, int out_size, void* d_ws, size_t ws_size, hipStream_t stream) {
    static int grid = 0;
    if (grid == 0) {
        if (n_in != 16 || in_sizes[0] != M * DM || out_size != M * DM || ws_size < WS_END) { fprintf(stderr, "kernel_launch: unexpected shapes (n_in %d, in0 %d, out %d, ws %zu)\n", n_in, n_in > 0 ? in_sizes[0] : -1, out_size, ws_size); grid = -1; return; }
        int dev = 0, cus = 0, per_cu = 0;
        if (hipGetDevice(&dev) != hipSuccess || hipDeviceGetAttribute(&cus, hipDeviceAttributeMultiprocessorCount, dev) != hipSuccess) { grid = -1; return; }
        if (hipFuncSetAttribute((const void*)mega_fwd, hipFuncAttributeMaxDynamicSharedMemorySize, LDS_BYTES) != hipSuccess) { fprintf(stderr, "kernel_launch: hipFuncSetAttribute failed\n"); grid = -1; return; }
        if (hipOccupancyMaxActiveBlocksPerMultiprocessor(&per_cu, (const void*)mega_fwd, NWAVES * 64, LDS_BYTES) != hipSuccess || per_cu < 1) { fprintf(stderr, "kernel_launch: occupancy query says %d\n", per_cu); (void)hipGetLastError(); per_cu = 1; }
        if (per_cu > 1) per_cu = 1;
        grid = cus * per_cu;
    }
    if (grid < 0) return;
    (void)hipMemsetAsync((char*)d_ws + WS_CTL, 0, CTL_ZERO_BYTES, stream);
    Args a{};
    for (int i = 0; i < 16; ++i) a.in[i] = (const float*)d_in[i];
    a.out = (float*)d_out; a.ws = (unsigned char*)d_ws;
    a.ph_lo = 0; a.ph_hi = N_PHASES;
    hipLaunchKernelGGL(mega_fwd, dim3(grid), dim3(NWAVES * 64), LDS_BYTES, stream, a);
}
```
